# Optimizing an MI355X kernel written in HIP

```python
import math
import jax
import jax.numpy as jnp
from jax import lax
import numpy as np

D_MODEL = 1024
BATCH = 8
SEQ = 4096
DEPTH = 1

EPS = 1e-6
A_HEADS = 8
A_LAT = 128
A_VDIM = 64
IDX_HEADS = 4
IDX_DIM = 64
IDX_TOPK_MAX = 256
Q_BLOCK = 128
B_HEADS = 4
B_DIM = 128
CONV_W = 4
CHUNK = 64
PEER_HEADS = 8
PEER_NKEYS = 128
PEER_QDIM = 256
PEER_TOPK = 16
PEER_BLOCK = 128
N_EXPERTS = PEER_NKEYS * PEER_NKEYS

A_WIDTH = A_HEADS * A_VDIM
B_WIDTH = B_HEADS * B_DIM
MIX_WIDTH = A_WIDTH + B_WIDTH
IN_SPLITS = (A_HEADS * A_LAT, A_LAT, IDX_HEADS * IDX_DIM, IDX_DIM, IDX_HEADS,
             B_WIDTH, B_WIDTH, B_WIDTH, B_WIDTH, B_HEADS, B_HEADS)
IN_WIDTH = sum(IN_SPLITS)

kernel_name = 'hybrid_dsa_gdn_peer_adaln_layer'


def rms(x):
    xf = x.astype(jnp.float32)
    return xf * lax.rsqrt(jnp.mean(xf * xf, -1, keepdims=True) + EPS)


def l2n(x):
    return x * lax.rsqrt(jnp.sum(x * x, -1, keepdims=True) + EPS)


def modulate(xn, shift, scale):
    return xn * (1.0 + scale[:, None, :]) + shift[:, None, :]


def causal_dwconv(x, w):
    C = x.shape[-1]
    return lax.conv_general_dilated(
        x, w[:, None, :].astype(x.dtype), window_strides=(1,),
        padding=[(w.shape[0] - 1, 0)], dimension_numbers=('NWC', 'WIO', 'NWC'),
        feature_group_count=C)


def dsa_attention(q_lat, kv, iq, ik, iw, q_gain, k_gain, w_uv):
    B, S = kv.shape[:2]
    topk = min(IDX_TOPK_MAX, S // 4)
    q = rms(q_lat) * q_gain
    k = rms(kv) * k_gain
    slopes = jnp.exp2(-8.0 * jnp.arange(1, A_HEADS + 1, dtype=jnp.float32) / A_HEADS)
    nb = S // Q_BLOCK
    key_pos = jnp.arange(S)
    scale = A_LAT ** -0.5
    idx_scale = (IDX_DIM ** -0.5) * (IDX_HEADS ** -0.5)

    def blocks(a):
        return a.reshape((B, nb, Q_BLOCK) + a.shape[2:]).swapaxes(0, 1)

    def one_block(args):
        qb, iqb, iwb, start = args
        qpos = start + jnp.arange(Q_BLOCK)
        causal = key_pos[None, :] <= qpos[:, None]
        logits = jnp.einsum('bqhd,bsd->bqhs', iqb, ik)
        score = jnp.einsum('bqhs,bqh->bqs', jax.nn.relu(logits), iwb).astype(jnp.float32) * idx_scale
        score = jnp.where(causal[None], score, -jnp.inf)
        _, sel = lax.top_k(score, topk)
        kv_sel = jax.vmap(lambda kb, ib: kb[ib])(k, sel)
        s = jnp.einsum('bqhr,bqkr->bqhk', qb, kv_sel) * scale
        dist = (qpos[None, :, None] - sel).astype(jnp.float32)
        s = s - slopes[None, None, :, None] * dist[:, :, None, :]
        valid = (sel <= qpos[None, :, None])[:, :, None, :]
        p = jax.nn.softmax(jnp.where(valid, s, -jnp.inf), axis=-1)
        return jnp.einsum('bqhk,bqkr->bqhr', p, kv_sel)

    starts = jnp.arange(nb, dtype=jnp.int32) * Q_BLOCK
    o = lax.map(one_block, (blocks(q), blocks(iq), blocks(iw), starts))
    o = o.swapaxes(0, 1).reshape(B, S, A_HEADS, A_LAT)
    return jnp.einsum('bshr,hrv->bshv', o, w_uv).reshape(B, S, A_WIDTH)


def gated_deltanet(q, k, v, z, a, b, conv_w, a_log, dt_bias, norm_gain):
    B, S = q.shape[:2]
    qkv = jax.nn.silu(causal_dwconv(jnp.concatenate([q, k, v], -1), conv_w)).astype(jnp.float32)
    q, k, v = jnp.split(qkv, 3, axis=-1)

    def heads(t):
        return t.reshape(B, S, B_HEADS, B_DIM).transpose(0, 2, 1, 3)

    q = l2n(heads(q)) * (B_DIM ** -0.5)
    k = l2n(heads(k))
    v = heads(v)
    beta = jax.nn.sigmoid(b.astype(jnp.float32)).transpose(0, 2, 1)
    g = (-jnp.exp(a_log.astype(jnp.float32))
         * jax.nn.softplus(a.astype(jnp.float32) + dt_bias.astype(jnp.float32))).transpose(0, 2, 1)
    n = S // CHUNK

    def chunks(t):
        return t.reshape(t.shape[:2] + (n, CHUNK) + t.shape[3:])

    q, k, v, beta, g = (chunks(t) for t in (q, k, v, beta, g))
    G = jnp.cumsum(g, axis=-1)
    tril = jnp.tril(jnp.ones((CHUNK, CHUNK), bool))
    strict = jnp.tril(jnp.ones((CHUNK, CHUNK), bool), -1)
    decay = jnp.exp(jnp.where(tril, G[..., :, None] - G[..., None, :], -jnp.inf))
    kb = k * beta[..., None]
    Lmat = jnp.where(strict, jnp.einsum('bhnid,bhnjd->bhnij', kb, k) * decay, 0.0)
    eye = jnp.eye(CHUNK, dtype=jnp.float32)
    T = lax.linalg.triangular_solve(eye + Lmat, jnp.broadcast_to(eye, Lmat.shape),
                                    left_side=True, lower=True, unit_diagonal=True)
    u = T @ (v * beta[..., None])
    w = T @ (kb * jnp.exp(G)[..., None])
    attn_intra = jnp.einsum('bhnid,bhnjd->bhnij', q, k) * decay
    q_dec = q * jnp.exp(G)[..., None]
    k_dec = k * jnp.exp(G[..., -1:] - G)[..., None]
    g_last = jnp.exp(G[..., -1])

    def step(state, xs):
        u_c, w_c, a_c, qd_c, kd_c, gl_c = xs
        v_new = u_c - jnp.einsum('bhck,bhkv->bhcv', w_c, state)
        o = jnp.einsum('bhck,bhkv->bhcv', qd_c, state) + jnp.einsum('bhij,bhjv->bhiv', a_c, v_new)
        state = state * gl_c[..., None, None] + jnp.einsum('bhck,bhcv->bhkv', kd_c, v_new)
        return state, o

    xs = tuple(jnp.moveaxis(t, 2, 0) for t in (u, w, attn_intra, q_dec, k_dec, g_last))
    state0 = jnp.zeros((B, B_HEADS, B_DIM, B_DIM), jnp.float32)
    _, o = lax.scan(step, state0, xs)
    o = jnp.moveaxis(o, 0, 2).reshape(B, B_HEADS, S, B_DIM).transpose(0, 2, 1, 3)
    zh = z.reshape(B, S, B_HEADS, B_DIM).astype(jnp.float32)
    o = rms(o) * norm_gain * jax.nn.silu(zh)
    return o.reshape(B, S, B_WIDTH)


def peer(h, w_query, sub_keys, u_tab, v_tab):
    B, S, D = h.shape
    hb_all = h.reshape(-1, PEER_BLOCK, D)

    def one_block(hb):
        q = (hb @ w_query).reshape(PEER_BLOCK, PEER_HEADS, 2, PEER_QDIM // 2)
        s = jnp.einsum('thpd,hpnd->thpn', q, sub_keys).astype(jnp.float32)
        s_half, i_half = lax.top_k(s, PEER_TOPK)
        cand = s_half[..., 0, :, None] + s_half[..., 1, None, :]
        cand_s, cand_i = lax.top_k(cand.reshape(PEER_BLOCK, PEER_HEADS, PEER_TOPK * PEER_TOPK), PEER_TOPK)
        i1 = jnp.take_along_axis(i_half[..., 0, :], cand_i // PEER_TOPK, axis=-1)
        i2 = jnp.take_along_axis(i_half[..., 1, :], cand_i % PEER_TOPK, axis=-1)
        expert = i1 * PEER_NKEYS + i2
        gate = jax.nn.softmax(cand_s, axis=-1)
        act = jax.nn.gelu(jnp.einsum('tpkd,td->tpk', u_tab[expert], hb).astype(jnp.float32),
                          approximate=False) * gate
        return jnp.einsum('tpk,tpkd->td', act.astype(v_tab.dtype), v_tab[expert])

    return lax.map(one_block, hb_all).reshape(B, S, D)


def setup_inputs(seed: int = 0) -> dict:
    key = jax.random.key(seed)
    ks = jax.random.split(key, 18)
    f32 = jnp.float32
    L = DEPTH

    def nrm(k, shape, fan_in, gain=1.0):
        return jax.random.normal(k, shape, f32) * (gain * fan_in ** -0.5)

    dt = jnp.exp(jax.random.uniform(ks[10], (L, B_HEADS), f32,
                                    minval=math.log(1e-3), maxval=math.log(1e-1)))
    return {
        'x': jax.random.normal(ks[0], (BATCH, SEQ, D_MODEL), f32),
        'c': jax.random.normal(ks[1], (BATCH, D_MODEL), f32),
        'w_ada': nrm(ks[2], (L, D_MODEL, 6 * D_MODEL), D_MODEL, 0.5),
        'b_ada': 0.02 * jax.random.normal(ks[3], (L, 6 * D_MODEL), f32),
        'w_in': nrm(ks[4], (L, D_MODEL, IN_WIDTH), D_MODEL),
        'q_gain': 1.0 + 0.02 * jax.random.normal(ks[5], (L, A_LAT), f32),
        'k_gain': 1.0 + 0.02 * jax.random.normal(ks[6], (L, A_LAT), f32),
        'w_uv': nrm(ks[7], (L, A_HEADS, A_LAT, A_VDIM), A_LAT),
        'conv_w': nrm(ks[8], (L, CONV_W, 3 * B_WIDTH), CONV_W),
        'a_log': jnp.log(jax.random.uniform(ks[9], (L, B_HEADS), f32, minval=1.0, maxval=16.0)),
        'dt_bias': dt + jnp.log(-jnp.expm1(-dt)),
        'gdn_gain': 1.0 + 0.02 * jax.random.normal(ks[11], (L, B_DIM), f32),
        'w_out': nrm(ks[12], (L, MIX_WIDTH, D_MODEL), MIX_WIDTH),
        'w_query': nrm(ks[13], (L, D_MODEL, PEER_HEADS * PEER_QDIM), D_MODEL),
        'sub_keys': nrm(ks[14], (L, PEER_HEADS, 2, PEER_NKEYS, PEER_QDIM // 2), PEER_QDIM // 2),
        'u_tab': nrm(ks[15], (L, N_EXPERTS, D_MODEL), D_MODEL),
        'v_tab': nrm(ks[16], (L, N_EXPERTS, D_MODEL), D_MODEL),
    }


def reference(x, c, w_ada, b_ada, w_in, q_gain, k_gain, w_uv, conv_w, a_log, dt_bias,
              gdn_gain, w_out, w_query, sub_keys, u_tab, v_tab):
    B, S, _ = x.shape
    offsets = [int(o) for o in np.cumsum(IN_SPLITS)[:-1]]
    for l in range(DEPTH):
        sh1, sc1, g1, sh2, sc2, g2 = jnp.split(jax.nn.silu(c) @ w_ada[l] + b_ada[l], 6, axis=-1)
        h = modulate(rms(x), sh1, sc1).astype(x.dtype)
        proj = h @ w_in[l]
        aq, akv, iq, ik, iw, bq, bk, bv, bz, ba, bb = jnp.split(proj, offsets, axis=-1)
        ya = dsa_attention(aq.reshape(B, S, A_HEADS, A_LAT), akv,
                           iq.reshape(B, S, IDX_HEADS, IDX_DIM), ik, iw,
                           q_gain[l], k_gain[l], w_uv[l])
        yb = gated_deltanet(bq, bk, bv, bz, ba, bb, conv_w[l], a_log[l], dt_bias[l], gdn_gain[l])
        mix = jnp.concatenate([ya, yb], axis=-1).astype(x.dtype) @ w_out[l]
        x = x + (g1[:, None, :] * mix).astype(x.dtype)
        h = modulate(rms(x), sh2, sc2).astype(x.dtype)
        y = peer(h, w_query[l], sub_keys[l], u_tab[l], v_tab[l])
        x = x + (g2[:, None, :] * y).astype(x.dtype)
    return x
```

```cpp
#include <hip/hip_runtime.h>
#include <hip/hip_cooperative_groups.h>
#include <cstdio>
#include <cstdint>
namespace cg = cooperative_groups;
namespace pg8 {
#define PG8_LAS __attribute__((address_space(3)))
typedef unsigned short bf16_t;
typedef short bf16x8 __attribute__((ext_vector_type(8)));
typedef float f32x4 __attribute__((ext_vector_type(4)));
typedef unsigned u32x4 __attribute__((ext_vector_type(4)));
constexpr int BM = 256, BK = 64, HALF = 128, HTB = HALF * BK * 2  , STAGE_BYTES = 8 * HTB, NXCD = 8, WGM = 8;

__host__ __device__ __forceinline__ int lds_byte(int r, int c) { const int st = (r >> 4) * 2 + (c >> 5), rr = r & 15, cc = c & 31, ob = rr * 64 + cc * 2; return st * 1024 + (ob ^ (((ob >> 9) & 1) << 5)); }
__host__ __device__ __forceinline__ void stage_rc(int b, int& R, int& C) { const int st = b / 1024, sb = b % 1024, swz = sb ^ (((sb >> 9) & 1) << 5); R = (st >> 1) * 16 + swz / 64; C = (st & 1) * 32 + (swz % 64) / 2; }
__host__ __device__ __forceinline__ int perm32(int rho) { const int n = rho >> 4, i = rho & 15; return 8 * (i >> 2) + 4 * n + (i & 3); }

struct Unit { int pm, pn; };
struct Gemm { const bf16_t* A; const bf16_t* Bt; int M, N, K; };

struct StaticOrder {
    int nM, nN, nwg, G, c;
    __host__ __device__ void init(int M, int N, int G_, int c_) { nM = M / BM; nN = N / BM; nwg = nM * nN; G = G_; c = c_; }
    __host__ __device__ bool next(int i, Unit& u) const {
        const long L = (long)i * G + c; if (L >= nwg) return false;
        int wgid = (int)L; { const int q = nwg / NXCD, r = nwg % NXCD, xcd = wgid % NXCD, off = wgid / NXCD; wgid = (xcd < r ? xcd * (q + 1) : r * (q + 1) + (xcd - r) * q) + off; }
        const int nig = WGM * nN, gid = wgid / nig, fm = gid * WGM, gsz = (nM - fm) < WGM ? (nM - fm) : WGM;
        u.pm = fm + ((wgid % nig) % gsz); u.pn = (wgid % nig) / gsz; return true;
    }
    __device__ __forceinline__ void a_ready(const Unit&) const {}
    __device__ __forceinline__ void done(const Unit&) const {}
};
__device__ __forceinline__ unsigned cvt_pk_bf16(float lo, float hi) { unsigned r; asm volatile("v_cvt_pk_bf16_f32 %0, %1, %2" : "=v"(r) : "v"(lo), "v"(hi)); return r; }
template <class Epi, class Sched, bool STAMP = false>
__device__ __forceinline__ void gemm_phase(PG8_LAS unsigned char* lds, const Gemm g, const Sched& S, const Epi& E, unsigned long long* stamps) {
    const int tid = threadIdx.x, wid = __builtin_amdgcn_readfirstlane(tid >> 6), lane = tid & 63, wr = wid >> 2, wc = wid & 3, fr = lane & 15, fq = lane >> 4;
    const int K = g.K, nt = K / BK;
    int ts_lo = 0, ts_hi = 0, nts = 0; const unsigned long long rt_entry = STAMP ? (unsigned long long)wall_clock64() : 0ull;
#define PG8_STAMP() do { if (STAMP && wid == 0 && nts < 64) { const unsigned long long _c = (unsigned long long)clock64(); \
        ts_lo = (lane == nts) ? (int)(unsigned)_c : ts_lo; ts_hi = (lane == nts) ? (int)(unsigned)(_c >> 32) : ts_hi; ++nts; } } while (0)
    PG8_STAMP();
    unsigned voffA[2], voffB[2];
#pragma unroll
    for (int i = 0; i < 2; ++i) { int R, C; stage_rc(tid * 16 + i * 8192, R, C); const int Rb = Epi::PERM ? ((R & ~31) + perm32(R & 31)) : R;
        voffA[i] = (unsigned)(R * K + C) * 2u; voffB[i] = (unsigned)(Rb * K + C) * 2u; }
    const size_t kstep = (size_t)(BK * 2);
    const size_t hstep = (size_t)HALF * K * 2;
    const size_t tstep = 2 * hstep;
    const unsigned ldsw = (unsigned)wid * 1024u;
    const int aoff = lds_byte(wr * 64 + fr, fq * 8), boff = lds_byte(wc * 32 + fr, fq * 8);
#define PG8_SA(b, h) (((b) * 2 + (h)) * HTB)
#define PG8_SB(b, h) ((4 + (b) * 2 + (h)) * HTB)
#define PG8_STAGE(bufoff, gbase, voff) do { _Pragma("unroll") for (int _i = 0; _i < 2; ++_i) \
        __builtin_amdgcn_global_load_lds((const unsigned*)((const char*)(gbase) + (voff)[_i]), (PG8_LAS unsigned*)(lds + (bufoff) + ldsw + _i * 8192), 16, 0, 0); } while (0)
#define PG8_LDA(dst, b, h) do { _Pragma("unroll") for (int m = 0; m < 4; ++m) _Pragma("unroll") for (int k = 0; k < 2; ++k) dst[m][k] = *(const PG8_LAS bf16x8*)(lds + PG8_SA(b, h) + aoff + m * 2048 + k * 1024); } while (0)
#define PG8_LDB(dst, b, h) do { _Pragma("unroll") for (int n = 0; n < 2; ++n) _Pragma("unroll") for (int k = 0; k < 2; ++k) dst[n][k] = *(const PG8_LAS bf16x8*)(lds + PG8_SB(b, h) + boff + n * 2048 + k * 1024); } while (0)
#define PG8_MMA(ai, bj, At, Bt) do { __builtin_amdgcn_s_setprio(1); _Pragma("unroll") for (int m = 0; m < 4; ++m) _Pragma("unroll") for (int n = 0; n < 2; ++n) _Pragma("unroll") for (int k = 0; k < 2; ++k) \
        acc[ai][bj][m][n] = __builtin_amdgcn_mfma_f32_16x16x32_bf16(Bt[n][k], At[m][k], acc[ai][bj][m][n], 0, 0, 0); __builtin_amdgcn_s_setprio(0); } while (0)
#define PG8_WAIT_V(n) asm volatile("s_waitcnt vmcnt(" #n ")" ::: "memory")
#define PG8_WAIT_L(n) asm volatile("s_waitcnt lgkmcnt(" #n ")" ::: "memory")
#define PG8_BAR __builtin_amdgcn_s_barrier()
#define PG8_SCHED __builtin_amdgcn_sched_barrier(0)
    Unit cur, nxt; int ui = 0;
    if (!S.next(0, cur)) return;
    f32x4 acc[2][2][4][2];
#pragma unroll
    for (int a = 0; a < 2; ++a)
#pragma unroll
        for (int b = 0; b < 2; ++b)
#pragma unroll
            for (int m = 0; m < 4; ++m)
#pragma unroll
                for (int n = 0; n < 2; ++n) acc[a][b][m][n] = (f32x4){0.f, 0.f, 0.f, 0.f};
    bf16x8 At[4][2], B0[2][2], B1[2][2];
    const char* cA = (const char*)g.A + (size_t)cur.pm * tstep; const char* cB = (const char*)g.Bt + (size_t)cur.pn * tstep;
    S.a_ready(cur);
    PG8_STAGE(PG8_SB(0, 0), cB, voffB); PG8_STAGE(PG8_SA(0, 0), cA, voffA); PG8_STAGE(PG8_SB(0, 1), cB + hstep, voffB); PG8_STAGE(PG8_SA(0, 1), cA + hstep, voffA);
    if (wr == 1) PG8_BAR;
    PG8_WAIT_V(4); PG8_BAR;
    PG8_STAGE(PG8_SB(1, 0), cB + kstep, voffB); PG8_STAGE(PG8_SA(1, 0), cA + kstep, voffA); PG8_STAGE(PG8_SB(1, 1), cB + hstep + kstep, voffB);
    PG8_WAIT_V(6); PG8_BAR;
    PG8_STAMP();
    for (;;) {
        const bool has_next = S.next(ui + 1, nxt);
        const char* nA = has_next ? (const char*)g.A + (size_t)nxt.pm * tstep : cA; const char* nB = has_next ? (const char*)g.Bt + (size_t)nxt.pn * tstep : cB;
        for (int t = 0; t < nt; t += 2) {
            const bool last = (t == nt - 2);
            const char* a1 = cA + (size_t)(t + 1) * kstep;
            const char* a2 = last ? nA : cA + (size_t)(t + 2) * kstep; const char* b2 = last ? nB : cB + (size_t)(t + 2) * kstep;
            const char* a3 = a2 + kstep; const char* b3 = b2 + kstep;
            if (last && has_next) S.a_ready(nxt);
            PG8_LDB(B0, 0, 0); PG8_SCHED; PG8_LDA(At, 0, 0); PG8_STAGE(PG8_SA(1, 1), a1 + hstep, voffA);
            PG8_WAIT_L(8); PG8_BAR; PG8_WAIT_L(0); PG8_MMA(0, 0, At, B0); PG8_BAR; PG8_SCHED;
            PG8_LDB(B1, 0, 1); PG8_STAGE(PG8_SB(0, 0), b2, voffB);
            PG8_BAR; PG8_WAIT_L(0); PG8_MMA(0, 1, At, B1); PG8_BAR;
            PG8_LDA(At, 0, 1); PG8_STAGE(PG8_SA(0, 0), a2, voffA);
            PG8_BAR; PG8_WAIT_L(0); PG8_MMA(1, 0, At, B0); PG8_BAR; PG8_SCHED;
            PG8_STAGE(PG8_SB(0, 1), b2 + hstep, voffB);
            PG8_WAIT_V(6); PG8_BAR; PG8_MMA(1, 1, At, B1); PG8_BAR;
            PG8_LDB(B0, 1, 0); PG8_SCHED; PG8_LDA(At, 1, 0); PG8_STAGE(PG8_SA(0, 1), a2 + hstep, voffA);
            PG8_WAIT_L(8); PG8_BAR; PG8_WAIT_L(0); PG8_MMA(0, 0, At, B0); PG8_BAR; PG8_SCHED;
            PG8_LDB(B1, 1, 1); PG8_STAGE(PG8_SB(1, 0), b3, voffB);
            PG8_BAR; PG8_WAIT_L(0); PG8_MMA(0, 1, At, B1); PG8_BAR;
            PG8_LDA(At, 1, 1); PG8_STAGE(PG8_SA(1, 0), a3, voffA);
            PG8_BAR; PG8_WAIT_L(0); PG8_MMA(1, 0, At, B0); PG8_BAR; PG8_SCHED;
            PG8_STAGE(PG8_SB(1, 1), b3 + hstep, voffB);
            PG8_WAIT_V(6); PG8_BAR; PG8_MMA(1, 1, At, B1); PG8_BAR;
        }
        PG8_STAMP();
        if constexpr (!Epi::AFTER_DRAIN) { E(acc, cur, wr, wc, fr, fq); S.done(cur); }
        PG8_STAMP();
        if (!has_next) break;
#pragma unroll
        for (int a = 0; a < 2; ++a)
#pragma unroll
            for (int b = 0; b < 2; ++b)
#pragma unroll
                for (int m = 0; m < 4; ++m)
#pragma unroll
                    for (int n = 0; n < 2; ++n) acc[a][b][m][n] = (f32x4){0.f, 0.f, 0.f, 0.f};
        cur = nxt; cA = nA; cB = nB; ++ui;
    }
    PG8_WAIT_V(0);
    if (wr == 0) PG8_BAR;
    PG8_BAR;
    if constexpr (Epi::AFTER_DRAIN) { E.fused(acc, cur, wr, wc, fr, fq, lds, wid, lane); S.done(cur); }
    PG8_STAMP();
    if (STAMP && wid == 0) { stamps[lane] = lane < nts ? (((unsigned long long)(unsigned)ts_hi << 32) | (unsigned)ts_lo) : 0ull;
        if (lane == 62) stamps[62] = rt_entry; if (lane == 63) stamps[63] = (unsigned long long)wall_clock64(); }
#undef PG8_STAMP
#undef PG8_SA
#undef PG8_SB
#undef PG8_STAGE
#undef PG8_LDA
#undef PG8_LDB
#undef PG8_MMA
#undef PG8_WAIT_V
#undef PG8_WAIT_L
#undef PG8_BAR
#undef PG8_SCHED
}
}

#define LAS __attribute__((address_space(3)))
typedef unsigned short bf16;
typedef unsigned v4u __attribute__((ext_vector_type(4)));
typedef unsigned v2u __attribute__((ext_vector_type(2)));
typedef float f32x4 __attribute__((ext_vector_type(4)));
typedef float f32x16 __attribute__((ext_vector_type(16)));
typedef short bf16x8 __attribute__((ext_vector_type(8)));

constexpr int T_TOK = 32768, DM = 1024, SEQ = 4096, NBATCH = 8;
constexpr int PW = 3584;
constexpr int IN_W = 3532;
constexpr int C_AQ = 0, C_AKV = 1024, C_IQ = 1152, C_IK = 1408, C_IW = 1472, C_BA = 1476, C_BB = 1480, C_BQ = 1536, C_BK = 2048, C_BV = 2560, C_BZ = 3072;
constexpr int YW = 1536;
constexpr int NCHUNK = 2048;
constexpr float EPS = 1e-6f;

constexpr size_t MiB = 1u << 20;
constexpr size_t WS_CTL = 0;
constexpr size_t WS_MOD = 1 * MiB;
constexpr size_t WS_GL = WS_MOD + 256 * 1024;
constexpr size_t WS_WIN = 2 * MiB;
constexpr size_t WS_BT2 = 9 * MiB;
constexpr size_t WS_WQ = 12 * MiB;
constexpr size_t WS_SUBK = 16 * MiB;
constexpr size_t WS_H = 18 * MiB;
constexpr size_t WS_KN = WS_H;
constexpr size_t WS_SEL = WS_H + 8 * MiB;
constexpr size_t WS_PROJ = 82 * MiB;
constexpr size_t WS_QUERY = WS_PROJ;
constexpr size_t WS_YAB = 306 * MiB;
constexpr size_t WS_EXPID = WS_YAB;
constexpr size_t WS_GATE = WS_YAB + 16 * MiB;
constexpr size_t WS_GA = 402 * MiB;
constexpr size_t WS_UT = 418 * MiB;
constexpr size_t WS_VT = 450 * MiB;
constexpr size_t WS_END = 482 * MiB;
constexpr size_t DO_W = 0, DO_QD = 32 * MiB, DO_KDT = 64 * MiB, DO_UT = 96 * MiB;

constexpr int LDS_BYTES = 147456;

struct Args { const float* in[17]; float* out; unsigned char* ws; int ph_lo, ph_hi; };

__device__ __forceinline__ unsigned f2bf(float f) { unsigned u = __float_as_uint(f); return (u + 0x7fffu + ((u >> 16) & 1u)) >> 16; }
__device__ __forceinline__ unsigned pk2(float lo, float hi) { return f2bf(lo) | (f2bf(hi) << 16); }
__device__ __forceinline__ float bflo(unsigned u) { return __uint_as_float(u << 16); }
__device__ __forceinline__ float bfhi(unsigned u) { return __uint_as_float(u & 0xffff0000u); }
__device__ __forceinline__ float bf1(bf16 b) { return __uint_as_float(((unsigned)b) << 16); }
__device__ __forceinline__ float wave_sum(float v) {
#pragma unroll
    for (int o = 1; o < 64; o <<= 1) v += __shfl_xor(v, o);
    return v;
}
__device__ __forceinline__ float wave_max(float v) {
#pragma unroll
    for (int o = 1; o < 64; o <<= 1) v = fmaxf(v, __shfl_xor(v, o));
    return v;
}
__device__ __forceinline__ float silu_f(float v) { return v / (1.f + expf(-v)); }
__device__ __forceinline__ float sigmoid_f(float v) { return 1.f / (1.f + expf(-v)); }
__device__ __forceinline__ float softplus_f(float v) { return fmaxf(v, 0.f) + log1pf(expf(-fabsf(v))); }
#define LDS_WAIT() asm volatile("s_waitcnt lgkmcnt(0)" ::: "memory")

__device__ __forceinline__ int win_srccol(int n) {
    if (n < 1476) return n;
    if (n < 1480) return 3524 + (n - 1476);
    if (n < 1484) return 3528 + (n - 1480);
    if (n < 1536) return -1;
    return 1476 + (n - 1536);
}
__device__ __forceinline__ void transpose_item(const float* W, int spitch, int k0, int sc, bf16* WT, int dpitch, int drow0, int dcol0, LAS float* scr, int lane) {
#pragma unroll 8
    for (int i = 0; i < 32; ++i) { const int kk = 2 * i + (lane >> 5); scr[kk * 33 + (lane & 31)] = (sc >= 0) ? W[(size_t)(k0 + kk) * spitch + sc] : 0.f; }
    LDS_WAIT();
    const int c = lane & 7;
#pragma unroll
    for (int j = 0; j < 4; ++j) { const int n = (lane >> 3) + 8 * j; const LAS float* s = scr + (8 * c) * 33 + n;
        v4u o; o.x = pk2(s[0 * 33], s[1 * 33]); o.y = pk2(s[2 * 33], s[3 * 33]); o.z = pk2(s[4 * 33], s[5 * 33]); o.w = pk2(s[6 * 33], s[7 * 33]);
        *(v4u*)(WT + (size_t)(drow0 + n) * dpitch + dcol0 + 8 * c) = o; }
    LDS_WAIT();
}

__device__ __forceinline__ void phase0(const Args& a, LAS unsigned char* lds) {
    const int tid = threadIdx.x, lane = tid & 63, wave = tid >> 6, bid = blockIdx.x, G = gridDim.x;
    unsigned char* ws = a.ws;
    for (int item = bid; item < 192; item += G) {
        LAS float* sc = (LAS float*)lds;
        LAS float* red = sc + 8192;
        const float* c = a.in[1];
        for (int i = tid; i < 8192; i += 512) sc[i] = silu_f(c[i]);
        __syncthreads();
        const int cc = tid & 31, kg = tid >> 5;
        const float* w = a.in[2] + item * 32 + cc;
        float acc[8];
#pragma unroll
        for (int b = 0; b < 8; ++b) acc[b] = 0.f;
        for (int k = kg; k < 1024; k += 16) { const float wv = w[(size_t)k * 6144];
#pragma unroll
            for (int b = 0; b < 8; ++b) acc[b] += sc[b * 1024 + k] * wv; }
#pragma unroll
        for (int b = 0; b < 8; ++b) red[(kg * 8 + b) * 32 + cc] = acc[b];
        __syncthreads();
        if (tid < 256) { const int b = tid >> 5; float s = 0.f;
            for (int k2 = 0; k2 < 16; ++k2) s += red[(k2 * 8 + b) * 32 + cc];
            ((float*)(ws + WS_MOD))[b * 6144 + item * 32 + cc] = s + a.in[3][item * 32 + cc]; }
        __syncthreads();
    }
    {
        LAS float* scr = (LAS float*)(lds + 65536 + wave * 8704);
        const int gw = bid * 8 + wave, NGW = G * 8;
        constexpr int I_WIN = 16 * 112, I_WQ = 16 * 64, I_WO = 8 * 32;
        for (int it = gw; it < I_WIN + I_WQ + I_WO; it += NGW) {
            int r = it;
            if (r < I_WIN) { const int kb = r / 112, nb = r % 112; transpose_item(a.in[4], IN_W, 64 * kb, win_srccol(32 * nb + (lane & 31)), (bf16*)(ws + WS_WIN), 1024, 32 * nb, 64 * kb, scr, lane); continue; }
            r -= I_WIN;
            if (r < I_WQ) { const int kb = r / 64, nb = r % 64; transpose_item(a.in[13], 2048, 64 * kb, 32 * nb + (lane & 31), (bf16*)(ws + WS_WQ), 1024, 32 * nb, 64 * kb, scr, lane); continue; }
            r -= I_WQ;
            { const int kb = r / 32, nb = r % 32; transpose_item(a.in[12] + (size_t)512 * 1024, 1024, 64 * kb, 32 * nb + (lane & 31), (bf16*)(ws + WS_BT2), YW, 32 * nb, 1024 + 64 * kb, scr, lane); }
        }
    }
    {
        const float* wuv = a.in[7]; const float* wout = a.in[12]; bf16* bt2 = (bf16*)(ws + WS_BT2);
        for (int it = bid * 512 + tid; it < 1024 * 128; it += G * 512) {
            const int n = it & 1023, kb = __builtin_amdgcn_readfirstlane(it >> 10);
            const int h = kb >> 4, r0 = (kb & 15) * 8;
            float acc[8];
#pragma unroll
            for (int j = 0; j < 8; ++j) acc[j] = 0.f;
            for (int v = 0; v < 64; ++v) { const float wo = wout[(size_t)(h * 64 + v) * 1024 + n];
#pragma unroll
                for (int j = 0; j < 8; ++j) acc[j] += wuv[(size_t)(h * 128 + r0 + j) * 64 + v] * wo; }
            v4u o; o.x = pk2(acc[0], acc[1]); o.y = pk2(acc[2], acc[3]); o.z = pk2(acc[4], acc[5]); o.w = pk2(acc[6], acc[7]);
            *(v4u*)(bt2 + (size_t)n * YW + h * 128 + r0) = o;
        }
    }
    {
        const size_t gt = (size_t)bid * 512 + tid, GT = (size_t)G * 512;
        const size_t n_sk = 262144 / 8, n_tab = (size_t)16384 * 1024 / 8;
        for (size_t i = gt; i < n_sk + 2 * n_tab; i += GT) {
            const float* src; bf16* dst; size_t j = i;
            if (j < n_sk) { src = a.in[14]; dst = (bf16*)(ws + WS_SUBK); }
            else if (j < n_sk + n_tab) { j -= n_sk; src = a.in[15]; dst = (bf16*)(ws + WS_UT); }
            else { j -= n_sk + n_tab; src = a.in[16]; dst = (bf16*)(ws + WS_VT); }
            const f32x4 v0 = *(const f32x4*)(src + j * 8), v1 = *(const f32x4*)(src + j * 8 + 4);
            v4u o; o.x = pk2(v0.x, v0.y); o.y = pk2(v0.z, v0.w); o.z = pk2(v1.x, v1.y); o.w = pk2(v1.z, v1.w);
            *(v4u*)(dst + j * 8) = o;
        }
    }
}

__device__ __forceinline__ void phase_norm(const float* x, const float* mod, int shift_off, int scale_off, bf16* hout) {
    const int tid = threadIdx.x, lane = tid & 63, wave = tid >> 6;
    const int gw = blockIdx.x * 8 + wave, NGW = gridDim.x * 8;
    for (int m = gw; m < T_TOK; m += NGW) {
        const int b = m >> 12;
        const f32x4* xr = (const f32x4*)(x + (size_t)m * DM) + lane;
        f32x4 v[4]; float s = 0.f;
#pragma unroll
        for (int j = 0; j < 4; ++j) { v[j] = xr[64 * j]; s += (v[j].x * v[j].x + v[j].y * v[j].y) + (v[j].z * v[j].z + v[j].w * v[j].w); }
        const float inv = rsqrtf(wave_sum(s) * (1.f / DM) + EPS);
        const f32x4* sh = (const f32x4*)(mod + b * 6144 + shift_off) + lane;
        const f32x4* sc = (const f32x4*)(mod + b * 6144 + scale_off) + lane;
        v2u* o8 = (v2u*)(hout + (size_t)m * DM) + lane;
#pragma unroll
        for (int j = 0; j < 4; ++j) { const f32x4 a = sh[64 * j], c = sc[64 * j];
            v2u o; o.x = pk2(v[j].x * inv * (1.f + c.x) + a.x, v[j].y * inv * (1.f + c.y) + a.y);
            o.y = pk2(v[j].z * inv * (1.f + c.z) + a.z, v[j].w * inv * (1.f + c.w) + a.w);
            o8[64 * j] = o; }
    }
}

struct EpiX1 {
    static constexpr bool PERM = false, AFTER_DRAIN = false;
    const float* x; float* out; const float* mod;
    __device__ __forceinline__ void operator()(const pg8::f32x4 (&acc)[2][2][4][2], const pg8::Unit& u, int wr, int wc, int fr, int fq) const {
        const int row0 = u.pm * 256 + wr * 64 + fr, col0 = u.pn * 256 + wc * 32 + 4 * fq;
        const int b = (u.pm * 256) >> 12;
        f32x4 gv[2][2];
#pragma unroll
        for (int bj = 0; bj < 2; ++bj)
#pragma unroll
            for (int n = 0; n < 2; ++n) gv[bj][n] = *(const f32x4*)(mod + b * 6144 + 2048 + col0 + bj * 128 + n * 16);
#pragma unroll
        for (int ai = 0; ai < 2; ++ai)
#pragma unroll
            for (int m = 0; m < 4; ++m) { const size_t ro = (size_t)(row0 + ai * 128 + m * 16) * DM + col0;
#pragma unroll
                for (int bj = 0; bj < 2; ++bj)
#pragma unroll
                    for (int n = 0; n < 2; ++n) { const f32x4 xv = *(const f32x4*)(x + ro + bj * 128 + n * 16);
                        *(f32x4*)(out + ro + bj * 128 + n * 16) = xv + gv[bj][n] * acc[ai][bj][m][n]; } }
    }
};
struct EpiBf {
    static constexpr bool PERM = true, AFTER_DRAIN = false;
    bf16* O; int ldc;
    __device__ __forceinline__ void operator()(const pg8::f32x4 (&acc)[2][2][4][2], const pg8::Unit& u, int wr, int wc, int fr, int fq) const {
        const int row0 = u.pm * 256 + wr * 64 + fr, col0 = u.pn * 256 + wc * 32 + 8 * fq;
#pragma unroll
        for (int ai = 0; ai < 2; ++ai)
#pragma unroll
            for (int m = 0; m < 4; ++m) { bf16* rowp = O + (size_t)(row0 + ai * 128 + m * 16) * ldc + col0;
#pragma unroll
                for (int bj = 0; bj < 2; ++bj) { const pg8::f32x4 v0 = acc[ai][bj][m][0], v1 = acc[ai][bj][m][1];
                    v4u w; w.x = pg8::cvt_pk_bf16(v0[0], v0[1]); w.y = pg8::cvt_pk_bf16(v0[2], v0[3]); w.z = pg8::cvt_pk_bf16(v1[0], v1[1]); w.w = pg8::cvt_pk_bf16(v1[2], v1[3]);
                    *(v4u*)(rowp + bj * 128) = w; } }
    }
};

constexpr int GP_QS = 0, GP_KS = 33792, GP_VS = 67584, GP_LS = 101376, GP_GV = 118784;
__device__ __forceinline__ void gdn_prep_item(const Args& a, LAS unsigned char* lds, int chunk) {
    const int tid = threadIdx.x, lane = tid & 63, wave = __builtin_amdgcn_readfirstlane(tid >> 6);
    unsigned char* ws = a.ws;
    const bf16* proj = (const bf16*)(ws + WS_PROJ);
    const int bh = chunk >> 6, n = chunk & 63, b = bh >> 2, h = bh & 3;
    const int t0 = b * SEQ + n * 64;
    LAS float* QS = (LAS float*)(lds + GP_QS); LAS float* KS = (LAS float*)(lds + GP_KS); LAS float* VS = (LAS float*)(lds + GP_VS);
    LAS float* LS = (LAS float*)(lds + GP_LS); LAS float* GV = (LAS float*)(lds + GP_GV);
#ifndef GP_MASK
#define GP_MASK 31
#endif
    if ((GP_MASK & 1) && tid < 384) {
        const int sec = tid >> 7, c = tid & 127;
        const int pcol = C_BQ + sec * 512 + h * 128 + c;
        const int wcol = sec * 512 + h * 128 + c;
        const float* cw = a.in[8];
        const float w0 = cw[wcol], w1 = cw[1536 + wcol], w2 = cw[3072 + wcol], w3 = cw[4608 + wcol];
        LAS float* XS = (sec == 0) ? QS : (sec == 1 ? KS : VS);
        float xm3 = 0.f, xm2 = 0.f, xm1 = 0.f;
        if (n > 0) { xm3 = bf1(proj[(size_t)(t0 - 3) * PW + pcol]); xm2 = bf1(proj[(size_t)(t0 - 2) * PW + pcol]); xm1 = bf1(proj[(size_t)(t0 - 1) * PW + pcol]); }
#pragma unroll 8
        for (int r = 0; r < 64; ++r) {
            const float x0 = bf1(proj[(size_t)(t0 + r) * PW + pcol]);
            const float y = w0 * xm3 + w1 * xm2 + w2 * xm1 + w3 * x0;
            XS[r * 132 + c] = silu_f(y);
            xm3 = xm2; xm2 = xm1; xm1 = x0;
        }
    }
    if (wave == 7) {
        const int i = lane;
        const float av = bf1(proj[(size_t)(t0 + i) * PW + C_BA + h]), bv = bf1(proj[(size_t)(t0 + i) * PW + C_BB + h]);
        const float beta = sigmoid_f(bv);
        const float g = -expf(a.in[9][h]) * softplus_f(av + a.in[10][h]);
        float G = g;
#pragma unroll
        for (int o = 1; o < 64; o <<= 1) { const float t = __shfl_up(G, o); if (lane >= o) G += t; }
        const float Glast = __shfl(G, 63);
        GV[i] = G; GV[64 + i] = expf(G); GV[128 + i] = beta; GV[192 + i] = expf(Glast - G); GV[256 + i] = beta * expf(G);
        if (lane == 0) ((float*)(ws + WS_GL))[chunk] = expf(Glast);
    }
    __syncthreads();
    if (GP_MASK & 2) {
#pragma unroll 4
        for (int rr = 0; rr < 16; ++rr) {
            const int row = wave * 16 + rr;
            LAS float* X = (row < 64) ? (QS + row * 132) : (KS + (row - 64) * 132);
            const float v0 = X[lane], v1 = X[lane + 64];
            const float ss = wave_sum(v0 * v0 + v1 * v1);
            const float sc = rsqrtf(ss + EPS) * ((row < 64) ? 0.08838834764831845f : 1.f);
            X[lane] = v0 * sc; X[lane + 64] = v1 * sc;
        }
    }
    __syncthreads();
    if (GP_MASK & 4) {
        const int gram = wave >> 2, ti = wave & 3, r = lane & 15, g = lane >> 4;
        const LAS float* X = gram ? QS : KS;
        f32x4 acc[4];
#pragma unroll
        for (int tj = 0; tj < 4; ++tj) acc[tj] = (f32x4){0.f, 0.f, 0.f, 0.f};
#pragma unroll 2
        for (int kk = 0; kk < 8; ++kk) {
            const f32x4 xa = *(const LAS f32x4*)(X + (16 * ti + r) * 132 + 16 * kk + 4 * g);
#pragma unroll
            for (int tj = 0; tj < 4; ++tj) {
                if (tj <= ti) {
                    const f32x4 kb = *(const LAS f32x4*)(KS + (16 * tj + r) * 132 + 16 * kk + 4 * g);
                    acc[tj] = __builtin_amdgcn_mfma_f32_16x16x4f32(xa.x, kb.x, acc[tj], 0, 0, 0);
                    acc[tj] = __builtin_amdgcn_mfma_f32_16x16x4f32(xa.y, kb.y, acc[tj], 0, 0, 0);
                    acc[tj] = __builtin_amdgcn_mfma_f32_16x16x4f32(xa.z, kb.z, acc[tj], 0, 0, 0);
                    acc[tj] = __builtin_amdgcn_mfma_f32_16x16x4f32(xa.w, kb.w, acc[tj], 0, 0, 0);
                }
            }
        }
        bf16* Aout = (bf16*)(ws + WS_GA) + (size_t)chunk * 4096;
#pragma unroll
        for (int tj = 0; tj < 4; ++tj)
#pragma unroll
            for (int rg = 0; rg < 4; ++rg) {
                const int i = 16 * ti + 4 * g + rg, j = 16 * tj + r;
                const float dec = (j <= i) ? expf(GV[i] - GV[j]) : 0.f;
                if (gram == 0) { if (tj <= ti) LS[i * 68 + j] = (j < i) ? GV[128 + i] * acc[tj][rg] * dec : 0.f; }
                else Aout[i * 64 + j] = (bf16)f2bf((tj <= ti) ? acc[tj][rg] * dec : 0.f);
            }
    }
    __syncthreads();
    if (!(GP_MASK & 8)) {} else if (tid < 256) {
        const int isw = tid >> 7, cc = tid & 127;
        const LAS float* R = (isw ? KS : VS) + cc;
        const LAS float* MU = GV + (isw ? 256 : 128);
        float x[64];
#pragma unroll
        for (int i = 0; i < 64; ++i) {
            float a0 = R[i * 132] * MU[i], a1 = 0.f, a2 = 0.f, a3 = 0.f;
#pragma unroll
            for (int j4 = 0; j4 < (i + 3) / 4; ++j4) {
                const f32x4 l = *(const LAS f32x4*)(LS + i * 68 + 4 * j4);
                if (4 * j4 + 0 < i) a0 -= l.x * x[4 * j4 + 0];
                if (4 * j4 + 1 < i) a1 -= l.y * x[4 * j4 + 1];
                if (4 * j4 + 2 < i) a2 -= l.z * x[4 * j4 + 2];
                if (4 * j4 + 3 < i) a3 -= l.w * x[4 * j4 + 3];
            }
            x[i] = (a0 + a1) + (a2 + a3);
            __builtin_amdgcn_sched_barrier(0);
        }
        if (!isw) {
            bf16* UT = (bf16*)((unsigned char*)a.out + DO_UT) + (size_t)chunk * 8192 + cc * 64;
#pragma unroll
            for (int q = 0; q < 8; ++q) { v4u o; o.x = pk2(x[8 * q], x[8 * q + 1]); o.y = pk2(x[8 * q + 2], x[8 * q + 3]); o.z = pk2(x[8 * q + 4], x[8 * q + 5]); o.w = pk2(x[8 * q + 6], x[8 * q + 7]);
                *(v4u*)(UT + 8 * q) = o; }
        } else {
            bf16* W = (bf16*)((unsigned char*)a.out + DO_W) + (size_t)chunk * 8192 + cc;
#pragma unroll
            for (int i = 0; i < 64; ++i) W[i * 128] = (bf16)f2bf(x[i]);
        }
    } else {
        const int t2 = tid - 256;
        bf16* QD = (bf16*)((unsigned char*)a.out + DO_QD) + (size_t)chunk * 8192;
        bf16* KDT = (bf16*)((unsigned char*)a.out + DO_KDT) + (size_t)chunk * 8192;
#pragma unroll
        for (int m = 0; m < 4; ++m) {
            const int p = t2 + 256 * m;
            { const int i = p >> 4, k8 = (p & 15) * 8; const float e = GV[64 + i]; const LAS float* s = QS + i * 132 + k8;
              v4u o; o.x = pk2(s[0] * e, s[1] * e); o.y = pk2(s[2] * e, s[3] * e); o.z = pk2(s[4] * e, s[5] * e); o.w = pk2(s[6] * e, s[7] * e);
              *(v4u*)(QD + i * 128 + k8) = o; }
            { const int k = p >> 3, i8 = (p & 7) * 8; float v[8];
#pragma unroll
              for (int j = 0; j < 8; ++j) v[j] = KS[(i8 + j) * 132 + k] * GV[192 + i8 + j];
              v4u o; o.x = pk2(v[0], v[1]); o.y = pk2(v[2], v[3]); o.z = pk2(v[4], v[5]); o.w = pk2(v[6], v[7]);
              *(v4u*)(KDT + k * 64 + i8) = o; }
        }
    }
    __syncthreads();
}

__device__ __forceinline__ void kn_item(const Args& a, int item) {
    const int tid = threadIdx.x, lane = tid & 63, wave = tid >> 6;
    const bf16* proj = (const bf16*)(a.ws + WS_PROJ); bf16* KN = (bf16*)(a.ws + WS_KN);
    const float g0 = a.in[6][2 * lane], g1 = a.in[6][2 * lane + 1];
    for (int rr = 0; rr < 16; ++rr) {
        const int t = item * 128 + wave * 16 + rr;
        const unsigned u = *(const unsigned*)(proj + (size_t)t * PW + C_AKV + 2 * lane);
        const float v0 = bflo(u), v1 = bfhi(u);
        const float inv = rsqrtf(wave_sum(v0 * v0 + v1 * v1) * (1.f / 128.f) + EPS);
        *(unsigned*)(KN + (size_t)t * 128 + 2 * lane) = pk2(v0 * inv * g0, v1 * inv * g1);
    }
}

__device__ __forceinline__ unsigned sortable(float f) { const unsigned u = __float_as_uint(f + 0.f); return (u & 0x80000000u) ? ~u : (u | 0x80000000u); }
template <int NS> __device__ __forceinline__ void topk_select(const LAS float* row, int n, int lane, unsigned short* out) {
    unsigned key[NS];
#pragma unroll
    for (int s = 0; s < NS; ++s) { const int idx = s * 64 + lane; key[s] = (idx < n) ? sortable(row[idx]) : 0u; }
    unsigned thr = 0u;
    for (int bit = 31; bit >= 0; --bit) {
        const unsigned cand = thr | (1u << bit);
        int cnt = 0;
#pragma unroll
        for (int s = 0; s < NS; ++s) { cnt += __builtin_popcountll(__builtin_amdgcn_ballot_w64(key[s] >= cand)); if ((s & 7) == 7) __builtin_amdgcn_sched_barrier(0); }
        if (cnt >= 256) thr = cand;
    }
    int cgt = 0;
#pragma unroll
    for (int s = 0; s < NS; ++s) { cgt += __builtin_popcountll(__builtin_amdgcn_ballot_w64(key[s] > thr)); if ((s & 7) == 7) __builtin_amdgcn_sched_barrier(0); }
    const int need_eq = 256 - cgt;
    const unsigned long long ltmask = (1ull << lane) - 1ull;
    int pos_out = 0, eq_seen = 0;
#pragma unroll
    for (int s = 0; s < NS; ++s) {
        const bool gt = key[s] > thr, eq = key[s] == thr;
        const unsigned long long meq = __builtin_amdgcn_ballot_w64(eq);
        const bool take = gt || (eq && (eq_seen + __builtin_popcountll(meq & ltmask) < need_eq));
        const unsigned long long mt = __builtin_amdgcn_ballot_w64(take);
        if (take) out[pos_out + __builtin_popcountll(mt & ltmask)] = (unsigned short)(s * 64 + lane);
        pos_out += __builtin_popcountll(mt); eq_seen += __builtin_popcountll(meq);
        __builtin_amdgcn_sched_barrier(0);
    }
}
__device__ __forceinline__ void indexer_item(const Args& a, LAS unsigned char* lds, int b, int qblk) {
    const int tid = threadIdx.x, lane = tid & 63, wave = __builtin_amdgcn_readfirstlane(tid >> 6);
    const bf16* proj = (const bf16*)(a.ws + WS_PROJ);
    unsigned short* SEL = (unsigned short*)(a.ws + WS_SEL);
    LAS float* SC = (LAS float*)lds;
    const int p0 = qblk * 8;
    const int r = lane & 31, hh = lane >> 5;
    const size_t rowb = (size_t)b * SEQ;
    if (p0 + 7 >= 256) {
        bf16x8 af[4];
        { const bf16* qp = proj + (rowb + p0 + (r & 7)) * PW + C_IQ + (r >> 3) * 64 + 32 * hh;
#pragma unroll
          for (int s = 0; s < 4; ++s) af[s] = *(const bf16x8*)(qp + 8 * s); }
        float wq[4][4];
#pragma unroll
        for (int i = 0; i < 4; ++i)
#pragma unroll
            for (int hd = 0; hd < 4; ++hd) wq[i][hd] = bf1(proj[(rowb + p0 + 4 * hh + i) * PW + C_IW + hd]) * 0.0625f;
        const int ntiles = (p0 + 7) / 32 + 1;
        for (int kt = wave; kt < ntiles; kt += 8) {
            const bf16* kp = proj + (rowb + kt * 32 + r) * PW + C_IK + 32 * hh;
            bf16x8 bfr[4];
#pragma unroll
            for (int s = 0; s < 4; ++s) bfr[s] = *(const bf16x8*)(kp + 8 * s);
            f32x16 acc;
#pragma unroll
            for (int i = 0; i < 16; ++i) acc[i] = 0.f;
#pragma unroll
            for (int s = 0; s < 4; ++s) acc = __builtin_amdgcn_mfma_f32_32x32x16_bf16(af[s], bfr[s], acc, 0, 0, 0);
#pragma unroll
            for (int i = 0; i < 4; ++i) {
                float s = 0.f;
#pragma unroll
                for (int hd = 0; hd < 4; ++hd) s += wq[i][hd] * fmaxf(acc[i + 4 * hd], 0.f);
                SC[(4 * hh + i) * 4096 + kt * 32 + r] = s;
            }
        }
    }
    __syncthreads();
    {
        const int pos = p0 + wave, n = pos + 1;
        unsigned short* out = SEL + (rowb + pos) * 256;
        if (n <= 256) {
#pragma unroll
            for (int q = 0; q < 4; ++q) { const int j = lane + 64 * q; out[j] = (unsigned short)((j < n) ? j : 0xFFFF); }
        } else {
            const LAS float* row = SC + wave * 4096;
            const int nslots = (n + 63) >> 6;
            if (nslots <= 16) topk_select<16>(row, n, lane, out);
            else if (nslots <= 32) topk_select<32>(row, n, lane, out);
            else if (nslots <= 48) topk_select<48>(row, n, lane, out);
            else topk_select<64>(row, n, lane, out);
        }
    }
    __syncthreads();
}

__device__ __forceinline__ void phase3(const Args& a, LAS unsigned char* lds) {
    const int bid = blockIdx.x, G = gridDim.x;
    for (int it = bid; it < 6400; it += G) {
#ifndef P3_MASK
#define P3_MASK 7
#endif
        if (it < 2048) { if (P3_MASK & 1) gdn_prep_item(a, lds, it); }
        else if (it < 6144) { if (P3_MASK & 2) { const int j = it - 2048, i = j >> 8, c = j & 255; indexer_item(a, lds, i >> 1, (i & 1) ? 511 - c : c); } }
        else { if (P3_MASK & 4) kn_item(a, it - 6144); }
    }
}

constexpr int SC_ST = 0, SC_VNT = 34816;
__device__ __forceinline__ v2u pack4(float a, float b, float c, float d) { v2u o; o.x = pk2(a, b); o.y = pk2(c, d); return o; }
__device__ __forceinline__ void gdn_scan(const Args& a, LAS unsigned char* lds, int bh) {
    const int tid = threadIdx.x, lane = tid & 63, w = __builtin_amdgcn_readfirstlane(tid >> 6), r = lane & 15, g = lane >> 4;
    const int b = bh >> 2, h = bh & 3;
    LAS bf16* ST = (LAS bf16*)(lds + SC_ST); LAS bf16* VNT = (LAS bf16*)(lds + SC_VNT);
    const bf16* proj = (const bf16*)(a.ws + WS_PROJ); bf16* yab = (bf16*)(a.ws + WS_YAB);
    const float* GL = (const float*)(a.ws + WS_GL);
    for (int i = tid; i < 34816 / 4; i += 512) ((LAS unsigned*)ST)[i] = 0u;
    f32x4 S[8];
#pragma unroll
    for (int vt = 0; vt < 8; ++vt) S[vt] = (f32x4){0.f, 0.f, 0.f, 0.f};
    float gain[8];
#pragma unroll
    for (int vt = 0; vt < 8; ++vt) gain[vt] = a.in[11][16 * vt + r];
    __syncthreads();
    const int ct = w & 3;
    for (int n = 0; n < 64; ++n) {
        const int chunk = bh * 64 + n;
        const bf16* Wc = (const bf16*)((const unsigned char*)a.out + DO_W) + (size_t)chunk * 8192;
        const bf16* QDc = (const bf16*)((const unsigned char*)a.out + DO_QD) + (size_t)chunk * 8192;
        const bf16* KDTc = (const bf16*)((const unsigned char*)a.out + DO_KDT) + (size_t)chunk * 8192;
        const bf16* UTc = (const bf16*)((const unsigned char*)a.out + DO_UT) + (size_t)chunk * 8192;
        const bf16* Ac = (const bf16*)(a.ws + WS_GA) + (size_t)chunk * 4096;
        const float gl = GL[chunk];
        const bf16* X = (w < 4) ? Wc : QDc;
        f32x4 acc[8];
#pragma unroll
        for (int vt = 0; vt < 8; ++vt) acc[vt] = (f32x4){0.f, 0.f, 0.f, 0.f};
#pragma unroll
        for (int ks = 0; ks < 4; ++ks) {
            const bf16x8 af = *(const bf16x8*)(X + (16 * ct + r) * 128 + 32 * ks + 8 * g);
#pragma unroll
            for (int vt = 0; vt < 8; ++vt) {
                const bf16x8 bfr = *(const LAS bf16x8*)(ST + (16 * vt + r) * 136 + 32 * ks + 8 * g);
                acc[vt] = __builtin_amdgcn_mfma_f32_16x16x32_bf16(af, bfr, acc[vt], 0, 0, 0);
            }
        }
        if (w < 4) {
#pragma unroll
            for (int vt = 0; vt < 8; ++vt) {
                const v2u uu = *(const v2u*)(UTc + (16 * vt + r) * 64 + 16 * ct + 4 * g);
                const v2u o = pack4(bflo(uu.x) - acc[vt][0], bfhi(uu.x) - acc[vt][1], bflo(uu.y) - acc[vt][2], bfhi(uu.y) - acc[vt][3]);
                *(LAS v2u*)(VNT + (16 * vt + r) * 72 + 16 * ct + 4 * g) = o;
            }
        }
        __syncthreads();
        bf16x8 vb[2][8];
#pragma unroll
        for (int ks = 0; ks < 2; ++ks)
#pragma unroll
            for (int vt = 0; vt < 8; ++vt) vb[ks][vt] = *(const LAS bf16x8*)(VNT + (16 * vt + r) * 72 + 32 * ks + 8 * g);
        if (w >= 4) {
#pragma unroll
            for (int ks = 0; ks < 2; ++ks) {
                const bf16x8 af = *(const bf16x8*)(Ac + (16 * ct + r) * 64 + 32 * ks + 8 * g);
#pragma unroll
                for (int vt = 0; vt < 8; ++vt) acc[vt] = __builtin_amdgcn_mfma_f32_16x16x32_bf16(af, vb[ks][vt], acc[vt], 0, 0, 0);
            }
            float inv[4];
#pragma unroll
            for (int rg = 0; rg < 4; ++rg) {
                float ss = 0.f;
#pragma unroll
                for (int vt = 0; vt < 8; ++vt) ss += acc[vt][rg] * acc[vt][rg];
                ss += __shfl_xor(ss, 1); ss += __shfl_xor(ss, 2); ss += __shfl_xor(ss, 4); ss += __shfl_xor(ss, 8);
                inv[rg] = rsqrtf(ss * (1.f / 128.f) + EPS);
            }
#pragma unroll
            for (int rg = 0; rg < 4; ++rg) {
                const size_t t = (size_t)b * SEQ + n * 64 + 16 * ct + 4 * g + rg;
#pragma unroll
                for (int vt = 0; vt < 8; ++vt) {
                    const float z = bf1(proj[t * PW + C_BZ + h * 128 + 16 * vt + r]);
                    yab[t * YW + 1024 + h * 128 + 16 * vt + r] = (bf16)f2bf(acc[vt][rg] * inv[rg] * gain[vt] * silu_f(z));
                }
            }
        }
#pragma unroll
        for (int vt = 0; vt < 8; ++vt) S[vt] = S[vt] * gl;
#pragma unroll
        for (int ks = 0; ks < 2; ++ks) {
            const bf16x8 af = *(const bf16x8*)(KDTc + (16 * w + r) * 64 + 32 * ks + 8 * g);
#pragma unroll
            for (int vt = 0; vt < 8; ++vt) S[vt] = __builtin_amdgcn_mfma_f32_16x16x32_bf16(af, vb[ks][vt], S[vt], 0, 0, 0);
        }
#pragma unroll
        for (int vt = 0; vt < 8; ++vt)
            *(LAS v2u*)(ST + (16 * vt + r) * 136 + 16 * w + 4 * g) = pack4(S[vt][0], S[vt][1], S[vt][2], S[vt][3]);
        __syncthreads();
    }
}

__device__ __forceinline__ void attn_query(const Args& a, LAS float* qs, LAS float* P, int t, int lane) {
    const bf16* proj = (const bf16*)(a.ws + WS_PROJ); const bf16* KN = (const bf16*)(a.ws + WS_KN);
    const unsigned short* SEL = (const unsigned short*)(a.ws + WS_SEL); bf16* yab = (bf16*)(a.ws + WS_YAB);
    const int b = t >> 12, pos = t & 4095;
    const bf16* knb = KN + (size_t)b * SEQ * 128;
    int idx[4]; bool valid[4];
#pragma unroll
    for (int q = 0; q < 4; ++q) { const int v = SEL[(size_t)t * 256 + lane + 64 * q]; valid[q] = (v != 0xFFFF); idx[q] = valid[q] ? v : 0; }
    {
        const float g0 = a.in[5][2 * lane], g1 = a.in[5][2 * lane + 1];
#pragma unroll
        for (int hd = 0; hd < 8; ++hd) {
            const unsigned u = *(const unsigned*)(proj + (size_t)t * PW + C_AQ + hd * 128 + 2 * lane);
            const float v0 = bflo(u), v1 = bfhi(u);
            const float inv = rsqrtf(wave_sum(v0 * v0 + v1 * v1) * (1.f / 128.f) + EPS) * 0.08838834764831845f;
            qs[hd * 128 + 2 * lane] = v0 * inv * g0; qs[hd * 128 + 2 * lane + 1] = v1 * inv * g1;
        }
    }
    LDS_WAIT();
    float s[4][8];
#pragma unroll
    for (int q = 0; q < 4; ++q)
#pragma unroll
        for (int hd = 0; hd < 8; ++hd) s[q][hd] = 0.f;
#pragma unroll 2
    for (int dc = 0; dc < 16; ++dc) {
        float kf[4][8];
#pragma unroll
        for (int q = 0; q < 4; ++q) { const v4u kr = *(const v4u*)(knb + (size_t)idx[q] * 128 + dc * 8);
            kf[q][0] = bflo(kr.x); kf[q][1] = bfhi(kr.x); kf[q][2] = bflo(kr.y); kf[q][3] = bfhi(kr.y); kf[q][4] = bflo(kr.z); kf[q][5] = bfhi(kr.z); kf[q][6] = bflo(kr.w); kf[q][7] = bfhi(kr.w); }
#pragma unroll
        for (int hd = 0; hd < 8; ++hd) {
            const f32x4 qa = *(const LAS f32x4*)(qs + hd * 128 + dc * 8), qb = *(const LAS f32x4*)(qs + hd * 128 + dc * 8 + 4);
#pragma unroll
            for (int q = 0; q < 4; ++q)
                s[q][hd] += (kf[q][0] * qa.x + kf[q][1] * qa.y) + (kf[q][2] * qa.z + kf[q][3] * qa.w) + (kf[q][4] * qb.x + kf[q][5] * qb.y) + (kf[q][6] * qb.z + kf[q][7] * qb.w);
        }
    }
#pragma unroll
    for (int hd = 0; hd < 8; ++hd) {
        const float slope = exp2f(-(float)(hd + 1));
        float m = -INFINITY;
#pragma unroll
        for (int q = 0; q < 4; ++q) { s[q][hd] = valid[q] ? (s[q][hd] - slope * (float)(pos - idx[q])) : -INFINITY; m = fmaxf(m, s[q][hd]); }
        m = wave_max(m);
        float l = 0.f;
#pragma unroll
        for (int q = 0; q < 4; ++q) { s[q][hd] = valid[q] ? expf(s[q][hd] - m) : 0.f; l += s[q][hd]; }
        l = 1.f / wave_sum(l);
#pragma unroll
        for (int q = 0; q < 4; ++q) P[(lane + 64 * q) * 8 + hd] = s[q][hd] * l;
    }
    LDS_WAIT();
    float o0[8], o1[8];
#pragma unroll
    for (int hd = 0; hd < 8; ++hd) { o0[hd] = 0.f; o1[hd] = 0.f; }
    const int cnt = (pos + 1 < 256) ? pos + 1 : 256;
#pragma unroll
    for (int q = 0; q < 4; ++q) {
        const int jn = (cnt - 64 * q) < 64 ? (cnt - 64 * q) : 64;
#pragma unroll 4
        for (int jj = 0; jj < jn; ++jj) {
            const int kidx = __shfl(idx[q], jj);
            const unsigned kv = *(const unsigned*)(knb + (size_t)kidx * 128 + 2 * lane);
            const float k0 = bflo(kv), k1 = bfhi(kv);
            const f32x4 pa = *(const LAS f32x4*)(P + (64 * q + jj) * 8), pb = *(const LAS f32x4*)(P + (64 * q + jj) * 8 + 4);
            o0[0] += pa.x * k0; o1[0] += pa.x * k1; o0[1] += pa.y * k0; o1[1] += pa.y * k1; o0[2] += pa.z * k0; o1[2] += pa.z * k1; o0[3] += pa.w * k0; o1[3] += pa.w * k1;
            o0[4] += pb.x * k0; o1[4] += pb.x * k1; o0[5] += pb.y * k0; o1[5] += pb.y * k1; o0[6] += pb.z * k0; o1[6] += pb.z * k1; o0[7] += pb.w * k0; o1[7] += pb.w * k1;
        }
    }
#pragma unroll
    for (int hd = 0; hd < 8; ++hd) *(unsigned*)(yab + (size_t)t * YW + hd * 128 + 2 * lane) = pk2(o0[hd], o1[hd]);
    LDS_WAIT();
}

__device__ __forceinline__ void phase4(const Args& a, LAS unsigned char* lds) {
    const int bid = blockIdx.x, G = gridDim.x, tid = threadIdx.x, lane = tid & 63, wave = tid >> 6;
    const int nscan = (G >= 64) ? 32 : 0;
    if (nscan && bid < 32) { gdn_scan(a, lds, bid); return; }
    if (!nscan) { for (int bh = bid; bh < 32; bh += G) gdn_scan(a, lds, bh); __syncthreads(); }
    LAS float* qs = (LAS float*)(lds + wave * 12288); LAS float* P = qs + 1024;
    const int gw = (bid - nscan) * 8 + wave, NGW = (G - nscan) * 8;
    for (int t = gw; t < T_TOK; t += NGW) attn_query(a, qs, P, t, lane);
}

#define INS16P(L, v_) do { float _x = (v_); \
    _Pragma("unroll") for (int _k = 0; _k < 16; ++_k) { const float _h = __builtin_fmaxf(L[_k], _x); _x = __builtin_fminf(L[_k], _x); L[_k] = _h; } } while (0)
__device__ __forceinline__ float packf(float v, unsigned id, unsigned mask) { return __uint_as_float((__float_as_uint(v) & ~mask) | id); }

__device__ __forceinline__ void peer_route_unit(const Args& a, LAS float* SC, int tt, int p, int lane) {
    const bf16* query = (const bf16*)(a.ws + WS_QUERY); const bf16* subk = (const bf16*)(a.ws + WS_SUBK);
    int* expid = (int*)(a.ws + WS_EXPID); float* gate = (float*)(a.ws + WS_GATE);
    const int r = lane & 15, g = lane >> 4;
    const int tok = lane & 31, ch = lane >> 5;
    float L1[16], L2[16];
#pragma unroll
    for (int half = 0; half < 2; ++half) {
#pragma unroll 1
        for (int mt = 0; mt < 2; ++mt) {
            const bf16* qp = query + (size_t)(tt * 32 + mt * 16 + r) * 2048 + p * 256 + half * 128 + 8 * g;
            bf16x8 af[4];
#pragma unroll
            for (int ks = 0; ks < 4; ++ks) af[ks] = *(const bf16x8*)(qp + 32 * ks);
#pragma unroll 2
            for (int nt = 0; nt < 8; ++nt) {
                const bf16* kp = subk + (size_t)((p * 2 + half) * 128 + nt * 16 + r) * 128 + 8 * g;
                f32x4 acc = (f32x4){0.f, 0.f, 0.f, 0.f};
#pragma unroll
                for (int ks = 0; ks < 4; ++ks) acc = __builtin_amdgcn_mfma_f32_16x16x32_bf16(af[ks], *(const bf16x8*)(kp + 32 * ks), acc, 0, 0, 0);
#pragma unroll
                for (int rg = 0; rg < 4; ++rg) SC[(mt * 16 + 4 * g + rg) * 132 + nt * 16 + r] = acc[rg];
            }
        }
        LDS_WAIT();
        float L[16];
#pragma unroll
        for (int k = 0; k < 16; ++k) L[k] = -INFINITY;
        for (int c4 = 0; c4 < 16; ++c4) {
            const f32x4 v = *(const LAS f32x4*)(SC + tok * 132 + 64 * ch + 4 * c4);
            const unsigned n0 = 64 * ch + 4 * c4;
            INS16P(L, packf(v.x, n0, 127u)); INS16P(L, packf(v.y, n0 + 1, 127u)); INS16P(L, packf(v.z, n0 + 2, 127u)); INS16P(L, packf(v.w, n0 + 3, 127u));
        }
#pragma unroll
        for (int k = 0; k < 16; ++k) { const float pv = __shfl(L[k], tok + 32); if (ch == 0) INS16P(L, pv); }
        if (half == 0) {
#pragma unroll
            for (int k = 0; k < 16; ++k) L1[k] = L[k];
        } else {
#pragma unroll
            for (int k = 0; k < 16; ++k) L2[k] = L[k];
        }
        LDS_WAIT();
    }
    float V1[16], V2[16];
#pragma unroll
    for (int k = 0; k < 16; ++k) { V1[k] = __uint_as_float(__float_as_uint(L1[k]) & ~127u); V2[k] = __uint_as_float(__float_as_uint(L2[k]) & ~127u); }
    float C[16];
#pragma unroll
    for (int k = 0; k < 16; ++k) C[k] = -INFINITY;
#pragma unroll
    for (int i = 0; i < 16; ++i)
#pragma unroll
        for (int j = 0; j < 16; ++j)
            if ((i + 1) * (j + 1) <= 16) INS16P(C, packf(V1[i] + V2[j], (unsigned)(i * 16 + j), 255u));
    if (ch == 0) {
        float e[16], sum = 0.f; int ex[16];
        const float c0 = __uint_as_float(__float_as_uint(C[0]) & ~255u);
#pragma unroll
        for (int k = 0; k < 16; ++k) {
            const unsigned cb = __float_as_uint(C[k]); const int ci = (cb >> 4) & 15, cj = cb & 15;
            int i1 = 0, i2 = 0;
#pragma unroll
            for (int m = 0; m < 16; ++m) { i1 = (ci == m) ? (int)(__float_as_uint(L1[m]) & 127u) : i1; i2 = (cj == m) ? (int)(__float_as_uint(L2[m]) & 127u) : i2; }
            ex[k] = i1 * 128 + i2;
            e[k] = expf(__uint_as_float(cb & ~255u) - c0); sum += e[k];
        }
        const float inv = 1.f / sum;
        const size_t base = ((size_t)(tt * 32 + tok) * 8 + p) * 16;
#pragma unroll
        for (int q = 0; q < 4; ++q) {
            *(v4u*)(expid + base + 4 * q) = (v4u){(unsigned)ex[4 * q], (unsigned)ex[4 * q + 1], (unsigned)ex[4 * q + 2], (unsigned)ex[4 * q + 3]};
            *(f32x4*)(gate + base + 4 * q) = (f32x4){e[4 * q] * inv, e[4 * q + 1] * inv, e[4 * q + 2] * inv, e[4 * q + 3] * inv};
        }
    }
}
__device__ __forceinline__ void phase8(const Args& a, LAS unsigned char* lds) {
    const int tid = threadIdx.x, lane = tid & 63, wave = tid >> 6;
    LAS float* SC = (LAS float*)(lds + wave * 16896);
    const int gw = blockIdx.x * 8 + wave, NGW = gridDim.x * 8;
    for (int u = gw; u < 1024 * 8; u += NGW) peer_route_unit(a, SC, u >> 3, u & 7, lane);
}

__device__ __forceinline__ void cvt8(const v4u u, float* f) { f[0] = bflo(u.x); f[1] = bfhi(u.x); f[2] = bflo(u.y); f[3] = bfhi(u.y); f[4] = bflo(u.z); f[5] = bfhi(u.z); f[6] = bflo(u.w); f[7] = bfhi(u.w); }
__device__ __forceinline__ void phase9(const Args& a) {
    const int tid = threadIdx.x, lane = tid & 63, wave = tid >> 6;
    const int gw = blockIdx.x * 8 + wave, NGW = gridDim.x * 8;
    const bf16* H = (const bf16*)(a.ws + WS_H); const bf16* UT = (const bf16*)(a.ws + WS_UT); const bf16* VT = (const bf16*)(a.ws + WS_VT);
    const int* expid = (const int*)(a.ws + WS_EXPID); const float* gate = (const float*)(a.ws + WS_GATE);
    const float* mod = (const float*)(a.ws + WS_MOD);
    for (int t = gw; t < T_TOK; t += NGW) {
        const int b = t >> 12;
        float hf[16];
        cvt8(*(const v4u*)(H + (size_t)t * DM + 8 * lane), hf); cvt8(*(const v4u*)(H + (size_t)t * DM + 512 + 8 * lane), hf + 8);
        int eid[2]; float gt[2], act[2];
#pragma unroll
        for (int q = 0; q < 2; ++q) { eid[q] = expid[(size_t)t * 128 + lane + 64 * q]; gt[q] = gate[(size_t)t * 128 + lane + 64 * q]; act[q] = 0.f; }
#pragma unroll
        for (int q = 0; q < 2; ++q) {
            for (int j0 = 0; j0 < 64; j0 += 8) {
                v4u ua[8], ub[8];
#pragma unroll
                for (int jj = 0; jj < 8; ++jj) { const int e = __shfl(eid[q], j0 + jj); const bf16* row = UT + (size_t)e * DM; ua[jj] = *(const v4u*)(row + 8 * lane); ub[jj] = *(const v4u*)(row + 512 + 8 * lane); }
#pragma unroll
                for (int jj = 0; jj < 8; ++jj) {
                    float f[16]; cvt8(ua[jj], f); cvt8(ub[jj], f + 8);
                    float d = 0.f;
#pragma unroll
                    for (int k = 0; k < 16; ++k) d += f[k] * hf[k];
                    d = wave_sum(d);
                    const float ge = 0.5f * d * (1.f + erff(d * 0.70710678118654752f));
                    if (lane == j0 + jj) act[q] = ge * gt[q];
                }
            }
        }
        float y[16];
#pragma unroll
        for (int k = 0; k < 16; ++k) y[k] = 0.f;
#pragma unroll
        for (int q = 0; q < 2; ++q) {
            for (int j0 = 0; j0 < 64; j0 += 8) {
                v4u va[8], vb[8]; float aj[8];
#pragma unroll
                for (int jj = 0; jj < 8; ++jj) { const int e = __shfl(eid[q], j0 + jj); aj[jj] = __shfl(act[q], j0 + jj); const bf16* row = VT + (size_t)e * DM; va[jj] = *(const v4u*)(row + 8 * lane); vb[jj] = *(const v4u*)(row + 512 + 8 * lane); }
#pragma unroll
                for (int jj = 0; jj < 8; ++jj) {
                    float f[16]; cvt8(va[jj], f); cvt8(vb[jj], f + 8);
#pragma unroll
                    for (int k = 0; k < 16; ++k) y[k] += aj[jj] * f[k];
                }
            }
        }
        float* orow = a.out + (size_t)t * DM; const float* g2 = mod + b * 6144 + 5120;
#pragma unroll
        for (int c = 0; c < 2; ++c)
#pragma unroll
            for (int q4 = 0; q4 < 2; ++q4) {
                const int col = 512 * c + 8 * lane + 4 * q4;
                const f32x4 xv = *(const f32x4*)(orow + col), gv = *(const f32x4*)(g2 + col);
                const f32x4 yv = (f32x4){y[8 * c + 4 * q4], y[8 * c + 4 * q4 + 1], y[8 * c + 4 * q4 + 2], y[8 * c + 4 * q4 + 3]};
                *(f32x4*)(orow + col) = xv + gv * yv;
            }
    }
}

__global__ void __launch_bounds__(512, 2) mega_fwd(Args a) {
    extern __shared__ __attribute__((aligned(16))) unsigned char lds_raw[];
    LAS unsigned char* lds = (LAS unsigned char*)lds_raw;
    asm volatile("" : "+v"(lds));
    cg::grid_group grid = cg::this_grid();
    unsigned char* ws = a.ws;
    const int lo = a.ph_lo, hi = a.ph_hi;
#ifndef PH_MASK
#define PH_MASK 0x3ff
#endif
#define IN(k) (((PH_MASK >> (k)) & 1) && lo <= (k) && (k) < hi)
#define SEAM(k) do { if (IN(k) && IN((k) + 1)) grid.sync(); } while (0)
    if (IN(0)) { phase0(a, lds); } SEAM(0);
    if (IN(1)) { phase_norm(a.in[0], (const float*)(ws + WS_MOD), 0, 1024, (bf16*)(ws + WS_H)); } SEAM(1);
    if (IN(2)) {
        pg8::Gemm g{(const pg8::bf16_t*)(ws + WS_H), (const pg8::bf16_t*)(ws + WS_WIN), T_TOK, PW, DM}; pg8::StaticOrder S; S.init(T_TOK, PW, gridDim.x, blockIdx.x);
        EpiBf E{(bf16*)(ws + WS_PROJ), PW};
        pg8::gemm_phase<EpiBf, pg8::StaticOrder>(lds, g, S, E, nullptr);
    } SEAM(2);
    if (IN(3)) { phase3(a, lds); } SEAM(3);
    if (IN(4)) { phase4(a, lds); } SEAM(4);
    if (IN(5)) {
        pg8::Gemm g{(const pg8::bf16_t*)(ws + WS_YAB), (const pg8::bf16_t*)(ws + WS_BT2), T_TOK, DM, YW}; pg8::StaticOrder S; S.init(T_TOK, DM, gridDim.x, blockIdx.x);
        EpiX1 E{a.in[0], a.out, (const float*)(ws + WS_MOD)};
        pg8::gemm_phase<EpiX1, pg8::StaticOrder>(lds, g, S, E, nullptr);
    } SEAM(5);
    if (IN(6)) { phase_norm(a.out, (const float*)(ws + WS_MOD), 3072, 4096, (bf16*)(ws + WS_H)); } SEAM(6);
    if (IN(7)) {
        pg8::Gemm g{(const pg8::bf16_t*)(ws + WS_H), (const pg8::bf16_t*)(ws + WS_WQ), T_TOK, 2048, DM}; pg8::StaticOrder S; S.init(T_TOK, 2048, gridDim.x, blockIdx.x);
        EpiBf E{(bf16*)(ws + WS_QUERY), 2048};
        pg8::gemm_phase<EpiBf, pg8::StaticOrder>(lds, g, S, E, nullptr);
    } SEAM(7);
    if (IN(8)) { phase8(a, lds); } SEAM(8);
    if (IN(9)) { phase9(a); }
#undef IN
#undef SEAM
}

#ifndef MK_N_LAUNCHES
#define MK_N_LAUNCHES 1
#endif
extern "C" void kernel_launch(void* const* d_in, const int* in_sizes, int n_in, void* d_out, int out_size, void* d_ws, size_t ws_size, hipStream_t stream) {
    static int grid = 0;
    if (grid == 0) {
        int dev = 0, cus = 0, per_cu = 0;
        hipGetDevice(&dev);
        hipDeviceGetAttribute(&cus, hipDeviceAttributeMultiprocessorCount, dev);
        hipFuncSetAttribute((const void*)mega_fwd, hipFuncAttributeMaxDynamicSharedMemorySize, LDS_BYTES);
        hipOccupancyMaxActiveBlocksPerMultiprocessor(&per_cu, (const void*)mega_fwd, 512, LDS_BYTES);
        if (per_cu < 1) { fprintf(stderr, "kernel_launch: occupancy query says %d blocks per CU\n", per_cu); per_cu = 1; }
        grid = cus * 1;
        if (n_in != 17 || ws_size < WS_END) fprintf(stderr, "kernel_launch: unexpected n_in %d / ws_size %zu\n", n_in, ws_size);
    }
    Args a{};
    for (int i = 0; i < 17; ++i) a.in[i] = (const float*)d_in[i];
    a.out = (float*)d_out; a.ws = (unsigned char*)d_ws;
#if MK_N_LAUNCHES == 1
    a.ph_lo = 0; a.ph_hi = 10;
    void* args[] = {&a};
    hipError_t e = hipLaunchCooperativeKernel((const void*)mega_fwd, dim3(grid), dim3(512), args, LDS_BYTES, stream);
    if (e != hipSuccess) fprintf(stderr, "cooperative launch failed: %s (grid %d)\n", hipGetErrorString(e), grid);
#else
    for (int p = 0; p < 10; ++p) { a.ph_lo = p; a.ph_hi = p + 1; hipLaunchKernelGGL(mega_fwd, dim3(grid), dim3(512), LDS_BYTES, stream, a); }
#endif
}
```

```cpp
#include <hip/hip_runtime.h>
#include <hip/hip_cooperative_groups.h>
#include <cstdio>
#include <cstdint>
namespace cg = cooperative_groups;
namespace pg8 {
#define PG8_LAS __attribute__((address_space(3)))
typedef unsigned short bf16_t;
typedef short bf16x8 __attribute__((ext_vector_type(8)));
typedef float f32x4 __attribute__((ext_vector_type(4)));
typedef unsigned u32x4 __attribute__((ext_vector_type(4)));
constexpr int BM = 256, BK = 64, HALF = 128, HTB = HALF * BK * 2  , STAGE_BYTES = 8 * HTB, NXCD = 8, WGM = 8;

__host__ __device__ __forceinline__ int lds_byte(int r, int c) { const int st = (r >> 4) * 2 + (c >> 5), rr = r & 15, cc = c & 31, ob = rr * 64 + cc * 2; return st * 1024 + (ob ^ (((ob >> 9) & 1) << 5)); }
__host__ __device__ __forceinline__ void stage_rc(int b, int& R, int& C) { const int st = b / 1024, sb = b % 1024, swz = sb ^ (((sb >> 9) & 1) << 5); R = (st >> 1) * 16 + swz / 64; C = (st & 1) * 32 + (swz % 64) / 2; }
__host__ __device__ __forceinline__ int perm32(int rho) { const int n = rho >> 4, i = rho & 15; return 8 * (i >> 2) + 4 * n + (i & 3); }

struct Unit { int pm, pn; };
struct Gemm { const bf16_t* A; const bf16_t* Bt; int M, N, K; };

struct StaticOrder {
    int nM, nN, nwg, G, c;
    __host__ __device__ void init(int M, int N, int G_, int c_) { nM = M / BM; nN = N / BM; nwg = nM * nN; G = G_; c = c_; }
    __host__ __device__ bool next(int i, Unit& u) const {
        const long L = (long)i * G + c; if (L >= nwg) return false;
        int wgid = (int)L; { const int q = nwg / NXCD, r = nwg % NXCD, xcd = wgid % NXCD, off = wgid / NXCD; wgid = (xcd < r ? xcd * (q + 1) : r * (q + 1) + (xcd - r) * q) + off; }
        const int nig = WGM * nN, gid = wgid / nig, fm = gid * WGM, gsz = (nM - fm) < WGM ? (nM - fm) : WGM;
        u.pm = fm + ((wgid % nig) % gsz); u.pn = (wgid % nig) / gsz; return true;
    }
    __device__ __forceinline__ void a_ready(const Unit&) const {}
    __device__ __forceinline__ void done(const Unit&) const {}
};
__device__ __forceinline__ unsigned cvt_pk_bf16(float lo, float hi) { unsigned r; asm volatile("v_cvt_pk_bf16_f32 %0, %1, %2" : "=v"(r) : "v"(lo), "v"(hi)); return r; }
template <class Epi, class Sched, bool STAMP = false>
__device__ __forceinline__ void gemm_phase(PG8_LAS unsigned char* lds, const Gemm g, const Sched& S, const Epi& E, unsigned long long* stamps) {
    const int tid = threadIdx.x, wid = __builtin_amdgcn_readfirstlane(tid >> 6), lane = tid & 63, wr = wid >> 2, wc = wid & 3, fr = lane & 15, fq = lane >> 4;
    const int K = g.K, nt = K / BK;
    int ts_lo = 0, ts_hi = 0, nts = 0; const unsigned long long rt_entry = STAMP ? (unsigned long long)wall_clock64() : 0ull;
#define PG8_STAMP() do { if (STAMP && wid == 0 && nts < 64) { const unsigned long long _c = (unsigned long long)clock64(); \
        ts_lo = (lane == nts) ? (int)(unsigned)_c : ts_lo; ts_hi = (lane == nts) ? (int)(unsigned)(_c >> 32) : ts_hi; ++nts; } } while (0)
    PG8_STAMP();
    unsigned voffA[2], voffB[2];
#pragma unroll
    for (int i = 0; i < 2; ++i) { int R, C; stage_rc(tid * 16 + i * 8192, R, C); const int Rb = Epi::PERM ? ((R & ~31) + perm32(R & 31)) : R;
        voffA[i] = (unsigned)(R * K + C) * 2u; voffB[i] = (unsigned)(Rb * K + C) * 2u; }
    const size_t kstep = (size_t)(BK * 2);
    const size_t hstep = (size_t)HALF * K * 2;
    const size_t tstep = 2 * hstep;
    const unsigned ldsw = (unsigned)wid * 1024u;
    const int aoff = lds_byte(wr * 64 + fr, fq * 8), boff = lds_byte(wc * 32 + fr, fq * 8);
#define PG8_SA(b, h) (((b) * 2 + (h)) * HTB)
#define PG8_SB(b, h) ((4 + (b) * 2 + (h)) * HTB)
#define PG8_STAGE(bufoff, gbase, voff) do { _Pragma("unroll") for (int _i = 0; _i < 2; ++_i) \
        __builtin_amdgcn_global_load_lds((const unsigned*)((const char*)(gbase) + (voff)[_i]), (PG8_LAS unsigned*)(lds + (bufoff) + ldsw + _i * 8192), 16, 0, 0); } while (0)
#define PG8_LDA(dst, b, h) do { _Pragma("unroll") for (int m = 0; m < 4; ++m) _Pragma("unroll") for (int k = 0; k < 2; ++k) dst[m][k] = *(const PG8_LAS bf16x8*)(lds + PG8_SA(b, h) + aoff + m * 2048 + k * 1024); } while (0)
#define PG8_LDB(dst, b, h) do { _Pragma("unroll") for (int n = 0; n < 2; ++n) _Pragma("unroll") for (int k = 0; k < 2; ++k) dst[n][k] = *(const PG8_LAS bf16x8*)(lds + PG8_SB(b, h) + boff + n * 2048 + k * 1024); } while (0)
#define PG8_MMA(ai, bj, At, Bt) do { __builtin_amdgcn_s_setprio(1); _Pragma("unroll") for (int m = 0; m < 4; ++m) _Pragma("unroll") for (int n = 0; n < 2; ++n) _Pragma("unroll") for (int k = 0; k < 2; ++k) \
        acc[ai][bj][m][n] = __builtin_amdgcn_mfma_f32_16x16x32_bf16(Bt[n][k], At[m][k], acc[ai][bj][m][n], 0, 0, 0); __builtin_amdgcn_s_setprio(0); } while (0)
#define PG8_WAIT_V(n) asm volatile("s_waitcnt vmcnt(" #n ")" ::: "memory")
#define PG8_WAIT_L(n) asm volatile("s_waitcnt lgkmcnt(" #n ")" ::: "memory")
#define PG8_BAR __builtin_amdgcn_s_barrier()
#define PG8_SCHED __builtin_amdgcn_sched_barrier(0)
    Unit cur, nxt; int ui = 0;
    if (!S.next(0, cur)) return;
    f32x4 acc[2][2][4][2];
#pragma unroll
    for (int a = 0; a < 2; ++a)
#pragma unroll
        for (int b = 0; b < 2; ++b)
#pragma unroll
            for (int m = 0; m < 4; ++m)
#pragma unroll
                for (int n = 0; n < 2; ++n) acc[a][b][m][n] = (f32x4){0.f, 0.f, 0.f, 0.f};
    bf16x8 At[4][2], B0[2][2], B1[2][2];
    const char* cA = (const char*)g.A + (size_t)cur.pm * tstep; const char* cB = (const char*)g.Bt + (size_t)cur.pn * tstep;
    S.a_ready(cur);
    PG8_STAGE(PG8_SB(0, 0), cB, voffB); PG8_STAGE(PG8_SA(0, 0), cA, voffA); PG8_STAGE(PG8_SB(0, 1), cB + hstep, voffB); PG8_STAGE(PG8_SA(0, 1), cA + hstep, voffA);
    if (wr == 1) PG8_BAR;
    PG8_WAIT_V(4); PG8_BAR;
    PG8_STAGE(PG8_SB(1, 0), cB + kstep, voffB); PG8_STAGE(PG8_SA(1, 0), cA + kstep, voffA); PG8_STAGE(PG8_SB(1, 1), cB + hstep + kstep, voffB);
    PG8_WAIT_V(6); PG8_BAR;
    PG8_STAMP();
    for (;;) {
        const bool has_next = S.next(ui + 1, nxt);
        const char* nA = has_next ? (const char*)g.A + (size_t)nxt.pm * tstep : cA; const char* nB = has_next ? (const char*)g.Bt + (size_t)nxt.pn * tstep : cB;
        for (int t = 0; t < nt; t += 2) {
            const bool last = (t == nt - 2);
            const char* a1 = cA + (size_t)(t + 1) * kstep;
            const char* a2 = last ? nA : cA + (size_t)(t + 2) * kstep; const char* b2 = last ? nB : cB + (size_t)(t + 2) * kstep;
            const char* a3 = a2 + kstep; const char* b3 = b2 + kstep;
            if (last && has_next) S.a_ready(nxt);
            PG8_LDB(B0, 0, 0); PG8_SCHED; PG8_LDA(At, 0, 0); PG8_STAGE(PG8_SA(1, 1), a1 + hstep, voffA);
            PG8_WAIT_L(8); PG8_BAR; PG8_WAIT_L(0); PG8_MMA(0, 0, At, B0); PG8_BAR; PG8_SCHED;
            PG8_LDB(B1, 0, 1); PG8_STAGE(PG8_SB(0, 0), b2, voffB);
            PG8_BAR; PG8_WAIT_L(0); PG8_MMA(0, 1, At, B1); PG8_BAR;
            PG8_LDA(At, 0, 1); PG8_STAGE(PG8_SA(0, 0), a2, voffA);
            PG8_BAR; PG8_WAIT_L(0); PG8_MMA(1, 0, At, B0); PG8_BAR; PG8_SCHED;
            PG8_STAGE(PG8_SB(0, 1), b2 + hstep, voffB);
            PG8_WAIT_V(6); PG8_BAR; PG8_MMA(1, 1, At, B1); PG8_BAR;
            PG8_LDB(B0, 1, 0); PG8_SCHED; PG8_LDA(At, 1, 0); PG8_STAGE(PG8_SA(0, 1), a2 + hstep, voffA);
            PG8_WAIT_L(8); PG8_BAR; PG8_WAIT_L(0); PG8_MMA(0, 0, At, B0); PG8_BAR; PG8_SCHED;
            PG8_LDB(B1, 1, 1); PG8_STAGE(PG8_SB(1, 0), b3, voffB);
            PG8_BAR; PG8_WAIT_L(0); PG8_MMA(0, 1, At, B1); PG8_BAR;
            PG8_LDA(At, 1, 1); PG8_STAGE(PG8_SA(1, 0), a3, voffA);
            PG8_BAR; PG8_WAIT_L(0); PG8_MMA(1, 0, At, B0); PG8_BAR; PG8_SCHED;
            PG8_STAGE(PG8_SB(1, 1), b3 + hstep, voffB);
            PG8_WAIT_V(6); PG8_BAR; PG8_MMA(1, 1, At, B1); PG8_BAR;
        }
        PG8_STAMP();
        if constexpr (!Epi::AFTER_DRAIN) { E(acc, cur, wr, wc, fr, fq); S.done(cur); }
        PG8_STAMP();
        if (!has_next) break;
#pragma unroll
        for (int a = 0; a < 2; ++a)
#pragma unroll
            for (int b = 0; b < 2; ++b)
#pragma unroll
                for (int m = 0; m < 4; ++m)
#pragma unroll
                    for (int n = 0; n < 2; ++n) acc[a][b][m][n] = (f32x4){0.f, 0.f, 0.f, 0.f};
        cur = nxt; cA = nA; cB = nB; ++ui;
    }
    PG8_WAIT_V(0);
    if (wr == 0) PG8_BAR;
    PG8_BAR;
    if constexpr (Epi::AFTER_DRAIN) { E.fused(acc, cur, wr, wc, fr, fq, lds, wid, lane); S.done(cur); }
    PG8_STAMP();
    if (STAMP && wid == 0) { stamps[lane] = lane < nts ? (((unsigned long long)(unsigned)ts_hi << 32) | (unsigned)ts_lo) : 0ull;
        if (lane == 62) stamps[62] = rt_entry; if (lane == 63) stamps[63] = (unsigned long long)wall_clock64(); }
#undef PG8_STAMP
#undef PG8_SA
#undef PG8_SB
#undef PG8_STAGE
#undef PG8_LDA
#undef PG8_LDB
#undef PG8_MMA
#undef PG8_WAIT_V
#undef PG8_WAIT_L
#undef PG8_BAR
#undef PG8_SCHED
}
}

#define LAS __attribute__((address_space(3)))
typedef unsigned short bf16;
typedef unsigned v4u __attribute__((ext_vector_type(4)));
typedef unsigned v2u __attribute__((ext_vector_type(2)));
typedef float f32x4 __attribute__((ext_vector_type(4)));
typedef float f32x16 __attribute__((ext_vector_type(16)));
typedef short bf16x8 __attribute__((ext_vector_type(8)));

constexpr int T_TOK = 32768, DM = 1024, SEQ = 4096, NBATCH = 8;
constexpr int PW = 3584;
constexpr int IN_W = 3532;
constexpr int C_AQ = 0, C_AKV = 1024, C_IQ = 1152, C_IK = 1408, C_IW = 1472, C_BA = 1476, C_BB = 1480, C_BQ = 1536, C_BK = 2048, C_BV = 2560, C_BZ = 3072;
constexpr int YW = 1536;
constexpr int NCHUNK = 2048;
constexpr float EPS = 1e-6f;

constexpr size_t MiB = 1u << 20;
constexpr size_t WS_CTL = 0;
constexpr size_t WS_MOD = 1 * MiB;
constexpr size_t WS_GL = WS_MOD + 256 * 1024;
constexpr size_t WS_SU = WS_MOD + 512 * 1024;
constexpr size_t WS_SV = WS_MOD + 640 * 1024;
constexpr size_t WS_WIN = 2 * MiB;
constexpr size_t WS_BT2 = 9 * MiB;
constexpr size_t WS_WQ = 12 * MiB;
constexpr size_t WS_SUBK = 16 * MiB;
constexpr size_t WS_H = 18 * MiB;
constexpr size_t WS_KN = WS_H;
constexpr size_t WS_SEL = WS_H + 8 * MiB;
constexpr size_t WS_PROJ = 82 * MiB;
constexpr size_t WS_QUERY = WS_PROJ;
constexpr size_t WS_YAB = 306 * MiB;
constexpr size_t WS_EXPID = WS_YAB;
constexpr size_t WS_GATE = WS_YAB + 16 * MiB;
constexpr size_t WS_H8 = WS_YAB + 32 * MiB;
constexpr size_t WS_HS = WS_YAB + 64 * MiB;
constexpr size_t WS_GA = 402 * MiB;
constexpr size_t WS_UT = 418 * MiB;
constexpr size_t WS_VT = 450 * MiB;
constexpr size_t WS_END = 482 * MiB;
constexpr size_t DO_W = 0, DO_QD = 32 * MiB, DO_KDT = 64 * MiB, DO_UT = 96 * MiB;

constexpr int LDS_BYTES = 147456;

struct Args { const float* in[17]; float* out; unsigned char* ws; int ph_lo, ph_hi; };

__device__ __forceinline__ unsigned pk2(float lo, float hi) { unsigned r; asm("v_cvt_pk_bf16_f32 %0, %1, %2" : "=v"(r) : "v"(lo), "v"(hi)); return r; }
__device__ __forceinline__ unsigned f2bf(float f) { return pk2(f, f) & 0xffffu; }
__device__ __forceinline__ float bflo(unsigned u) { return __uint_as_float(u << 16); }
__device__ __forceinline__ float bfhi(unsigned u) { return __uint_as_float(u & 0xffff0000u); }
__device__ __forceinline__ float bf1(bf16 b) { return __uint_as_float(((unsigned)b) << 16); }
__device__ __forceinline__ float wave_sum(float v) {
#pragma unroll
    for (int o = 1; o < 64; o <<= 1) v += __shfl_xor(v, o);
    return v;
}
__device__ __forceinline__ float wave_max(float v) {
#pragma unroll
    for (int o = 1; o < 64; o <<= 1) v = fmaxf(v, __shfl_xor(v, o));
    return v;
}
__device__ __forceinline__ float silu_f(float v) { return v / (1.f + expf(-v)); }
__device__ __forceinline__ float silu_fast(float v) { return v * __builtin_amdgcn_rcpf(1.f + __expf(-v)); }
__device__ __forceinline__ float sigmoid_f(float v) { return 1.f / (1.f + expf(-v)); }
__device__ __forceinline__ float softplus_f(float v) { return fmaxf(v, 0.f) + log1pf(expf(-fabsf(v))); }
#define LDS_WAIT() asm volatile("s_waitcnt lgkmcnt(0)" ::: "memory")

__device__ __forceinline__ int win_srccol(int n) {
    if (n < 1476) return n;
    if (n < 1480) return 3524 + (n - 1476);
    if (n < 1484) return 3528 + (n - 1480);
    if (n < 1536) return -1;
    return 1476 + (n - 1536);
}
__device__ __forceinline__ void transpose_item(const float* W, int spitch, int k0, int sc, bf16* WT, int dpitch, int drow0, int dcol0, LAS float* scr, int lane) {
#pragma unroll 8
    for (int i = 0; i < 32; ++i) { const int kk = 2 * i + (lane >> 5); scr[kk * 33 + (lane & 31)] = (sc >= 0) ? W[(size_t)(k0 + kk) * spitch + sc] : 0.f; }
    LDS_WAIT();
    const int c = lane & 7;
#pragma unroll
    for (int j = 0; j < 4; ++j) { const int n = (lane >> 3) + 8 * j; const LAS float* s = scr + (8 * c) * 33 + n;
        v4u o; o.x = pk2(s[0 * 33], s[1 * 33]); o.y = pk2(s[2 * 33], s[3 * 33]); o.z = pk2(s[4 * 33], s[5 * 33]); o.w = pk2(s[6 * 33], s[7 * 33]);
        *(v4u*)(WT + (size_t)(drow0 + n) * dpitch + dcol0 + 8 * c) = o; }
    LDS_WAIT();
}

__device__ __forceinline__ void phase0(const Args& a, LAS unsigned char* lds) {
    const int tid = threadIdx.x, lane = tid & 63, wave = tid >> 6, bid = blockIdx.x, G = gridDim.x;
    unsigned char* ws = a.ws;
#ifndef P0_REP
#define P0_REP 0
#endif
    for (int rep0_ = 0; rep0_ < 1 + (P0_REP ? 1 : 0); ++rep0_) {
    if (rep0_ == 0 || (P0_REP & 1))
    for (int item = bid; item < 192; item += G) {
        LAS float* sc = (LAS float*)lds;
        LAS float* red = sc + 8192;
        const float* c = a.in[1];
        for (int i = tid; i < 8192; i += 512) sc[i] = silu_f(c[i]);
        __syncthreads();
        const int cc = tid & 31, kg = tid >> 5;
        const float* w = a.in[2] + item * 32 + cc;
        float acc[8];
#pragma unroll
        for (int b = 0; b < 8; ++b) acc[b] = 0.f;
        for (int k = kg; k < 1024; k += 16) { const float wv = w[(size_t)k * 6144];
#pragma unroll
            for (int b = 0; b < 8; ++b) acc[b] += sc[b * 1024 + k] * wv; }
#pragma unroll
        for (int b = 0; b < 8; ++b) red[(kg * 8 + b) * 32 + cc] = acc[b];
        __syncthreads();
        if (tid < 256) { const int b = tid >> 5; float s = 0.f;
            for (int k2 = 0; k2 < 16; ++k2) s += red[(k2 * 8 + b) * 32 + cc];
            ((float*)(ws + WS_MOD))[b * 6144 + item * 32 + cc] = s + a.in[3][item * 32 + cc]; }
        __syncthreads();
    }
    if (rep0_ == 0 || (P0_REP & 2)) {
        LAS float* scr = (LAS float*)(lds + 65536 + wave * 8704);
        const int gw = bid * 8 + wave, NGW = G * 8;
        constexpr int I_WIN = 16 * 112, I_WQ = 16 * 64, I_WO = 8 * 32;
        for (int it = gw; it < I_WIN + I_WQ + I_WO; it += NGW) {
            int r = it;
            if (r < I_WIN) { const int kb = r / 112, nb = r % 112; transpose_item(a.in[4], IN_W, 64 * kb, win_srccol(32 * nb + (lane & 31)), (bf16*)(ws + WS_WIN), 1024, 32 * nb, 64 * kb, scr, lane); continue; }
            r -= I_WIN;
            if (r < I_WQ) { const int kb = r / 64, nb = r % 64; transpose_item(a.in[13], 2048, 64 * kb, 32 * nb + (lane & 31), (bf16*)(ws + WS_WQ), 1024, 32 * nb, 64 * kb, scr, lane); continue; }
            r -= I_WQ;
            { const int kb = r / 32, nb = r % 32; transpose_item(a.in[12] + (size_t)512 * 1024, 1024, 64 * kb, 32 * nb + (lane & 31), (bf16*)(ws + WS_BT2), YW, 32 * nb, 1024 + 64 * kb, scr, lane); }
        }
    }
    if (rep0_ == 0 || (P0_REP & 4)) {
        const float* wuv = a.in[7]; const float* wout = a.in[12]; bf16* bt2 = (bf16*)(ws + WS_BT2);
        for (int it = bid * 512 + tid; it < 1024 * 128; it += G * 512) {
            const int n = it & 1023, kb = __builtin_amdgcn_readfirstlane(it >> 10);
            const int h = kb >> 4, r0 = (kb & 15) * 8;
            float acc[8];
#pragma unroll
            for (int j = 0; j < 8; ++j) acc[j] = 0.f;
            for (int v = 0; v < 64; ++v) { const float wo = wout[(size_t)(h * 64 + v) * 1024 + n];
#pragma unroll
                for (int j = 0; j < 8; ++j) acc[j] += wuv[(size_t)(h * 128 + r0 + j) * 64 + v] * wo; }
            v4u o; o.x = pk2(acc[0], acc[1]); o.y = pk2(acc[2], acc[3]); o.z = pk2(acc[4], acc[5]); o.w = pk2(acc[6], acc[7]);
            *(v4u*)(bt2 + (size_t)n * YW + h * 128 + r0) = o;
        }
    }
    if (rep0_ == 0 || (P0_REP & 8)) {
        const size_t gt = (size_t)bid * 512 + tid, GT = (size_t)G * 512;
        for (size_t i = gt; i < 262144 / 8; i += GT) {
            const f32x4 v0 = *(const f32x4*)(a.in[14] + i * 8), v1 = *(const f32x4*)(a.in[14] + i * 8 + 4);
            v4u o; o.x = pk2(v0.x, v0.y); o.y = pk2(v0.z, v0.w); o.z = pk2(v1.x, v1.y); o.w = pk2(v1.z, v1.w);
            *(v4u*)((bf16*)(ws + WS_SUBK) + i * 8) = o;
        }
        const int gw = bid * 8 + wave, NGW = G * 8;
        for (int row = gw; row < 2 * 16384; row += NGW) {
            const int tb = row >> 14, e = row & 16383;
            const float* src = (tb ? a.in[16] : a.in[15]) + (size_t)e * 1024 + 16 * lane;
            f32x4 v[4]; float mx = 0.f;
#pragma unroll
            for (int q = 0; q < 4; ++q) { v[q] = *(const f32x4*)(src + 4 * q); mx = fmaxf(fmaxf(mx, fmaxf(fabsf(v[q].x), fabsf(v[q].y))), fmaxf(fabsf(v[q].z), fabsf(v[q].w))); }
            mx = wave_max(mx);
            const float scale = (mx > 0.f) ? mx * (1.f / 240.f) : 1.f, inv = 1.f / scale;
            v4u o;
#pragma unroll
            for (int q = 0; q < 4; ++q) { int p = __builtin_amdgcn_cvt_pk_fp8_f32(v[q].x * inv, v[q].y * inv, 0, false); p = __builtin_amdgcn_cvt_pk_fp8_f32(v[q].z * inv, v[q].w * inv, p, true); o[q] = (unsigned)p; }
            *(v4u*)(ws + (tb ? WS_VT : WS_UT) + (size_t)e * 1024 + 16 * lane) = o;
            if (lane == 0) ((float*)(ws + (tb ? WS_SV : WS_SU)))[e] = scale;
        }
    }
    }
}

__device__ __forceinline__ void phase_norm(const float* x, const float* mod, int shift_off, int scale_off, bf16* hout, unsigned char* h8 = nullptr, float* hs = nullptr) {
    const int tid = threadIdx.x, lane = tid & 63, wave = tid >> 6;
    const int gw = blockIdx.x * 8 + wave, NGW = gridDim.x * 8;
    for (int m = gw; m < T_TOK; m += NGW) {
        const int b = m >> 12;
        const f32x4* xr = (const f32x4*)(x + (size_t)m * DM) + lane;
        f32x4 v[4]; float s = 0.f;
#pragma unroll
        for (int j = 0; j < 4; ++j) { v[j] = xr[64 * j]; s += (v[j].x * v[j].x + v[j].y * v[j].y) + (v[j].z * v[j].z + v[j].w * v[j].w); }
        const float inv = rsqrtf(wave_sum(s) * (1.f / DM) + EPS);
        const f32x4* sh = (const f32x4*)(mod + b * 6144 + shift_off) + lane;
        const f32x4* sc = (const f32x4*)(mod + b * 6144 + scale_off) + lane;
        v2u* o8 = (v2u*)(hout + (size_t)m * DM) + lane;
        float amax = 0.f;
#pragma unroll
        for (int j = 0; j < 4; ++j) { const f32x4 a = sh[64 * j], c = sc[64 * j];
            v[j].x = v[j].x * inv * (1.f + c.x) + a.x; v[j].y = v[j].y * inv * (1.f + c.y) + a.y; v[j].z = v[j].z * inv * (1.f + c.z) + a.z; v[j].w = v[j].w * inv * (1.f + c.w) + a.w;
            v2u o; o.x = pk2(v[j].x, v[j].y); o.y = pk2(v[j].z, v[j].w);
            o8[64 * j] = o;
            amax = fmaxf(fmaxf(amax, fmaxf(fabsf(v[j].x), fabsf(v[j].y))), fmaxf(fabsf(v[j].z), fabsf(v[j].w))); }
        if (h8) {
            amax = wave_max(amax);
            const float scale = (amax > 0.f) ? amax * (1.f / 240.f) : 1.f, qi = 1.f / scale;
#pragma unroll
            for (int j = 0; j < 4; ++j) { int p = __builtin_amdgcn_cvt_pk_fp8_f32(v[j].x * qi, v[j].y * qi, 0, false); p = __builtin_amdgcn_cvt_pk_fp8_f32(v[j].z * qi, v[j].w * qi, p, true);
                *(unsigned*)(h8 + (size_t)m * DM + 4 * (lane + 64 * j)) = (unsigned)p; }
            if (lane == 0) hs[m] = scale;
        }
    }
}

struct EpiX1 {
    static constexpr bool PERM = false, AFTER_DRAIN = false;
    const float* x; float* out; const float* mod;
    __device__ __forceinline__ void operator()(const pg8::f32x4 (&acc)[2][2][4][2], const pg8::Unit& u, int wr, int wc, int fr, int fq) const {
        const int row0 = u.pm * 256 + wr * 64 + fr, col0 = u.pn * 256 + wc * 32 + 4 * fq;
        const int b = (u.pm * 256) >> 12;
        f32x4 gv[2][2];
#pragma unroll
        for (int bj = 0; bj < 2; ++bj)
#pragma unroll
            for (int n = 0; n < 2; ++n) gv[bj][n] = *(const f32x4*)(mod + b * 6144 + 2048 + col0 + bj * 128 + n * 16);
#pragma unroll
        for (int ai = 0; ai < 2; ++ai)
#pragma unroll
            for (int m = 0; m < 4; ++m) { const size_t ro = (size_t)(row0 + ai * 128 + m * 16) * DM + col0;
#pragma unroll
                for (int bj = 0; bj < 2; ++bj)
#pragma unroll
                    for (int n = 0; n < 2; ++n) { const f32x4 xv = *(const f32x4*)(x + ro + bj * 128 + n * 16);
                        *(f32x4*)(out + ro + bj * 128 + n * 16) = xv + gv[bj][n] * acc[ai][bj][m][n]; } }
    }
};
struct EpiBf {
    static constexpr bool PERM = true, AFTER_DRAIN = false;
    bf16* O; int ldc;
    __device__ __forceinline__ void operator()(const pg8::f32x4 (&acc)[2][2][4][2], const pg8::Unit& u, int wr, int wc, int fr, int fq) const {
        const int row0 = u.pm * 256 + wr * 64 + fr, col0 = u.pn * 256 + wc * 32 + 8 * fq;
#pragma unroll
        for (int ai = 0; ai < 2; ++ai)
#pragma unroll
            for (int m = 0; m < 4; ++m) { bf16* rowp = O + (size_t)(row0 + ai * 128 + m * 16) * ldc + col0;
#pragma unroll
                for (int bj = 0; bj < 2; ++bj) { const pg8::f32x4 zz = (pg8::f32x4){0.f, 0.f, 0.f, 0.f}; const pg8::f32x4 v0 = acc[ai][bj][m][0] + zz, v1 = acc[ai][bj][m][1] + zz;
                    v4u w; w.x = pg8::cvt_pk_bf16(v0[0], v0[1]); w.y = pg8::cvt_pk_bf16(v0[2], v0[3]); w.z = pg8::cvt_pk_bf16(v1[0], v1[1]); w.w = pg8::cvt_pk_bf16(v1[2], v1[3]);
                    *(v4u*)(rowp + bj * 128) = w; } }
    }
};

constexpr int GP_QS = 0, GP_KS = 33792, GP_VS = 67584, GP_LS = 101376, GP_GV = 118784;
__device__ __forceinline__ void gdn_prep_item(const Args& a, LAS unsigned char* lds, int chunk) {
    int tid = threadIdx.x; asm volatile("" : "+v"(tid));
    const int lane = tid & 63, wave = __builtin_amdgcn_readfirstlane(tid >> 6);
    unsigned char* ws = a.ws;
    const bf16* proj = (const bf16*)(ws + WS_PROJ);
    const int bh = chunk >> 6, n = chunk & 63, b = bh >> 2, h = bh & 3;
    const int t0 = b * SEQ + n * 64;
    LAS float* QS = (LAS float*)(lds + GP_QS); LAS float* KS = (LAS float*)(lds + GP_KS); LAS float* VS = (LAS float*)(lds + GP_VS);
    LAS float* LS = (LAS float*)(lds + GP_LS); LAS float* GV = (LAS float*)(lds + GP_GV);
#ifndef GP_MASK
#define GP_MASK 31
#endif
#ifndef GP_REP
#define GP_REP 0
#endif
    for (int rep_ = 0; rep_ < 1 + (GP_REP & 1); ++rep_)
    if ((GP_MASK & 1) && tid < 384) {
        const int cg = tid % 48, rs = tid / 48;
        const int sec = cg >> 4, c8 = (cg & 15) * 8;
        const int pcol = C_BQ + sec * 512 + h * 128 + c8;
        const float* cw = a.in[8] + sec * 512 + h * 128 + c8;
        float wt[4][8];
#pragma unroll
        for (int i = 0; i < 4; ++i) { const f32x4 w0 = *(const f32x4*)(cw + i * 1536), w1 = *(const f32x4*)(cw + i * 1536 + 4);
            wt[i][0] = w0.x; wt[i][1] = w0.y; wt[i][2] = w0.z; wt[i][3] = w0.w; wt[i][4] = w1.x; wt[i][5] = w1.y; wt[i][6] = w1.z; wt[i][7] = w1.w; }
        LAS float* XS = (sec == 0) ? QS : (sec == 1 ? KS : VS);
        v4u raw[11];
#pragma unroll
        for (int j = 0; j < 11; ++j) { const int rr = 8 * rs - 3 + j;
            raw[j] = (rr >= 0 || n > 0) ? *(const v4u*)(proj + (size_t)(t0 + rr) * PW + pcol) : (v4u){0u, 0u, 0u, 0u}; }
#pragma unroll
        for (int j = 0; j < 8; ++j) {
            float y[8];
#pragma unroll
            for (int c = 0; c < 8; ++c) y[c] = 0.f;
#pragma unroll
            for (int i = 0; i < 4; ++i) { float xv[8]; const v4u u = raw[j + i];
                xv[0] = bflo(u.x); xv[1] = bfhi(u.x); xv[2] = bflo(u.y); xv[3] = bfhi(u.y); xv[4] = bflo(u.z); xv[5] = bfhi(u.z); xv[6] = bflo(u.w); xv[7] = bfhi(u.w);
#pragma unroll
                for (int c = 0; c < 8; ++c) y[c] += wt[i][c] * xv[c]; }
            f32x4 o0, o1;
            o0.x = silu_f(y[0]); o0.y = silu_f(y[1]); o0.z = silu_f(y[2]); o0.w = silu_f(y[3]); o1.x = silu_f(y[4]); o1.y = silu_f(y[5]); o1.z = silu_f(y[6]); o1.w = silu_f(y[7]);
            *(LAS f32x4*)(XS + (8 * rs + j) * 132 + c8) = o0; *(LAS f32x4*)(XS + (8 * rs + j) * 132 + c8 + 4) = o1;
        }
    }
    if (wave == 7) {
        const int i = lane;
        const float av = bf1(proj[(size_t)(t0 + i) * PW + C_BA + h]), bv = bf1(proj[(size_t)(t0 + i) * PW + C_BB + h]);
        const float beta = sigmoid_f(bv);
        const float g = -expf(a.in[9][h]) * softplus_f(av + a.in[10][h]);
        float G = g;
#pragma unroll
        for (int o = 1; o < 64; o <<= 1) { const float t = __shfl_up(G, o); if (lane >= o) G += t; }
        const float Glast = __shfl(G, 63);
        GV[i] = G; GV[64 + i] = expf(G); GV[128 + i] = beta; GV[192 + i] = expf(Glast - G); GV[256 + i] = beta * expf(G);
        if (lane == 0) ((float*)(ws + WS_GL))[chunk] = expf(Glast);
    }
    __syncthreads();
    if (GP_MASK & 2) {
#pragma unroll 4
        for (int rr = 0; rr < 16; ++rr) {
            const int row = wave * 16 + rr;
            LAS float* X = (row < 64) ? (QS + row * 132) : (KS + (row - 64) * 132);
            const float v0 = X[lane], v1 = X[lane + 64];
            const float ss = wave_sum(v0 * v0 + v1 * v1);
            const float sc = rsqrtf(ss + EPS) * ((row < 64) ? 0.08838834764831845f : 1.f);
            X[lane] = v0 * sc; X[lane + 64] = v1 * sc;
        }
    }
    __syncthreads();
    for (int rep_ = 0; rep_ < 1 + ((GP_REP >> 2) & 1); ++rep_)
    if (GP_MASK & 4) {
        const int gram = wave >> 2, ti = wave & 3, r = lane & 15, g = lane >> 4;
        const LAS float* X = gram ? QS : KS;
        f32x4 acc[4];
#pragma unroll
        for (int tj = 0; tj < 4; ++tj) acc[tj] = (f32x4){0.f, 0.f, 0.f, 0.f};
#pragma unroll 2
        for (int kk = 0; kk < 8; ++kk) {
            const f32x4 xa = *(const LAS f32x4*)(X + (16 * ti + r) * 132 + 16 * kk + 4 * g);
#pragma unroll
            for (int tj = 0; tj < 4; ++tj) {
                if (tj <= ti) {
                    const f32x4 kb = *(const LAS f32x4*)(KS + (16 * tj + r) * 132 + 16 * kk + 4 * g);
                    acc[tj] = __builtin_amdgcn_mfma_f32_16x16x4f32(xa.x, kb.x, acc[tj], 0, 0, 0);
                    acc[tj] = __builtin_amdgcn_mfma_f32_16x16x4f32(xa.y, kb.y, acc[tj], 0, 0, 0);
                    acc[tj] = __builtin_amdgcn_mfma_f32_16x16x4f32(xa.z, kb.z, acc[tj], 0, 0, 0);
                    acc[tj] = __builtin_amdgcn_mfma_f32_16x16x4f32(xa.w, kb.w, acc[tj], 0, 0, 0);
                }
            }
        }
        bf16* Aout = (bf16*)(ws + WS_GA) + (size_t)chunk * 4096;
#pragma unroll
        for (int tj = 0; tj < 4; ++tj)
#pragma unroll
            for (int rg = 0; rg < 4; ++rg) {
                const int i = 16 * ti + 4 * g + rg, j = 16 * tj + r;
                const float dec = (j <= i) ? expf(GV[i] - GV[j]) : 0.f;
                if (gram == 0) { if (tj <= ti) LS[i * 68 + j] = (j < i) ? GV[128 + i] * acc[tj][rg] * dec : 0.f; }
                else Aout[((((i >> 4) * 2 + (j >> 5)) * 64 + (i & 15) + 16 * ((j >> 3) & 3)) << 3) + (j & 7)] = (bf16)f2bf((tj <= ti) ? acc[tj][rg] * dec : 0.f);
            }
    }
    __syncthreads();
    {
        bf16* QD = (bf16*)((unsigned char*)a.out + DO_QD) + (size_t)chunk * 8192;
        bf16* KDT = (bf16*)((unsigned char*)a.out + DO_KDT) + (size_t)chunk * 8192;
#pragma unroll
        for (int m = 0; m < 2; ++m) {
            const int p = tid + 512 * m;
            { const int i = p >> 4, k8 = (p & 15) * 8; const float e = GV[64 + i]; const LAS float* sq = QS + i * 132 + k8;
              v4u o; o.x = pk2(sq[0] * e, sq[1] * e); o.y = pk2(sq[2] * e, sq[3] * e); o.z = pk2(sq[4] * e, sq[5] * e); o.w = pk2(sq[6] * e, sq[7] * e);
              *(v4u*)(QD + ((((i >> 4) * 4 + ((p & 15) >> 2)) * 64 + (i & 15) + 16 * (p & 3)) << 3)) = o; }
            { const int k = p >> 3, i8 = (p & 7) * 8; float v[8];
#pragma unroll
              for (int j = 0; j < 8; ++j) v[j] = KS[(i8 + j) * 132 + k] * GV[192 + i8 + j];
              v4u o; o.x = pk2(v[0], v[1]); o.y = pk2(v[2], v[3]); o.z = pk2(v[4], v[5]); o.w = pk2(v[6], v[7]);
              *(v4u*)(KDT + ((((k >> 4) * 2 + ((p & 7) >> 2)) * 64 + (k & 15) + 16 * (p & 3)) << 3)) = o; }
        }
    }
    __syncthreads();
    {
#pragma unroll
        for (int m = 0; m < 4; ++m) {
            const int p = tid + 512 * m, i = p >> 5, c4 = (p & 31) * 4;
            const float mu = GV[128 + i], mw = GV[256 + i];
            f32x4 v = *(LAS f32x4*)(VS + i * 132 + c4); v.x *= mu; v.y *= mu; v.z *= mu; v.w *= mu; *(LAS f32x4*)(VS + i * 132 + c4) = v;
            f32x4 k = *(LAS f32x4*)(KS + i * 132 + c4); k.x *= mw; k.y *= mw; k.z *= mw; k.w *= mw; *(LAS f32x4*)(KS + i * 132 + c4) = k;
        }
    }
    __syncthreads();
    {
        const int r = lane & 15, g = lane >> 4;
#pragma unroll 1
        for (int I = 0; I < 4; ++I) {
            if (I > 0) {
#pragma unroll
                for (int tt = 0; tt < 2; ++tt) {
                    const int ct = 2 * wave + tt;
                    LAS float* XB = ((ct < 8) ? VS : KS) + (ct & 7) * 16 + r;
                    f32x4 acc;
#pragma unroll
                    for (int rg = 0; rg < 4; ++rg) acc[rg] = XB[(16 * I + 4 * g + rg) * 132];
                    for (int J = 0; J < I; ++J) {
#pragma unroll
                        for (int ks = 0; ks < 4; ++ks) {
                            const float la = -LS[(16 * I + r) * 68 + 16 * J + 4 * ks + g];
                            const float xb = XB[(16 * J + 4 * ks + g) * 132];
                            acc = __builtin_amdgcn_mfma_f32_16x16x4f32(la, xb, acc, 0, 0, 0);
                        }
                    }
#pragma unroll
                    for (int rg = 0; rg < 4; ++rg) XB[(16 * I + 4 * g + rg) * 132] = acc[rg];
                }
                __syncthreads();
            }
            if (tid < 256) {
                LAS float* XC = ((tid < 128) ? VS : KS) + (tid & 127);
                float x[16];
#pragma unroll
                for (int rr = 0; rr < 16; ++rr) {
                    float a0 = XC[(16 * I + rr) * 132], a1 = 0.f, a2 = 0.f, a3 = 0.f;
#pragma unroll
                    for (int j4 = 0; j4 < (rr + 3) / 4; ++j4) {
                        const f32x4 l = *(const LAS f32x4*)(LS + (16 * I + rr) * 68 + 16 * I + 4 * j4);
                        if (4 * j4 + 0 < rr) a0 -= l.x * x[4 * j4 + 0];
                        if (4 * j4 + 1 < rr) a1 -= l.y * x[4 * j4 + 1];
                        if (4 * j4 + 2 < rr) a2 -= l.z * x[4 * j4 + 2];
                        if (4 * j4 + 3 < rr) a3 -= l.w * x[4 * j4 + 3];
                    }
                    x[rr] = (a0 + a1) + (a2 + a3);
                }
#pragma unroll
                for (int rr = 0; rr < 16; ++rr) XC[(16 * I + rr) * 132] = x[rr];
            }
            __syncthreads();
        }
    }
    {
        bf16* W = (bf16*)((unsigned char*)a.out + DO_W) + (size_t)chunk * 8192;
        bf16* UT = (bf16*)((unsigned char*)a.out + DO_UT) + (size_t)chunk * 8192;
#pragma unroll
        for (int m = 0; m < 2; ++m) {
            const int p = tid + 512 * m, i = p >> 4, k8 = p & 15;
            const f32x4 x0 = *(const LAS f32x4*)(KS + i * 132 + 8 * k8), x1 = *(const LAS f32x4*)(KS + i * 132 + 8 * k8 + 4);
            v4u o; o.x = pk2(x0.x, x0.y); o.y = pk2(x0.z, x0.w); o.z = pk2(x1.x, x1.y); o.w = pk2(x1.z, x1.w);
            *(v4u*)(W + ((((i >> 4) * 4 + (k8 >> 2)) * 64 + (i & 15) + 16 * (k8 & 3)) << 3)) = o;
        }
#pragma unroll
        for (int m = 0; m < 4; ++m) {
            const int p = tid + 512 * m, v = p & 127, q = p >> 7;
            v2u o; o.x = pk2(VS[(4 * q) * 132 + v], VS[(4 * q + 1) * 132 + v]); o.y = pk2(VS[(4 * q + 2) * 132 + v], VS[(4 * q + 3) * 132 + v]);
            *(v2u*)(UT + ((((q >> 2) * 8 + (v >> 4)) * 64 + (v & 15) + 16 * (q & 3)) << 2)) = o;
        }
    }
    __syncthreads();
}

__device__ __forceinline__ void kn_item(const Args& a, int item) {
    const int tid = threadIdx.x, lane = tid & 63, wave = tid >> 6;
    const bf16* proj = (const bf16*)(a.ws + WS_PROJ); bf16* KN = (bf16*)(a.ws + WS_KN);
    const float g0 = a.in[6][2 * lane], g1 = a.in[6][2 * lane + 1];
    for (int rr = 0; rr < 16; ++rr) {
        const int t = item * 128 + wave * 16 + rr;
        const unsigned u = *(const unsigned*)(proj + (size_t)t * PW + C_AKV + 2 * lane);
        const float v0 = bflo(u), v1 = bfhi(u);
        const float inv = rsqrtf(wave_sum(v0 * v0 + v1 * v1) * (1.f / 128.f) + EPS);
        *(unsigned*)(KN + (size_t)t * 128 + 2 * lane) = pk2(v0 * inv * g0, v1 * inv * g1);
    }
}


#ifdef IDX_FP32
__device__ __forceinline__ void phase_idx32(const Args& a, LAS unsigned char* lds) {
    const int tid = threadIdx.x, lane = tid & 63, wave = tid >> 6;
    LAS float* HS = (LAS float*)lds;
    float* IDX32 = (float*)(a.ws + WS_YAB);
    const float* mod = (const float*)(a.ws + WS_MOD);
    for (int tile = blockIdx.x; tile < 1024; tile += gridDim.x) {
        const int t0 = tile * 32, b = t0 >> 12;
        for (int rr = 0; rr < 4; ++rr) {
            const int m = t0 + wave * 4 + rr;
            const f32x4* xr = (const f32x4*)(a.in[0] + (size_t)m * DM) + lane;
            f32x4 v[4]; float s = 0.f;
#pragma unroll
            for (int j = 0; j < 4; ++j) { v[j] = xr[64 * j]; s += (v[j].x * v[j].x + v[j].y * v[j].y) + (v[j].z * v[j].z + v[j].w * v[j].w); }
            const float inv = rsqrtf(wave_sum(s) * (1.f / DM) + EPS);
            const f32x4* sh = (const f32x4*)(mod + b * 6144) + lane; const f32x4* sc = (const f32x4*)(mod + b * 6144 + 1024) + lane;
#pragma unroll
            for (int j = 0; j < 4; ++j) { const f32x4 aa = sh[64 * j], c = sc[64 * j];
                f32x4 o; o.x = v[j].x * inv * (1.f + c.x) + aa.x; o.y = v[j].y * inv * (1.f + c.y) + aa.y; o.z = v[j].z * inv * (1.f + c.z) + aa.z; o.w = v[j].w * inv * (1.f + c.w) + aa.w;
                *(LAS f32x4*)(HS + (wave * 4 + rr) * 1028 + 4 * (lane + 64 * j)) = o; }
        }
        __syncthreads();
        if (tid < 324) {
            const float* w = a.in[4] + 1152 + tid;
            float acc[32];
#pragma unroll
            for (int t = 0; t < 32; ++t) acc[t] = 0.f;
            for (int k4 = 0; k4 < 256; ++k4) {
                const float w0 = w[(size_t)(4 * k4) * IN_W], w1 = w[(size_t)(4 * k4 + 1) * IN_W], w2 = w[(size_t)(4 * k4 + 2) * IN_W], w3 = w[(size_t)(4 * k4 + 3) * IN_W];
#pragma unroll
                for (int t = 0; t < 32; ++t) { const f32x4 hv = *(const LAS f32x4*)(HS + t * 1028 + 4 * k4); acc[t] += hv.x * w0 + hv.y * w1 + hv.z * w2 + hv.w * w3; }
            }
#pragma unroll
            for (int t = 0; t < 32; ++t) IDX32[(size_t)(t0 + t) * 384 + tid] = acc[t];
        }
        __syncthreads();
    }
}
#endif
__device__ __forceinline__ unsigned sortable(float f) { const unsigned u = __float_as_uint(f + 0.f); return (u & 0x80000000u) ? ~u : (u | 0x80000000u); }
__device__ __forceinline__ int wave_sum_dpp(int x) {
    x += __builtin_amdgcn_update_dpp(0, x, 0xB1, 0xF, 0xF, false);
    x += __builtin_amdgcn_update_dpp(0, x, 0x4E, 0xF, 0xF, false);
    x += __builtin_amdgcn_update_dpp(0, x, 0x141, 0xF, 0xF, false);
    x += __builtin_amdgcn_update_dpp(0, x, 0x140, 0xF, 0xF, false);
    return __builtin_amdgcn_readlane(x, 0) + __builtin_amdgcn_readlane(x, 16) + __builtin_amdgcn_readlane(x, 32) + __builtin_amdgcn_readlane(x, 48);
}
#define CNT8(OP, acc_, k_, s_, c_) asm("v_cmp_" OP "_u32 s[36:37], %1, %9\n\tv_cmp_" OP "_u32 s[38:39], %2, %9\n\tv_cmp_" OP "_u32 s[40:41], %3, %9\n\tv_cmp_" OP "_u32 s[42:43], %4, %9\n\t" \
        "v_cmp_" OP "_u32 s[44:45], %5, %9\n\tv_cmp_" OP "_u32 s[46:47], %6, %9\n\tv_cmp_" OP "_u32 s[48:49], %7, %9\n\tv_cmp_" OP "_u32 s[50:51], %8, %9\n\t" \
        "v_addc_co_u32 %0, s[36:37], 0, %0, s[36:37]\n\tv_addc_co_u32 %0, s[38:39], 0, %0, s[38:39]\n\tv_addc_co_u32 %0, s[40:41], 0, %0, s[40:41]\n\tv_addc_co_u32 %0, s[42:43], 0, %0, s[42:43]\n\t" \
        "v_addc_co_u32 %0, s[44:45], 0, %0, s[44:45]\n\tv_addc_co_u32 %0, s[46:47], 0, %0, s[46:47]\n\tv_addc_co_u32 %0, s[48:49], 0, %0, s[48:49]\n\tv_addc_co_u32 %0, s[50:51], 0, %0, s[50:51]" \
        : "+v"(acc_) : "v"(k_[(s_)]), "v"(k_[(s_) + 1]), "v"(k_[(s_) + 2]), "v"(k_[(s_) + 3]), "v"(k_[(s_) + 4]), "v"(k_[(s_) + 5]), "v"(k_[(s_) + 6]), "v"(k_[(s_) + 7]), "v"(c_) \
        : "s36", "s37", "s38", "s39", "s40", "s41", "s42", "s43", "s44", "s45", "s46", "s47", "s48", "s49", "s50", "s51")
template <int NS> __device__ __forceinline__ void topk_select(LAS float* row, int n, int lane, unsigned short* out) {
    asm volatile("" : "+v"(lane));
    unsigned key[NS];
#pragma unroll
    for (int s = 0; s < NS; ++s) key[s] = __float_as_uint(row[s * 64 + lane]);
#pragma unroll
    for (int s = 0; s < NS; ++s) { const int idx = s * 64 + lane; const unsigned k = sortable(__uint_as_float(key[s])); key[s] = (idx < n) ? k : 0u; }
    LAS unsigned short* sel_l = (LAS unsigned short*)row;
    unsigned thr = 0u;
    for (int bit = 31; bit >= 0; --bit) {
        const unsigned cand = thr | (1u << bit);
        int c0 = 0, c1 = 0;
#pragma unroll
        for (int s = 0; s < NS; s += 16) { CNT8("ge", c0, key, s, cand); CNT8("ge", c1, key, s + 8, cand); }
        const int cnt = wave_sum_dpp(c0 + c1);
        if (cnt >= 256) thr = cand;
        if (cnt == 256) break;
    }
    int g0 = 0, e0 = 0;
#pragma unroll
    for (int s = 0; s < NS; s += 8) { CNT8("gt", g0, key, s, thr); CNT8("eq", e0, key, s, thr); }
    const int cgt = wave_sum_dpp(g0), ceq = wave_sum_dpp(e0);
    const int need_eq = 256 - cgt;
    asm volatile("" : "+v"(thr));
    asm volatile("" : "+v"(lane));
    int pos_out = 0;
    if (ceq == need_eq) {
#pragma unroll
        for (int s = 0; s < NS; ++s) {
            const bool take = key[s] >= thr;
            const unsigned long long mt = __builtin_amdgcn_ballot_w64(take);
            const int pre = __builtin_amdgcn_mbcnt_hi((unsigned)(mt >> 32), __builtin_amdgcn_mbcnt_lo((unsigned)mt, 0));
            sel_l[take ? pos_out + pre : 256] = (unsigned short)(s * 64 + lane);
            pos_out += __builtin_popcountll(mt);
        }
    } else {
        const unsigned long long ltmask = (1ull << lane) - 1ull;
        int eq_seen = 0;
#pragma unroll
        for (int s = 0; s < NS; ++s) {
            const bool gt = key[s] > thr, eq = key[s] == thr;
            const unsigned long long meq = __builtin_amdgcn_ballot_w64(eq);
            const bool take = gt || (eq && (eq_seen + __builtin_popcountll(meq & ltmask) < need_eq));
            const unsigned long long mt = __builtin_amdgcn_ballot_w64(take);
            if (take) sel_l[pos_out + __builtin_popcountll(mt & ltmask)] = (unsigned short)(s * 64 + lane);
            pos_out += __builtin_popcountll(mt); eq_seen += __builtin_popcountll(meq);
            if ((s & 3) == 3) __builtin_amdgcn_sched_barrier(0);
        }
    }
    LDS_WAIT();
    *(v2u*)(out + 4 * lane) = *(const LAS v2u*)(sel_l + 4 * lane);
}
struct IdxPre { bf16x8 af[4]; v2u wqr[4]; bf16x8 bfr[4][4]; };
__device__ __forceinline__ void idx_issue(const Args& a, int b, int qblk, int wave, int lane, IdxPre& P) {
    const bf16* proj = (const bf16*)(a.ws + WS_PROJ);
    const int p0 = qblk * 8, r = lane & 31, hh = lane >> 5;
    const size_t rowb = (size_t)b * SEQ;
    if (p0 + 7 < 256) return;
    { const bf16* qp = proj + (rowb + p0 + (r & 7)) * PW + C_IQ + (r >> 3) * 64 + 32 * hh;
#pragma unroll
      for (int s = 0; s < 4; ++s) P.af[s] = *(const bf16x8*)(qp + 8 * s); }
#pragma unroll
    for (int i = 0; i < 4; ++i) P.wqr[i] = *(const v2u*)(proj + (rowb + p0 + 4 * hh + i) * PW + C_IW);
    const int ntiles = (p0 + 7) / 32 + 1;
#pragma unroll
    for (int u = 0; u < 4; ++u) {
        const int kt = (wave + 8 * u < ntiles) ? wave + 8 * u : 0;
        const bf16* kp = proj + (rowb + (size_t)kt * 32 + r) * PW + C_IK + 32 * hh;
#pragma unroll
        for (int s = 0; s < 4; ++s) P.bfr[u][s] = *(const bf16x8*)(kp + 8 * s);
    }
}
__device__ __forceinline__ void indexer_item(const Args& a, LAS unsigned char* lds, int b, int qblk, IdxPre& P, bool has_next, int b_next, int qblk_next) {
    int tid = threadIdx.x; asm volatile("" : "+v"(tid));
    const int lane = tid & 63, wave = __builtin_amdgcn_readfirstlane(tid >> 6);
    const bf16* proj = (const bf16*)(a.ws + WS_PROJ);
    unsigned short* SEL = (unsigned short*)(a.ws + WS_SEL);
    LAS float* SC = (LAS float*)lds;
    const int p0 = qblk * 8;
    const int r = lane & 31, hh = lane >> 5;
    const size_t rowb = (size_t)b * SEQ;
#ifdef IDX_FP32
    if (p0 + 7 >= 256) {
        const float* IDX32 = (const float*)(a.ws + WS_YAB);
        LAS float* IQS = (LAS float*)(lds + 131072);
        for (int i = tid; i < 2048; i += 512) IQS[i] = IDX32[(rowb + p0 + (i >> 8)) * 384 + (i & 255)];
        float wq8[8][4];
#pragma unroll
        for (int q = 0; q < 8; ++q)
#pragma unroll
            for (int hd = 0; hd < 4; ++hd) wq8[q][hd] = IDX32[(rowb + p0 + q) * 384 + 320 + hd];
        __syncthreads();
        for (int s = tid; s <= p0 + 7; s += 512) {
            float kf[64];
#pragma unroll
            for (int d4 = 0; d4 < 16; ++d4) { const f32x4 v = *(const f32x4*)(IDX32 + (rowb + s) * 384 + 256 + 4 * d4); kf[4 * d4] = v.x; kf[4 * d4 + 1] = v.y; kf[4 * d4 + 2] = v.z; kf[4 * d4 + 3] = v.w; }
#pragma unroll 1
            for (int q = 0; q < 8; ++q) {
                float sc = 0.f;
#pragma unroll
                for (int hd = 0; hd < 4; ++hd) {
                    float lg = 0.f;
#pragma unroll
                    for (int d4 = 0; d4 < 16; ++d4) { const f32x4 qv = *(const LAS f32x4*)(IQS + q * 256 + hd * 64 + 4 * d4); lg += kf[4 * d4] * qv.x + kf[4 * d4 + 1] * qv.y + kf[4 * d4 + 2] * qv.z + kf[4 * d4 + 3] * qv.w; }
                    sc += fmaxf(lg, 0.f) * wq8[q][hd];
                }
                SC[q * 4096 + s] = sc * 0.0625f;
            }
        }
    }
#else
    if (p0 + 7 >= 256) {
        float wq[4][4];
#pragma unroll
        for (int i = 0; i < 4; ++i) { wq[i][0] = bflo(P.wqr[i].x) * 0.0625f; wq[i][1] = bfhi(P.wqr[i].x) * 0.0625f; wq[i][2] = bflo(P.wqr[i].y) * 0.0625f; wq[i][3] = bfhi(P.wqr[i].y) * 0.0625f; }
        const int ntiles = (p0 + 7) / 32 + 1;
        for (int kt0 = wave; kt0 < ntiles; kt0 += 32) {
            bf16x8 nxt[4][4];
            const bool more = kt0 + 32 < ntiles;
            if (more) {
#pragma unroll
                for (int u = 0; u < 4; ++u) {
                    const int kt = (kt0 + 32 + 8 * u < ntiles) ? kt0 + 32 + 8 * u : kt0;
                    const bf16* kp = proj + (rowb + (size_t)kt * 32 + r) * PW + C_IK + 32 * hh;
#pragma unroll
                    for (int s = 0; s < 4; ++s) nxt[u][s] = *(const bf16x8*)(kp + 8 * s);
                }
            }
#pragma unroll
            for (int u = 0; u < 4; ++u) {
                const int kt = kt0 + 8 * u;
                if (kt < ntiles) {
                    f32x16 acc;
#pragma unroll
                    for (int i = 0; i < 16; ++i) acc[i] = 0.f;
#pragma unroll
                    for (int s = 0; s < 4; ++s) acc = __builtin_amdgcn_mfma_f32_32x32x16_bf16(P.af[s], P.bfr[u][s], acc, 0, 0, 0);
#pragma unroll
                    for (int i = 0; i < 4; ++i) {
                        float s = 0.f;
#pragma unroll
                        for (int hd = 0; hd < 4; ++hd) s += wq[i][hd] * fmaxf(acc[i + 4 * hd], 0.f);
                        SC[(4 * hh + i) * 4096 + kt * 32 + r] = s;
                    }
                }
            }
            if (more) {
#pragma unroll
                for (int u = 0; u < 4; ++u)
#pragma unroll
                    for (int s = 0; s < 4; ++s) P.bfr[u][s] = nxt[u][s];
            }
        }
    }
#endif
    __syncthreads();
#ifndef IDX_FP32
    if (has_next) idx_issue(a, b_next, qblk_next, wave, lane, P);
#endif
    {
        const int pos = p0 + wave, n = pos + 1;
        unsigned short* out = SEL + (rowb + pos) * 256;
        if (n <= 256) {
#pragma unroll
            for (int q = 0; q < 4; ++q) { const int j = lane + 64 * q; out[j] = (unsigned short)((j < n) ? j : 0xFFFF); }
        } else {
            LAS float* row = SC + wave * 4096;
            const int nslots = (n + 63) >> 6;
#ifndef IDX_REP_SELECT
#define IDX_REP_SELECT 1
#endif
            float* bk_ = (float*)(a.ws + WS_YAB) + ((size_t)blockIdx.x * 8 + wave) * 4096;
            if (IDX_REP_SELECT > 1) for (int i_ = lane; i_ < 4096; i_ += 64) bk_[i_] = row[i_];
            for (int rep_ = 0; rep_ < IDX_REP_SELECT; ++rep_) {
            if (rep_ > 0) { for (int i_ = lane; i_ < 4096; i_ += 64) row[i_] = bk_[i_]; LDS_WAIT(); }
            if (nslots <= 16) topk_select<16>(row, n, lane, out);
            else if (nslots <= 32) topk_select<32>(row, n, lane, out);
            else if (nslots <= 48) topk_select<48>(row, n, lane, out);
            else topk_select<64>(row, n, lane, out);
            }
        }
    }
    __syncthreads();
}

__device__ __forceinline__ void phase3(const Args& a, LAS unsigned char* lds) {
    const int bid = blockIdx.x, G = gridDim.x;
#ifndef P3_MASK
#define P3_MASK 7
#endif
#ifndef P3_REP
#define P3_REP 0
#endif
    if (P3_MASK & 1) for (int it = bid; it < 2048; it += G) { gdn_prep_item(a, lds, it); if (P3_REP & 1) gdn_prep_item(a, lds, it); }
    if (P3_MASK & 2) {
#define IDX_MAP(j_, bb_, qb_) do { if (G == 256) { const int i_ = (j_) / G, c_ = (j_) % G, q0_ = (c_ >> 3) + 32 * (i_ >> 1); bb_ = c_ & 7; qb_ = (i_ & 1) ? 511 - q0_ : q0_; } else { bb_ = (j_) >> 9; qb_ = (j_) & 511; } } while (0)
        IdxPre P;
        const int tid_ = threadIdx.x, lane_ = tid_ & 63, wave_ = __builtin_amdgcn_readfirstlane(tid_ >> 6);
        int bb, qb;
        if (bid < 4096) { IDX_MAP(bid, bb, qb); idx_issue(a, bb, qb, wave_, lane_, P); }
        for (int j = bid; j < 4096; j += G) {
            IDX_MAP(j, bb, qb);
            int bn = 0, qn = 0; const bool hn = (j + G < 4096);
            if (hn) IDX_MAP(j + G, bn, qn);
            indexer_item(a, lds, bb, qb, P, hn, bn, qn);
            if (P3_REP & 2) { idx_issue(a, bb, qb, wave_, lane_, P); indexer_item(a, lds, bb, qb, P, false, 0, 0); if (hn) idx_issue(a, bn, qn, wave_, lane_, P); }
        }
#undef IDX_MAP
    }
    if (P3_MASK & 4) for (int it = bid; it < 256; it += G) kn_item(a, it);
}

constexpr int SC_ST = 0, SC_VNT = 34816, SC_O = 53248;
__device__ __forceinline__ v2u pack4(float a, float b, float c, float d) { v2u o; o.x = pk2(a, b); o.y = pk2(c, d); return o; }
__device__ __forceinline__ void scan_epilogue(const LAS float* OS, const v4u z0, const v4u z1, const LAS float* gainl, bf16* ydst, int tid) {
    const int row = tid >> 3, seg = tid & 7;
    float o[16];
#pragma unroll
    for (int q = 0; q < 4; ++q) { const f32x4 v = *(const LAS f32x4*)(OS + row * 132 + 16 * seg + 4 * q); o[4 * q] = v.x; o[4 * q + 1] = v.y; o[4 * q + 2] = v.z; o[4 * q + 3] = v.w; }
    float ss = 0.f;
#pragma unroll
    for (int i = 0; i < 16; ++i) ss += o[i] * o[i];
    ss += __shfl_xor(ss, 1); ss += __shfl_xor(ss, 2); ss += __shfl_xor(ss, 4);
    const float inv = rsqrtf(ss * (1.f / 128.f) + EPS);
    float z[16];
    z[0] = bflo(z0.x); z[1] = bfhi(z0.x); z[2] = bflo(z0.y); z[3] = bfhi(z0.y); z[4] = bflo(z0.z); z[5] = bfhi(z0.z); z[6] = bflo(z0.w); z[7] = bfhi(z0.w);
    z[8] = bflo(z1.x); z[9] = bfhi(z1.x); z[10] = bflo(z1.y); z[11] = bfhi(z1.y); z[12] = bflo(z1.z); z[13] = bfhi(z1.z); z[14] = bflo(z1.w); z[15] = bfhi(z1.w);
    float y[16];
#pragma unroll
    for (int q = 0; q < 4; ++q) { const f32x4 gq = *(const LAS f32x4*)(gainl + 16 * seg + 4 * q);
        y[4 * q] = o[4 * q] * inv * gq.x * silu_fast(z[4 * q]); y[4 * q + 1] = o[4 * q + 1] * inv * gq.y * silu_fast(z[4 * q + 1]); y[4 * q + 2] = o[4 * q + 2] * inv * gq.z * silu_fast(z[4 * q + 2]); y[4 * q + 3] = o[4 * q + 3] * inv * gq.w * silu_fast(z[4 * q + 3]); }
    v4u w0, w1;
    w0.x = pk2(y[0], y[1]); w0.y = pk2(y[2], y[3]); w0.z = pk2(y[4], y[5]); w0.w = pk2(y[6], y[7]);
    w1.x = pk2(y[8], y[9]); w1.y = pk2(y[10], y[11]); w1.z = pk2(y[12], y[13]); w1.w = pk2(y[14], y[15]);
    *(v4u*)(ydst) = w0; *(v4u*)(ydst + 8) = w1;
}
__device__ __forceinline__ void gdn_scan(const Args& a, LAS unsigned char* lds, int bh) {
    const int tid = threadIdx.x, lane = tid & 63, w = __builtin_amdgcn_readfirstlane(tid >> 6), r = lane & 15, g = lane >> 4;
    const int b = bh >> 2, h = bh & 3;
    LAS bf16* ST = (LAS bf16*)(lds + SC_ST); LAS bf16* VNT = (LAS bf16*)(lds + SC_VNT); LAS float* OS = (LAS float*)(lds + SC_O);
    const bf16* proj = (const bf16*)(a.ws + WS_PROJ); bf16* yab = (bf16*)(a.ws + WS_YAB);
    const float* GL = (const float*)(a.ws + WS_GL);
    for (int i = tid; i < 34816 / 4; i += 512) ((LAS unsigned*)ST)[i] = 0u;
    f32x4 S[8];
#pragma unroll
    for (int vt = 0; vt < 8; ++vt) S[vt] = (f32x4){0.f, 0.f, 0.f, 0.f};
    const int erow = tid >> 3, eseg = tid & 7;
    LAS float* gainl = (LAS float*)(lds + 87040);
    if (tid < 128) gainl[tid] = a.in[11][tid];
    const int ct = w & 3;
    const size_t cb = (size_t)bh * 64;
    const bf16* Wb = (const bf16*)((const unsigned char*)a.out + DO_W) + cb * 8192;
    const bf16* QDb = (const bf16*)((const unsigned char*)a.out + DO_QD) + cb * 8192;
    const bf16* KDTb = (const bf16*)((const unsigned char*)a.out + DO_KDT) + cb * 8192;
    const bf16* UTb = (const bf16*)((const unsigned char*)a.out + DO_UT) + cb * 8192;
    const bf16* Ab = (const bf16*)(a.ws + WS_GA) + cb * 4096;
    const bf16* Xb = (w < 4) ? Wb : QDb;
    const size_t tz = ((size_t)b * SEQ + erow) * PW + C_BZ + h * 128 + 16 * eseg;
    const size_t ty = ((size_t)b * SEQ + erow) * YW + 1024 + h * 128 + 16 * eseg;
    bf16x8 af[4], kd[2]; v4u xr[4]; float gl; v4u zh0, zh1;
#define SCAN_LOAD(n_, af_, kd_, xr_, gl_) do { \
        const bf16* X_ = Xb + (size_t)(n_) * 8192 + (ct * 4 * 64 + lane) * 8; \
        _Pragma("unroll") for (int ks = 0; ks < 4; ++ks) af_[ks] = *(const bf16x8*)(X_ + ks * 512); \
        const bf16* K_ = KDTb + (size_t)(n_) * 8192 + (w * 2 * 64 + lane) * 8; \
        kd_[0] = *(const bf16x8*)(K_); kd_[1] = *(const bf16x8*)(K_ + 512); \
        if (w >= 4) { const bf16* A_ = Ab + (size_t)(n_) * 4096 + (ct * 2 * 64 + lane) * 8; xr_[0] = *(const v4u*)(A_); xr_[1] = *(const v4u*)(A_ + 512); } \
        else { const bf16* U_ = UTb + (size_t)(n_) * 8192 + (ct * 8 * 64 + lane) * 4; _Pragma("unroll") for (int q_ = 0; q_ < 4; ++q_) { const v2u u0_ = *(const v2u*)(U_ + (2 * q_) * 256), u1_ = *(const v2u*)(U_ + (2 * q_ + 1) * 256); xr_[q_] = (v4u){u0_.x, u0_.y, u1_.x, u1_.y}; } } \
        gl_ = GL[cb + (n_)]; } while (0)
    SCAN_LOAD(0, af, kd, xr, gl);
    zh0 = (v4u){0u, 0u, 0u, 0u}; zh1 = zh0;
    __syncthreads();
    for (int n = 0; n < 64; ++n) {
        bf16x8 afn[4], kdn[2]; v4u xrn[4]; float gln;
        const int nn = (n < 63) ? n + 1 : 63;
        SCAN_LOAD(nn, afn, kdn, xrn, gln);
        const v4u zn0 = *(const v4u*)(proj + tz + (size_t)n * 64 * PW), zn1 = *(const v4u*)(proj + tz + (size_t)n * 64 * PW + 8);
        if (n > 0) scan_epilogue(OS, zh0, zh1, gainl, yab + ty + (size_t)(n - 1) * 64 * YW, tid);
        zh0 = zn0; zh1 = zn1;
        f32x4 acc[8];
#pragma unroll
        for (int vt = 0; vt < 8; ++vt) acc[vt] = (f32x4){0.f, 0.f, 0.f, 0.f};
#pragma unroll
        for (int ks = 0; ks < 4; ++ks) {
#pragma unroll
            for (int vt = 0; vt < 8; ++vt) {
                const bf16x8 bfr = *(const LAS bf16x8*)(ST + (16 * vt + r) * 136 + 32 * ks + 8 * g);
                acc[vt] = __builtin_amdgcn_mfma_f32_16x16x32_bf16(af[ks], bfr, acc[vt], 0, 0, 0);
            }
        }
        if (w < 4) {
#pragma unroll
            for (int vt = 0; vt < 8; ++vt) {
                const unsigned ux = (vt & 1) ? xr[vt >> 1].z : xr[vt >> 1].x, uy = (vt & 1) ? xr[vt >> 1].w : xr[vt >> 1].y;
                const v2u o = pack4(bflo(ux) - acc[vt][0], bfhi(ux) - acc[vt][1], bflo(uy) - acc[vt][2], bfhi(uy) - acc[vt][3]);
                *(LAS v2u*)(VNT + (16 * vt + r) * 72 + 16 * ct + 4 * g) = o;
            }
        }
        __syncthreads();
        if (w >= 4) {
#pragma unroll
            for (int ks = 0; ks < 2; ++ks)
#pragma unroll
                for (int vt = 0; vt < 8; ++vt) {
                    const bf16x8 vb = *(const LAS bf16x8*)(VNT + (16 * vt + r) * 72 + 32 * ks + 8 * g);
                    acc[vt] = __builtin_amdgcn_mfma_f32_16x16x32_bf16(__builtin_bit_cast(bf16x8, xr[ks]), vb, acc[vt], 0, 0, 0);
                }
#pragma unroll
            for (int vt = 0; vt < 8; ++vt)
#pragma unroll
                for (int rg = 0; rg < 4; ++rg) OS[(16 * ct + 4 * g + rg) * 132 + 16 * vt + r] = acc[vt][rg];
        }
#pragma unroll
        for (int vt = 0; vt < 8; ++vt) S[vt] = S[vt] * gl;
#pragma unroll
        for (int ks = 0; ks < 2; ++ks)
#pragma unroll
            for (int vt = 0; vt < 8; ++vt) {
                const bf16x8 vb = *(const LAS bf16x8*)(VNT + (16 * vt + r) * 72 + 32 * ks + 8 * g);
                S[vt] = __builtin_amdgcn_mfma_f32_16x16x32_bf16(kd[ks], vb, S[vt], 0, 0, 0);
            }
#pragma unroll
        for (int vt = 0; vt < 8; ++vt)
            *(LAS v2u*)(ST + (16 * vt + r) * 136 + 16 * w + 4 * g) = pack4(S[vt][0] + 0.f, S[vt][1] + 0.f, S[vt][2] + 0.f, S[vt][3] + 0.f);
#pragma unroll
        for (int ks = 0; ks < 4; ++ks) af[ks] = afn[ks];
        kd[0] = kdn[0]; kd[1] = kdn[1];
#pragma unroll
        for (int q = 0; q < 4; ++q) xr[q] = xrn[q];
        gl = gln;
        __syncthreads();
    }
    scan_epilogue(OS, zh0, zh1, gainl, yab + ty + (size_t)63 * 64 * YW, tid);
    __syncthreads();
#undef SCAN_LOAD
}

typedef short v4s __attribute__((ext_vector_type(4)));
constexpr int AQ_STRIDE = 272, AQ_WAVE_LDS = 64 * AQ_STRIDE + 512;
__device__ __forceinline__ void attn_query_q4(const Args& a, LAS unsigned char* wl, const LAS float* qgl, int t, int lane) {
    const bf16* proj = (const bf16*)(a.ws + WS_PROJ); const bf16* KN = (const bf16*)(a.ws + WS_KN);
    const unsigned short* SEL = (const unsigned short*)(a.ws + WS_SEL); bf16* yab = (bf16*)(a.ws + WS_YAB);
    LAS unsigned char* KT = wl; LAS unsigned short* SL = (LAS unsigned short*)(wl + 64 * AQ_STRIDE);
    const int r = lane & 15, g = lane >> 4;
    const int b = t >> 12, pos = t & 4095;
    const bf16* knb = KN + (size_t)b * SEQ * 128;
    *(LAS v2u*)(SL + 4 * lane) = *(const v2u*)(SEL + (size_t)t * 256 + 4 * lane);
    bf16x8 qf[4];
    {
        const bf16* qp = proj + (size_t)t * PW + C_AQ + (r & 7) * 128 + 8 * g;
        float f[32]; float ss = 0.f;
#pragma unroll
        for (int ks = 0; ks < 4; ++ks) { const v4u raw = *(const v4u*)(qp + 32 * ks);
            f[8 * ks] = bflo(raw.x); f[8 * ks + 1] = bfhi(raw.x); f[8 * ks + 2] = bflo(raw.y); f[8 * ks + 3] = bfhi(raw.y); f[8 * ks + 4] = bflo(raw.z); f[8 * ks + 5] = bfhi(raw.z); f[8 * ks + 6] = bflo(raw.w); f[8 * ks + 7] = bfhi(raw.w); }
#pragma unroll
        for (int i = 0; i < 32; ++i) ss += f[i] * f[i];
        ss += __shfl_xor(ss, 16); ss += __shfl_xor(ss, 32);
        float inv = rsqrtf(ss * (1.f / 128.f) + EPS) * 0.08838834764831845f;
        if (r >= 8) inv = 0.f;
#pragma unroll
        for (int ks = 0; ks < 4; ++ks) { const f32x4 ga = *(const LAS f32x4*)(qgl + 32 * ks + 8 * g), gb = *(const LAS f32x4*)(qgl + 32 * ks + 8 * g + 4);
            v4u o; o.x = pk2(f[8 * ks] * inv * ga.x, f[8 * ks + 1] * inv * ga.y); o.y = pk2(f[8 * ks + 2] * inv * ga.z, f[8 * ks + 3] * inv * ga.w);
            o.z = pk2(f[8 * ks + 4] * inv * gb.x, f[8 * ks + 5] * inv * gb.y); o.w = pk2(f[8 * ks + 6] * inv * gb.z, f[8 * ks + 7] * inv * gb.w);
            qf[ks] = __builtin_bit_cast(bf16x8, o); }
    }
    LDS_WAIT();
    const int cnt = (pos + 1 < 256) ? pos + 1 : 256, nq = (cnt + 63) >> 6;
    const float slope = exp2f(-(float)((r & 7) + 1));
    float m_run = -INFINITY, l_run = 0.f;
    f32x4 O[8];
#pragma unroll
    for (int dt = 0; dt < 8; ++dt) O[dt] = (f32x4){0.f, 0.f, 0.f, 0.f};
    bf16x8 ka[4][4], kb[4][4];
#define AQ_LOAD(q_, k_) do { _Pragma("unroll") for (int kt = 0; kt < 4; ++kt) { int ix_ = SL[64 * (q_) + 16 * kt + r]; ix_ = (ix_ == 0xFFFF) ? 0 : ix_; \
        const bf16* kp_ = knb + (size_t)ix_ * 128 + 8 * g; _Pragma("unroll") for (int ks = 0; ks < 4; ++ks) k_[kt][ks] = *(const bf16x8*)(kp_ + 32 * ks); } } while (0)
#define AQ_PASS(q_, k_) do { \
        f32x4 sc[4]; \
        _Pragma("unroll") for (int kt = 0; kt < 4; ++kt) { f32x4 acc = (f32x4){0.f, 0.f, 0.f, 0.f}; \
            _Pragma("unroll") for (int ks = 0; ks < 4; ++ks) { acc = __builtin_amdgcn_mfma_f32_16x16x32_bf16(k_[kt][ks], qf[ks], acc, 0, 0, 0); \
                *(LAS bf16x8*)(KT + (16 * kt + r) * AQ_STRIDE + (32 * ks + 8 * g) * 2) = k_[kt][ks]; } \
            sc[kt] = acc; } \
        float m = m_run; \
        _Pragma("unroll") for (int kt = 0; kt < 4; ++kt) { const v2u s4 = *(const LAS v2u*)(SL + 64 * (q_) + 16 * kt + 4 * g); \
            const int i0 = s4.x & 0xFFFF, i1 = s4.x >> 16, i2 = s4.y & 0xFFFF, i3 = s4.y >> 16; \
            sc[kt][0] = (i0 != 0xFFFF) ? sc[kt][0] - slope * (float)(pos - i0) : -INFINITY; sc[kt][1] = (i1 != 0xFFFF) ? sc[kt][1] - slope * (float)(pos - i1) : -INFINITY; \
            sc[kt][2] = (i2 != 0xFFFF) ? sc[kt][2] - slope * (float)(pos - i2) : -INFINITY; sc[kt][3] = (i3 != 0xFFFF) ? sc[kt][3] - slope * (float)(pos - i3) : -INFINITY; \
            m = fmaxf(fmaxf(m, fmaxf(sc[kt][0], sc[kt][1])), fmaxf(sc[kt][2], sc[kt][3])); } \
        m = fmaxf(m, __shfl_xor(m, 16)); m = fmaxf(m, __shfl_xor(m, 32)); \
        const float alpha = __expf(m_run - m); \
        float ls = 0.f; \
        _Pragma("unroll") for (int kt = 0; kt < 4; ++kt) _Pragma("unroll") for (int rg = 0; rg < 4; ++rg) { const float e = __expf(sc[kt][rg] - m); sc[kt][rg] = e; ls += e; } \
        ls += __shfl_xor(ls, 16); ls += __shfl_xor(ls, 32); \
        l_run = l_run * alpha + ls; m_run = m; \
        _Pragma("unroll") for (int rg = 0; rg < 4; ++rg) { const float ah = __shfl(alpha, 4 * g + rg); _Pragma("unroll") for (int dt = 0; dt < 8; ++dt) O[dt][rg] *= ah; } \
        _Pragma("unroll") for (int c = 0; c < 2; ++c) { v4u o_; o_.x = pk2(sc[2 * c][0], sc[2 * c][1]); o_.y = pk2(sc[2 * c][2], sc[2 * c][3]); o_.z = pk2(sc[2 * c + 1][0], sc[2 * c + 1][1]); o_.w = pk2(sc[2 * c + 1][2], sc[2 * c + 1][3]); \
            const bf16x8 pa = __builtin_bit_cast(bf16x8, o_); \
            _Pragma("unroll") for (int dt = 0; dt < 8; ++dt) { \
                const v4s b0 = __builtin_amdgcn_ds_read_tr16_b64_v4i16((LAS v4s*)(tb + (32 * c) * AQ_STRIDE + 32 * dt)); \
                const v4s b1 = __builtin_amdgcn_ds_read_tr16_b64_v4i16((LAS v4s*)(tb + (32 * c + 16) * AQ_STRIDE + 32 * dt)); \
                const bf16x8 bfr = __builtin_shufflevector(b0, b1, 0, 1, 2, 3, 4, 5, 6, 7); \
                O[dt] = __builtin_amdgcn_mfma_f32_16x16x32_bf16(pa, bfr, O[dt], 0, 0, 0); } } \
        __builtin_amdgcn_sched_barrier(0); } while (0)
    const LAS unsigned char* tb = KT + (4 * g + (r >> 2)) * AQ_STRIDE + 8 * (r & 3);
    AQ_LOAD(0, ka);
    if (nq > 1) AQ_LOAD(1, kb);
    AQ_PASS(0, ka);
    if (nq > 1) { if (nq > 2) AQ_LOAD(2, ka); AQ_PASS(1, kb); }
    if (nq > 2) { if (nq > 3) AQ_LOAD(3, kb); AQ_PASS(2, ka); }
    if (nq > 3) { AQ_PASS(3, kb); }
#undef AQ_LOAD
#undef AQ_PASS
    const float il = 1.f / l_run;
    if (true) {
        float ih[4];
#pragma unroll
        for (int rg = 0; rg < 4; ++rg) ih[rg] = __shfl(il, 4 * g + rg);
        if (g < 2) {
#pragma unroll
            for (int rg = 0; rg < 4; ++rg)
#pragma unroll
                for (int dt = 0; dt < 8; ++dt) yab[(size_t)t * YW + (4 * g + rg) * 128 + 16 * dt + r] = (bf16)f2bf(O[dt][rg] * ih[rg]);
        }
    }
    LDS_WAIT();
}

__device__ __forceinline__ void phase4(const Args& a, LAS unsigned char* lds) {
    const int bid = blockIdx.x, G = gridDim.x, tid = threadIdx.x, lane = tid & 63, wave = tid >> 6;
    const int nscan = (G >= 64) ? 32 : 0;
#ifndef P4_REP
#define P4_REP 0
#endif
    if (nscan && bid < 32) { gdn_scan(a, lds, bid); if (P4_REP & 1) { __syncthreads(); gdn_scan(a, lds, bid); } return; }
    if (!nscan) { for (int bh = bid; bh < 32; bh += G) gdn_scan(a, lds, bh); __syncthreads(); }
    LAS float* qg4 = (LAS float*)(lds + 8 * AQ_WAVE_LDS);
    if (tid < 128) qg4[tid] = a.in[5][tid];
    __syncthreads();
    LAS unsigned char* wl4 = lds + wave * AQ_WAVE_LDS;
    if (nscan == 32 && (G & 7) == 0) {
        const int bb = bid & 7, wl_i = ((bid - 32) >> 3) * 8 + wave, nwl = ((G - 32) >> 3) * 8;
        for (int p = wl_i; p < SEQ; p += nwl) attn_query_q4(a, wl4, qg4, bb * SEQ + p, lane);
        if (P4_REP & 2) for (int p = wl_i; p < SEQ; p += nwl) attn_query_q4(a, wl4, qg4, bb * SEQ + p, lane);
    } else {
        const int gw = (bid - nscan) * 8 + wave, NGW = (G - nscan) * 8;
        for (int t = gw; t < T_TOK; t += NGW) attn_query_q4(a, wl4, qg4, t, lane);
    }
}

#define INS16P(L, v_) do { float _x = (v_); \
    _Pragma("unroll") for (int _k = 0; _k < 16; ++_k) { const float _h = __builtin_fmaxf(L[_k], _x); _x = __builtin_fminf(L[_k], _x); L[_k] = _h; } } while (0)
#define CE_D(a_, b_) do { const float _h = __builtin_fmaxf(a_, b_), _l = __builtin_fminf(a_, b_); a_ = _h; b_ = _l; } while (0)
#define SORT16_DESC(A) do { \
    _Pragma("unroll") for (int k_ = 2; k_ <= 16; k_ <<= 1) \
    _Pragma("unroll") for (int j_ = k_ >> 1; j_ > 0; j_ >>= 1) \
    _Pragma("unroll") for (int i_ = 0; i_ < 16; ++i_) { const int l_ = i_ ^ j_; if (l_ > i_) { if ((i_ & k_) == 0) CE_D(A[i_], A[l_]); else CE_D(A[l_], A[i_]); } } } while (0)
#define MERGE16_TOP(L, B) do { \
    _Pragma("unroll") for (int i_ = 0; i_ < 16; ++i_) L[i_] = __builtin_fmaxf(L[i_], B[15 - i_]); \
    _Pragma("unroll") for (int j_ = 8; j_ > 0; j_ >>= 1) \
    _Pragma("unroll") for (int i_ = 0; i_ < 16; ++i_) { const int l_ = i_ ^ j_; if (l_ > i_) CE_D(L[i_], L[l_]); } } while (0)
__device__ __forceinline__ float packf(float v, unsigned id, unsigned mask) { return __uint_as_float((__float_as_uint(v) & ~mask) | id); }

__device__ __forceinline__ void peer_route_unit(const Args& a, LAS float* SC, int tt, int p, int lane) {
    const bf16* query = (const bf16*)(a.ws + WS_QUERY); const bf16* subk = (const bf16*)(a.ws + WS_SUBK);
    int* expid = (int*)(a.ws + WS_EXPID); float* gate = (float*)(a.ws + WS_GATE);
    const int r = lane & 15, g = lane >> 4;
    const int tok = lane & 31, ch = lane >> 5;
    float L1[16], L2[16];
#pragma unroll
    for (int k = 0; k < 16; ++k) { L1[k] = 0.f; L2[k] = 0.f; }
#pragma unroll 1
    for (int half = 0; half < 2; ++half) {
        bf16x8 bk[8][4];
        {
            const bf16* kp = subk + (size_t)((p * 2 + half) * 128 + r) * 128 + 8 * g;
#pragma unroll
            for (int nt = 0; nt < 8; ++nt)
#pragma unroll
                for (int ks = 0; ks < 4; ++ks) bk[nt][ks] = *(const bf16x8*)(kp + (size_t)nt * 16 * 128 + 32 * ks);
        }
        bf16x8 af[2][4];
#pragma unroll
        for (int mt = 0; mt < 2; ++mt) {
            const bf16* qp = query + (size_t)(tt * 32 + mt * 16 + r) * 2048 + p * 256 + half * 128 + 8 * g;
#pragma unroll
            for (int ks = 0; ks < 4; ++ks) af[mt][ks] = *(const bf16x8*)(qp + 32 * ks);
        }
#pragma unroll
        for (int mt = 0; mt < 2; ++mt) {
#pragma unroll
            for (int nt = 0; nt < 8; ++nt) {
                f32x4 acc = (f32x4){0.f, 0.f, 0.f, 0.f};
#pragma unroll
                for (int ks = 0; ks < 4; ++ks) acc = __builtin_amdgcn_mfma_f32_16x16x32_bf16(af[mt][ks], bk[nt][ks], acc, 0, 0, 0);
#pragma unroll
                for (int rg = 0; rg < 4; ++rg) SC[(mt * 16 + 4 * g + rg) * 132 + nt * 16 + r] = acc[rg];
            }
        }
        LDS_WAIT();
        float L[16];
#pragma unroll
        for (int c16 = 0; c16 < 4; ++c16) {
            float B[16];
#pragma unroll
            for (int c4 = 0; c4 < 4; ++c4) {
                const f32x4 v = *(const LAS f32x4*)(SC + tok * 132 + 64 * ch + 16 * c16 + 4 * c4);
                const unsigned n0 = 64 * ch + 16 * c16 + 4 * c4;
                B[4 * c4] = packf(v.x, n0, 127u); B[4 * c4 + 1] = packf(v.y, n0 + 1, 127u); B[4 * c4 + 2] = packf(v.z, n0 + 2, 127u); B[4 * c4 + 3] = packf(v.w, n0 + 3, 127u);
            }
            SORT16_DESC(B);
            if (c16 == 0) {
#pragma unroll
                for (int k = 0; k < 16; ++k) L[k] = B[k];
            } else MERGE16_TOP(L, B);
        }
        {
            float B[16];
#pragma unroll
            for (int k = 0; k < 16; ++k) B[k] = __shfl(L[k], tok + 32);
            MERGE16_TOP(L, B);
        }
#pragma unroll
        for (int k = 0; k < 16; ++k) { L1[k] = (half == 0) ? L[k] : L1[k]; L2[k] = (half == 0) ? L2[k] : L[k]; }
        LDS_WAIT();
    }
    float V1[16], V2[16];
#pragma unroll
    for (int k = 0; k < 16; ++k) { V1[k] = __uint_as_float(__float_as_uint(L1[k]) & ~127u); V2[k] = __uint_as_float(__float_as_uint(L2[k]) & ~127u); }
    float C[16];
#pragma unroll
    for (int k = 0; k < 16; ++k) C[k] = -INFINITY;
#pragma unroll
    for (int i = 0; i < 16; ++i)
#pragma unroll
        for (int j = 0; j < 16; ++j)
            if ((i + 1) * (j + 1) <= 16) INS16P(C, packf(V1[i] + V2[j], (unsigned)(i * 16 + j), 255u));
    if (ch == 0) {
        float e[16], sum = 0.f; int ex[16];
        const float c0 = __uint_as_float(__float_as_uint(C[0]) & ~255u);
#pragma unroll
        for (int k = 0; k < 16; ++k) {
            const unsigned cb = __float_as_uint(C[k]); const int ci = (cb >> 4) & 15, cj = cb & 15;
            int i1 = 0, i2 = 0;
#pragma unroll
            for (int m = 0; m < 16; ++m) { i1 = (ci == m) ? (int)(__float_as_uint(L1[m]) & 127u) : i1; i2 = (cj == m) ? (int)(__float_as_uint(L2[m]) & 127u) : i2; }
            ex[k] = i1 * 128 + i2;
            e[k] = expf(__uint_as_float(cb & ~255u) - c0); sum += e[k];
        }
        const float inv = 1.f / sum;
        const size_t base = ((size_t)(tt * 32 + tok) * 8 + p) * 16;
#pragma unroll
        for (int q = 0; q < 4; ++q) {
            *(v4u*)(expid + base + 4 * q) = (v4u){(unsigned)ex[4 * q], (unsigned)ex[4 * q + 1], (unsigned)ex[4 * q + 2], (unsigned)ex[4 * q + 3]};
            *(f32x4*)(gate + base + 4 * q) = (f32x4){e[4 * q] * inv, e[4 * q + 1] * inv, e[4 * q + 2] * inv, e[4 * q + 3] * inv};
        }
    }
}
__device__ __forceinline__ void phase8(const Args& a, LAS unsigned char* lds) {
    const int tid = threadIdx.x, lane = tid & 63, wave = tid >> 6;
    LAS float* SC = (LAS float*)(lds + wave * 16896);
    const int gw = blockIdx.x * 8 + wave, NGW = gridDim.x * 8;
#ifndef P8_REP
#define P8_REP 1
#endif
    for (int rep_ = 0; rep_ < P8_REP; ++rep_)
    for (int u = gw; u < 1024 * 8; u += NGW) peer_route_unit(a, SC, u >> 3, u & 7, lane);
}

typedef float f32x2 __attribute__((ext_vector_type(2)));
__device__ __forceinline__ void cvt8(const v4u u, float* f) { f[0] = bflo(u.x); f[1] = bfhi(u.x); f[2] = bflo(u.y); f[3] = bfhi(u.y); f[4] = bflo(u.z); f[5] = bfhi(u.z); f[6] = bflo(u.w); f[7] = bfhi(u.w); }
__device__ __forceinline__ void cvt16_fp8(const v4u u, float* f) {
#pragma unroll
    for (int q = 0; q < 4; ++q) { const f32x2 lo = __builtin_amdgcn_cvt_pk_f32_fp8((int)u[q], false), hi = __builtin_amdgcn_cvt_pk_f32_fp8((int)u[q], true);
        f[4 * q] = lo.x; f[4 * q + 1] = lo.y; f[4 * q + 2] = hi.x; f[4 * q + 3] = hi.y; }
}
#define DPPF(x_, ctrl_) __builtin_bit_cast(float, __builtin_amdgcn_update_dpp(0, __builtin_bit_cast(int, (x_)), (ctrl_), 0xF, 0xF, false))
__device__ __forceinline__ float reduce8(const float* d, int lane) {
    const bool b0 = lane & 1, b1 = lane & 2, b2 = lane & 4;
    float s1[4], s2[2];
#pragma unroll
    for (int i = 0; i < 4; ++i) { const float a = b0 ? d[2 * i + 1] : d[2 * i], b = b0 ? d[2 * i] : d[2 * i + 1]; s1[i] = a + DPPF(b, 0xB1); }
#pragma unroll
    for (int i = 0; i < 2; ++i) { const float a = b1 ? s1[2 * i + 1] : s1[2 * i], b = b1 ? s1[2 * i] : s1[2 * i + 1]; s2[i] = a + DPPF(b, 0x4E); }
    const float a3 = b2 ? s2[1] : s2[0], b3 = b2 ? s2[0] : s2[1];
    float s = a3 + DPPF(b3, 0x124);
    s += DPPF(s, 0x128);
    s += __shfl_xor(s, 16); s += __shfl_xor(s, 32);
    return s;
}
constexpr int P9L_WAVE = 4 * (136 * 4 * 3);
__device__ __forceinline__ void phase9l(const Args& a, LAS unsigned char* lds) {
    const int tid = threadIdx.x, lane = tid & 63, wave = tid >> 6, G = gridDim.x;
    const unsigned char* UT = a.ws + WS_UT; const unsigned char* VT = a.ws + WS_VT;
    const float* SU = (const float*)(a.ws + WS_SU); const float* SV = (const float*)(a.ws + WS_SV);
    const int* expid = (const int*)(a.ws + WS_EXPID); const float* gate = (const float*)(a.ws + WS_GATE);
    const float* mod = (const float*)(a.ws + WS_MOD);
    LAS int* LE = (LAS int*)(lds + wave * P9L_WAVE);
    LAS float* LG = (LAS float*)(LE + 4 * 136);
    LAS float* LA = LG + 4 * 136;
    const bool isdiag = (lane >> 4) == ((lane & 15) >> 2);
    for (int rd = 0; ; ++rd) {
        const int tb = ((rd * G + (int)blockIdx.x) * 8 + wave) * 4;
        if (tb >= T_TOK) break;
        v4u h8[4]; float hsc[4]; int off[4][5];
#pragma unroll
        for (int i = 0; i < 4; ++i) {
            const size_t t = (size_t)(tb + i);
            h8[i] = *(const v4u*)(a.ws + WS_H8 + t * DM + 16 * lane); hsc[i] = ((const float*)(a.ws + WS_HS))[t];
            int e[2]; float gq[2];
#pragma unroll
            for (int q = 0; q < 2; ++q) { e[q] = expid[t * 128 + lane + 64 * q]; gq[q] = gate[t * 128 + lane + 64 * q]; }
            int base = 0;
#pragma unroll
            for (int s = 0; s < 4; ++s) {
                off[i][s] = base;
#pragma unroll
                for (int q = 0; q < 2; ++q) {
                    const bool in = (e[q] >> 12) == s;
                    const unsigned long long mk = __builtin_amdgcn_ballot_w64(in);
                    const int pos = base + __builtin_amdgcn_mbcnt_hi((unsigned)(mk >> 32), __builtin_amdgcn_mbcnt_lo((unsigned)mk, 0));
                    if (in) { LE[i * 136 + pos] = e[q]; LG[i * 136 + pos] = gq[q]; }
                    base += __builtin_popcountll(mk);
                }
            }
            off[i][4] = 128;
            if (lane < 8) LE[i * 136 + 128 + lane] = e[0];
        }
        LDS_WAIT();
#pragma unroll 1
        for (int s = 0; s < 4; ++s) {
#pragma unroll
            for (int i = 0; i < 4; ++i) {
                for (int g0 = off[i][s]; g0 < off[i][s + 1]; g0 += 8) {
                    const int n = off[i][s + 1] - g0;
                    const int ev = LE[i * 136 + g0 + (lane & 7)];
                    v4u ua[8];
#pragma unroll
                    for (int k = 0; k < 8; ++k) { const int e = __builtin_amdgcn_readlane(ev, k); ua[k] = *(const v4u*)(UT + (size_t)e * 1024 + 16 * lane); }
                    float dd[8];
#pragma unroll
                    for (int k = 0; k < 8; ++k) {
                        f32x4 cacc = (f32x4){0.f, 0.f, 0.f, 0.f};
                        cacc = __builtin_amdgcn_mfma_f32_16x16x32_fp8_fp8((long)(((unsigned long long)ua[k].y << 32) | ua[k].x), (long)(((unsigned long long)h8[i].y << 32) | h8[i].x), cacc, 0, 0, 0);
                        cacc = __builtin_amdgcn_mfma_f32_16x16x32_fp8_fp8((long)(((unsigned long long)ua[k].w << 32) | ua[k].z), (long)(((unsigned long long)h8[i].w << 32) | h8[i].z), cacc, 0, 0, 0);
                        const float c01 = (lane & 1) ? cacc[1] : cacc[0], c23 = (lane & 1) ? cacc[3] : cacc[2];
                        dd[k] = isdiag ? ((lane & 2) ? c23 : c01) : 0.f;
                    }
                    const float tot = reduce8(dd, lane);
                    if (lane < 8 && lane < n) LA[i * 136 + g0 + lane] = tot;
                }
            }
        }
        LDS_WAIT();
#pragma unroll
        for (int i = 0; i < 4; ++i)
#pragma unroll
            for (int q = 0; q < 2; ++q) { const int ix = i * 136 + lane + 64 * q; const int e = LE[ix];
                const float dq = LA[ix] * SU[e] * hsc[i];
                LA[ix] = 0.5f * dq * (1.f + erff(dq * 0.70710678118654752f)) * LG[ix] * SV[e]; }
        LDS_WAIT();
        float y[4][16];
#pragma unroll
        for (int i = 0; i < 4; ++i)
#pragma unroll
            for (int c = 0; c < 16; ++c) y[i][c] = 0.f;
#pragma unroll 1
        for (int s = 0; s < 4; ++s) {
#pragma unroll
            for (int i = 0; i < 4; ++i) {
                for (int g0 = off[i][s]; g0 < off[i][s + 1]; g0 += 8) {
                    const int n = off[i][s + 1] - g0;
                    const int ev = LE[i * 136 + g0 + (lane & 7)];
                    const float av = ((lane & 7) < n) ? LA[i * 136 + g0 + (lane & 7)] : 0.f;
                    v4u va[8];
#pragma unroll
                    for (int k = 0; k < 8; ++k) { const int e = __builtin_amdgcn_readlane(ev, k); va[k] = *(const v4u*)(VT + (size_t)e * 1024 + 16 * lane); }
#pragma unroll
                    for (int k = 0; k < 8; ++k) { const float aj = __builtin_bit_cast(float, __builtin_amdgcn_readlane(__builtin_bit_cast(int, av), k));
                        float f[16]; cvt16_fp8(va[k], f);
#pragma unroll
                        for (int c = 0; c < 16; ++c) y[i][c] = __builtin_fmaf(aj, f[c], y[i][c]); }
                }
            }
        }
#pragma unroll
        for (int i = 0; i < 4; ++i) {
            const int t = tb + i, b = t >> 12;
            float* orow = a.out + (size_t)t * DM + 16 * lane; const float* g2 = mod + b * 6144 + 5120 + 16 * lane;
#pragma unroll
            for (int q4 = 0; q4 < 4; ++q4) {
                const f32x4 xv = *(const f32x4*)(orow + 4 * q4), gv = *(const f32x4*)(g2 + 4 * q4);
                const f32x4 yv = (f32x4){y[i][4 * q4], y[i][4 * q4 + 1], y[i][4 * q4 + 2], y[i][4 * q4 + 3]};
                *(f32x4*)(orow + 4 * q4) = xv + gv * yv;
            }
        }
        LDS_WAIT();
    }
}

#define XB_TMO      128
#define XB_XCNT(j)  (256  + 64 * (j))
#define XB_XSUB(j)  (1280 + 64 * (j))
#define XB_XGEN(j)  (2304 + 64 * (j))
#define XB_TOP      3328
#define XB_TOPGEN   3392
#define XCD_BAR_WORDS 3456
#define XB_SPIN_CAP (1u << 18)

__device__ __forceinline__ unsigned xb_ld(unsigned* p)              { return __hip_atomic_load(p, __ATOMIC_RELAXED, __HIP_MEMORY_SCOPE_AGENT); }
__device__ __forceinline__ unsigned xb_add(unsigned* p, unsigned v) { return __hip_atomic_fetch_add(p, v, __ATOMIC_RELAXED, __HIP_MEMORY_SCOPE_AGENT); }
__device__ __forceinline__ unsigned xb_xcc_id() { return (unsigned)__builtin_amdgcn_s_getreg((3 << 11) | 20) & 0xFu; }
#define XB_SPIN(cond, bar) do { unsigned _sp = 0; while (cond) { __builtin_amdgcn_s_sleep(1); \
    if ((++_sp & 255u) == 0u) { if (xb_ld(&(bar)[XB_TMO])) break; if (_sp > XB_SPIN_CAP) { atomicAdd(&(bar)[XB_TMO], 1u); break; } } } } while (0)

struct XcdBarrier {
    unsigned* bar; unsigned x;
    volatile LAS unsigned* st;
};

__device__ __forceinline__ XcdBarrier xcd_barrier_post(unsigned* bar, volatile LAS unsigned* st) {
    XcdBarrier b; b.bar = bar; b.x = xb_xcc_id(); b.st = st;
    if (threadIdx.x == 0) (void)xb_add(&bar[XB_XCNT(b.x)], 1u);
    return b;
}
__device__ __forceinline__ void xcd_barrier_complete(unsigned* bar, unsigned x, unsigned& nloc, unsigned& nx) {
    const unsigned G = gridDim.x * gridDim.y * gridDim.z;
    unsigned sum, cnt, mine, sp = 0u;
    for (;;) {
        sum = 0u; cnt = 0u; mine = 0u;
#pragma unroll
        for (unsigned j = 0; j < 16; ++j) { const unsigned c = xb_ld(&bar[XB_XCNT(j)]); sum += c; cnt += (c > 0u) ? 1u : 0u; mine = (j == x) ? c : mine; }
        if (sum == G) break;
        __builtin_amdgcn_s_sleep(1);
        if ((++sp & 255u) == 0u) { if (xb_ld(&bar[XB_TMO])) break; if (sp > XB_SPIN_CAP) { atomicAdd(&bar[XB_TMO], 1u); break; } }
    }
    nloc = mine > 0u ? mine : 1u; nx = cnt > 0u ? cnt : 1u;
}

__device__ __forceinline__ void xcd_barrier(const XcdBarrier& b) {
    asm volatile("s_waitcnt vmcnt(0)" ::: "memory");
    __syncthreads();
    if (threadIdx.x == 0) {
        unsigned* bar = b.bar;
        __builtin_amdgcn_s_waitcnt(0);
        unsigned nloc = b.st[0], nx = b.st[1];
        if (nloc == 0u) { xcd_barrier_complete(bar, b.x, nloc, nx); b.st[0] = nloc; b.st[1] = nx; }
        const unsigned old = xb_add(&bar[XB_XSUB(b.x)], 1u);
        const unsigned gen = old / nloc;
        if (old + 1u == (gen + 1u) * nloc) {
            __builtin_amdgcn_fence(__ATOMIC_RELEASE, "agent");
            asm volatile("s_waitcnt vmcnt(0)" ::: "memory");
            const unsigned og = xb_add(&bar[XB_TOP], 1u);
            const unsigned tg = og / nx;
            if (og + 1u == (tg + 1u) * nx) xb_add(&bar[XB_TOPGEN], 1u);
            else XB_SPIN(xb_ld(&bar[XB_TOPGEN]) == tg, bar);
            __builtin_amdgcn_fence(__ATOMIC_ACQUIRE, "agent");
            xb_add(&bar[XB_XGEN(b.x)], 1u);
            asm volatile("s_waitcnt vmcnt(0)" ::: "memory");
        } else {
            XB_SPIN(xb_ld(&bar[XB_XGEN(b.x)]) == gen, bar);
            __builtin_amdgcn_fence(__ATOMIC_ACQUIRE, "agent");
            asm volatile("s_waitcnt vmcnt(0)" ::: "memory");
        }
    }
    __syncthreads();
}

__global__ void __launch_bounds__(512, 2) mega_fwd(Args a) {
    extern __shared__ __attribute__((aligned(16))) unsigned char lds_raw[];
    LAS unsigned char* lds = (LAS unsigned char*)lds_raw;
    asm volatile("" : "+v"(lds));
    cg::grid_group grid = cg::this_grid();
#define MISC_PTR ((volatile LAS unsigned*)((LAS unsigned char*)lds_raw + (LDS_BYTES - 64)))
    if (threadIdx.x < 16) MISC_PTR[threadIdx.x] = 0u;
    __syncthreads();
    const unsigned xcc_id = xcd_barrier_post((unsigned*)(a.ws + WS_CTL) + 4096, MISC_PTR).x;
    grid.sync();
    unsigned char* ws = a.ws;
    const int lo = a.ph_lo, hi = a.ph_hi;
#ifndef PH_MASK
#define PH_MASK 0x3ff
#endif
#define IN(k) (((PH_MASK >> (k)) & 1) && lo <= (k) && (k) < hi)
#define SEAM(k) do { if (IN(k) && IN((k) + 1)) { if ((k) == 99) grid.sync(); else { XcdBarrier xb_; xb_.bar = (unsigned*)(a.ws + WS_CTL) + 4096; xb_.x = xcc_id; xb_.st = MISC_PTR; xcd_barrier(xb_); } } } while (0)
#ifndef REP_MASK
#define REP_MASK 0
#endif
#define RUNP(k, body) do { if (IN(k)) { body; if ((REP_MASK >> (k)) & 1) { grid.sync(); body; } } } while (0)
    RUNP(0, phase0(a, lds)); SEAM(0);
    RUNP(1, phase_norm(a.in[0], (const float*)(ws + WS_MOD), 0, 1024, (bf16*)(ws + WS_H))); SEAM(1);
    RUNP(2, ({
        pg8::Gemm g{(const pg8::bf16_t*)(ws + WS_H), (const pg8::bf16_t*)(ws + WS_WIN), T_TOK, PW, DM}; pg8::StaticOrder S; S.init(T_TOK, PW, gridDim.x, blockIdx.x);
        EpiBf E{(bf16*)(ws + WS_PROJ), PW};
        pg8::gemm_phase<EpiBf, pg8::StaticOrder>(lds, g, S, E, nullptr); })); SEAM(2);
#ifdef IDX_FP32
    if (IN(3)) { phase_idx32(a, lds); grid.sync(); }
#endif
    RUNP(3, phase3(a, lds)); SEAM(3);
    RUNP(4, phase4(a, lds)); SEAM(4);
    RUNP(5, ({
        pg8::Gemm g{(const pg8::bf16_t*)(ws + WS_YAB), (const pg8::bf16_t*)(ws + WS_BT2), T_TOK, DM, YW}; pg8::StaticOrder S; S.init(T_TOK, DM, gridDim.x, blockIdx.x);
        EpiX1 E{a.in[0], a.out, (const float*)(ws + WS_MOD)};
        pg8::gemm_phase<EpiX1, pg8::StaticOrder>(lds, g, S, E, nullptr); })); SEAM(5);
    RUNP(6, phase_norm(a.out, (const float*)(ws + WS_MOD), 3072, 4096, (bf16*)(ws + WS_H), ws + WS_H8, (float*)(ws + WS_HS))); SEAM(6);
    RUNP(7, ({
        pg8::Gemm g{(const pg8::bf16_t*)(ws + WS_H), (const pg8::bf16_t*)(ws + WS_WQ), T_TOK, 2048, DM}; pg8::StaticOrder S; S.init(T_TOK, 2048, gridDim.x, blockIdx.x);
        EpiBf E{(bf16*)(ws + WS_QUERY), 2048};
        pg8::gemm_phase<EpiBf, pg8::StaticOrder>(lds, g, S, E, nullptr); })); SEAM(7);
    RUNP(8, phase8(a, lds)); SEAM(8);
    if (IN(9)) { phase9l(a, lds); }
#undef IN
#undef SEAM
}

#ifndef MK_N_LAUNCHES
#define MK_N_LAUNCHES 1
#endif
extern "C" void kernel_launch(void* const* d_in, const int* in_sizes, int n_in, void* d_out, int out_size, void* d_ws, size_t ws_size, hipStream_t stream) {
    static int grid = 0;
    if (grid == 0) {
        int dev = 0, cus = 0, per_cu = 0;
        hipGetDevice(&dev);
        hipDeviceGetAttribute(&cus, hipDeviceAttributeMultiprocessorCount, dev);
        hipFuncSetAttribute((const void*)mega_fwd, hipFuncAttributeMaxDynamicSharedMemorySize, LDS_BYTES);
        hipOccupancyMaxActiveBlocksPerMultiprocessor(&per_cu, (const void*)mega_fwd, 512, LDS_BYTES);
        if (per_cu < 1) { fprintf(stderr, "kernel_launch: occupancy query says %d blocks per CU\n", per_cu); per_cu = 1; }
        grid = cus * 1;
        if (n_in != 17 || ws_size < WS_END) fprintf(stderr, "kernel_launch: unexpected n_in %d / ws_size %zu\n", n_in, ws_size);
    }
    (void)hipMemsetAsync((char*)d_ws + WS_CTL, 0, 65536, stream);
    Args a{};
    for (int i = 0; i < 17; ++i) a.in[i] = (const float*)d_in[i];
    a.out = (float*)d_out; a.ws = (unsigned char*)d_ws;
#if MK_N_LAUNCHES == 1
    a.ph_lo = 0; a.ph_hi = 10;
    void* args[] = {&a};
    hipError_t e = hipLaunchCooperativeKernel((const void*)mega_fwd, dim3(grid), dim3(512), args, LDS_BYTES, stream);
    if (e != hipSuccess) fprintf(stderr, "cooperative launch failed: %s (grid %d)\n", hipGetErrorString(e), grid);
#else
    for (int p = 0; p < 10; ++p) { a.ph_lo = p; a.ph_hi = p + 1; hipLaunchKernelGGL(mega_fwd, dim3(grid), dim3(512), LDS_BYTES, stream, a); }
#endif
}
```

```cpp
#include <hip/hip_runtime.h>
#include <hip/hip_cooperative_groups.h>
#include <cstdio>
#include <cstdint>
namespace cg = cooperative_groups;
namespace pg8 {
#define PG8_LAS __attribute__((address_space(3)))
typedef unsigned short bf16_t;
typedef short bf16x8 __attribute__((ext_vector_type(8)));
typedef float f32x4 __attribute__((ext_vector_type(4)));
typedef unsigned u32x4 __attribute__((ext_vector_type(4)));
constexpr int BM = 256, BK = 64, HALF = 128, HTB = HALF * BK * 2  , STAGE_BYTES = 8 * HTB, NXCD = 8, WGM = 8;

__host__ __device__ __forceinline__ int lds_byte(int r, int c) { const int st = (r >> 4) * 2 + (c >> 5), rr = r & 15, cc = c & 31, ob = rr * 64 + cc * 2; return st * 1024 + (ob ^ (((ob >> 9) & 1) << 5)); }
__host__ __device__ __forceinline__ void stage_rc(int b, int& R, int& C) { const int st = b / 1024, sb = b % 1024, swz = sb ^ (((sb >> 9) & 1) << 5); R = (st >> 1) * 16 + swz / 64; C = (st & 1) * 32 + (swz % 64) / 2; }
__host__ __device__ __forceinline__ int perm32(int rho) { const int n = rho >> 4, i = rho & 15; return 8 * (i >> 2) + 4 * n + (i & 3); }

struct Unit { int pm, pn; };
struct Gemm { const bf16_t* A; const bf16_t* Bt; int M, N, K; };

struct StaticOrder {
    int nM, nN, nwg, G, c;
    __host__ __device__ void init(int M, int N, int G_, int c_) { nM = M / BM; nN = N / BM; nwg = nM * nN; G = G_; c = c_; }
    __host__ __device__ bool next(int i, Unit& u) const {
        const long L = (long)i * G + c; if (L >= nwg) return false;
        int wgid = (int)L; { const int q = nwg / NXCD, r = nwg % NXCD, xcd = wgid % NXCD, off = wgid / NXCD; wgid = (xcd < r ? xcd * (q + 1) : r * (q + 1) + (xcd - r) * q) + off; }
        const int nig = WGM * nN, gid = wgid / nig, fm = gid * WGM, gsz = (nM - fm) < WGM ? (nM - fm) : WGM;
        u.pm = fm + ((wgid % nig) % gsz); u.pn = (wgid % nig) / gsz; return true;
    }
    __device__ __forceinline__ void a_ready(const Unit&) const {}
    __device__ __forceinline__ void done(const Unit&) const {}
};
__device__ __forceinline__ unsigned cvt_pk_bf16(float lo, float hi) { unsigned r; asm volatile("v_cvt_pk_bf16_f32 %0, %1, %2" : "=v"(r) : "v"(lo), "v"(hi)); return r; }
template <class Epi, class Sched, bool STAMP = false>
__device__ __forceinline__ void gemm_phase(PG8_LAS unsigned char* lds, const Gemm g, const Sched& S, const Epi& E, unsigned long long* stamps) {
    const int tid = threadIdx.x, wid = __builtin_amdgcn_readfirstlane(tid >> 6), lane = tid & 63, wr = wid >> 2, wc = wid & 3, fr = lane & 15, fq = lane >> 4;
    const int K = g.K, nt = K / BK;
    int ts_lo = 0, ts_hi = 0, nts = 0; const unsigned long long rt_entry = STAMP ? (unsigned long long)wall_clock64() : 0ull;
#define PG8_STAMP() do { if (STAMP && wid == 0 && nts < 64) { const unsigned long long _c = (unsigned long long)clock64(); \
        ts_lo = (lane == nts) ? (int)(unsigned)_c : ts_lo; ts_hi = (lane == nts) ? (int)(unsigned)(_c >> 32) : ts_hi; ++nts; } } while (0)
    PG8_STAMP();
    unsigned voffA[2], voffB[2];
#pragma unroll
    for (int i = 0; i < 2; ++i) { int R, C; stage_rc(tid * 16 + i * 8192, R, C); const int Rb = Epi::PERM ? ((R & ~31) + perm32(R & 31)) : R;
        voffA[i] = (unsigned)(R * K + C) * 2u; voffB[i] = (unsigned)(Rb * K + C) * 2u; }
    const size_t kstep = (size_t)(BK * 2);
    const size_t hstep = (size_t)HALF * K * 2;
    const size_t tstep = 2 * hstep;
    const unsigned ldsw = (unsigned)wid * 1024u;
    const int aoff = lds_byte(wr * 64 + fr, fq * 8), boff = lds_byte(wc * 32 + fr, fq * 8);
#define PG8_SA(b, h) (((b) * 2 + (h)) * HTB)
#define PG8_SB(b, h) ((4 + (b) * 2 + (h)) * HTB)
#define PG8_STAGE(bufoff, gbase, voff) do { _Pragma("unroll") for (int _i = 0; _i < 2; ++_i) \
        __builtin_amdgcn_global_load_lds((const unsigned*)((const char*)(gbase) + (voff)[_i]), (PG8_LAS unsigned*)(lds + (bufoff) + ldsw + _i * 8192), 16, 0, 0); } while (0)
#define PG8_LDA(dst, b, h) do { _Pragma("unroll") for (int m = 0; m < 4; ++m) _Pragma("unroll") for (int k = 0; k < 2; ++k) dst[m][k] = *(const PG8_LAS bf16x8*)(lds + PG8_SA(b, h) + aoff + m * 2048 + k * 1024); } while (0)
#define PG8_LDB(dst, b, h) do { _Pragma("unroll") for (int n = 0; n < 2; ++n) _Pragma("unroll") for (int k = 0; k < 2; ++k) dst[n][k] = *(const PG8_LAS bf16x8*)(lds + PG8_SB(b, h) + boff + n * 2048 + k * 1024); } while (0)
#define PG8_MMA(ai, bj, At, Bt) do { __builtin_amdgcn_s_setprio(1); _Pragma("unroll") for (int m = 0; m < 4; ++m) _Pragma("unroll") for (int n = 0; n < 2; ++n) _Pragma("unroll") for (int k = 0; k < 2; ++k) \
        acc[ai][bj][m][n] = __builtin_amdgcn_mfma_f32_16x16x32_bf16(Bt[n][k], At[m][k], acc[ai][bj][m][n], 0, 0, 0); __builtin_amdgcn_s_setprio(0); } while (0)
#define PG8_WAIT_V(n) asm volatile("s_waitcnt vmcnt(" #n ")" ::: "memory")
#define PG8_WAIT_L(n) asm volatile("s_waitcnt lgkmcnt(" #n ")" ::: "memory")
#define PG8_BAR __builtin_amdgcn_s_barrier()
#define PG8_SCHED __builtin_amdgcn_sched_barrier(0)
    Unit cur, nxt; int ui = 0;
    if (!S.next(0, cur)) return;
    f32x4 acc[2][2][4][2];
#pragma unroll
    for (int a = 0; a < 2; ++a)
#pragma unroll
        for (int b = 0; b < 2; ++b)
#pragma unroll
            for (int m = 0; m < 4; ++m)
#pragma unroll
                for (int n = 0; n < 2; ++n) acc[a][b][m][n] = (f32x4){0.f, 0.f, 0.f, 0.f};
    bf16x8 At[4][2], B0[2][2], B1[2][2];
    const char* cA = (const char*)g.A + (size_t)cur.pm * tstep; const char* cB = (const char*)g.Bt + (size_t)cur.pn * tstep;
    S.a_ready(cur);
    PG8_STAGE(PG8_SB(0, 0), cB, voffB); PG8_STAGE(PG8_SA(0, 0), cA, voffA); PG8_STAGE(PG8_SB(0, 1), cB + hstep, voffB); PG8_STAGE(PG8_SA(0, 1), cA + hstep, voffA);
    if (wr == 1) PG8_BAR;
    PG8_WAIT_V(4); PG8_BAR;
    PG8_STAGE(PG8_SB(1, 0), cB + kstep, voffB); PG8_STAGE(PG8_SA(1, 0), cA + kstep, voffA); PG8_STAGE(PG8_SB(1, 1), cB + hstep + kstep, voffB);
    PG8_WAIT_V(6); PG8_BAR;
    PG8_STAMP();
    for (;;) {
        const bool has_next = S.next(ui + 1, nxt);
        const char* nA = has_next ? (const char*)g.A + (size_t)nxt.pm * tstep : cA; const char* nB = has_next ? (const char*)g.Bt + (size_t)nxt.pn * tstep : cB;
        for (int t = 0; t < nt; t += 2) {
            const bool last = (t == nt - 2);
            const char* a1 = cA + (size_t)(t + 1) * kstep;
            const char* a2 = last ? nA : cA + (size_t)(t + 2) * kstep; const char* b2 = last ? nB : cB + (size_t)(t + 2) * kstep;
            const char* a3 = a2 + kstep; const char* b3 = b2 + kstep;
            if (last && has_next) S.a_ready(nxt);
            PG8_LDB(B0, 0, 0); PG8_SCHED; PG8_LDA(At, 0, 0); PG8_STAGE(PG8_SA(1, 1), a1 + hstep, voffA);
            PG8_WAIT_L(8); PG8_BAR; PG8_WAIT_L(0); PG8_MMA(0, 0, At, B0); PG8_BAR; PG8_SCHED;
            PG8_LDB(B1, 0, 1); PG8_STAGE(PG8_SB(0, 0), b2, voffB);
            PG8_BAR; PG8_WAIT_L(0); PG8_MMA(0, 1, At, B1); PG8_BAR;
            PG8_LDA(At, 0, 1); PG8_STAGE(PG8_SA(0, 0), a2, voffA);
            PG8_BAR; PG8_WAIT_L(0); PG8_MMA(1, 0, At, B0); PG8_BAR; PG8_SCHED;
            PG8_STAGE(PG8_SB(0, 1), b2 + hstep, voffB);
            PG8_WAIT_V(6); PG8_BAR; PG8_MMA(1, 1, At, B1); PG8_BAR;
            PG8_LDB(B0, 1, 0); PG8_SCHED; PG8_LDA(At, 1, 0); PG8_STAGE(PG8_SA(0, 1), a2 + hstep, voffA);
            PG8_WAIT_L(8); PG8_BAR; PG8_WAIT_L(0); PG8_MMA(0, 0, At, B0); PG8_BAR; PG8_SCHED;
            PG8_LDB(B1, 1, 1); PG8_STAGE(PG8_SB(1, 0), b3, voffB);
            PG8_BAR; PG8_WAIT_L(0); PG8_MMA(0, 1, At, B1); PG8_BAR;
            PG8_LDA(At, 1, 1); PG8_STAGE(PG8_SA(1, 0), a3, voffA);
            PG8_BAR; PG8_WAIT_L(0); PG8_MMA(1, 0, At, B0); PG8_BAR; PG8_SCHED;
            PG8_STAGE(PG8_SB(1, 1), b3 + hstep, voffB);
            PG8_WAIT_V(6); PG8_BAR; PG8_MMA(1, 1, At, B1); PG8_BAR;
        }
        PG8_STAMP();
        if constexpr (!Epi::AFTER_DRAIN) { E(acc, cur, wr, wc, fr, fq); S.done(cur); }
        PG8_STAMP();
        if (!has_next) break;
#pragma unroll
        for (int a = 0; a < 2; ++a)
#pragma unroll
            for (int b = 0; b < 2; ++b)
#pragma unroll
                for (int m = 0; m < 4; ++m)
#pragma unroll
                    for (int n = 0; n < 2; ++n) acc[a][b][m][n] = (f32x4){0.f, 0.f, 0.f, 0.f};
        cur = nxt; cA = nA; cB = nB; ++ui;
    }
    PG8_WAIT_V(0);
    if (wr == 0) PG8_BAR;
    PG8_BAR;
    if constexpr (Epi::AFTER_DRAIN) { E.fused(acc, cur, wr, wc, fr, fq, lds, wid, lane); S.done(cur); }
    PG8_STAMP();
    if (STAMP && wid == 0) { stamps[lane] = lane < nts ? (((unsigned long long)(unsigned)ts_hi << 32) | (unsigned)ts_lo) : 0ull;
        if (lane == 62) stamps[62] = rt_entry; if (lane == 63) stamps[63] = (unsigned long long)wall_clock64(); }
#undef PG8_STAMP
#undef PG8_SA
#undef PG8_SB
#undef PG8_STAGE
#undef PG8_LDA
#undef PG8_LDB
#undef PG8_MMA
#undef PG8_WAIT_V
#undef PG8_WAIT_L
#undef PG8_BAR
#undef PG8_SCHED
}
}

#define LAS __attribute__((address_space(3)))
typedef unsigned short bf16;
typedef unsigned v4u __attribute__((ext_vector_type(4)));
typedef unsigned v2u __attribute__((ext_vector_type(2)));
typedef float f32x4 __attribute__((ext_vector_type(4)));
typedef float f32x16 __attribute__((ext_vector_type(16)));
typedef short bf16x8 __attribute__((ext_vector_type(8)));

constexpr int T_TOK = 32768, DM = 1024, SEQ = 4096, NBATCH = 8;
constexpr int PW = 3584;
constexpr int IN_W = 3532;
constexpr int C_AQ = 0, C_AKV = 1024, C_IQ = 1152, C_IK = 1408, C_IW = 1472, C_BA = 1476, C_BB = 1480, C_BQ = 1536, C_BK = 2048, C_BV = 2560, C_BZ = 3072;
constexpr int YW = 1536;
constexpr int NCHUNK = 2048;
constexpr float EPS = 1e-6f;

constexpr size_t MiB = 1u << 20;
constexpr size_t WS_CTL = 0;
constexpr size_t WS_MOD = 1 * MiB;
constexpr size_t WS_GL = WS_MOD + 256 * 1024;
constexpr size_t WS_SU = WS_MOD + 512 * 1024;
constexpr size_t WS_SV = WS_MOD + 640 * 1024;
constexpr size_t WS_WIN = 2 * MiB;
constexpr size_t WS_BT2 = 9 * MiB;
constexpr size_t WS_WQ = 12 * MiB;
constexpr size_t WS_SUBK = 16 * MiB;
constexpr size_t WS_H = 18 * MiB;
constexpr size_t WS_KN = WS_H;
constexpr size_t WS_SEL = WS_H + 8 * MiB;
constexpr size_t WS_PROJ = 82 * MiB;
constexpr size_t WS_QUERY = WS_PROJ;
constexpr size_t WS_YAB = 306 * MiB;
constexpr size_t WS_EXPID = WS_YAB;
constexpr size_t WS_GATE = WS_YAB + 16 * MiB;
constexpr size_t WS_H8 = WS_YAB + 32 * MiB;
constexpr size_t WS_HS = WS_YAB + 64 * MiB;
constexpr size_t WS_GA = 402 * MiB;
constexpr size_t WS_UT = 418 * MiB;
constexpr size_t WS_VT = 450 * MiB;
constexpr size_t WS_END = 482 * MiB;
constexpr size_t DO_W = 0, DO_QD = 32 * MiB, DO_KDT = 64 * MiB, DO_UT = 96 * MiB;

constexpr int LDS_BYTES = 147456;

struct Args { const float* in[17]; float* out; unsigned char* ws; int ph_lo, ph_hi; };

__device__ __forceinline__ unsigned pk2(float lo, float hi) { unsigned r; asm("v_cvt_pk_bf16_f32 %0, %1, %2" : "=v"(r) : "v"(lo), "v"(hi)); return r; }
__device__ __forceinline__ unsigned f2bf(float f) { return pk2(f, f) & 0xffffu; }
__device__ __forceinline__ float bflo(unsigned u) { return __uint_as_float(u << 16); }
__device__ __forceinline__ float bfhi(unsigned u) { return __uint_as_float(u & 0xffff0000u); }
__device__ __forceinline__ float bf1(bf16 b) { return __uint_as_float(((unsigned)b) << 16); }
__device__ __forceinline__ float wave_sum(float v) {
#pragma unroll
    for (int o = 1; o < 64; o <<= 1) v += __shfl_xor(v, o);
    return v;
}
__device__ __forceinline__ float wave_max(float v) {
#pragma unroll
    for (int o = 1; o < 64; o <<= 1) v = fmaxf(v, __shfl_xor(v, o));
    return v;
}
__device__ __forceinline__ float silu_f(float v) { return v / (1.f + expf(-v)); }
__device__ __forceinline__ float silu_fast(float v) { return v * __builtin_amdgcn_rcpf(1.f + __expf(-v)); }
__device__ __forceinline__ float sigmoid_f(float v) { return 1.f / (1.f + expf(-v)); }
__device__ __forceinline__ float softplus_f(float v) { return fmaxf(v, 0.f) + log1pf(expf(-fabsf(v))); }
#define LDS_WAIT() asm volatile("s_waitcnt lgkmcnt(0)" ::: "memory")

__device__ __forceinline__ int win_srccol(int n) {
    if (n < 1476) return n;
    if (n < 1480) return 3524 + (n - 1476);
    if (n < 1484) return 3528 + (n - 1480);
    if (n < 1536) return -1;
    return 1476 + (n - 1536);
}
__device__ __forceinline__ void transpose_item(const float* W, int spitch, int k0, int sc, bf16* WT, int dpitch, int drow0, int dcol0, LAS float* scr, int lane) {
#pragma unroll 8
    for (int i = 0; i < 32; ++i) { const int kk = 2 * i + (lane >> 5); scr[kk * 33 + (lane & 31)] = (sc >= 0) ? W[(size_t)(k0 + kk) * spitch + sc] : 0.f; }
    LDS_WAIT();
    const int c = lane & 7;
#pragma unroll
    for (int j = 0; j < 4; ++j) { const int n = (lane >> 3) + 8 * j; const LAS float* s = scr + (8 * c) * 33 + n;
        v4u o; o.x = pk2(s[0 * 33], s[1 * 33]); o.y = pk2(s[2 * 33], s[3 * 33]); o.z = pk2(s[4 * 33], s[5 * 33]); o.w = pk2(s[6 * 33], s[7 * 33]);
        *(v4u*)(WT + (size_t)(drow0 + n) * dpitch + dcol0 + 8 * c) = o; }
    LDS_WAIT();
}

__device__ __forceinline__ void phase0(const Args& a, LAS unsigned char* lds) {
    const int tid = threadIdx.x, lane = tid & 63, wave = tid >> 6, bid = blockIdx.x, G = gridDim.x;
    unsigned char* ws = a.ws;
#ifndef P0_REP
#define P0_REP 0
#endif
    for (int rep0_ = 0; rep0_ < 1 + (P0_REP ? 1 : 0); ++rep0_) {
    if (rep0_ == 0 || (P0_REP & 1))
    for (int item = bid; item < 192; item += G) {
        LAS float* sc = (LAS float*)lds;
        LAS float* red = sc + 8192;
        const float* c = a.in[1];
        for (int i = tid; i < 8192; i += 512) sc[i] = silu_f(c[i]);
        __syncthreads();
        const int cc = tid & 31, kg = tid >> 5;
        const float* w = a.in[2] + item * 32 + cc;
        float acc[8];
#pragma unroll
        for (int b = 0; b < 8; ++b) acc[b] = 0.f;
        for (int k = kg; k < 1024; k += 16) { const float wv = w[(size_t)k * 6144];
#pragma unroll
            for (int b = 0; b < 8; ++b) acc[b] += sc[b * 1024 + k] * wv; }
#pragma unroll
        for (int b = 0; b < 8; ++b) red[(kg * 8 + b) * 32 + cc] = acc[b];
        __syncthreads();
        if (tid < 256) { const int b = tid >> 5; float s = 0.f;
            for (int k2 = 0; k2 < 16; ++k2) s += red[(k2 * 8 + b) * 32 + cc];
            ((float*)(ws + WS_MOD))[b * 6144 + item * 32 + cc] = s + a.in[3][item * 32 + cc]; }
        __syncthreads();
    }
    if (rep0_ == 0 || (P0_REP & 2)) {
        LAS float* scr = (LAS float*)(lds + 65536 + wave * 8704);
        const int gw = bid * 8 + wave, NGW = G * 8;
        constexpr int I_WIN = 16 * 112, I_WQ = 16 * 64, I_WO = 8 * 32;
        for (int it = gw; it < I_WIN + I_WQ + I_WO; it += NGW) {
            int r = it;
            if (r < I_WIN) { const int kb = r / 112, nb = r % 112; transpose_item(a.in[4], IN_W, 64 * kb, win_srccol(32 * nb + (lane & 31)), (bf16*)(ws + WS_WIN), 1024, 32 * nb, 64 * kb, scr, lane); continue; }
            r -= I_WIN;
            if (r < I_WQ) { const int kb = r / 64, nb = r % 64; transpose_item(a.in[13], 2048, 64 * kb, 32 * nb + (lane & 31), (bf16*)(ws + WS_WQ), 1024, 32 * nb, 64 * kb, scr, lane); continue; }
            r -= I_WQ;
            { const int kb = r / 32, nb = r % 32; transpose_item(a.in[12] + (size_t)512 * 1024, 1024, 64 * kb, 32 * nb + (lane & 31), (bf16*)(ws + WS_BT2), YW, 32 * nb, 1024 + 64 * kb, scr, lane); }
        }
    }
    if (rep0_ == 0 || (P0_REP & 4)) {
        const float* wuv = a.in[7]; const float* wout = a.in[12]; bf16* bt2 = (bf16*)(ws + WS_BT2);
        for (int it = bid * 512 + tid; it < 1024 * 128; it += G * 512) {
            const int n = it & 1023, kb = __builtin_amdgcn_readfirstlane(it >> 10);
            const int h = kb >> 4, r0 = (kb & 15) * 8;
            float acc[8];
#pragma unroll
            for (int j = 0; j < 8; ++j) acc[j] = 0.f;
            for (int v = 0; v < 64; ++v) { const float wo = wout[(size_t)(h * 64 + v) * 1024 + n];
#pragma unroll
                for (int j = 0; j < 8; ++j) acc[j] += wuv[(size_t)(h * 128 + r0 + j) * 64 + v] * wo; }
            v4u o; o.x = pk2(acc[0], acc[1]); o.y = pk2(acc[2], acc[3]); o.z = pk2(acc[4], acc[5]); o.w = pk2(acc[6], acc[7]);
            *(v4u*)(bt2 + (size_t)n * YW + h * 128 + r0) = o;
        }
    }
    if (rep0_ == 0 || (P0_REP & 8)) {
        const size_t gt = (size_t)bid * 512 + tid, GT = (size_t)G * 512;
        for (size_t i = gt; i < 262144 / 8; i += GT) {
            const f32x4 v0 = *(const f32x4*)(a.in[14] + i * 8), v1 = *(const f32x4*)(a.in[14] + i * 8 + 4);
            v4u o; o.x = pk2(v0.x, v0.y); o.y = pk2(v0.z, v0.w); o.z = pk2(v1.x, v1.y); o.w = pk2(v1.z, v1.w);
            *(v4u*)((bf16*)(ws + WS_SUBK) + i * 8) = o;
        }
        const int gw = bid * 8 + wave, NGW = G * 8;
        for (int row = gw; row < 2 * 16384; row += NGW) {
            const int tb = row >> 14, e = row & 16383;
            const float* src = (tb ? a.in[16] : a.in[15]) + (size_t)e * 1024 + 16 * lane;
            f32x4 v[4]; float mx = 0.f;
#pragma unroll
            for (int q = 0; q < 4; ++q) { v[q] = *(const f32x4*)(src + 4 * q); mx = fmaxf(fmaxf(mx, fmaxf(fabsf(v[q].x), fabsf(v[q].y))), fmaxf(fabsf(v[q].z), fabsf(v[q].w))); }
            mx = wave_max(mx);
            const float scale = (mx > 0.f) ? mx * (1.f / 240.f) : 1.f, inv = 1.f / scale;
            v4u o;
#pragma unroll
            for (int q = 0; q < 4; ++q) { int p = __builtin_amdgcn_cvt_pk_fp8_f32(v[q].x * inv, v[q].y * inv, 0, false); p = __builtin_amdgcn_cvt_pk_fp8_f32(v[q].z * inv, v[q].w * inv, p, true); o[q] = (unsigned)p; }
            *(v4u*)(ws + (tb ? WS_VT : WS_UT) + (size_t)e * 1024 + 16 * lane) = o;
            if (lane == 0) ((float*)(ws + (tb ? WS_SV : WS_SU)))[e] = scale;
        }
    }
    }
}

__device__ __forceinline__ void phase_norm(const float* x, const float* mod, int shift_off, int scale_off, bf16* hout, unsigned char* h8 = nullptr, float* hs = nullptr) {
    const int tid = threadIdx.x, lane = tid & 63, wave = tid >> 6;
    const int gw = blockIdx.x * 8 + wave, NGW = gridDim.x * 8;
    for (int m = gw; m < T_TOK; m += NGW) {
        const int b = m >> 12;
        const f32x4* xr = (const f32x4*)(x + (size_t)m * DM) + lane;
        f32x4 v[4]; float s = 0.f;
#pragma unroll
        for (int j = 0; j < 4; ++j) { v[j] = xr[64 * j]; s += (v[j].x * v[j].x + v[j].y * v[j].y) + (v[j].z * v[j].z + v[j].w * v[j].w); }
        const float inv = rsqrtf(wave_sum(s) * (1.f / DM) + EPS);
        const f32x4* sh = (const f32x4*)(mod + b * 6144 + shift_off) + lane;
        const f32x4* sc = (const f32x4*)(mod + b * 6144 + scale_off) + lane;
        v2u* o8 = (v2u*)(hout + (size_t)m * DM) + lane;
        float amax = 0.f;
#pragma unroll
        for (int j = 0; j < 4; ++j) { const f32x4 a = sh[64 * j], c = sc[64 * j];
            v[j].x = v[j].x * inv * (1.f + c.x) + a.x; v[j].y = v[j].y * inv * (1.f + c.y) + a.y; v[j].z = v[j].z * inv * (1.f + c.z) + a.z; v[j].w = v[j].w * inv * (1.f + c.w) + a.w;
            v2u o; o.x = pk2(v[j].x, v[j].y); o.y = pk2(v[j].z, v[j].w);
            o8[64 * j] = o;
            amax = fmaxf(fmaxf(amax, fmaxf(fabsf(v[j].x), fabsf(v[j].y))), fmaxf(fabsf(v[j].z), fabsf(v[j].w))); }
        if (h8) {
            amax = wave_max(amax);
            const float scale = (amax > 0.f) ? amax * (1.f / 240.f) : 1.f, qi = 1.f / scale;
#pragma unroll
            for (int j = 0; j < 4; ++j) { int p = __builtin_amdgcn_cvt_pk_fp8_f32(v[j].x * qi, v[j].y * qi, 0, false); p = __builtin_amdgcn_cvt_pk_fp8_f32(v[j].z * qi, v[j].w * qi, p, true);
                *(unsigned*)(h8 + (size_t)m * DM + 4 * (lane + 64 * j)) = (unsigned)p; }
            if (lane == 0) hs[m] = scale;
        }
    }
}

struct EpiX1 {
    static constexpr bool PERM = false, AFTER_DRAIN = false;
    const float* x; float* out; const float* mod;
    __device__ __forceinline__ void operator()(const pg8::f32x4 (&acc)[2][2][4][2], const pg8::Unit& u, int wr, int wc, int fr, int fq) const {
        const int row0 = u.pm * 256 + wr * 64 + fr, col0 = u.pn * 256 + wc * 32 + 4 * fq;
        const int b = (u.pm * 256) >> 12;
        f32x4 gv[2][2];
#pragma unroll
        for (int bj = 0; bj < 2; ++bj)
#pragma unroll
            for (int n = 0; n < 2; ++n) gv[bj][n] = *(const f32x4*)(mod + b * 6144 + 2048 + col0 + bj * 128 + n * 16);
#pragma unroll
        for (int ai = 0; ai < 2; ++ai)
#pragma unroll
            for (int m = 0; m < 4; ++m) { const size_t ro = (size_t)(row0 + ai * 128 + m * 16) * DM + col0;
#pragma unroll
                for (int bj = 0; bj < 2; ++bj)
#pragma unroll
                    for (int n = 0; n < 2; ++n) { const f32x4 xv = *(const f32x4*)(x + ro + bj * 128 + n * 16);
                        *(f32x4*)(out + ro + bj * 128 + n * 16) = xv + gv[bj][n] * acc[ai][bj][m][n]; } }
    }
};
struct EpiBf {
    static constexpr bool PERM = true, AFTER_DRAIN = false;
    bf16* O; int ldc;
    __device__ __forceinline__ void operator()(const pg8::f32x4 (&acc)[2][2][4][2], const pg8::Unit& u, int wr, int wc, int fr, int fq) const {
        const int row0 = u.pm * 256 + wr * 64 + fr, col0 = u.pn * 256 + wc * 32 + 8 * fq;
#pragma unroll
        for (int ai = 0; ai < 2; ++ai)
#pragma unroll
            for (int m = 0; m < 4; ++m) { bf16* rowp = O + (size_t)(row0 + ai * 128 + m * 16) * ldc + col0;
#pragma unroll
                for (int bj = 0; bj < 2; ++bj) { const pg8::f32x4 zz = (pg8::f32x4){0.f, 0.f, 0.f, 0.f}; const pg8::f32x4 v0 = acc[ai][bj][m][0] + zz, v1 = acc[ai][bj][m][1] + zz;
                    v4u w; w.x = pg8::cvt_pk_bf16(v0[0], v0[1]); w.y = pg8::cvt_pk_bf16(v0[2], v0[3]); w.z = pg8::cvt_pk_bf16(v1[0], v1[1]); w.w = pg8::cvt_pk_bf16(v1[2], v1[3]);
                    *(v4u*)(rowp + bj * 128) = w; } }
    }
};

constexpr int GP_QS = 0, GP_KS = 33792, GP_VS = 67584, GP_LS = 101376, GP_GV = 118784;
__device__ __forceinline__ void gdn_prep_item(const Args& a, LAS unsigned char* lds, int chunk) {
    int tid = threadIdx.x; asm volatile("" : "+v"(tid));
    const int lane = tid & 63, wave = __builtin_amdgcn_readfirstlane(tid >> 6);
    unsigned char* ws = a.ws;
    const bf16* proj = (const bf16*)(ws + WS_PROJ);
    const int bh = chunk >> 6, n = chunk & 63, b = bh >> 2, h = bh & 3;
    const int t0 = b * SEQ + n * 64;
    LAS float* QS = (LAS float*)(lds + GP_QS); LAS float* KS = (LAS float*)(lds + GP_KS); LAS float* VS = (LAS float*)(lds + GP_VS);
    LAS float* LS = (LAS float*)(lds + GP_LS); LAS float* GV = (LAS float*)(lds + GP_GV);
#ifndef GP_MASK
#define GP_MASK 31
#endif
#ifndef GP_REP
#define GP_REP 0
#endif
    for (int rep_ = 0; rep_ < 1 + (GP_REP & 1); ++rep_)
    if ((GP_MASK & 1) && tid < 384) {
        const int cg = tid % 48, rs = tid / 48;
        const int sec = cg >> 4, c8 = (cg & 15) * 8;
        const int pcol = C_BQ + sec * 512 + h * 128 + c8;
        const float* cw = a.in[8] + sec * 512 + h * 128 + c8;
        float wt[4][8];
#pragma unroll
        for (int i = 0; i < 4; ++i) { const f32x4 w0 = *(const f32x4*)(cw + i * 1536), w1 = *(const f32x4*)(cw + i * 1536 + 4);
            wt[i][0] = w0.x; wt[i][1] = w0.y; wt[i][2] = w0.z; wt[i][3] = w0.w; wt[i][4] = w1.x; wt[i][5] = w1.y; wt[i][6] = w1.z; wt[i][7] = w1.w; }
        LAS float* XS = (sec == 0) ? QS : (sec == 1 ? KS : VS);
        v4u raw[11];
#pragma unroll
        for (int j = 0; j < 11; ++j) { const int rr = 8 * rs - 3 + j;
            raw[j] = (rr >= 0 || n > 0) ? *(const v4u*)(proj + (size_t)(t0 + rr) * PW + pcol) : (v4u){0u, 0u, 0u, 0u}; }
#pragma unroll
        for (int j = 0; j < 8; ++j) {
            float y[8];
#pragma unroll
            for (int c = 0; c < 8; ++c) y[c] = 0.f;
#pragma unroll
            for (int i = 0; i < 4; ++i) { float xv[8]; const v4u u = raw[j + i];
                xv[0] = bflo(u.x); xv[1] = bfhi(u.x); xv[2] = bflo(u.y); xv[3] = bfhi(u.y); xv[4] = bflo(u.z); xv[5] = bfhi(u.z); xv[6] = bflo(u.w); xv[7] = bfhi(u.w);
#pragma unroll
                for (int c = 0; c < 8; ++c) y[c] += wt[i][c] * xv[c]; }
            f32x4 o0, o1;
            o0.x = silu_f(y[0]); o0.y = silu_f(y[1]); o0.z = silu_f(y[2]); o0.w = silu_f(y[3]); o1.x = silu_f(y[4]); o1.y = silu_f(y[5]); o1.z = silu_f(y[6]); o1.w = silu_f(y[7]);
            *(LAS f32x4*)(XS + (8 * rs + j) * 132 + c8) = o0; *(LAS f32x4*)(XS + (8 * rs + j) * 132 + c8 + 4) = o1;
        }
    }
    if (wave == 7) {
        const int i = lane;
        const float av = bf1(proj[(size_t)(t0 + i) * PW + C_BA + h]), bv = bf1(proj[(size_t)(t0 + i) * PW + C_BB + h]);
        const float beta = sigmoid_f(bv);
        const float g = -expf(a.in[9][h]) * softplus_f(av + a.in[10][h]);
        float G = g;
#pragma unroll
        for (int o = 1; o < 64; o <<= 1) { const float t = __shfl_up(G, o); if (lane >= o) G += t; }
        const float Glast = __shfl(G, 63);
        GV[i] = G; GV[64 + i] = expf(G); GV[128 + i] = beta; GV[192 + i] = expf(Glast - G); GV[256 + i] = beta * expf(G);
        if (lane == 0) ((float*)(ws + WS_GL))[chunk] = expf(Glast);
    }
    __syncthreads();
    if (GP_MASK & 2) {
#pragma unroll 4
        for (int rr = 0; rr < 16; ++rr) {
            const int row = wave * 16 + rr;
            LAS float* X = (row < 64) ? (QS + row * 132) : (KS + (row - 64) * 132);
            const float v0 = X[lane], v1 = X[lane + 64];
            const float ss = wave_sum(v0 * v0 + v1 * v1);
            const float sc = rsqrtf(ss + EPS) * ((row < 64) ? 0.08838834764831845f : 1.f);
            X[lane] = v0 * sc; X[lane + 64] = v1 * sc;
        }
    }
    __syncthreads();
    for (int rep_ = 0; rep_ < 1 + ((GP_REP >> 2) & 1); ++rep_)
    if (GP_MASK & 4) {
        const int gram = wave >> 2, ti = wave & 3, r = lane & 15, g = lane >> 4;
        const LAS float* X = gram ? QS : KS;
        f32x4 acc[4];
#pragma unroll
        for (int tj = 0; tj < 4; ++tj) acc[tj] = (f32x4){0.f, 0.f, 0.f, 0.f};
#pragma unroll 2
        for (int kk = 0; kk < 8; ++kk) {
            const f32x4 xa = *(const LAS f32x4*)(X + (16 * ti + r) * 132 + 16 * kk + 4 * g);
#pragma unroll
            for (int tj = 0; tj < 4; ++tj) {
                if (tj <= ti) {
                    const f32x4 kb = *(const LAS f32x4*)(KS + (16 * tj + r) * 132 + 16 * kk + 4 * g);
                    acc[tj] = __builtin_amdgcn_mfma_f32_16x16x4f32(xa.x, kb.x, acc[tj], 0, 0, 0);
                    acc[tj] = __builtin_amdgcn_mfma_f32_16x16x4f32(xa.y, kb.y, acc[tj], 0, 0, 0);
                    acc[tj] = __builtin_amdgcn_mfma_f32_16x16x4f32(xa.z, kb.z, acc[tj], 0, 0, 0);
                    acc[tj] = __builtin_amdgcn_mfma_f32_16x16x4f32(xa.w, kb.w, acc[tj], 0, 0, 0);
                }
            }
        }
        bf16* Aout = (bf16*)(ws + WS_GA) + (size_t)chunk * 4096;
#pragma unroll
        for (int tj = 0; tj < 4; ++tj)
#pragma unroll
            for (int rg = 0; rg < 4; ++rg) {
                const int i = 16 * ti + 4 * g + rg, j = 16 * tj + r;
                const float dec = (j <= i) ? expf(GV[i] - GV[j]) : 0.f;
                if (gram == 0) { if (tj <= ti) LS[i * 68 + j] = (j < i) ? GV[128 + i] * acc[tj][rg] * dec : 0.f; }
                else Aout[((((i >> 4) * 2 + (j >> 5)) * 64 + (i & 15) + 16 * ((j >> 3) & 3)) << 3) + (j & 7)] = (bf16)f2bf((tj <= ti) ? acc[tj][rg] * dec : 0.f);
            }
    }
    __syncthreads();
    {
        bf16* QD = (bf16*)((unsigned char*)a.out + DO_QD) + (size_t)chunk * 8192;
        bf16* KDT = (bf16*)((unsigned char*)a.out + DO_KDT) + (size_t)chunk * 8192;
#pragma unroll
        for (int m = 0; m < 2; ++m) {
            const int p = tid + 512 * m;
            { const int i = p >> 4, k8 = (p & 15) * 8; const float e = GV[64 + i]; const LAS float* sq = QS + i * 132 + k8;
              v4u o; o.x = pk2(sq[0] * e, sq[1] * e); o.y = pk2(sq[2] * e, sq[3] * e); o.z = pk2(sq[4] * e, sq[5] * e); o.w = pk2(sq[6] * e, sq[7] * e);
              *(v4u*)(QD + ((((i >> 4) * 4 + ((p & 15) >> 2)) * 64 + (i & 15) + 16 * (p & 3)) << 3)) = o; }
            { const int k = p >> 3, i8 = (p & 7) * 8; float v[8];
#pragma unroll
              for (int j = 0; j < 8; ++j) v[j] = KS[(i8 + j) * 132 + k] * GV[192 + i8 + j];
              v4u o; o.x = pk2(v[0], v[1]); o.y = pk2(v[2], v[3]); o.z = pk2(v[4], v[5]); o.w = pk2(v[6], v[7]);
              *(v4u*)(KDT + ((((k >> 4) * 2 + ((p & 7) >> 2)) * 64 + (k & 15) + 16 * (p & 3)) << 3)) = o; }
        }
    }
    __syncthreads();
    {
#pragma unroll
        for (int m = 0; m < 4; ++m) {
            const int p = tid + 512 * m, i = p >> 5, c4 = (p & 31) * 4;
            const float mu = GV[128 + i], mw = GV[256 + i];
            f32x4 v = *(LAS f32x4*)(VS + i * 132 + c4); v.x *= mu; v.y *= mu; v.z *= mu; v.w *= mu; *(LAS f32x4*)(VS + i * 132 + c4) = v;
            f32x4 k = *(LAS f32x4*)(KS + i * 132 + c4); k.x *= mw; k.y *= mw; k.z *= mw; k.w *= mw; *(LAS f32x4*)(KS + i * 132 + c4) = k;
        }
    }
    __syncthreads();
    {
        const int r = lane & 15, g = lane >> 4;
#pragma unroll 1
        for (int I = 0; I < 4; ++I) {
            if (I > 0) {
#pragma unroll
                for (int tt = 0; tt < 2; ++tt) {
                    const int ct = 2 * wave + tt;
                    LAS float* XB = ((ct < 8) ? VS : KS) + (ct & 7) * 16 + r;
                    f32x4 acc;
#pragma unroll
                    for (int rg = 0; rg < 4; ++rg) acc[rg] = XB[(16 * I + 4 * g + rg) * 132];
                    for (int J = 0; J < I; ++J) {
#pragma unroll
                        for (int ks = 0; ks < 4; ++ks) {
                            const float la = -LS[(16 * I + r) * 68 + 16 * J + 4 * ks + g];
                            const float xb = XB[(16 * J + 4 * ks + g) * 132];
                            acc = __builtin_amdgcn_mfma_f32_16x16x4f32(la, xb, acc, 0, 0, 0);
                        }
                    }
#pragma unroll
                    for (int rg = 0; rg < 4; ++rg) XB[(16 * I + 4 * g + rg) * 132] = acc[rg];
                }
                __syncthreads();
            }
            if (tid < 256) {
                LAS float* XC = ((tid < 128) ? VS : KS) + (tid & 127);
                float x[16];
#pragma unroll
                for (int rr = 0; rr < 16; ++rr) {
                    float a0 = XC[(16 * I + rr) * 132], a1 = 0.f, a2 = 0.f, a3 = 0.f;
#pragma unroll
                    for (int j4 = 0; j4 < (rr + 3) / 4; ++j4) {
                        const f32x4 l = *(const LAS f32x4*)(LS + (16 * I + rr) * 68 + 16 * I + 4 * j4);
                        if (4 * j4 + 0 < rr) a0 -= l.x * x[4 * j4 + 0];
                        if (4 * j4 + 1 < rr) a1 -= l.y * x[4 * j4 + 1];
                        if (4 * j4 + 2 < rr) a2 -= l.z * x[4 * j4 + 2];
                        if (4 * j4 + 3 < rr) a3 -= l.w * x[4 * j4 + 3];
                    }
                    x[rr] = (a0 + a1) + (a2 + a3);
                }
#pragma unroll
                for (int rr = 0; rr < 16; ++rr) XC[(16 * I + rr) * 132] = x[rr];
            }
            __syncthreads();
        }
    }
    {
        bf16* W = (bf16*)((unsigned char*)a.out + DO_W) + (size_t)chunk * 8192;
        bf16* UT = (bf16*)((unsigned char*)a.out + DO_UT) + (size_t)chunk * 8192;
#pragma unroll
        for (int m = 0; m < 2; ++m) {
            const int p = tid + 512 * m, i = p >> 4, k8 = p & 15;
            const f32x4 x0 = *(const LAS f32x4*)(KS + i * 132 + 8 * k8), x1 = *(const LAS f32x4*)(KS + i * 132 + 8 * k8 + 4);
            v4u o; o.x = pk2(x0.x, x0.y); o.y = pk2(x0.z, x0.w); o.z = pk2(x1.x, x1.y); o.w = pk2(x1.z, x1.w);
            *(v4u*)(W + ((((i >> 4) * 4 + (k8 >> 2)) * 64 + (i & 15) + 16 * (k8 & 3)) << 3)) = o;
        }
#pragma unroll
        for (int m = 0; m < 4; ++m) {
            const int p = tid + 512 * m, v = p & 127, q = p >> 7;
            v2u o; o.x = pk2(VS[(4 * q) * 132 + v], VS[(4 * q + 1) * 132 + v]); o.y = pk2(VS[(4 * q + 2) * 132 + v], VS[(4 * q + 3) * 132 + v]);
            *(v2u*)(UT + ((((q >> 2) * 8 + (v >> 4)) * 64 + (v & 15) + 16 * (q & 3)) << 2)) = o;
        }
    }
    __syncthreads();
}

__device__ __forceinline__ void kn_item(const Args& a, int item) {
    const int tid = threadIdx.x, lane = tid & 63, wave = tid >> 6;
    const bf16* proj = (const bf16*)(a.ws + WS_PROJ); bf16* KN = (bf16*)(a.ws + WS_KN);
    const float g0 = a.in[6][2 * lane], g1 = a.in[6][2 * lane + 1];
    for (int rr = 0; rr < 16; ++rr) {
        const int t = item * 128 + wave * 16 + rr;
        const unsigned u = *(const unsigned*)(proj + (size_t)t * PW + C_AKV + 2 * lane);
        const float v0 = bflo(u), v1 = bfhi(u);
        const float inv = rsqrtf(wave_sum(v0 * v0 + v1 * v1) * (1.f / 128.f) + EPS);
        *(unsigned*)(KN + (size_t)t * 128 + 2 * lane) = pk2(v0 * inv * g0, v1 * inv * g1);
    }
}


#ifdef IDX_FP32
__device__ __forceinline__ void phase_idx32(const Args& a, LAS unsigned char* lds) {
    const int tid = threadIdx.x, lane = tid & 63, wave = tid >> 6;
    LAS float* HS = (LAS float*)lds;
    float* IDX32 = (float*)(a.ws + WS_YAB);
    const float* mod = (const float*)(a.ws + WS_MOD);
    for (int tile = blockIdx.x; tile < 1024; tile += gridDim.x) {
        const int t0 = tile * 32, b = t0 >> 12;
        for (int rr = 0; rr < 4; ++rr) {
            const int m = t0 + wave * 4 + rr;
            const f32x4* xr = (const f32x4*)(a.in[0] + (size_t)m * DM) + lane;
            f32x4 v[4]; float s = 0.f;
#pragma unroll
            for (int j = 0; j < 4; ++j) { v[j] = xr[64 * j]; s += (v[j].x * v[j].x + v[j].y * v[j].y) + (v[j].z * v[j].z + v[j].w * v[j].w); }
            const float inv = rsqrtf(wave_sum(s) * (1.f / DM) + EPS);
            const f32x4* sh = (const f32x4*)(mod + b * 6144) + lane; const f32x4* sc = (const f32x4*)(mod + b * 6144 + 1024) + lane;
#pragma unroll
            for (int j = 0; j < 4; ++j) { const f32x4 aa = sh[64 * j], c = sc[64 * j];
                f32x4 o; o.x = v[j].x * inv * (1.f + c.x) + aa.x; o.y = v[j].y * inv * (1.f + c.y) + aa.y; o.z = v[j].z * inv * (1.f + c.z) + aa.z; o.w = v[j].w * inv * (1.f + c.w) + aa.w;
                *(LAS f32x4*)(HS + (wave * 4 + rr) * 1028 + 4 * (lane + 64 * j)) = o; }
        }
        __syncthreads();
        if (tid < 324) {
            const float* w = a.in[4] + 1152 + tid;
            float acc[32];
#pragma unroll
            for (int t = 0; t < 32; ++t) acc[t] = 0.f;
            for (int k4 = 0; k4 < 256; ++k4) {
                const float w0 = w[(size_t)(4 * k4) * IN_W], w1 = w[(size_t)(4 * k4 + 1) * IN_W], w2 = w[(size_t)(4 * k4 + 2) * IN_W], w3 = w[(size_t)(4 * k4 + 3) * IN_W];
#pragma unroll
                for (int t = 0; t < 32; ++t) { const f32x4 hv = *(const LAS f32x4*)(HS + t * 1028 + 4 * k4); acc[t] += hv.x * w0 + hv.y * w1 + hv.z * w2 + hv.w * w3; }
            }
#pragma unroll
            for (int t = 0; t < 32; ++t) IDX32[(size_t)(t0 + t) * 384 + tid] = acc[t];
        }
        __syncthreads();
    }
}
#endif
__device__ __forceinline__ unsigned sortable(float f) { const unsigned u = __float_as_uint(f + 0.f); return (u & 0x80000000u) ? ~u : (u | 0x80000000u); }
__device__ __forceinline__ int wave_sum_dpp(int x) {
    x += __builtin_amdgcn_update_dpp(0, x, 0xB1, 0xF, 0xF, false);
    x += __builtin_amdgcn_update_dpp(0, x, 0x4E, 0xF, 0xF, false);
    x += __builtin_amdgcn_update_dpp(0, x, 0x141, 0xF, 0xF, false);
    x += __builtin_amdgcn_update_dpp(0, x, 0x140, 0xF, 0xF, false);
    return __builtin_amdgcn_readlane(x, 0) + __builtin_amdgcn_readlane(x, 16) + __builtin_amdgcn_readlane(x, 32) + __builtin_amdgcn_readlane(x, 48);
}
#define CNT8(OP, acc_, k_, s_, c_) asm("v_cmp_" OP "_u32 s[36:37], %1, %9\n\tv_cmp_" OP "_u32 s[38:39], %2, %9\n\tv_cmp_" OP "_u32 s[40:41], %3, %9\n\tv_cmp_" OP "_u32 s[42:43], %4, %9\n\t" \
        "v_cmp_" OP "_u32 s[44:45], %5, %9\n\tv_cmp_" OP "_u32 s[46:47], %6, %9\n\tv_cmp_" OP "_u32 s[48:49], %7, %9\n\tv_cmp_" OP "_u32 s[50:51], %8, %9\n\t" \
        "v_addc_co_u32 %0, s[36:37], 0, %0, s[36:37]\n\tv_addc_co_u32 %0, s[38:39], 0, %0, s[38:39]\n\tv_addc_co_u32 %0, s[40:41], 0, %0, s[40:41]\n\tv_addc_co_u32 %0, s[42:43], 0, %0, s[42:43]\n\t" \
        "v_addc_co_u32 %0, s[44:45], 0, %0, s[44:45]\n\tv_addc_co_u32 %0, s[46:47], 0, %0, s[46:47]\n\tv_addc_co_u32 %0, s[48:49], 0, %0, s[48:49]\n\tv_addc_co_u32 %0, s[50:51], 0, %0, s[50:51]" \
        : "+v"(acc_) : "v"(k_[(s_)]), "v"(k_[(s_) + 1]), "v"(k_[(s_) + 2]), "v"(k_[(s_) + 3]), "v"(k_[(s_) + 4]), "v"(k_[(s_) + 5]), "v"(k_[(s_) + 6]), "v"(k_[(s_) + 7]), "v"(c_) \
        : "s36", "s37", "s38", "s39", "s40", "s41", "s42", "s43", "s44", "s45", "s46", "s47", "s48", "s49", "s50", "s51")
template <int NS> __device__ __forceinline__ void topk_select(LAS float* row, int n, int lane, unsigned short* out) {
    asm volatile("" : "+v"(lane));
    unsigned key[NS];
#pragma unroll
    for (int s = 0; s < NS; ++s) key[s] = __float_as_uint(row[s * 64 + lane]);
#pragma unroll
    for (int s = 0; s < NS; ++s) { const int idx = s * 64 + lane; const unsigned k = sortable(__uint_as_float(key[s])); key[s] = (idx < n) ? k : 0u; }
    LAS unsigned short* sel_l = (LAS unsigned short*)row;
    unsigned thr = 0u;
    for (int bit = 31; bit >= 0; --bit) {
        const unsigned cand = thr | (1u << bit);
        int c0 = 0, c1 = 0;
#pragma unroll
        for (int s = 0; s < NS; s += 16) { CNT8("ge", c0, key, s, cand); CNT8("ge", c1, key, s + 8, cand); }
        const int cnt = wave_sum_dpp(c0 + c1);
        if (cnt >= 256) thr = cand;
        if (cnt == 256) break;
    }
    int g0 = 0, e0 = 0;
#pragma unroll
    for (int s = 0; s < NS; s += 8) { CNT8("gt", g0, key, s, thr); CNT8("eq", e0, key, s, thr); }
    const int cgt = wave_sum_dpp(g0), ceq = wave_sum_dpp(e0);
    const int need_eq = 256 - cgt;
    asm volatile("" : "+v"(thr));
    asm volatile("" : "+v"(lane));
    int pos_out = 0;
    if (ceq == need_eq) {
#pragma unroll
        for (int s = 0; s < NS; ++s) {
            const bool take = key[s] >= thr;
            const unsigned long long mt = __builtin_amdgcn_ballot_w64(take);
            const int pre = __builtin_amdgcn_mbcnt_hi((unsigned)(mt >> 32), __builtin_amdgcn_mbcnt_lo((unsigned)mt, 0));
            sel_l[take ? pos_out + pre : 256] = (unsigned short)(s * 64 + lane);
            pos_out += __builtin_popcountll(mt);
        }
    } else {
        const unsigned long long ltmask = (1ull << lane) - 1ull;
        int eq_seen = 0;
#pragma unroll
        for (int s = 0; s < NS; ++s) {
            const bool gt = key[s] > thr, eq = key[s] == thr;
            const unsigned long long meq = __builtin_amdgcn_ballot_w64(eq);
            const bool take = gt || (eq && (eq_seen + __builtin_popcountll(meq & ltmask) < need_eq));
            const unsigned long long mt = __builtin_amdgcn_ballot_w64(take);
            if (take) sel_l[pos_out + __builtin_popcountll(mt & ltmask)] = (unsigned short)(s * 64 + lane);
            pos_out += __builtin_popcountll(mt); eq_seen += __builtin_popcountll(meq);
            if ((s & 3) == 3) __builtin_amdgcn_sched_barrier(0);
        }
    }
    LDS_WAIT();
    *(v2u*)(out + 4 * lane) = *(const LAS v2u*)(sel_l + 4 * lane);
}
struct IdxPre { bf16x8 af[4]; v2u wqr[4]; bf16x8 bfr[4][4]; };
__device__ __forceinline__ void idx_issue(const Args& a, int b, int qblk, int wave, int lane, IdxPre& P) {
    const bf16* proj = (const bf16*)(a.ws + WS_PROJ);
    const int p0 = qblk * 8, r = lane & 31, hh = lane >> 5;
    const size_t rowb = (size_t)b * SEQ;
    if (p0 + 7 < 256) return;
    { const bf16* qp = proj + (rowb + p0 + (r & 7)) * PW + C_IQ + (r >> 3) * 64 + 32 * hh;
#pragma unroll
      for (int s = 0; s < 4; ++s) P.af[s] = *(const bf16x8*)(qp + 8 * s); }
#pragma unroll
    for (int i = 0; i < 4; ++i) P.wqr[i] = *(const v2u*)(proj + (rowb + p0 + 4 * hh + i) * PW + C_IW);
    const int ntiles = (p0 + 7) / 32 + 1;
#pragma unroll
    for (int u = 0; u < 4; ++u) {
        const int kt = (wave + 8 * u < ntiles) ? wave + 8 * u : 0;
        const bf16* kp = proj + (rowb + (size_t)kt * 32 + r) * PW + C_IK + 32 * hh;
#pragma unroll
        for (int s = 0; s < 4; ++s) P.bfr[u][s] = *(const bf16x8*)(kp + 8 * s);
    }
}
__device__ __forceinline__ void indexer_item(const Args& a, LAS unsigned char* lds, int b, int qblk, IdxPre& P, bool has_next, int b_next, int qblk_next) {
    int tid = threadIdx.x; asm volatile("" : "+v"(tid));
    const int lane = tid & 63, wave = __builtin_amdgcn_readfirstlane(tid >> 6);
    const bf16* proj = (const bf16*)(a.ws + WS_PROJ);
    unsigned short* SEL = (unsigned short*)(a.ws + WS_SEL);
    LAS float* SC = (LAS float*)lds;
    const int p0 = qblk * 8;
    const int r = lane & 31, hh = lane >> 5;
    const size_t rowb = (size_t)b * SEQ;
#ifdef IDX_FP32
    if (p0 + 7 >= 256) {
        const float* IDX32 = (const float*)(a.ws + WS_YAB);
        LAS float* IQS = (LAS float*)(lds + 131072);
        for (int i = tid; i < 2048; i += 512) IQS[i] = IDX32[(rowb + p0 + (i >> 8)) * 384 + (i & 255)];
        float wq8[8][4];
#pragma unroll
        for (int q = 0; q < 8; ++q)
#pragma unroll
            for (int hd = 0; hd < 4; ++hd) wq8[q][hd] = IDX32[(rowb + p0 + q) * 384 + 320 + hd];
        __syncthreads();
        for (int s = tid; s <= p0 + 7; s += 512) {
            float kf[64];
#pragma unroll
            for (int d4 = 0; d4 < 16; ++d4) { const f32x4 v = *(const f32x4*)(IDX32 + (rowb + s) * 384 + 256 + 4 * d4); kf[4 * d4] = v.x; kf[4 * d4 + 1] = v.y; kf[4 * d4 + 2] = v.z; kf[4 * d4 + 3] = v.w; }
#pragma unroll 1
            for (int q = 0; q < 8; ++q) {
                float sc = 0.f;
#pragma unroll
                for (int hd = 0; hd < 4; ++hd) {
                    float lg = 0.f;
#pragma unroll
                    for (int d4 = 0; d4 < 16; ++d4) { const f32x4 qv = *(const LAS f32x4*)(IQS + q * 256 + hd * 64 + 4 * d4); lg += kf[4 * d4] * qv.x + kf[4 * d4 + 1] * qv.y + kf[4 * d4 + 2] * qv.z + kf[4 * d4 + 3] * qv.w; }
                    sc += fmaxf(lg, 0.f) * wq8[q][hd];
                }
                SC[q * 4096 + s] = sc * 0.0625f;
            }
        }
    }
#else
    if (p0 + 7 >= 256) {
        float wq[4][4];
#pragma unroll
        for (int i = 0; i < 4; ++i) { wq[i][0] = bflo(P.wqr[i].x) * 0.0625f; wq[i][1] = bfhi(P.wqr[i].x) * 0.0625f; wq[i][2] = bflo(P.wqr[i].y) * 0.0625f; wq[i][3] = bfhi(P.wqr[i].y) * 0.0625f; }
        const int ntiles = (p0 + 7) / 32 + 1;
        for (int kt0 = wave; kt0 < ntiles; kt0 += 32) {
            bf16x8 nxt[4][4];
            const bool more = kt0 + 32 < ntiles;
            if (more) {
#pragma unroll
                for (int u = 0; u < 4; ++u) {
                    const int kt = (kt0 + 32 + 8 * u < ntiles) ? kt0 + 32 + 8 * u : kt0;
                    const bf16* kp = proj + (rowb + (size_t)kt * 32 + r) * PW + C_IK + 32 * hh;
#pragma unroll
                    for (int s = 0; s < 4; ++s) nxt[u][s] = *(const bf16x8*)(kp + 8 * s);
                }
            }
#pragma unroll
            for (int u = 0; u < 4; ++u) {
                const int kt = kt0 + 8 * u;
                if (kt < ntiles) {
                    f32x16 acc;
#pragma unroll
                    for (int i = 0; i < 16; ++i) acc[i] = 0.f;
#pragma unroll
                    for (int s = 0; s < 4; ++s) acc = __builtin_amdgcn_mfma_f32_32x32x16_bf16(P.af[s], P.bfr[u][s], acc, 0, 0, 0);
#pragma unroll
                    for (int i = 0; i < 4; ++i) {
                        float s = 0.f;
#pragma unroll
                        for (int hd = 0; hd < 4; ++hd) s += wq[i][hd] * fmaxf(acc[i + 4 * hd], 0.f);
                        SC[(4 * hh + i) * 4096 + kt * 32 + r] = s;
                    }
                }
            }
            if (more) {
#pragma unroll
                for (int u = 0; u < 4; ++u)
#pragma unroll
                    for (int s = 0; s < 4; ++s) P.bfr[u][s] = nxt[u][s];
            }
        }
    }
#endif
    __syncthreads();
#ifndef IDX_FP32
    if (has_next) idx_issue(a, b_next, qblk_next, wave, lane, P);
#endif
    {
        const int pos = p0 + wave, n = pos + 1;
        unsigned short* out = SEL + (rowb + pos) * 256;
        if (n <= 256) {
#pragma unroll
            for (int q = 0; q < 4; ++q) { const int j = lane + 64 * q; out[j] = (unsigned short)((j < n) ? j : 0xFFFF); }
        } else {
            LAS float* row = SC + wave * 4096;
            const int nslots = (n + 63) >> 6;
#ifndef IDX_REP_SELECT
#define IDX_REP_SELECT 1
#endif
            float* bk_ = (float*)(a.ws + WS_YAB) + ((size_t)blockIdx.x * 8 + wave) * 4096;
            if (IDX_REP_SELECT > 1) for (int i_ = lane; i_ < 4096; i_ += 64) bk_[i_] = row[i_];
            for (int rep_ = 0; rep_ < IDX_REP_SELECT; ++rep_) {
            if (rep_ > 0) { for (int i_ = lane; i_ < 4096; i_ += 64) row[i_] = bk_[i_]; LDS_WAIT(); }
            if (nslots <= 16) topk_select<16>(row, n, lane, out);
            else if (nslots <= 32) topk_select<32>(row, n, lane, out);
            else if (nslots <= 48) topk_select<48>(row, n, lane, out);
            else topk_select<64>(row, n, lane, out);
            }
        }
    }
    __syncthreads();
}

__device__ __forceinline__ void phase3(const Args& a, LAS unsigned char* lds) {
    const int bid = blockIdx.x, G = gridDim.x;
#ifndef P3_MASK
#define P3_MASK 7
#endif
#ifndef P3_REP
#define P3_REP 0
#endif
    if (P3_MASK & 1) for (int it = bid; it < 2048; it += G) { gdn_prep_item(a, lds, it); if (P3_REP & 1) gdn_prep_item(a, lds, it); }
    if (P3_MASK & 2) {
#define IDX_MAP(j_, bb_, qb_) do { if (G == 256) { const int i_ = (j_) / G, c_ = (j_) % G, q0_ = (c_ >> 3) + 32 * (i_ >> 1); bb_ = c_ & 7; qb_ = (i_ & 1) ? 511 - q0_ : q0_; } else { bb_ = (j_) >> 9; qb_ = (j_) & 511; } } while (0)
        IdxPre P;
        const int tid_ = threadIdx.x, lane_ = tid_ & 63, wave_ = __builtin_amdgcn_readfirstlane(tid_ >> 6);
        int bb, qb;
        if (bid < 4096) { IDX_MAP(bid, bb, qb); idx_issue(a, bb, qb, wave_, lane_, P); }
        for (int j = bid; j < 4096; j += G) {
            IDX_MAP(j, bb, qb);
            int bn = 0, qn = 0; const bool hn = (j + G < 4096);
            if (hn) IDX_MAP(j + G, bn, qn);
            indexer_item(a, lds, bb, qb, P, hn, bn, qn);
            if (P3_REP & 2) { idx_issue(a, bb, qb, wave_, lane_, P); indexer_item(a, lds, bb, qb, P, false, 0, 0); if (hn) idx_issue(a, bn, qn, wave_, lane_, P); }
        }
#undef IDX_MAP
    }
    if (P3_MASK & 4) for (int it = bid; it < 256; it += G) kn_item(a, it);
}

constexpr int SC_ST = 0, SC_VNT = 34816, SC_O = 53248;
__device__ __forceinline__ v2u pack4(float a, float b, float c, float d) { v2u o; o.x = pk2(a, b); o.y = pk2(c, d); return o; }
__device__ __forceinline__ void scan_epilogue(const LAS float* OS, const v4u z0, const v4u z1, const LAS float* gainl, bf16* ydst, int tid) {
    const int row = tid >> 3, seg = tid & 7;
    float o[16];
#pragma unroll
    for (int q = 0; q < 4; ++q) { const f32x4 v = *(const LAS f32x4*)(OS + row * 132 + 16 * seg + 4 * q); o[4 * q] = v.x; o[4 * q + 1] = v.y; o[4 * q + 2] = v.z; o[4 * q + 3] = v.w; }
    float ss = 0.f;
#pragma unroll
    for (int i = 0; i < 16; ++i) ss += o[i] * o[i];
    ss += __shfl_xor(ss, 1); ss += __shfl_xor(ss, 2); ss += __shfl_xor(ss, 4);
    const float inv = rsqrtf(ss * (1.f / 128.f) + EPS);
    float z[16];
    z[0] = bflo(z0.x); z[1] = bfhi(z0.x); z[2] = bflo(z0.y); z[3] = bfhi(z0.y); z[4] = bflo(z0.z); z[5] = bfhi(z0.z); z[6] = bflo(z0.w); z[7] = bfhi(z0.w);
    z[8] = bflo(z1.x); z[9] = bfhi(z1.x); z[10] = bflo(z1.y); z[11] = bfhi(z1.y); z[12] = bflo(z1.z); z[13] = bfhi(z1.z); z[14] = bflo(z1.w); z[15] = bfhi(z1.w);
    float y[16];
#pragma unroll
    for (int q = 0; q < 4; ++q) { const f32x4 gq = *(const LAS f32x4*)(gainl + 16 * seg + 4 * q);
        y[4 * q] = o[4 * q] * inv * gq.x * silu_fast(z[4 * q]); y[4 * q + 1] = o[4 * q + 1] * inv * gq.y * silu_fast(z[4 * q + 1]); y[4 * q + 2] = o[4 * q + 2] * inv * gq.z * silu_fast(z[4 * q + 2]); y[4 * q + 3] = o[4 * q + 3] * inv * gq.w * silu_fast(z[4 * q + 3]); }
    v4u w0, w1;
    w0.x = pk2(y[0], y[1]); w0.y = pk2(y[2], y[3]); w0.z = pk2(y[4], y[5]); w0.w = pk2(y[6], y[7]);
    w1.x = pk2(y[8], y[9]); w1.y = pk2(y[10], y[11]); w1.z = pk2(y[12], y[13]); w1.w = pk2(y[14], y[15]);
    *(v4u*)(ydst) = w0; *(v4u*)(ydst + 8) = w1;
}
__device__ __forceinline__ void gdn_scan(const Args& a, LAS unsigned char* lds, int bh) {
    const int tid = threadIdx.x, lane = tid & 63, w = __builtin_amdgcn_readfirstlane(tid >> 6), r = lane & 15, g = lane >> 4;
    const int b = bh >> 2, h = bh & 3;
    LAS bf16* ST = (LAS bf16*)(lds + SC_ST); LAS bf16* VNT = (LAS bf16*)(lds + SC_VNT); LAS float* OS = (LAS float*)(lds + SC_O);
    const bf16* proj = (const bf16*)(a.ws + WS_PROJ); bf16* yab = (bf16*)(a.ws + WS_YAB);
    const float* GL = (const float*)(a.ws + WS_GL);
    for (int i = tid; i < 34816 / 4; i += 512) ((LAS unsigned*)ST)[i] = 0u;
    f32x4 S[8];
#pragma unroll
    for (int vt = 0; vt < 8; ++vt) S[vt] = (f32x4){0.f, 0.f, 0.f, 0.f};
    const int erow = tid >> 3, eseg = tid & 7;
    LAS float* gainl = (LAS float*)(lds + 87040);
    if (tid < 128) gainl[tid] = a.in[11][tid];
    const int ct = w & 3;
    const size_t cb = (size_t)bh * 64;
    const bf16* Wb = (const bf16*)((const unsigned char*)a.out + DO_W) + cb * 8192;
    const bf16* QDb = (const bf16*)((const unsigned char*)a.out + DO_QD) + cb * 8192;
    const bf16* KDTb = (const bf16*)((const unsigned char*)a.out + DO_KDT) + cb * 8192;
    const bf16* UTb = (const bf16*)((const unsigned char*)a.out + DO_UT) + cb * 8192;
    const bf16* Ab = (const bf16*)(a.ws + WS_GA) + cb * 4096;
    const bf16* Xb = (w < 4) ? Wb : QDb;
    const size_t tz = ((size_t)b * SEQ + erow) * PW + C_BZ + h * 128 + 16 * eseg;
    const size_t ty = ((size_t)b * SEQ + erow) * YW + 1024 + h * 128 + 16 * eseg;
    bf16x8 af[4], kd[2]; v4u xr[4]; float gl; v4u zh0, zh1;
#define SCAN_LOAD(n_, af_, kd_, xr_, gl_) do { \
        const bf16* X_ = Xb + (size_t)(n_) * 8192 + (ct * 4 * 64 + lane) * 8; \
        _Pragma("unroll") for (int ks = 0; ks < 4; ++ks) af_[ks] = *(const bf16x8*)(X_ + ks * 512); \
        const bf16* K_ = KDTb + (size_t)(n_) * 8192 + (w * 2 * 64 + lane) * 8; \
        kd_[0] = *(const bf16x8*)(K_); kd_[1] = *(const bf16x8*)(K_ + 512); \
        if (w >= 4) { const bf16* A_ = Ab + (size_t)(n_) * 4096 + (ct * 2 * 64 + lane) * 8; xr_[0] = *(const v4u*)(A_); xr_[1] = *(const v4u*)(A_ + 512); } \
        else { const bf16* U_ = UTb + (size_t)(n_) * 8192 + (ct * 8 * 64 + lane) * 4; _Pragma("unroll") for (int q_ = 0; q_ < 4; ++q_) { const v2u u0_ = *(const v2u*)(U_ + (2 * q_) * 256), u1_ = *(const v2u*)(U_ + (2 * q_ + 1) * 256); xr_[q_] = (v4u){u0_.x, u0_.y, u1_.x, u1_.y}; } } \
        gl_ = GL[cb + (n_)]; } while (0)
    SCAN_LOAD(0, af, kd, xr, gl);
    zh0 = (v4u){0u, 0u, 0u, 0u}; zh1 = zh0;
    __syncthreads();
    for (int n = 0; n < 64; ++n) {
        bf16x8 afn[4], kdn[2]; v4u xrn[4]; float gln;
        const int nn = (n < 63) ? n + 1 : 63;
        SCAN_LOAD(nn, afn, kdn, xrn, gln);
        const v4u zn0 = *(const v4u*)(proj + tz + (size_t)n * 64 * PW), zn1 = *(const v4u*)(proj + tz + (size_t)n * 64 * PW + 8);
        if (n > 0) scan_epilogue(OS, zh0, zh1, gainl, yab + ty + (size_t)(n - 1) * 64 * YW, tid);
        zh0 = zn0; zh1 = zn1;
        f32x4 acc[8];
#pragma unroll
        for (int vt = 0; vt < 8; ++vt) acc[vt] = (f32x4){0.f, 0.f, 0.f, 0.f};
#pragma unroll
        for (int ks = 0; ks < 4; ++ks) {
#pragma unroll
            for (int vt = 0; vt < 8; ++vt) {
                const bf16x8 bfr = *(const LAS bf16x8*)(ST + (16 * vt + r) * 136 + 32 * ks + 8 * g);
                acc[vt] = __builtin_amdgcn_mfma_f32_16x16x32_bf16(af[ks], bfr, acc[vt], 0, 0, 0);
            }
        }
        if (w < 4) {
#pragma unroll
            for (int vt = 0; vt < 8; ++vt) {
                const unsigned ux = (vt & 1) ? xr[vt >> 1].z : xr[vt >> 1].x, uy = (vt & 1) ? xr[vt >> 1].w : xr[vt >> 1].y;
                const v2u o = pack4(bflo(ux) - acc[vt][0], bfhi(ux) - acc[vt][1], bflo(uy) - acc[vt][2], bfhi(uy) - acc[vt][3]);
                *(LAS v2u*)(VNT + (16 * vt + r) * 72 + 16 * ct + 4 * g) = o;
            }
        }
        __syncthreads();
        if (w >= 4) {
#pragma unroll
            for (int ks = 0; ks < 2; ++ks)
#pragma unroll
                for (int vt = 0; vt < 8; ++vt) {
                    const bf16x8 vb = *(const LAS bf16x8*)(VNT + (16 * vt + r) * 72 + 32 * ks + 8 * g);
                    acc[vt] = __builtin_amdgcn_mfma_f32_16x16x32_bf16(__builtin_bit_cast(bf16x8, xr[ks]), vb, acc[vt], 0, 0, 0);
                }
#pragma unroll
            for (int vt = 0; vt < 8; ++vt)
#pragma unroll
                for (int rg = 0; rg < 4; ++rg) OS[(16 * ct + 4 * g + rg) * 132 + 16 * vt + r] = acc[vt][rg];
        }
#pragma unroll
        for (int vt = 0; vt < 8; ++vt) S[vt] = S[vt] * gl;
#pragma unroll
        for (int ks = 0; ks < 2; ++ks)
#pragma unroll
            for (int vt = 0; vt < 8; ++vt) {
                const bf16x8 vb = *(const LAS bf16x8*)(VNT + (16 * vt + r) * 72 + 32 * ks + 8 * g);
                S[vt] = __builtin_amdgcn_mfma_f32_16x16x32_bf16(kd[ks], vb, S[vt], 0, 0, 0);
            }
#pragma unroll
        for (int vt = 0; vt < 8; ++vt)
            *(LAS v2u*)(ST + (16 * vt + r) * 136 + 16 * w + 4 * g) = pack4(S[vt][0] + 0.f, S[vt][1] + 0.f, S[vt][2] + 0.f, S[vt][3] + 0.f);
#pragma unroll
        for (int ks = 0; ks < 4; ++ks) af[ks] = afn[ks];
        kd[0] = kdn[0]; kd[1] = kdn[1];
#pragma unroll
        for (int q = 0; q < 4; ++q) xr[q] = xrn[q];
        gl = gln;
        __syncthreads();
    }
    scan_epilogue(OS, zh0, zh1, gainl, yab + ty + (size_t)63 * 64 * YW, tid);
    __syncthreads();
#undef SCAN_LOAD
}

typedef short v4s __attribute__((ext_vector_type(4)));
constexpr int AQ_STRIDE = 272, AQ_WAVE_LDS = 64 * AQ_STRIDE + 512;
__device__ __forceinline__ void attn_query_q4(const Args& a, LAS unsigned char* wl, const LAS float* qgl, int t, int lane) {
    const bf16* proj = (const bf16*)(a.ws + WS_PROJ); const bf16* KN = (const bf16*)(a.ws + WS_KN);
    const unsigned short* SEL = (const unsigned short*)(a.ws + WS_SEL); bf16* yab = (bf16*)(a.ws + WS_YAB);
    LAS unsigned char* KT = wl; LAS unsigned short* SL = (LAS unsigned short*)(wl + 64 * AQ_STRIDE);
    const int r = lane & 15, g = lane >> 4;
    const int b = t >> 12, pos = t & 4095;
    const bf16* knb = KN + (size_t)b * SEQ * 128;
    *(LAS v2u*)(SL + 4 * lane) = *(const v2u*)(SEL + (size_t)t * 256 + 4 * lane);
    bf16x8 qf[4];
    {
        const bf16* qp = proj + (size_t)t * PW + C_AQ + (r & 7) * 128 + 8 * g;
        float f[32]; float ss = 0.f;
#pragma unroll
        for (int ks = 0; ks < 4; ++ks) { const v4u raw = *(const v4u*)(qp + 32 * ks);
            f[8 * ks] = bflo(raw.x); f[8 * ks + 1] = bfhi(raw.x); f[8 * ks + 2] = bflo(raw.y); f[8 * ks + 3] = bfhi(raw.y); f[8 * ks + 4] = bflo(raw.z); f[8 * ks + 5] = bfhi(raw.z); f[8 * ks + 6] = bflo(raw.w); f[8 * ks + 7] = bfhi(raw.w); }
#pragma unroll
        for (int i = 0; i < 32; ++i) ss += f[i] * f[i];
        ss += __shfl_xor(ss, 16); ss += __shfl_xor(ss, 32);
        float inv = rsqrtf(ss * (1.f / 128.f) + EPS) * 0.08838834764831845f;
        if (r >= 8) inv = 0.f;
#pragma unroll
        for (int ks = 0; ks < 4; ++ks) { const f32x4 ga = *(const LAS f32x4*)(qgl + 32 * ks + 8 * g), gb = *(const LAS f32x4*)(qgl + 32 * ks + 8 * g + 4);
            v4u o; o.x = pk2(f[8 * ks] * inv * ga.x, f[8 * ks + 1] * inv * ga.y); o.y = pk2(f[8 * ks + 2] * inv * ga.z, f[8 * ks + 3] * inv * ga.w);
            o.z = pk2(f[8 * ks + 4] * inv * gb.x, f[8 * ks + 5] * inv * gb.y); o.w = pk2(f[8 * ks + 6] * inv * gb.z, f[8 * ks + 7] * inv * gb.w);
            qf[ks] = __builtin_bit_cast(bf16x8, o); }
    }
    LDS_WAIT();
    const int cnt = (pos + 1 < 256) ? pos + 1 : 256, nq = (cnt + 63) >> 6;
    const float slope = exp2f(-(float)((r & 7) + 1));
    float m_run = -INFINITY, l_run = 0.f;
    f32x4 O[8];
#pragma unroll
    for (int dt = 0; dt < 8; ++dt) O[dt] = (f32x4){0.f, 0.f, 0.f, 0.f};
    bf16x8 ka[4][4], kb[4][4];
#define AQ_LOAD(q_, k_) do { _Pragma("unroll") for (int kt = 0; kt < 4; ++kt) { int ix_ = SL[64 * (q_) + 16 * kt + r]; ix_ = (ix_ == 0xFFFF) ? 0 : ix_; \
        const bf16* kp_ = knb + (size_t)ix_ * 128 + 8 * g; _Pragma("unroll") for (int ks = 0; ks < 4; ++ks) k_[kt][ks] = *(const bf16x8*)(kp_ + 32 * ks); } } while (0)
#define AQ_PASS(q_, k_) do { \
        f32x4 sc[4]; \
        _Pragma("unroll") for (int kt = 0; kt < 4; ++kt) { f32x4 acc = (f32x4){0.f, 0.f, 0.f, 0.f}; \
            _Pragma("unroll") for (int ks = 0; ks < 4; ++ks) { acc = __builtin_amdgcn_mfma_f32_16x16x32_bf16(k_[kt][ks], qf[ks], acc, 0, 0, 0); \
                *(LAS bf16x8*)(KT + (16 * kt + r) * AQ_STRIDE + (32 * ks + 8 * g) * 2) = k_[kt][ks]; } \
            sc[kt] = acc; } \
        float m = m_run; \
        _Pragma("unroll") for (int kt = 0; kt < 4; ++kt) { const v2u s4 = *(const LAS v2u*)(SL + 64 * (q_) + 16 * kt + 4 * g); \
            const int i0 = s4.x & 0xFFFF, i1 = s4.x >> 16, i2 = s4.y & 0xFFFF, i3 = s4.y >> 16; \
            sc[kt][0] = (i0 != 0xFFFF) ? sc[kt][0] - slope * (float)(pos - i0) : -INFINITY; sc[kt][1] = (i1 != 0xFFFF) ? sc[kt][1] - slope * (float)(pos - i1) : -INFINITY; \
            sc[kt][2] = (i2 != 0xFFFF) ? sc[kt][2] - slope * (float)(pos - i2) : -INFINITY; sc[kt][3] = (i3 != 0xFFFF) ? sc[kt][3] - slope * (float)(pos - i3) : -INFINITY; \
            m = fmaxf(fmaxf(m, fmaxf(sc[kt][0], sc[kt][1])), fmaxf(sc[kt][2], sc[kt][3])); } \
        m = fmaxf(m, __shfl_xor(m, 16)); m = fmaxf(m, __shfl_xor(m, 32)); \
        const float alpha = __expf(m_run - m); \
        float ls = 0.f; \
        _Pragma("unroll") for (int kt = 0; kt < 4; ++kt) _Pragma("unroll") for (int rg = 0; rg < 4; ++rg) { const float e = __expf(sc[kt][rg] - m); sc[kt][rg] = e; ls += e; } \
        ls += __shfl_xor(ls, 16); ls += __shfl_xor(ls, 32); \
        l_run = l_run * alpha + ls; m_run = m; \
        _Pragma("unroll") for (int rg = 0; rg < 4; ++rg) { const float ah = __shfl(alpha, 4 * g + rg); _Pragma("unroll") for (int dt = 0; dt < 8; ++dt) O[dt][rg] *= ah; } \
        _Pragma("unroll") for (int c = 0; c < 2; ++c) { v4u o_; o_.x = pk2(sc[2 * c][0], sc[2 * c][1]); o_.y = pk2(sc[2 * c][2], sc[2 * c][3]); o_.z = pk2(sc[2 * c + 1][0], sc[2 * c + 1][1]); o_.w = pk2(sc[2 * c + 1][2], sc[2 * c + 1][3]); \
            const bf16x8 pa = __builtin_bit_cast(bf16x8, o_); \
            _Pragma("unroll") for (int dt = 0; dt < 8; ++dt) { \
                const v4s b0 = __builtin_amdgcn_ds_read_tr16_b64_v4i16((LAS v4s*)(tb + (32 * c) * AQ_STRIDE + 32 * dt)); \
                const v4s b1 = __builtin_amdgcn_ds_read_tr16_b64_v4i16((LAS v4s*)(tb + (32 * c + 16) * AQ_STRIDE + 32 * dt)); \
                const bf16x8 bfr = __builtin_shufflevector(b0, b1, 0, 1, 2, 3, 4, 5, 6, 7); \
                O[dt] = __builtin_amdgcn_mfma_f32_16x16x32_bf16(pa, bfr, O[dt], 0, 0, 0); } } \
        __builtin_amdgcn_sched_barrier(0); } while (0)
    const LAS unsigned char* tb = KT + (4 * g + (r >> 2)) * AQ_STRIDE + 8 * (r & 3);
    AQ_LOAD(0, ka);
    if (nq > 1) AQ_LOAD(1, kb);
    AQ_PASS(0, ka);
    if (nq > 1) { if (nq > 2) AQ_LOAD(2, ka); AQ_PASS(1, kb); }
    if (nq > 2) { if (nq > 3) AQ_LOAD(3, kb); AQ_PASS(2, ka); }
    if (nq > 3) { AQ_PASS(3, kb); }
#undef AQ_LOAD
#undef AQ_PASS
    const float il = 1.f / l_run;
    if (true) {
        float ih[4];
#pragma unroll
        for (int rg = 0; rg < 4; ++rg) ih[rg] = __shfl(il, 4 * g + rg);
        if (g < 2) {
#pragma unroll
            for (int rg = 0; rg < 4; ++rg)
#pragma unroll
                for (int dt = 0; dt < 8; ++dt) yab[(size_t)t * YW + (4 * g + rg) * 128 + 16 * dt + r] = (bf16)f2bf(O[dt][rg] * ih[rg]);
        }
    }
    LDS_WAIT();
}

__device__ __forceinline__ void phase4(const Args& a, LAS unsigned char* lds) {
    const int bid = blockIdx.x, G = gridDim.x, tid = threadIdx.x, lane = tid & 63, wave = tid >> 6;
    const int nscan = (G >= 64) ? 32 : 0;
#ifndef P4_REP
#define P4_REP 0
#endif
    if (nscan && bid < 32) { gdn_scan(a, lds, bid); if (P4_REP & 1) { __syncthreads(); gdn_scan(a, lds, bid); } return; }
    if (!nscan) { for (int bh = bid; bh < 32; bh += G) gdn_scan(a, lds, bh); __syncthreads(); }
    LAS float* qg4 = (LAS float*)(lds + 8 * AQ_WAVE_LDS);
    if (tid < 128) qg4[tid] = a.in[5][tid];
    __syncthreads();
    LAS unsigned char* wl4 = lds + wave * AQ_WAVE_LDS;
    if (nscan == 32 && (G & 7) == 0) {
        const int bb = bid & 7, wl_i = ((bid - 32) >> 3) * 8 + wave, nwl = ((G - 32) >> 3) * 8;
        for (int p = wl_i; p < SEQ; p += nwl) attn_query_q4(a, wl4, qg4, bb * SEQ + p, lane);
        if (P4_REP & 2) for (int p = wl_i; p < SEQ; p += nwl) attn_query_q4(a, wl4, qg4, bb * SEQ + p, lane);
    } else {
        const int gw = (bid - nscan) * 8 + wave, NGW = (G - nscan) * 8;
        for (int t = gw; t < T_TOK; t += NGW) attn_query_q4(a, wl4, qg4, t, lane);
    }
}

#define INS16P(L, v_) do { float _x = (v_); \
    _Pragma("unroll") for (int _k = 0; _k < 16; ++_k) { const float _h = __builtin_fmaxf(L[_k], _x); _x = __builtin_fminf(L[_k], _x); L[_k] = _h; } } while (0)
#define CE_D(a_, b_) do { const float _h = __builtin_fmaxf(a_, b_), _l = __builtin_fminf(a_, b_); a_ = _h; b_ = _l; } while (0)
#define SORT16_DESC(A) do { \
    _Pragma("unroll") for (int k_ = 2; k_ <= 16; k_ <<= 1) \
    _Pragma("unroll") for (int j_ = k_ >> 1; j_ > 0; j_ >>= 1) \
    _Pragma("unroll") for (int i_ = 0; i_ < 16; ++i_) { const int l_ = i_ ^ j_; if (l_ > i_) { if ((i_ & k_) == 0) CE_D(A[i_], A[l_]); else CE_D(A[l_], A[i_]); } } } while (0)
#define MERGE16_TOP(L, B) do { \
    _Pragma("unroll") for (int i_ = 0; i_ < 16; ++i_) L[i_] = __builtin_fmaxf(L[i_], B[15 - i_]); \
    _Pragma("unroll") for (int j_ = 8; j_ > 0; j_ >>= 1) \
    _Pragma("unroll") for (int i_ = 0; i_ < 16; ++i_) { const int l_ = i_ ^ j_; if (l_ > i_) CE_D(L[i_], L[l_]); } } while (0)
__device__ __forceinline__ float packf(float v, unsigned id, unsigned mask) { return __uint_as_float((__float_as_uint(v) & ~mask) | id); }

__device__ __forceinline__ void peer_route_unit(const Args& a, LAS float* SC, int tt, int p, int lane) {
    const bf16* query = (const bf16*)(a.ws + WS_QUERY); const bf16* subk = (const bf16*)(a.ws + WS_SUBK);
    int* expid = (int*)(a.ws + WS_EXPID); float* gate = (float*)(a.ws + WS_GATE);
    const int r = lane & 15, g = lane >> 4;
    const int tok = lane & 31, ch = lane >> 5;
    float L1[16], L2[16];
#pragma unroll
    for (int k = 0; k < 16; ++k) { L1[k] = 0.f; L2[k] = 0.f; }
#pragma unroll 1
    for (int half = 0; half < 2; ++half) {
        bf16x8 bk[8][4];
        {
            const bf16* kp = subk + (size_t)((p * 2 + half) * 128 + r) * 128 + 8 * g;
#pragma unroll
            for (int nt = 0; nt < 8; ++nt)
#pragma unroll
                for (int ks = 0; ks < 4; ++ks) bk[nt][ks] = *(const bf16x8*)(kp + (size_t)nt * 16 * 128 + 32 * ks);
        }
        bf16x8 af[2][4];
#pragma unroll
        for (int mt = 0; mt < 2; ++mt) {
            const bf16* qp = query + (size_t)(tt * 32 + mt * 16 + r) * 2048 + p * 256 + half * 128 + 8 * g;
#pragma unroll
            for (int ks = 0; ks < 4; ++ks) af[mt][ks] = *(const bf16x8*)(qp + 32 * ks);
        }
#pragma unroll
        for (int mt = 0; mt < 2; ++mt) {
#pragma unroll
            for (int nt = 0; nt < 8; ++nt) {
                f32x4 acc = (f32x4){0.f, 0.f, 0.f, 0.f};
#pragma unroll
                for (int ks = 0; ks < 4; ++ks) acc = __builtin_amdgcn_mfma_f32_16x16x32_bf16(af[mt][ks], bk[nt][ks], acc, 0, 0, 0);
#pragma unroll
                for (int rg = 0; rg < 4; ++rg) SC[(mt * 16 + 4 * g + rg) * 132 + nt * 16 + r] = acc[rg];
            }
        }
        LDS_WAIT();
        float L[16];
#pragma unroll
        for (int c16 = 0; c16 < 4; ++c16) {
            float B[16];
#pragma unroll
            for (int c4 = 0; c4 < 4; ++c4) {
                const f32x4 v = *(const LAS f32x4*)(SC + tok * 132 + 64 * ch + 16 * c16 + 4 * c4);
                const unsigned n0 = 64 * ch + 16 * c16 + 4 * c4;
                B[4 * c4] = packf(v.x, n0, 127u); B[4 * c4 + 1] = packf(v.y, n0 + 1, 127u); B[4 * c4 + 2] = packf(v.z, n0 + 2, 127u); B[4 * c4 + 3] = packf(v.w, n0 + 3, 127u);
            }
            SORT16_DESC(B);
            if (c16 == 0) {
#pragma unroll
                for (int k = 0; k < 16; ++k) L[k] = B[k];
            } else MERGE16_TOP(L, B);
        }
        {
            float B[16];
#pragma unroll
            for (int k = 0; k < 16; ++k) B[k] = __shfl(L[k], tok + 32);
            MERGE16_TOP(L, B);
        }
#pragma unroll
        for (int k = 0; k < 16; ++k) { L1[k] = (half == 0) ? L[k] : L1[k]; L2[k] = (half == 0) ? L2[k] : L[k]; }
        LDS_WAIT();
    }
    float V1[16], V2[16];
#pragma unroll
    for (int k = 0; k < 16; ++k) { V1[k] = __uint_as_float(__float_as_uint(L1[k]) & ~127u); V2[k] = __uint_as_float(__float_as_uint(L2[k]) & ~127u); }
    float C[16];
#pragma unroll
    for (int k = 0; k < 16; ++k) C[k] = -INFINITY;
#pragma unroll
    for (int i = 0; i < 16; ++i)
#pragma unroll
        for (int j = 0; j < 16; ++j)
            if ((i + 1) * (j + 1) <= 16) INS16P(C, packf(V1[i] + V2[j], (unsigned)(i * 16 + j), 255u));
    if (ch == 0) {
        float e[16], sum = 0.f; int ex[16];
        const float c0 = __uint_as_float(__float_as_uint(C[0]) & ~255u);
#pragma unroll
        for (int k = 0; k < 16; ++k) {
            const unsigned cb = __float_as_uint(C[k]); const int ci = (cb >> 4) & 15, cj = cb & 15;
            int i1 = 0, i2 = 0;
#pragma unroll
            for (int m = 0; m < 16; ++m) { i1 = (ci == m) ? (int)(__float_as_uint(L1[m]) & 127u) : i1; i2 = (cj == m) ? (int)(__float_as_uint(L2[m]) & 127u) : i2; }
            ex[k] = i1 * 128 + i2;
            e[k] = expf(__uint_as_float(cb & ~255u) - c0); sum += e[k];
        }
        const float inv = 1.f / sum;
        const size_t base = ((size_t)(tt * 32 + tok) * 8 + p) * 16;
#pragma unroll
        for (int q = 0; q < 4; ++q) {
            *(v4u*)(expid + base + 4 * q) = (v4u){(unsigned)ex[4 * q], (unsigned)ex[4 * q + 1], (unsigned)ex[4 * q + 2], (unsigned)ex[4 * q + 3]};
            *(f32x4*)(gate + base + 4 * q) = (f32x4){e[4 * q] * inv, e[4 * q + 1] * inv, e[4 * q + 2] * inv, e[4 * q + 3] * inv};
        }
    }
}
__device__ __forceinline__ void phase8(const Args& a, LAS unsigned char* lds) {
    const int tid = threadIdx.x, lane = tid & 63, wave = tid >> 6;
    LAS float* SC = (LAS float*)(lds + wave * 16896);
    const int gw = blockIdx.x * 8 + wave, NGW = gridDim.x * 8;
#ifndef P8_REP
#define P8_REP 1
#endif
    for (int rep_ = 0; rep_ < P8_REP; ++rep_)
    for (int u = gw; u < 1024 * 8; u += NGW) peer_route_unit(a, SC, u >> 3, u & 7, lane);
}

typedef float f32x2 __attribute__((ext_vector_type(2)));
__device__ __forceinline__ void cvt8(const v4u u, float* f) { f[0] = bflo(u.x); f[1] = bfhi(u.x); f[2] = bflo(u.y); f[3] = bfhi(u.y); f[4] = bflo(u.z); f[5] = bfhi(u.z); f[6] = bflo(u.w); f[7] = bfhi(u.w); }
__device__ __forceinline__ void cvt16_fp8(const v4u u, float* f) {
#pragma unroll
    for (int q = 0; q < 4; ++q) { const f32x2 lo = __builtin_amdgcn_cvt_pk_f32_fp8((int)u[q], false), hi = __builtin_amdgcn_cvt_pk_f32_fp8((int)u[q], true);
        f[4 * q] = lo.x; f[4 * q + 1] = lo.y; f[4 * q + 2] = hi.x; f[4 * q + 3] = hi.y; }
}
#define DPPF(x_, ctrl_) __builtin_bit_cast(float, __builtin_amdgcn_update_dpp(0, __builtin_bit_cast(int, (x_)), (ctrl_), 0xF, 0xF, false))
__device__ __forceinline__ float reduce8(const float* d, int lane) {
    const bool b0 = lane & 1, b1 = lane & 2, b2 = lane & 4;
    float s1[4], s2[2];
#pragma unroll
    for (int i = 0; i < 4; ++i) { const float a = b0 ? d[2 * i + 1] : d[2 * i], b = b0 ? d[2 * i] : d[2 * i + 1]; s1[i] = a + DPPF(b, 0xB1); }
#pragma unroll
    for (int i = 0; i < 2; ++i) { const float a = b1 ? s1[2 * i + 1] : s1[2 * i], b = b1 ? s1[2 * i] : s1[2 * i + 1]; s2[i] = a + DPPF(b, 0x4E); }
    const float a3 = b2 ? s2[1] : s2[0], b3 = b2 ? s2[0] : s2[1];
    float s = a3 + DPPF(b3, 0x124);
    s += DPPF(s, 0x128);
    s += __shfl_xor(s, 16); s += __shfl_xor(s, 32);
    return s;
}
#ifndef P9L_G
#define P9L_G 8
#endif
constexpr int P9LG = P9L_G, P9LP = 128 + P9LG;
constexpr int P9L_WAVE = 4 * (P9LP * 4 * 3);
#ifndef P9L_SH
#define P9L_SH 12
#endif
constexpr int P9L_NS = 16384 >> P9L_SH;
__device__ __forceinline__ void phase9l(const Args& a, LAS unsigned char* lds) {
    const int tid = threadIdx.x, lane = tid & 63, wave = tid >> 6, G = gridDim.x;
    const unsigned char* UT = a.ws + WS_UT; const unsigned char* VT = a.ws + WS_VT;
    const float* SU = (const float*)(a.ws + WS_SU); const float* SV = (const float*)(a.ws + WS_SV);
    const int* expid = (const int*)(a.ws + WS_EXPID); const float* gate = (const float*)(a.ws + WS_GATE);
    const float* mod = (const float*)(a.ws + WS_MOD);
    LAS int* LE = (LAS int*)(lds + wave * P9L_WAVE);
    LAS float* LG = (LAS float*)(LE + 4 * P9LP);
    LAS float* LA = LG + 4 * P9LP;
    const bool isdiag = (lane >> 4) == ((lane & 15) >> 2);
    for (int rd = 0; ; ++rd) {
        const int tb = ((rd * G + (int)blockIdx.x) * 8 + wave) * 4;
        if (tb >= T_TOK) break;
        v4u h8[4]; float hsc[4]; int off[4][P9L_NS + 1];
#pragma unroll
        for (int i = 0; i < 4; ++i) {
            const size_t t = (size_t)(tb + i);
            h8[i] = *(const v4u*)(a.ws + WS_H8 + t * DM + 16 * lane); hsc[i] = ((const float*)(a.ws + WS_HS))[t];
            int e[2]; float gq[2];
#pragma unroll
            for (int q = 0; q < 2; ++q) { e[q] = expid[t * 128 + lane + 64 * q]; gq[q] = gate[t * 128 + lane + 64 * q]; }
            int base = 0;
#pragma unroll
            for (int s = 0; s < P9L_NS; ++s) {
                off[i][s] = base;
#pragma unroll
                for (int q = 0; q < 2; ++q) {
                    const bool in = (e[q] >> P9L_SH) == s;
                    const unsigned long long mk = __builtin_amdgcn_ballot_w64(in);
                    const int pos = base + __builtin_amdgcn_mbcnt_hi((unsigned)(mk >> 32), __builtin_amdgcn_mbcnt_lo((unsigned)mk, 0));
                    if (in) { LE[i * P9LP + pos] = e[q]; LG[i * P9LP + pos] = gq[q]; }
                    base += __builtin_popcountll(mk);
                }
            }
            off[i][P9L_NS] = 128;
            if (lane < P9LG) LE[i * P9LP + 128 + lane] = e[0];
        }
        LDS_WAIT();
#pragma unroll 1
        for (int s = 0; s < P9L_NS; ++s) {
#pragma unroll
            for (int i = 0; i < 4; ++i) {
                for (int g0 = off[i][s]; g0 < off[i][s + 1]; g0 += P9LG) {
                    const int n = off[i][s + 1] - g0;
                    const int ev = LE[i * P9LP + g0 + (lane & (P9LG - 1))];
                    v4u ua[P9LG];
#pragma unroll
                    for (int k = 0; k < P9LG; ++k) { const int e = __builtin_amdgcn_readlane(ev, k); ua[k] = *(const v4u*)(UT + (size_t)e * 1024 + 16 * lane); }
                    const long hlo = (long)(((unsigned long long)h8[i].y << 32) | h8[i].x), hhi = (long)(((unsigned long long)h8[i].w << 32) | h8[i].z);
#pragma unroll
                    for (int k8 = 0; k8 < P9LG; k8 += 8) {
                        float dd[8];
#pragma unroll
                        for (int k = 0; k < 8; ++k) {
                            f32x4 cacc = (f32x4){0.f, 0.f, 0.f, 0.f};
                            cacc = __builtin_amdgcn_mfma_f32_16x16x32_fp8_fp8((long)(((unsigned long long)ua[k8 + k].y << 32) | ua[k8 + k].x), hlo, cacc, 0, 0, 0);
                            cacc = __builtin_amdgcn_mfma_f32_16x16x32_fp8_fp8((long)(((unsigned long long)ua[k8 + k].w << 32) | ua[k8 + k].z), hhi, cacc, 0, 0, 0);
                            const float c01 = (lane & 1) ? cacc[1] : cacc[0], c23 = (lane & 1) ? cacc[3] : cacc[2];
                            dd[k] = isdiag ? ((lane & 2) ? c23 : c01) : 0.f;
                        }
                        const float tot = reduce8(dd, lane);
                        if (lane < 8 && k8 + lane < n) LA[i * P9LP + g0 + k8 + lane] = tot;
                        __builtin_amdgcn_sched_barrier(0);
                    }
                }
            }
        }
        LDS_WAIT();
#pragma unroll
        for (int i = 0; i < 4; ++i)
#pragma unroll
            for (int q = 0; q < 2; ++q) { const int ix = i * P9LP + lane + 64 * q; const int e = LE[ix];
                const float dq = LA[ix] * SU[e] * hsc[i];
                LA[ix] = 0.5f * dq * (1.f + erff(dq * 0.70710678118654752f)) * LG[ix] * SV[e]; }
        LDS_WAIT();
        float y[4][16];
#pragma unroll
        for (int i = 0; i < 4; ++i)
#pragma unroll
            for (int c = 0; c < 16; ++c) y[i][c] = 0.f;
#pragma unroll 1
        for (int s = 0; s < P9L_NS; ++s) {
#pragma unroll
            for (int i = 0; i < 4; ++i) {
                for (int g0 = off[i][s]; g0 < off[i][s + 1]; g0 += P9LG) {
                    const int n = off[i][s + 1] - g0;
                    const int ev = LE[i * P9LP + g0 + (lane & (P9LG - 1))];
                    const float av = ((lane & (P9LG - 1)) < n) ? LA[i * P9LP + g0 + (lane & (P9LG - 1))] : 0.f;
                    v4u va[P9LG];
#pragma unroll
                    for (int k = 0; k < P9LG; ++k) { const int e = __builtin_amdgcn_readlane(ev, k); va[k] = *(const v4u*)(VT + (size_t)e * 1024 + 16 * lane); }
#pragma unroll
                    for (int k = 0; k < P9LG; ++k) { const float aj = __builtin_bit_cast(float, __builtin_amdgcn_readlane(__builtin_bit_cast(int, av), k));
                        float f[16]; cvt16_fp8(va[k], f);
#pragma unroll
                        for (int c = 0; c < 16; ++c) y[i][c] = __builtin_fmaf(aj, f[c], y[i][c]);
                        if ((k & 3) == 3) __builtin_amdgcn_sched_barrier(0); }
                }
            }
        }
#pragma unroll
        for (int i = 0; i < 4; ++i) {
            const int t = tb + i, b = t >> 12;
            float* orow = a.out + (size_t)t * DM + 16 * lane; const float* g2 = mod + b * 6144 + 5120 + 16 * lane;
#pragma unroll
            for (int q4 = 0; q4 < 4; ++q4) {
                const f32x4 xv = *(const f32x4*)(orow + 4 * q4), gv = *(const f32x4*)(g2 + 4 * q4);
                const f32x4 yv = (f32x4){y[i][4 * q4], y[i][4 * q4 + 1], y[i][4 * q4 + 2], y[i][4 * q4 + 3]};
                *(f32x4*)(orow + 4 * q4) = xv + gv * yv;
            }
        }
        LDS_WAIT();
    }
}

#define XB_TMO      128
#define XB_XCNT(j)  (256  + 64 * (j))
#define XB_XSUB(j)  (1280 + 64 * (j))
#define XB_XGEN(j)  (2304 + 64 * (j))
#define XB_TOP      3328
#define XB_TOPGEN   3392
#define XCD_BAR_WORDS 3456
#define XB_SPIN_CAP (1u << 18)

__device__ __forceinline__ unsigned xb_ld(unsigned* p)              { return __hip_atomic_load(p, __ATOMIC_RELAXED, __HIP_MEMORY_SCOPE_AGENT); }
__device__ __forceinline__ unsigned xb_add(unsigned* p, unsigned v) { return __hip_atomic_fetch_add(p, v, __ATOMIC_RELAXED, __HIP_MEMORY_SCOPE_AGENT); }
__device__ __forceinline__ unsigned xb_xcc_id() { return (unsigned)__builtin_amdgcn_s_getreg((3 << 11) | 20) & 0xFu; }
#define XB_SPIN(cond, bar) do { unsigned _sp = 0; while (cond) { __builtin_amdgcn_s_sleep(1); \
    if ((++_sp & 255u) == 0u) { if (xb_ld(&(bar)[XB_TMO])) break; if (_sp > XB_SPIN_CAP) { atomicAdd(&(bar)[XB_TMO], 1u); break; } } } } while (0)

struct XcdBarrier {
    unsigned* bar; unsigned x;
    volatile LAS unsigned* st;
};

__device__ __forceinline__ XcdBarrier xcd_barrier_post(unsigned* bar, volatile LAS unsigned* st) {
    XcdBarrier b; b.bar = bar; b.x = xb_xcc_id(); b.st = st;
    if (threadIdx.x == 0) (void)xb_add(&bar[XB_XCNT(b.x)], 1u);
    return b;
}
__device__ __forceinline__ void xcd_barrier_complete(unsigned* bar, unsigned x, unsigned& nloc, unsigned& nx) {
    const unsigned G = gridDim.x * gridDim.y * gridDim.z;
    unsigned sum, cnt, mine, sp = 0u;
    for (;;) {
        sum = 0u; cnt = 0u; mine = 0u;
#pragma unroll
        for (unsigned j = 0; j < 16; ++j) { const unsigned c = xb_ld(&bar[XB_XCNT(j)]); sum += c; cnt += (c > 0u) ? 1u : 0u; mine = (j == x) ? c : mine; }
        if (sum == G) break;
        __builtin_amdgcn_s_sleep(1);
        if ((++sp & 255u) == 0u) { if (xb_ld(&bar[XB_TMO])) break; if (sp > XB_SPIN_CAP) { atomicAdd(&bar[XB_TMO], 1u); break; } }
    }
    nloc = mine > 0u ? mine : 1u; nx = cnt > 0u ? cnt : 1u;
}

__device__ __forceinline__ void xcd_barrier(const XcdBarrier& b) {
    asm volatile("s_waitcnt vmcnt(0)" ::: "memory");
    __syncthreads();
    if (threadIdx.x == 0) {
        unsigned* bar = b.bar;
        __builtin_amdgcn_s_waitcnt(0);
        unsigned nloc = b.st[0], nx = b.st[1];
        if (nloc == 0u) { xcd_barrier_complete(bar, b.x, nloc, nx); b.st[0] = nloc; b.st[1] = nx; }
        const unsigned old = xb_add(&bar[XB_XSUB(b.x)], 1u);
        const unsigned gen = old / nloc;
        if (old + 1u == (gen + 1u) * nloc) {
            __builtin_amdgcn_fence(__ATOMIC_RELEASE, "agent");
            asm volatile("s_waitcnt vmcnt(0)" ::: "memory");
            const unsigned og = xb_add(&bar[XB_TOP], 1u);
            const unsigned tg = og / nx;
            if (og + 1u == (tg + 1u) * nx) xb_add(&bar[XB_TOPGEN], 1u);
            else XB_SPIN(xb_ld(&bar[XB_TOPGEN]) == tg, bar);
            __builtin_amdgcn_fence(__ATOMIC_ACQUIRE, "agent");
            xb_add(&bar[XB_XGEN(b.x)], 1u);
            asm volatile("s_waitcnt vmcnt(0)" ::: "memory");
        } else {
            XB_SPIN(xb_ld(&bar[XB_XGEN(b.x)]) == gen, bar);
            __builtin_amdgcn_fence(__ATOMIC_ACQUIRE, "agent");
            asm volatile("s_waitcnt vmcnt(0)" ::: "memory");
        }
    }
    __syncthreads();
}

__global__ void __launch_bounds__(512, 2) mega_fwd(Args a) {
    extern __shared__ __attribute__((aligned(16))) unsigned char lds_raw[];
    LAS unsigned char* lds = (LAS unsigned char*)lds_raw;
    asm volatile("" : "+v"(lds));
    cg::grid_group grid = cg::this_grid();
#define MISC_PTR ((volatile LAS unsigned*)((LAS unsigned char*)lds_raw + (LDS_BYTES - 64)))
    if (threadIdx.x < 16) MISC_PTR[threadIdx.x] = 0u;
    __syncthreads();
    const unsigned xcc_id = xcd_barrier_post((unsigned*)(a.ws + WS_CTL) + 4096, MISC_PTR).x;
    grid.sync();
    unsigned char* ws = a.ws;
    const int lo = a.ph_lo, hi = a.ph_hi;
#ifndef PH_MASK
#define PH_MASK 0x3ff
#endif
#define IN(k) (((PH_MASK >> (k)) & 1) && lo <= (k) && (k) < hi)
#define SEAM(k) do { if (IN(k) && IN((k) + 1)) { if ((k) == 99) grid.sync(); else { XcdBarrier xb_; xb_.bar = (unsigned*)(a.ws + WS_CTL) + 4096; xb_.x = xcc_id; xb_.st = MISC_PTR; xcd_barrier(xb_); } } } while (0)
#ifndef REP_MASK
#define REP_MASK 0
#endif
#define RUNP(k, body) do { if (IN(k)) { body; if ((REP_MASK >> (k)) & 1) { grid.sync(); body; } } } while (0)
    RUNP(0, phase0(a, lds)); SEAM(0);
    RUNP(1, phase_norm(a.in[0], (const float*)(ws + WS_MOD), 0, 1024, (bf16*)(ws + WS_H))); SEAM(1);
    RUNP(2, ({
        pg8::Gemm g{(const pg8::bf16_t*)(ws + WS_H), (const pg8::bf16_t*)(ws + WS_WIN), T_TOK, PW, DM}; pg8::StaticOrder S; S.init(T_TOK, PW, gridDim.x, blockIdx.x);
        EpiBf E{(bf16*)(ws + WS_PROJ), PW};
        pg8::gemm_phase<EpiBf, pg8::StaticOrder>(lds, g, S, E, nullptr); })); SEAM(2);
#ifdef IDX_FP32
    if (IN(3)) { phase_idx32(a, lds); grid.sync(); }
#endif
    RUNP(3, phase3(a, lds)); SEAM(3);
    RUNP(4, phase4(a, lds)); SEAM(4);
    RUNP(5, ({
        pg8::Gemm g{(const pg8::bf16_t*)(ws + WS_YAB), (const pg8::bf16_t*)(ws + WS_BT2), T_TOK, DM, YW}; pg8::StaticOrder S; S.init(T_TOK, DM, gridDim.x, blockIdx.x);
        EpiX1 E{a.in[0], a.out, (const float*)(ws + WS_MOD)};
        pg8::gemm_phase<EpiX1, pg8::StaticOrder>(lds, g, S, E, nullptr); })); SEAM(5);
    RUNP(6, phase_norm(a.out, (const float*)(ws + WS_MOD), 3072, 4096, (bf16*)(ws + WS_H), ws + WS_H8, (float*)(ws + WS_HS))); SEAM(6);
    RUNP(7, ({
        pg8::Gemm g{(const pg8::bf16_t*)(ws + WS_H), (const pg8::bf16_t*)(ws + WS_WQ), T_TOK, 2048, DM}; pg8::StaticOrder S; S.init(T_TOK, 2048, gridDim.x, blockIdx.x);
        EpiBf E{(bf16*)(ws + WS_QUERY), 2048};
        pg8::gemm_phase<EpiBf, pg8::StaticOrder>(lds, g, S, E, nullptr); })); SEAM(7);
    RUNP(8, phase8(a, lds)); SEAM(8);
    if (IN(9)) { phase9l(a, lds); }
#undef IN
#undef SEAM
}

#ifndef MK_N_LAUNCHES
#define MK_N_LAUNCHES 1
#endif
extern "C" void kernel_launch(void* const* d_in, const int* in_sizes, int n_in, void* d_out, int out_size, void* d_ws, size_t ws_size, hipStream_t stream) {
    static int grid = 0;
    if (grid == 0) {
        int dev = 0, cus = 0, per_cu = 0;
        hipGetDevice(&dev);
        hipDeviceGetAttribute(&cus, hipDeviceAttributeMultiprocessorCount, dev);
        hipFuncSetAttribute((const void*)mega_fwd, hipFuncAttributeMaxDynamicSharedMemorySize, LDS_BYTES);
        hipOccupancyMaxActiveBlocksPerMultiprocessor(&per_cu, (const void*)mega_fwd, 512, LDS_BYTES);
        if (per_cu < 1) { fprintf(stderr, "kernel_launch: occupancy query says %d blocks per CU\n", per_cu); per_cu = 1; }
        grid = cus * 1;
        if (n_in != 17 || ws_size < WS_END) fprintf(stderr, "kernel_launch: unexpected n_in %d / ws_size %zu\n", n_in, ws_size);
    }
    (void)hipMemsetAsync((char*)d_ws + WS_CTL, 0, 65536, stream);
    Args a{};
    for (int i = 0; i < 17; ++i) a.in[i] = (const float*)d_in[i];
    a.out = (float*)d_out; a.ws = (unsigned char*)d_ws;
#if MK_N_LAUNCHES == 1
    a.ph_lo = 0; a.ph_hi = 10;
    void* args[] = {&a};
    hipError_t e = hipLaunchCooperativeKernel((const void*)mega_fwd, dim3(grid), dim3(512), args, LDS_BYTES, stream);
    if (e != hipSuccess) fprintf(stderr, "cooperative launch failed: %s (grid %d)\n", hipGetErrorString(e), grid);
#else
    for (int p = 0; p < 10; ++p) { a.ph_lo = p; a.ph_hi = p + 1; hipLaunchKernelGGL(mega_fwd, dim3(grid), dim3(512), LDS_BYTES, stream, a); }
#endif
}
```

```cpp
#include <hip/hip_runtime.h>
#include <hip/hip_cooperative_groups.h>
#include <cstdio>
#include <cstdint>
namespace cg = cooperative_groups;
namespace pg8 {
#define PG8_LAS __attribute__((address_space(3)))
typedef unsigned short bf16_t;
typedef short bf16x8 __attribute__((ext_vector_type(8)));
typedef float f32x4 __attribute__((ext_vector_type(4)));
typedef unsigned u32x4 __attribute__((ext_vector_type(4)));
constexpr int BM = 256, BK = 64, HALF = 128, HTB = HALF * BK * 2  , STAGE_BYTES = 8 * HTB, NXCD = 8, WGM = 8;

__host__ __device__ __forceinline__ int lds_byte(int r, int c) { const int st = (r >> 4) * 2 + (c >> 5), rr = r & 15, cc = c & 31, ob = rr * 64 + cc * 2; return st * 1024 + (ob ^ (((ob >> 9) & 1) << 5)); }
__host__ __device__ __forceinline__ void stage_rc(int b, int& R, int& C) { const int st = b / 1024, sb = b % 1024, swz = sb ^ (((sb >> 9) & 1) << 5); R = (st >> 1) * 16 + swz / 64; C = (st & 1) * 32 + (swz % 64) / 2; }
__host__ __device__ __forceinline__ int perm32(int rho) { const int n = rho >> 4, i = rho & 15; return 8 * (i >> 2) + 4 * n + (i & 3); }

struct Unit { int pm, pn; };
struct Gemm { const bf16_t* A; const bf16_t* Bt; int M, N, K; };

struct StaticOrder {
    int nM, nN, nwg, G, c;
    __host__ __device__ void init(int M, int N, int G_, int c_) { nM = M / BM; nN = N / BM; nwg = nM * nN; G = G_; c = c_; }
    __host__ __device__ bool next(int i, Unit& u) const {
        const long L = (long)i * G + c; if (L >= nwg) return false;
        int wgid = (int)L; { const int q = nwg / NXCD, r = nwg % NXCD, xcd = wgid % NXCD, off = wgid / NXCD; wgid = (xcd < r ? xcd * (q + 1) : r * (q + 1) + (xcd - r) * q) + off; }
        const int nig = WGM * nN, gid = wgid / nig, fm = gid * WGM, gsz = (nM - fm) < WGM ? (nM - fm) : WGM;
        u.pm = fm + ((wgid % nig) % gsz); u.pn = (wgid % nig) / gsz; return true;
    }
    __device__ __forceinline__ void a_ready(const Unit&) const {}
    __device__ __forceinline__ void done(const Unit&) const {}
};
__device__ __forceinline__ unsigned cvt_pk_bf16(float lo, float hi) { unsigned r; asm volatile("v_cvt_pk_bf16_f32 %0, %1, %2" : "=v"(r) : "v"(lo), "v"(hi)); return r; }
template <class Epi, class Sched, bool STAMP = false>
__device__ __forceinline__ void gemm_phase(PG8_LAS unsigned char* lds, const Gemm g, const Sched& S, const Epi& E, unsigned long long* stamps) {
    const int tid = threadIdx.x, wid = __builtin_amdgcn_readfirstlane(tid >> 6), lane = tid & 63, wr = wid >> 2, wc = wid & 3, fr = lane & 15, fq = lane >> 4;
    const int K = g.K, nt = K / BK;
    int ts_lo = 0, ts_hi = 0, nts = 0; const unsigned long long rt_entry = STAMP ? (unsigned long long)wall_clock64() : 0ull;
#define PG8_STAMP() do { if (STAMP && wid == 0 && nts < 64) { const unsigned long long _c = (unsigned long long)clock64(); \
        ts_lo = (lane == nts) ? (int)(unsigned)_c : ts_lo; ts_hi = (lane == nts) ? (int)(unsigned)(_c >> 32) : ts_hi; ++nts; } } while (0)
    PG8_STAMP();
    unsigned voffA[2], voffB[2];
#pragma unroll
    for (int i = 0; i < 2; ++i) { int R, C; stage_rc(tid * 16 + i * 8192, R, C); const int Rb = Epi::PERM ? ((R & ~31) + perm32(R & 31)) : R;
        voffA[i] = (unsigned)(R * K + C) * 2u; voffB[i] = (unsigned)(Rb * K + C) * 2u; }
    const size_t kstep = (size_t)(BK * 2);
    const size_t hstep = (size_t)HALF * K * 2;
    const size_t tstep = 2 * hstep;
    const unsigned ldsw = (unsigned)wid * 1024u;
    const int aoff = lds_byte(wr * 64 + fr, fq * 8), boff = lds_byte(wc * 32 + fr, fq * 8);
#define PG8_SA(b, h) (((b) * 2 + (h)) * HTB)
#define PG8_SB(b, h) ((4 + (b) * 2 + (h)) * HTB)
#define PG8_STAGE(bufoff, gbase, voff) do { _Pragma("unroll") for (int _i = 0; _i < 2; ++_i) \
        __builtin_amdgcn_global_load_lds((const unsigned*)((const char*)(gbase) + (voff)[_i]), (PG8_LAS unsigned*)(lds + (bufoff) + ldsw + _i * 8192), 16, 0, 0); } while (0)
#define PG8_LDA(dst, b, h) do { _Pragma("unroll") for (int m = 0; m < 4; ++m) _Pragma("unroll") for (int k = 0; k < 2; ++k) dst[m][k] = *(const PG8_LAS bf16x8*)(lds + PG8_SA(b, h) + aoff + m * 2048 + k * 1024); } while (0)
#define PG8_LDB(dst, b, h) do { _Pragma("unroll") for (int n = 0; n < 2; ++n) _Pragma("unroll") for (int k = 0; k < 2; ++k) dst[n][k] = *(const PG8_LAS bf16x8*)(lds + PG8_SB(b, h) + boff + n * 2048 + k * 1024); } while (0)
#define PG8_MMA(ai, bj, At, Bt) do { __builtin_amdgcn_s_setprio(1); _Pragma("unroll") for (int m = 0; m < 4; ++m) _Pragma("unroll") for (int n = 0; n < 2; ++n) _Pragma("unroll") for (int k = 0; k < 2; ++k) \
        acc[ai][bj][m][n] = __builtin_amdgcn_mfma_f32_16x16x32_bf16(Bt[n][k], At[m][k], acc[ai][bj][m][n], 0, 0, 0); __builtin_amdgcn_s_setprio(0); } while (0)
#define PG8_WAIT_V(n) asm volatile("s_waitcnt vmcnt(" #n ")" ::: "memory")
#define PG8_WAIT_L(n) asm volatile("s_waitcnt lgkmcnt(" #n ")" ::: "memory")
#define PG8_BAR __builtin_amdgcn_s_barrier()
#define PG8_SCHED __builtin_amdgcn_sched_barrier(0)
    Unit cur, nxt; int ui = 0;
    if (!S.next(0, cur)) return;
    f32x4 acc[2][2][4][2];
#pragma unroll
    for (int a = 0; a < 2; ++a)
#pragma unroll
        for (int b = 0; b < 2; ++b)
#pragma unroll
            for (int m = 0; m < 4; ++m)
#pragma unroll
                for (int n = 0; n < 2; ++n) acc[a][b][m][n] = (f32x4){0.f, 0.f, 0.f, 0.f};
    bf16x8 At[4][2], B0[2][2], B1[2][2];
    const char* cA = (const char*)g.A + (size_t)cur.pm * tstep; const char* cB = (const char*)g.Bt + (size_t)cur.pn * tstep;
    S.a_ready(cur);
    PG8_STAGE(PG8_SB(0, 0), cB, voffB); PG8_STAGE(PG8_SA(0, 0), cA, voffA); PG8_STAGE(PG8_SB(0, 1), cB + hstep, voffB); PG8_STAGE(PG8_SA(0, 1), cA + hstep, voffA);
    if (wr == 1) PG8_BAR;
    PG8_WAIT_V(4); PG8_BAR;
    PG8_STAGE(PG8_SB(1, 0), cB + kstep, voffB); PG8_STAGE(PG8_SA(1, 0), cA + kstep, voffA); PG8_STAGE(PG8_SB(1, 1), cB + hstep + kstep, voffB);
    PG8_WAIT_V(6); PG8_BAR;
    PG8_STAMP();
    for (;;) {
        const bool has_next = S.next(ui + 1, nxt);
        const char* nA = has_next ? (const char*)g.A + (size_t)nxt.pm * tstep : cA; const char* nB = has_next ? (const char*)g.Bt + (size_t)nxt.pn * tstep : cB;
        for (int t = 0; t < nt; t += 2) {
            const bool last = (t == nt - 2);
            const char* a1 = cA + (size_t)(t + 1) * kstep;
            const char* a2 = last ? nA : cA + (size_t)(t + 2) * kstep; const char* b2 = last ? nB : cB + (size_t)(t + 2) * kstep;
            const char* a3 = a2 + kstep; const char* b3 = b2 + kstep;
            if (last && has_next) S.a_ready(nxt);
            PG8_LDB(B0, 0, 0); PG8_SCHED; PG8_LDA(At, 0, 0); PG8_STAGE(PG8_SA(1, 1), a1 + hstep, voffA);
            PG8_WAIT_L(8); PG8_BAR; PG8_WAIT_L(0); PG8_MMA(0, 0, At, B0); PG8_BAR; PG8_SCHED;
            PG8_LDB(B1, 0, 1); PG8_STAGE(PG8_SB(0, 0), b2, voffB);
            PG8_BAR; PG8_WAIT_L(0); PG8_MMA(0, 1, At, B1); PG8_BAR;
            PG8_LDA(At, 0, 1); PG8_STAGE(PG8_SA(0, 0), a2, voffA);
            PG8_BAR; PG8_WAIT_L(0); PG8_MMA(1, 0, At, B0); PG8_BAR; PG8_SCHED;
            PG8_STAGE(PG8_SB(0, 1), b2 + hstep, voffB);
            PG8_WAIT_V(6); PG8_BAR; PG8_MMA(1, 1, At, B1); PG8_BAR;
            PG8_LDB(B0, 1, 0); PG8_SCHED; PG8_LDA(At, 1, 0); PG8_STAGE(PG8_SA(0, 1), a2 + hstep, voffA);
            PG8_WAIT_L(8); PG8_BAR; PG8_WAIT_L(0); PG8_MMA(0, 0, At, B0); PG8_BAR; PG8_SCHED;
            PG8_LDB(B1, 1, 1); PG8_STAGE(PG8_SB(1, 0), b3, voffB);
            PG8_BAR; PG8_WAIT_L(0); PG8_MMA(0, 1, At, B1); PG8_BAR;
            PG8_LDA(At, 1, 1); PG8_STAGE(PG8_SA(1, 0), a3, voffA);
            PG8_BAR; PG8_WAIT_L(0); PG8_MMA(1, 0, At, B0); PG8_BAR; PG8_SCHED;
            PG8_STAGE(PG8_SB(1, 1), b3 + hstep, voffB);
            PG8_WAIT_V(6); PG8_BAR; PG8_MMA(1, 1, At, B1); PG8_BAR;
        }
        PG8_STAMP();
        if constexpr (!Epi::AFTER_DRAIN) { E(acc, cur, wr, wc, fr, fq); S.done(cur); }
        PG8_STAMP();
        if (!has_next) break;
#pragma unroll
        for (int a = 0; a < 2; ++a)
#pragma unroll
            for (int b = 0; b < 2; ++b)
#pragma unroll
                for (int m = 0; m < 4; ++m)
#pragma unroll
                    for (int n = 0; n < 2; ++n) acc[a][b][m][n] = (f32x4){0.f, 0.f, 0.f, 0.f};
        cur = nxt; cA = nA; cB = nB; ++ui;
    }
    PG8_WAIT_V(0);
    if (wr == 0) PG8_BAR;
    PG8_BAR;
    if constexpr (Epi::AFTER_DRAIN) { E.fused(acc, cur, wr, wc, fr, fq, lds, wid, lane); S.done(cur); }
    PG8_STAMP();
    if (STAMP && wid == 0) { stamps[lane] = lane < nts ? (((unsigned long long)(unsigned)ts_hi << 32) | (unsigned)ts_lo) : 0ull;
        if (lane == 62) stamps[62] = rt_entry; if (lane == 63) stamps[63] = (unsigned long long)wall_clock64(); }
#undef PG8_STAMP
#undef PG8_SA
#undef PG8_SB
#undef PG8_STAGE
#undef PG8_LDA
#undef PG8_LDB
#undef PG8_MMA
#undef PG8_WAIT_V
#undef PG8_WAIT_L
#undef PG8_BAR
#undef PG8_SCHED
}
}

#define LAS __attribute__((address_space(3)))
typedef unsigned short bf16;
typedef unsigned v4u __attribute__((ext_vector_type(4)));
typedef unsigned v2u __attribute__((ext_vector_type(2)));
typedef float f32x4 __attribute__((ext_vector_type(4)));
typedef float f32x16 __attribute__((ext_vector_type(16)));
typedef short bf16x8 __attribute__((ext_vector_type(8)));

constexpr int T_TOK = 32768, DM = 1024, SEQ = 4096, NBATCH = 8;
constexpr int PW = 3584;
constexpr int IN_W = 3532;
constexpr int C_AQ = 0, C_AKV = 1024, C_IQ = 1152, C_IK = 1408, C_IW = 1472, C_BA = 1476, C_BB = 1480, C_BQ = 1536, C_BK = 2048, C_BV = 2560, C_BZ = 3072;
constexpr int YW = 1536;
constexpr int NCHUNK = 2048;
constexpr float EPS = 1e-6f;

constexpr size_t MiB = 1u << 20;
constexpr size_t WS_CTL = 0;
constexpr size_t WS_MOD = 1 * MiB;
constexpr size_t WS_GL = WS_MOD + 256 * 1024;
constexpr size_t WS_SU = WS_MOD + 512 * 1024;
constexpr size_t WS_SV = WS_MOD + 640 * 1024;
constexpr size_t WS_WIN = 2 * MiB;
constexpr size_t WS_BT2 = 9 * MiB;
constexpr size_t WS_WQ = 12 * MiB;
constexpr size_t WS_SUBK = 16 * MiB;
constexpr size_t WS_H = 18 * MiB;
constexpr size_t WS_KN = WS_H;
constexpr size_t WS_SEL = WS_H + 8 * MiB;
constexpr size_t WS_PROJ = 82 * MiB;
constexpr size_t WS_QUERY = WS_PROJ;
constexpr size_t WS_YAB = 306 * MiB;
constexpr size_t WS_EXPID = WS_YAB;
constexpr size_t WS_GATE = WS_YAB + 16 * MiB;
constexpr size_t WS_H8 = WS_YAB + 32 * MiB;
constexpr size_t WS_HS = WS_YAB + 64 * MiB;
constexpr size_t WS_GA = 402 * MiB;
constexpr size_t WS_UT = 418 * MiB;
constexpr size_t WS_VT = 450 * MiB;
constexpr size_t WS_END = 482 * MiB;
constexpr size_t DO_W = 0, DO_QD = 32 * MiB, DO_KDT = 64 * MiB, DO_UT = 96 * MiB;

constexpr int LDS_BYTES = 147456;

struct Args { const float* in[17]; float* out; unsigned char* ws; int ph_lo, ph_hi; };

__device__ __forceinline__ unsigned pk2(float lo, float hi) { unsigned r; asm("v_cvt_pk_bf16_f32 %0, %1, %2" : "=v"(r) : "v"(lo), "v"(hi)); return r; }
__device__ __forceinline__ unsigned f2bf(float f) { return pk2(f, f) & 0xffffu; }
__device__ __forceinline__ float bflo(unsigned u) { return __uint_as_float(u << 16); }
__device__ __forceinline__ float bfhi(unsigned u) { return __uint_as_float(u & 0xffff0000u); }
__device__ __forceinline__ float bf1(bf16 b) { return __uint_as_float(((unsigned)b) << 16); }
__device__ __forceinline__ float wave_sum(float v) {
#pragma unroll
    for (int o = 1; o < 64; o <<= 1) v += __shfl_xor(v, o);
    return v;
}
__device__ __forceinline__ float wave_max(float v) {
#pragma unroll
    for (int o = 1; o < 64; o <<= 1) v = fmaxf(v, __shfl_xor(v, o));
    return v;
}
__device__ __forceinline__ float silu_f(float v) { return v / (1.f + expf(-v)); }
__device__ __forceinline__ float silu_fast(float v) { return v * __builtin_amdgcn_rcpf(1.f + __expf(-v)); }
__device__ __forceinline__ float sigmoid_f(float v) { return 1.f / (1.f + expf(-v)); }
__device__ __forceinline__ float softplus_f(float v) { return fmaxf(v, 0.f) + log1pf(expf(-fabsf(v))); }
#define LDS_WAIT() asm volatile("s_waitcnt lgkmcnt(0)" ::: "memory")

__device__ __forceinline__ int win_srccol(int n) {
    if (n < 1476) return n;
    if (n < 1480) return 3524 + (n - 1476);
    if (n < 1484) return 3528 + (n - 1480);
    if (n < 1536) return -1;
    return 1476 + (n - 1536);
}
__device__ __forceinline__ void transpose_item(const float* W, int spitch, int k0, int sc, bf16* WT, int dpitch, int drow0, int dcol0, LAS float* scr, int lane) {
#pragma unroll 8
    for (int i = 0; i < 32; ++i) { const int kk = 2 * i + (lane >> 5); scr[kk * 33 + (lane & 31)] = (sc >= 0) ? W[(size_t)(k0 + kk) * spitch + sc] : 0.f; }
    LDS_WAIT();
    const int c = lane & 7;
#pragma unroll
    for (int j = 0; j < 4; ++j) { const int n = (lane >> 3) + 8 * j; const LAS float* s = scr + (8 * c) * 33 + n;
        v4u o; o.x = pk2(s[0 * 33], s[1 * 33]); o.y = pk2(s[2 * 33], s[3 * 33]); o.z = pk2(s[4 * 33], s[5 * 33]); o.w = pk2(s[6 * 33], s[7 * 33]);
        *(v4u*)(WT + (size_t)(drow0 + n) * dpitch + dcol0 + 8 * c) = o; }
    LDS_WAIT();
}

__device__ __forceinline__ void phase0(const Args& a, LAS unsigned char* lds) {
    const int tid = threadIdx.x, lane = tid & 63, wave = tid >> 6, bid = blockIdx.x, G = gridDim.x;
    unsigned char* ws = a.ws;
#ifndef P0_REP
#define P0_REP 0
#endif
    for (int rep0_ = 0; rep0_ < 1 + (P0_REP ? 1 : 0); ++rep0_) {
    if (rep0_ == 0 || (P0_REP & 1))
    for (int item = bid; item < 192; item += G) {
        LAS float* sc = (LAS float*)lds;
        LAS float* red = sc + 8192;
        const float* c = a.in[1];
        for (int i = tid; i < 8192; i += 512) sc[i] = silu_f(c[i]);
        __syncthreads();
        const int cc = tid & 31, kg = tid >> 5;
        const float* w = a.in[2] + item * 32 + cc;
        float acc[8];
#pragma unroll
        for (int b = 0; b < 8; ++b) acc[b] = 0.f;
        for (int k = kg; k < 1024; k += 16) { const float wv = w[(size_t)k * 6144];
#pragma unroll
            for (int b = 0; b < 8; ++b) acc[b] += sc[b * 1024 + k] * wv; }
#pragma unroll
        for (int b = 0; b < 8; ++b) red[(kg * 8 + b) * 32 + cc] = acc[b];
        __syncthreads();
        if (tid < 256) { const int b = tid >> 5; float s = 0.f;
            for (int k2 = 0; k2 < 16; ++k2) s += red[(k2 * 8 + b) * 32 + cc];
            ((float*)(ws + WS_MOD))[b * 6144 + item * 32 + cc] = s + a.in[3][item * 32 + cc]; }
        __syncthreads();
    }
    if (rep0_ == 0 || (P0_REP & 2)) {
        LAS float* scr = (LAS float*)(lds + 65536 + wave * 8704);
        const int gw = bid * 8 + wave, NGW = G * 8;
        constexpr int I_WIN = 16 * 112, I_WQ = 16 * 64, I_WO = 8 * 32;
        for (int it = gw; it < I_WIN + I_WQ + I_WO; it += NGW) {
            int r = it;
            if (r < I_WIN) { const int kb = r / 112, nb = r % 112; transpose_item(a.in[4], IN_W, 64 * kb, win_srccol(32 * nb + (lane & 31)), (bf16*)(ws + WS_WIN), 1024, 32 * nb, 64 * kb, scr, lane); continue; }
            r -= I_WIN;
            if (r < I_WQ) { const int kb = r / 64, nb = r % 64; transpose_item(a.in[13], 2048, 64 * kb, 32 * nb + (lane & 31), (bf16*)(ws + WS_WQ), 1024, 32 * nb, 64 * kb, scr, lane); continue; }
            r -= I_WQ;
            { const int kb = r / 32, nb = r % 32; transpose_item(a.in[12] + (size_t)512 * 1024, 1024, 64 * kb, 32 * nb + (lane & 31), (bf16*)(ws + WS_BT2), YW, 32 * nb, 1024 + 64 * kb, scr, lane); }
        }
    }
    if (rep0_ == 0 || (P0_REP & 4)) {
        const float* wuv = a.in[7]; const float* wout = a.in[12]; bf16* bt2 = (bf16*)(ws + WS_BT2);
        for (int it = bid * 512 + tid; it < 1024 * 128; it += G * 512) {
            const int n = it & 1023, kb = __builtin_amdgcn_readfirstlane(it >> 10);
            const int h = kb >> 4, r0 = (kb & 15) * 8;
            float acc[8];
#pragma unroll
            for (int j = 0; j < 8; ++j) acc[j] = 0.f;
            for (int v = 0; v < 64; ++v) { const float wo = wout[(size_t)(h * 64 + v) * 1024 + n];
#pragma unroll
                for (int j = 0; j < 8; ++j) acc[j] += wuv[(size_t)(h * 128 + r0 + j) * 64 + v] * wo; }
            v4u o; o.x = pk2(acc[0], acc[1]); o.y = pk2(acc[2], acc[3]); o.z = pk2(acc[4], acc[5]); o.w = pk2(acc[6], acc[7]);
            *(v4u*)(bt2 + (size_t)n * YW + h * 128 + r0) = o;
        }
    }
    if (rep0_ == 0 || (P0_REP & 8)) {
        const size_t gt = (size_t)bid * 512 + tid, GT = (size_t)G * 512;
        for (size_t i = gt; i < 262144 / 8; i += GT) {
            const f32x4 v0 = *(const f32x4*)(a.in[14] + i * 8), v1 = *(const f32x4*)(a.in[14] + i * 8 + 4);
            v4u o; o.x = pk2(v0.x, v0.y); o.y = pk2(v0.z, v0.w); o.z = pk2(v1.x, v1.y); o.w = pk2(v1.z, v1.w);
            *(v4u*)((bf16*)(ws + WS_SUBK) + i * 8) = o;
        }
        const int gw = bid * 8 + wave, NGW = G * 8;
        for (int row = gw; row < 2 * 16384; row += NGW) {
            const int tb = row >> 14, e = row & 16383;
            const float* src = (tb ? a.in[16] : a.in[15]) + (size_t)e * 1024 + 16 * lane;
            f32x4 v[4]; float mx = 0.f;
#pragma unroll
            for (int q = 0; q < 4; ++q) { v[q] = *(const f32x4*)(src + 4 * q); mx = fmaxf(fmaxf(mx, fmaxf(fabsf(v[q].x), fabsf(v[q].y))), fmaxf(fabsf(v[q].z), fabsf(v[q].w))); }
            mx = wave_max(mx);
            const float scale = (mx > 0.f) ? mx * (1.f / 240.f) : 1.f, inv = 1.f / scale;
            v4u o;
#pragma unroll
            for (int q = 0; q < 4; ++q) { int p = __builtin_amdgcn_cvt_pk_fp8_f32(v[q].x * inv, v[q].y * inv, 0, false); p = __builtin_amdgcn_cvt_pk_fp8_f32(v[q].z * inv, v[q].w * inv, p, true); o[q] = (unsigned)p; }
            *(v4u*)(ws + (tb ? WS_VT : WS_UT) + (size_t)e * 1024 + 16 * lane) = o;
            if (lane == 0) ((float*)(ws + (tb ? WS_SV : WS_SU)))[e] = scale;
        }
    }
    }
}

__device__ __forceinline__ void phase_norm(const float* x, const float* mod, int shift_off, int scale_off, bf16* hout, unsigned char* h8 = nullptr, float* hs = nullptr) {
    const int tid = threadIdx.x, lane = tid & 63, wave = tid >> 6;
    const int gw = blockIdx.x * 8 + wave, NGW = gridDim.x * 8;
    for (int m = gw; m < T_TOK; m += NGW) {
        const int b = m >> 12;
        const f32x4* xr = (const f32x4*)(x + (size_t)m * DM) + lane;
        f32x4 v[4]; float s = 0.f;
#pragma unroll
        for (int j = 0; j < 4; ++j) { v[j] = xr[64 * j]; s += (v[j].x * v[j].x + v[j].y * v[j].y) + (v[j].z * v[j].z + v[j].w * v[j].w); }
        const float inv = rsqrtf(wave_sum(s) * (1.f / DM) + EPS);
        const f32x4* sh = (const f32x4*)(mod + b * 6144 + shift_off) + lane;
        const f32x4* sc = (const f32x4*)(mod + b * 6144 + scale_off) + lane;
        v2u* o8 = (v2u*)(hout + (size_t)m * DM) + lane;
        float amax = 0.f;
#pragma unroll
        for (int j = 0; j < 4; ++j) { const f32x4 a = sh[64 * j], c = sc[64 * j];
            v[j].x = v[j].x * inv * (1.f + c.x) + a.x; v[j].y = v[j].y * inv * (1.f + c.y) + a.y; v[j].z = v[j].z * inv * (1.f + c.z) + a.z; v[j].w = v[j].w * inv * (1.f + c.w) + a.w;
            v2u o; o.x = pk2(v[j].x, v[j].y); o.y = pk2(v[j].z, v[j].w);
            o8[64 * j] = o;
            amax = fmaxf(fmaxf(amax, fmaxf(fabsf(v[j].x), fabsf(v[j].y))), fmaxf(fabsf(v[j].z), fabsf(v[j].w))); }
        if (h8) {
            amax = wave_max(amax);
            const float scale = (amax > 0.f) ? amax * (1.f / 240.f) : 1.f, qi = 1.f / scale;
#pragma unroll
            for (int j = 0; j < 4; ++j) { int p = __builtin_amdgcn_cvt_pk_fp8_f32(v[j].x * qi, v[j].y * qi, 0, false); p = __builtin_amdgcn_cvt_pk_fp8_f32(v[j].z * qi, v[j].w * qi, p, true);
                *(unsigned*)(h8 + (size_t)m * DM + 4 * (lane + 64 * j)) = (unsigned)p; }
            if (lane == 0) hs[m] = scale;
        }
    }
}

struct EpiX1 {
    static constexpr bool PERM = false, AFTER_DRAIN = false;
    const float* x; float* out; const float* mod;
    __device__ __forceinline__ void operator()(const pg8::f32x4 (&acc)[2][2][4][2], const pg8::Unit& u, int wr, int wc, int fr, int fq) const {
        const int row0 = u.pm * 256 + wr * 64 + fr, col0 = u.pn * 256 + wc * 32 + 4 * fq;
        const int b = (u.pm * 256) >> 12;
        f32x4 gv[2][2];
#pragma unroll
        for (int bj = 0; bj < 2; ++bj)
#pragma unroll
            for (int n = 0; n < 2; ++n) gv[bj][n] = *(const f32x4*)(mod + b * 6144 + 2048 + col0 + bj * 128 + n * 16);
#pragma unroll
        for (int ai = 0; ai < 2; ++ai)
#pragma unroll
            for (int m = 0; m < 4; ++m) { const size_t ro = (size_t)(row0 + ai * 128 + m * 16) * DM + col0;
#pragma unroll
                for (int bj = 0; bj < 2; ++bj)
#pragma unroll
                    for (int n = 0; n < 2; ++n) { const f32x4 xv = *(const f32x4*)(x + ro + bj * 128 + n * 16);
                        *(f32x4*)(out + ro + bj * 128 + n * 16) = xv + gv[bj][n] * acc[ai][bj][m][n]; } }
    }
};
struct EpiBf {
    static constexpr bool PERM = true, AFTER_DRAIN = false;
    bf16* O; int ldc;
    __device__ __forceinline__ void operator()(const pg8::f32x4 (&acc)[2][2][4][2], const pg8::Unit& u, int wr, int wc, int fr, int fq) const {
        const int row0 = u.pm * 256 + wr * 64 + fr, col0 = u.pn * 256 + wc * 32 + 8 * fq;
#pragma unroll
        for (int ai = 0; ai < 2; ++ai)
#pragma unroll
            for (int m = 0; m < 4; ++m) { bf16* rowp = O + (size_t)(row0 + ai * 128 + m * 16) * ldc + col0;
#pragma unroll
                for (int bj = 0; bj < 2; ++bj) { const pg8::f32x4 zz = (pg8::f32x4){0.f, 0.f, 0.f, 0.f}; const pg8::f32x4 v0 = acc[ai][bj][m][0] + zz, v1 = acc[ai][bj][m][1] + zz;
                    v4u w; w.x = pg8::cvt_pk_bf16(v0[0], v0[1]); w.y = pg8::cvt_pk_bf16(v0[2], v0[3]); w.z = pg8::cvt_pk_bf16(v1[0], v1[1]); w.w = pg8::cvt_pk_bf16(v1[2], v1[3]);
                    *(v4u*)(rowp + bj * 128) = w; } }
    }
};

constexpr int GP_QS = 0, GP_KS = 33792, GP_VS = 67584, GP_LS = 101376, GP_GV = 118784;
__device__ __forceinline__ void gdn_prep_item(const Args& a, LAS unsigned char* lds, int chunk) {
    int tid = threadIdx.x; asm volatile("" : "+v"(tid));
    const int lane = tid & 63, wave = __builtin_amdgcn_readfirstlane(tid >> 6);
    unsigned char* ws = a.ws;
    const bf16* proj = (const bf16*)(ws + WS_PROJ);
    const int bh = chunk >> 6, n = chunk & 63, b = bh >> 2, h = bh & 3;
    const int t0 = b * SEQ + n * 64;
    LAS float* QS = (LAS float*)(lds + GP_QS); LAS float* KS = (LAS float*)(lds + GP_KS); LAS float* VS = (LAS float*)(lds + GP_VS);
    LAS float* LS = (LAS float*)(lds + GP_LS); LAS float* GV = (LAS float*)(lds + GP_GV);
#ifndef GP_MASK
#define GP_MASK 31
#endif
#ifndef GP_REP
#define GP_REP 0
#endif
    for (int rep_ = 0; rep_ < 1 + (GP_REP & 1); ++rep_)
    if ((GP_MASK & 1) && tid < 384) {
        const int cg = tid % 48, rs = tid / 48;
        const int sec = cg >> 4, c8 = (cg & 15) * 8;
        const int pcol = C_BQ + sec * 512 + h * 128 + c8;
        const float* cw = a.in[8] + sec * 512 + h * 128 + c8;
        float wt[4][8];
#pragma unroll
        for (int i = 0; i < 4; ++i) { const f32x4 w0 = *(const f32x4*)(cw + i * 1536), w1 = *(const f32x4*)(cw + i * 1536 + 4);
            wt[i][0] = w0.x; wt[i][1] = w0.y; wt[i][2] = w0.z; wt[i][3] = w0.w; wt[i][4] = w1.x; wt[i][5] = w1.y; wt[i][6] = w1.z; wt[i][7] = w1.w; }
        LAS float* XS = (sec == 0) ? QS : (sec == 1 ? KS : VS);
        v4u raw[11];
#pragma unroll
        for (int j = 0; j < 11; ++j) { const int rr = 8 * rs - 3 + j;
            raw[j] = (rr >= 0 || n > 0) ? *(const v4u*)(proj + (size_t)(t0 + rr) * PW + pcol) : (v4u){0u, 0u, 0u, 0u}; }
#pragma unroll
        for (int j = 0; j < 8; ++j) {
            float y[8];
#pragma unroll
            for (int c = 0; c < 8; ++c) y[c] = 0.f;
#pragma unroll
            for (int i = 0; i < 4; ++i) { float xv[8]; const v4u u = raw[j + i];
                xv[0] = bflo(u.x); xv[1] = bfhi(u.x); xv[2] = bflo(u.y); xv[3] = bfhi(u.y); xv[4] = bflo(u.z); xv[5] = bfhi(u.z); xv[6] = bflo(u.w); xv[7] = bfhi(u.w);
#pragma unroll
                for (int c = 0; c < 8; ++c) y[c] += wt[i][c] * xv[c]; }
            f32x4 o0, o1;
            o0.x = silu_f(y[0]); o0.y = silu_f(y[1]); o0.z = silu_f(y[2]); o0.w = silu_f(y[3]); o1.x = silu_f(y[4]); o1.y = silu_f(y[5]); o1.z = silu_f(y[6]); o1.w = silu_f(y[7]);
            *(LAS f32x4*)(XS + (8 * rs + j) * 132 + c8) = o0; *(LAS f32x4*)(XS + (8 * rs + j) * 132 + c8 + 4) = o1;
        }
    }
    if (wave == 7) {
        const int i = lane;
        const float av = bf1(proj[(size_t)(t0 + i) * PW + C_BA + h]), bv = bf1(proj[(size_t)(t0 + i) * PW + C_BB + h]);
        const float beta = sigmoid_f(bv);
        const float g = -expf(a.in[9][h]) * softplus_f(av + a.in[10][h]);
        float G = g;
#pragma unroll
        for (int o = 1; o < 64; o <<= 1) { const float t = __shfl_up(G, o); if (lane >= o) G += t; }
        const float Glast = __shfl(G, 63);
        GV[i] = G; GV[64 + i] = expf(G); GV[128 + i] = beta; GV[192 + i] = expf(Glast - G); GV[256 + i] = beta * expf(G);
        if (lane == 0) ((float*)(ws + WS_GL))[chunk] = expf(Glast);
    }
    __syncthreads();
    if (GP_MASK & 2) {
#pragma unroll 4
        for (int rr = 0; rr < 16; ++rr) {
            const int row = wave * 16 + rr;
            LAS float* X = (row < 64) ? (QS + row * 132) : (KS + (row - 64) * 132);
            const float v0 = X[lane], v1 = X[lane + 64];
            const float ss = wave_sum(v0 * v0 + v1 * v1);
            const float sc = rsqrtf(ss + EPS) * ((row < 64) ? 0.08838834764831845f : 1.f);
            X[lane] = v0 * sc; X[lane + 64] = v1 * sc;
        }
    }
    __syncthreads();
    for (int rep_ = 0; rep_ < 1 + ((GP_REP >> 2) & 1); ++rep_)
    if (GP_MASK & 4) {
        const int gram = wave >> 2, ti = wave & 3, r = lane & 15, g = lane >> 4;
        const LAS float* X = gram ? QS : KS;
        f32x4 acc[4];
#pragma unroll
        for (int tj = 0; tj < 4; ++tj) acc[tj] = (f32x4){0.f, 0.f, 0.f, 0.f};
#pragma unroll 2
        for (int kk = 0; kk < 8; ++kk) {
            const f32x4 xa = *(const LAS f32x4*)(X + (16 * ti + r) * 132 + 16 * kk + 4 * g);
#pragma unroll
            for (int tj = 0; tj < 4; ++tj) {
                if (tj <= ti) {
                    const f32x4 kb = *(const LAS f32x4*)(KS + (16 * tj + r) * 132 + 16 * kk + 4 * g);
                    acc[tj] = __builtin_amdgcn_mfma_f32_16x16x4f32(xa.x, kb.x, acc[tj], 0, 0, 0);
                    acc[tj] = __builtin_amdgcn_mfma_f32_16x16x4f32(xa.y, kb.y, acc[tj], 0, 0, 0);
                    acc[tj] = __builtin_amdgcn_mfma_f32_16x16x4f32(xa.z, kb.z, acc[tj], 0, 0, 0);
                    acc[tj] = __builtin_amdgcn_mfma_f32_16x16x4f32(xa.w, kb.w, acc[tj], 0, 0, 0);
                }
            }
        }
        bf16* Aout = (bf16*)(ws + WS_GA) + (size_t)chunk * 4096;
#pragma unroll
        for (int tj = 0; tj < 4; ++tj)
#pragma unroll
            for (int rg = 0; rg < 4; ++rg) {
                const int i = 16 * ti + 4 * g + rg, j = 16 * tj + r;
                const float dec = (j <= i) ? expf(GV[i] - GV[j]) : 0.f;
                if (gram == 0) { if (tj <= ti) LS[i * 68 + j] = (j < i) ? GV[128 + i] * acc[tj][rg] * dec : 0.f; }
                else Aout[((((i >> 4) * 2 + (j >> 5)) * 64 + (i & 15) + 16 * ((j >> 3) & 3)) << 3) + (j & 7)] = (bf16)f2bf((tj <= ti) ? acc[tj][rg] * dec : 0.f);
            }
    }
    __syncthreads();
    {
        bf16* QD = (bf16*)((unsigned char*)a.out + DO_QD) + (size_t)chunk * 8192;
        bf16* KDT = (bf16*)((unsigned char*)a.out + DO_KDT) + (size_t)chunk * 8192;
#pragma unroll
        for (int m = 0; m < 2; ++m) {
            const int p = tid + 512 * m;
            { const int i = p >> 4, k8 = (p & 15) * 8; const float e = GV[64 + i]; const LAS float* sq = QS + i * 132 + k8;
              v4u o; o.x = pk2(sq[0] * e, sq[1] * e); o.y = pk2(sq[2] * e, sq[3] * e); o.z = pk2(sq[4] * e, sq[5] * e); o.w = pk2(sq[6] * e, sq[7] * e);
              *(v4u*)(QD + ((((i >> 4) * 4 + ((p & 15) >> 2)) * 64 + (i & 15) + 16 * (p & 3)) << 3)) = o; }
            { const int k = p >> 3, i8 = (p & 7) * 8; float v[8];
#pragma unroll
              for (int j = 0; j < 8; ++j) v[j] = KS[(i8 + j) * 132 + k] * GV[192 + i8 + j];
              v4u o; o.x = pk2(v[0], v[1]); o.y = pk2(v[2], v[3]); o.z = pk2(v[4], v[5]); o.w = pk2(v[6], v[7]);
              *(v4u*)(KDT + ((((k >> 4) * 2 + ((p & 7) >> 2)) * 64 + (k & 15) + 16 * (p & 3)) << 3)) = o; }
        }
    }
    __syncthreads();
    {
#pragma unroll
        for (int m = 0; m < 4; ++m) {
            const int p = tid + 512 * m, i = p >> 5, c4 = (p & 31) * 4;
            const float mu = GV[128 + i], mw = GV[256 + i];
            f32x4 v = *(LAS f32x4*)(VS + i * 132 + c4); v.x *= mu; v.y *= mu; v.z *= mu; v.w *= mu; *(LAS f32x4*)(VS + i * 132 + c4) = v;
            f32x4 k = *(LAS f32x4*)(KS + i * 132 + c4); k.x *= mw; k.y *= mw; k.z *= mw; k.w *= mw; *(LAS f32x4*)(KS + i * 132 + c4) = k;
        }
    }
    __syncthreads();
    {
        const int r = lane & 15, g = lane >> 4;
#pragma unroll 1
        for (int I = 0; I < 4; ++I) {
            if (I > 0) {
#pragma unroll
                for (int tt = 0; tt < 2; ++tt) {
                    const int ct = 2 * wave + tt;
                    LAS float* XB = ((ct < 8) ? VS : KS) + (ct & 7) * 16 + r;
                    f32x4 acc;
#pragma unroll
                    for (int rg = 0; rg < 4; ++rg) acc[rg] = XB[(16 * I + 4 * g + rg) * 132];
                    for (int J = 0; J < I; ++J) {
#pragma unroll
                        for (int ks = 0; ks < 4; ++ks) {
                            const float la = -LS[(16 * I + r) * 68 + 16 * J + 4 * ks + g];
                            const float xb = XB[(16 * J + 4 * ks + g) * 132];
                            acc = __builtin_amdgcn_mfma_f32_16x16x4f32(la, xb, acc, 0, 0, 0);
                        }
                    }
#pragma unroll
                    for (int rg = 0; rg < 4; ++rg) XB[(16 * I + 4 * g + rg) * 132] = acc[rg];
                }
                __syncthreads();
            }
            if (tid < 256) {
                LAS float* XC = ((tid < 128) ? VS : KS) + (tid & 127);
                float x[16];
#pragma unroll
                for (int rr = 0; rr < 16; ++rr) {
                    float a0 = XC[(16 * I + rr) * 132], a1 = 0.f, a2 = 0.f, a3 = 0.f;
#pragma unroll
                    for (int j4 = 0; j4 < (rr + 3) / 4; ++j4) {
                        const f32x4 l = *(const LAS f32x4*)(LS + (16 * I + rr) * 68 + 16 * I + 4 * j4);
                        if (4 * j4 + 0 < rr) a0 -= l.x * x[4 * j4 + 0];
                        if (4 * j4 + 1 < rr) a1 -= l.y * x[4 * j4 + 1];
                        if (4 * j4 + 2 < rr) a2 -= l.z * x[4 * j4 + 2];
                        if (4 * j4 + 3 < rr) a3 -= l.w * x[4 * j4 + 3];
                    }
                    x[rr] = (a0 + a1) + (a2 + a3);
                }
#pragma unroll
                for (int rr = 0; rr < 16; ++rr) XC[(16 * I + rr) * 132] = x[rr];
            }
            __syncthreads();
        }
    }
    {
        bf16* W = (bf16*)((unsigned char*)a.out + DO_W) + (size_t)chunk * 8192;
        bf16* UT = (bf16*)((unsigned char*)a.out + DO_UT) + (size_t)chunk * 8192;
#pragma unroll
        for (int m = 0; m < 2; ++m) {
            const int p = tid + 512 * m, i = p >> 4, k8 = p & 15;
            const f32x4 x0 = *(const LAS f32x4*)(KS + i * 132 + 8 * k8), x1 = *(const LAS f32x4*)(KS + i * 132 + 8 * k8 + 4);
            v4u o; o.x = pk2(x0.x, x0.y); o.y = pk2(x0.z, x0.w); o.z = pk2(x1.x, x1.y); o.w = pk2(x1.z, x1.w);
            *(v4u*)(W + ((((i >> 4) * 4 + (k8 >> 2)) * 64 + (i & 15) + 16 * (k8 & 3)) << 3)) = o;
        }
#pragma unroll
        for (int m = 0; m < 4; ++m) {
            const int p = tid + 512 * m, v = p & 127, q = p >> 7;
            v2u o; o.x = pk2(VS[(4 * q) * 132 + v], VS[(4 * q + 1) * 132 + v]); o.y = pk2(VS[(4 * q + 2) * 132 + v], VS[(4 * q + 3) * 132 + v]);
            *(v2u*)(UT + ((((q >> 2) * 8 + (v >> 4)) * 64 + (v & 15) + 16 * (q & 3)) << 2)) = o;
        }
    }
    __syncthreads();
}

__device__ __forceinline__ void kn_item(const Args& a, int item) {
    const int tid = threadIdx.x, lane = tid & 63, wave = tid >> 6;
    const bf16* proj = (const bf16*)(a.ws + WS_PROJ); bf16* KN = (bf16*)(a.ws + WS_KN);
    const float g0 = a.in[6][2 * lane], g1 = a.in[6][2 * lane + 1];
    for (int rr = 0; rr < 16; ++rr) {
        const int t = item * 128 + wave * 16 + rr;
        const unsigned u = *(const unsigned*)(proj + (size_t)t * PW + C_AKV + 2 * lane);
        const float v0 = bflo(u), v1 = bfhi(u);
        const float inv = rsqrtf(wave_sum(v0 * v0 + v1 * v1) * (1.f / 128.f) + EPS);
        *(unsigned*)(KN + (size_t)t * 128 + 2 * lane) = pk2(v0 * inv * g0, v1 * inv * g1);
    }
}


#ifdef IDX_FP32
__device__ __forceinline__ void phase_idx32(const Args& a, LAS unsigned char* lds) {
    const int tid = threadIdx.x, lane = tid & 63, wave = tid >> 6;
    LAS float* HS = (LAS float*)lds;
    float* IDX32 = (float*)(a.ws + WS_YAB);
    const float* mod = (const float*)(a.ws + WS_MOD);
    for (int tile = blockIdx.x; tile < 1024; tile += gridDim.x) {
        const int t0 = tile * 32, b = t0 >> 12;
        for (int rr = 0; rr < 4; ++rr) {
            const int m = t0 + wave * 4 + rr;
            const f32x4* xr = (const f32x4*)(a.in[0] + (size_t)m * DM) + lane;
            f32x4 v[4]; float s = 0.f;
#pragma unroll
            for (int j = 0; j < 4; ++j) { v[j] = xr[64 * j]; s += (v[j].x * v[j].x + v[j].y * v[j].y) + (v[j].z * v[j].z + v[j].w * v[j].w); }
            const float inv = rsqrtf(wave_sum(s) * (1.f / DM) + EPS);
            const f32x4* sh = (const f32x4*)(mod + b * 6144) + lane; const f32x4* sc = (const f32x4*)(mod + b * 6144 + 1024) + lane;
#pragma unroll
            for (int j = 0; j < 4; ++j) { const f32x4 aa = sh[64 * j], c = sc[64 * j];
                f32x4 o; o.x = v[j].x * inv * (1.f + c.x) + aa.x; o.y = v[j].y * inv * (1.f + c.y) + aa.y; o.z = v[j].z * inv * (1.f + c.z) + aa.z; o.w = v[j].w * inv * (1.f + c.w) + aa.w;
                *(LAS f32x4*)(HS + (wave * 4 + rr) * 1028 + 4 * (lane + 64 * j)) = o; }
        }
        __syncthreads();
        if (tid < 324) {
            const float* w = a.in[4] + 1152 + tid;
            float acc[32];
#pragma unroll
            for (int t = 0; t < 32; ++t) acc[t] = 0.f;
            for (int k4 = 0; k4 < 256; ++k4) {
                const float w0 = w[(size_t)(4 * k4) * IN_W], w1 = w[(size_t)(4 * k4 + 1) * IN_W], w2 = w[(size_t)(4 * k4 + 2) * IN_W], w3 = w[(size_t)(4 * k4 + 3) * IN_W];
#pragma unroll
                for (int t = 0; t < 32; ++t) { const f32x4 hv = *(const LAS f32x4*)(HS + t * 1028 + 4 * k4); acc[t] += hv.x * w0 + hv.y * w1 + hv.z * w2 + hv.w * w3; }
            }
#pragma unroll
            for (int t = 0; t < 32; ++t) IDX32[(size_t)(t0 + t) * 384 + tid] = acc[t];
        }
        __syncthreads();
    }
}
#endif
__device__ __forceinline__ unsigned sortable(float f) { const unsigned u = __float_as_uint(f + 0.f); return (u & 0x80000000u) ? ~u : (u | 0x80000000u); }
__device__ __forceinline__ int wave_sum_dpp(int x) {
    x += __builtin_amdgcn_update_dpp(0, x, 0xB1, 0xF, 0xF, false);
    x += __builtin_amdgcn_update_dpp(0, x, 0x4E, 0xF, 0xF, false);
    x += __builtin_amdgcn_update_dpp(0, x, 0x141, 0xF, 0xF, false);
    x += __builtin_amdgcn_update_dpp(0, x, 0x140, 0xF, 0xF, false);
    return __builtin_amdgcn_readlane(x, 0) + __builtin_amdgcn_readlane(x, 16) + __builtin_amdgcn_readlane(x, 32) + __builtin_amdgcn_readlane(x, 48);
}
#define CNT8(OP, acc_, k_, s_, c_) asm("v_cmp_" OP "_u32 s[36:37], %1, %9\n\tv_cmp_" OP "_u32 s[38:39], %2, %9\n\tv_cmp_" OP "_u32 s[40:41], %3, %9\n\tv_cmp_" OP "_u32 s[42:43], %4, %9\n\t" \
        "v_cmp_" OP "_u32 s[44:45], %5, %9\n\tv_cmp_" OP "_u32 s[46:47], %6, %9\n\tv_cmp_" OP "_u32 s[48:49], %7, %9\n\tv_cmp_" OP "_u32 s[50:51], %8, %9\n\t" \
        "v_addc_co_u32 %0, s[36:37], 0, %0, s[36:37]\n\tv_addc_co_u32 %0, s[38:39], 0, %0, s[38:39]\n\tv_addc_co_u32 %0, s[40:41], 0, %0, s[40:41]\n\tv_addc_co_u32 %0, s[42:43], 0, %0, s[42:43]\n\t" \
        "v_addc_co_u32 %0, s[44:45], 0, %0, s[44:45]\n\tv_addc_co_u32 %0, s[46:47], 0, %0, s[46:47]\n\tv_addc_co_u32 %0, s[48:49], 0, %0, s[48:49]\n\tv_addc_co_u32 %0, s[50:51], 0, %0, s[50:51]" \
        : "+v"(acc_) : "v"(k_[(s_)]), "v"(k_[(s_) + 1]), "v"(k_[(s_) + 2]), "v"(k_[(s_) + 3]), "v"(k_[(s_) + 4]), "v"(k_[(s_) + 5]), "v"(k_[(s_) + 6]), "v"(k_[(s_) + 7]), "v"(c_) \
        : "s36", "s37", "s38", "s39", "s40", "s41", "s42", "s43", "s44", "s45", "s46", "s47", "s48", "s49", "s50", "s51")
template <int NS> __device__ __forceinline__ void topk_select(LAS float* row, int n, int lane, unsigned short* out) {
    asm volatile("" : "+v"(lane));
    unsigned key[NS];
#pragma unroll
    for (int s = 0; s < NS; ++s) key[s] = __float_as_uint(row[s * 64 + lane]);
#pragma unroll
    for (int s = 0; s < NS; ++s) { const int idx = s * 64 + lane; const unsigned k = sortable(__uint_as_float(key[s])); key[s] = (idx < n) ? k : 0u; }
    LAS unsigned short* sel_l = (LAS unsigned short*)row;
    unsigned thr = 0u;
    for (int bit = 31; bit >= 0; --bit) {
        const unsigned cand = thr | (1u << bit);
        int c0 = 0, c1 = 0;
#pragma unroll
        for (int s = 0; s < NS; s += 16) { CNT8("ge", c0, key, s, cand); CNT8("ge", c1, key, s + 8, cand); }
        const int cnt = wave_sum_dpp(c0 + c1);
        if (cnt >= 256) thr = cand;
        if (cnt == 256) break;
    }
    int g0 = 0, e0 = 0;
#pragma unroll
    for (int s = 0; s < NS; s += 8) { CNT8("gt", g0, key, s, thr); CNT8("eq", e0, key, s, thr); }
    const int cgt = wave_sum_dpp(g0), ceq = wave_sum_dpp(e0);
    const int need_eq = 256 - cgt;
    asm volatile("" : "+v"(thr));
    asm volatile("" : "+v"(lane));
    int pos_out = 0;
    if (ceq == need_eq) {
#pragma unroll
        for (int s = 0; s < NS; ++s) {
            const bool take = key[s] >= thr;
            const unsigned long long mt = __builtin_amdgcn_ballot_w64(take);
            const int pre = __builtin_amdgcn_mbcnt_hi((unsigned)(mt >> 32), __builtin_amdgcn_mbcnt_lo((unsigned)mt, 0));
            sel_l[take ? pos_out + pre : 256] = (unsigned short)(s * 64 + lane);
            pos_out += __builtin_popcountll(mt);
        }
    } else {
        const unsigned long long ltmask = (1ull << lane) - 1ull;
        int eq_seen = 0;
#pragma unroll
        for (int s = 0; s < NS; ++s) {
            const bool gt = key[s] > thr, eq = key[s] == thr;
            const unsigned long long meq = __builtin_amdgcn_ballot_w64(eq);
            const bool take = gt || (eq && (eq_seen + __builtin_popcountll(meq & ltmask) < need_eq));
            const unsigned long long mt = __builtin_amdgcn_ballot_w64(take);
            if (take) sel_l[pos_out + __builtin_popcountll(mt & ltmask)] = (unsigned short)(s * 64 + lane);
            pos_out += __builtin_popcountll(mt); eq_seen += __builtin_popcountll(meq);
            if ((s & 3) == 3) __builtin_amdgcn_sched_barrier(0);
        }
    }
    LDS_WAIT();
    *(v2u*)(out + 4 * lane) = *(const LAS v2u*)(sel_l + 4 * lane);
}
struct IdxPre { bf16x8 af[4]; v2u wqr[4]; bf16x8 bfr[4][4]; };
__device__ __forceinline__ void idx_issue(const Args& a, int b, int qblk, int wave, int lane, IdxPre& P) {
    const bf16* proj = (const bf16*)(a.ws + WS_PROJ);
    const int p0 = qblk * 8, r = lane & 31, hh = lane >> 5;
    const size_t rowb = (size_t)b * SEQ;
    if (p0 + 7 < 256) return;
    { const bf16* qp = proj + (rowb + p0 + (r & 7)) * PW + C_IQ + (r >> 3) * 64 + 32 * hh;
#pragma unroll
      for (int s = 0; s < 4; ++s) P.af[s] = *(const bf16x8*)(qp + 8 * s); }
#pragma unroll
    for (int i = 0; i < 4; ++i) P.wqr[i] = *(const v2u*)(proj + (rowb + p0 + 4 * hh + i) * PW + C_IW);
    const int ntiles = (p0 + 7) / 32 + 1;
#pragma unroll
    for (int u = 0; u < 4; ++u) {
        const int kt = (wave + 8 * u < ntiles) ? wave + 8 * u : 0;
        const bf16* kp = proj + (rowb + (size_t)kt * 32 + r) * PW + C_IK + 32 * hh;
#pragma unroll
        for (int s = 0; s < 4; ++s) P.bfr[u][s] = *(const bf16x8*)(kp + 8 * s);
    }
}
__device__ __forceinline__ void indexer_item(const Args& a, LAS unsigned char* lds, int b, int qblk, IdxPre& P, bool has_next, int b_next, int qblk_next) {
    int tid = threadIdx.x; asm volatile("" : "+v"(tid));
    const int lane = tid & 63, wave = __builtin_amdgcn_readfirstlane(tid >> 6);
    const bf16* proj = (const bf16*)(a.ws + WS_PROJ);
    unsigned short* SEL = (unsigned short*)(a.ws + WS_SEL);
    LAS float* SC = (LAS float*)lds;
    const int p0 = qblk * 8;
    const int r = lane & 31, hh = lane >> 5;
    const size_t rowb = (size_t)b * SEQ;
#ifdef IDX_FP32
    if (p0 + 7 >= 256) {
        const float* IDX32 = (const float*)(a.ws + WS_YAB);
        LAS float* IQS = (LAS float*)(lds + 131072);
        for (int i = tid; i < 2048; i += 512) IQS[i] = IDX32[(rowb + p0 + (i >> 8)) * 384 + (i & 255)];
        float wq8[8][4];
#pragma unroll
        for (int q = 0; q < 8; ++q)
#pragma unroll
            for (int hd = 0; hd < 4; ++hd) wq8[q][hd] = IDX32[(rowb + p0 + q) * 384 + 320 + hd];
        __syncthreads();
        for (int s = tid; s <= p0 + 7; s += 512) {
            float kf[64];
#pragma unroll
            for (int d4 = 0; d4 < 16; ++d4) { const f32x4 v = *(const f32x4*)(IDX32 + (rowb + s) * 384 + 256 + 4 * d4); kf[4 * d4] = v.x; kf[4 * d4 + 1] = v.y; kf[4 * d4 + 2] = v.z; kf[4 * d4 + 3] = v.w; }
#pragma unroll 1
            for (int q = 0; q < 8; ++q) {
                float sc = 0.f;
#pragma unroll
                for (int hd = 0; hd < 4; ++hd) {
                    float lg = 0.f;
#pragma unroll
                    for (int d4 = 0; d4 < 16; ++d4) { const f32x4 qv = *(const LAS f32x4*)(IQS + q * 256 + hd * 64 + 4 * d4); lg += kf[4 * d4] * qv.x + kf[4 * d4 + 1] * qv.y + kf[4 * d4 + 2] * qv.z + kf[4 * d4 + 3] * qv.w; }
                    sc += fmaxf(lg, 0.f) * wq8[q][hd];
                }
                SC[q * 4096 + s] = sc * 0.0625f;
            }
        }
    }
#else
    if (p0 + 7 >= 256) {
        float wq[4][4];
#pragma unroll
        for (int i = 0; i < 4; ++i) { wq[i][0] = bflo(P.wqr[i].x) * 0.0625f; wq[i][1] = bfhi(P.wqr[i].x) * 0.0625f; wq[i][2] = bflo(P.wqr[i].y) * 0.0625f; wq[i][3] = bfhi(P.wqr[i].y) * 0.0625f; }
        const int ntiles = (p0 + 7) / 32 + 1;
        for (int kt0 = wave; kt0 < ntiles; kt0 += 32) {
            bf16x8 nxt[4][4];
            const bool more = kt0 + 32 < ntiles;
            if (more) {
#pragma unroll
                for (int u = 0; u < 4; ++u) {
                    const int kt = (kt0 + 32 + 8 * u < ntiles) ? kt0 + 32 + 8 * u : kt0;
                    const bf16* kp = proj + (rowb + (size_t)kt * 32 + r) * PW + C_IK + 32 * hh;
#pragma unroll
                    for (int s = 0; s < 4; ++s) nxt[u][s] = *(const bf16x8*)(kp + 8 * s);
                }
            }
#pragma unroll
            for (int u = 0; u < 4; ++u) {
                const int kt = kt0 + 8 * u;
                if (kt < ntiles) {
                    f32x16 acc;
#pragma unroll
                    for (int i = 0; i < 16; ++i) acc[i] = 0.f;
#pragma unroll
                    for (int s = 0; s < 4; ++s) acc = __builtin_amdgcn_mfma_f32_32x32x16_bf16(P.af[s], P.bfr[u][s], acc, 0, 0, 0);
#pragma unroll
                    for (int i = 0; i < 4; ++i) {
                        float s = 0.f;
#pragma unroll
                        for (int hd = 0; hd < 4; ++hd) s += wq[i][hd] * fmaxf(acc[i + 4 * hd], 0.f);
                        SC[(4 * hh + i) * 4096 + kt * 32 + r] = s;
                    }
                }
            }
            if (more) {
#pragma unroll
                for (int u = 0; u < 4; ++u)
#pragma unroll
                    for (int s = 0; s < 4; ++s) P.bfr[u][s] = nxt[u][s];
            }
        }
    }
#endif
    __syncthreads();
#ifndef IDX_FP32
    if (has_next) idx_issue(a, b_next, qblk_next, wave, lane, P);
#endif
    {
        const int pos = p0 + wave, n = pos + 1;
        unsigned short* out = SEL + (rowb + pos) * 256;
        if (n <= 256) {
#pragma unroll
            for (int q = 0; q < 4; ++q) { const int j = lane + 64 * q; out[j] = (unsigned short)((j < n) ? j : 0xFFFF); }
        } else {
            LAS float* row = SC + wave * 4096;
            const int nslots = (n + 63) >> 6;
#ifndef IDX_REP_SELECT
#define IDX_REP_SELECT 1
#endif
            float* bk_ = (float*)(a.ws + WS_YAB) + ((size_t)blockIdx.x * 8 + wave) * 4096;
            if (IDX_REP_SELECT > 1) for (int i_ = lane; i_ < 4096; i_ += 64) bk_[i_] = row[i_];
            for (int rep_ = 0; rep_ < IDX_REP_SELECT; ++rep_) {
            if (rep_ > 0) { for (int i_ = lane; i_ < 4096; i_ += 64) row[i_] = bk_[i_]; LDS_WAIT(); }
            if (nslots <= 16) topk_select<16>(row, n, lane, out);
            else if (nslots <= 32) topk_select<32>(row, n, lane, out);
            else if (nslots <= 48) topk_select<48>(row, n, lane, out);
            else topk_select<64>(row, n, lane, out);
            }
        }
    }
    __syncthreads();
}

__device__ __forceinline__ void phase3(const Args& a, LAS unsigned char* lds) {
    const int bid = blockIdx.x, G = gridDim.x;
#ifndef P3_MASK
#define P3_MASK 7
#endif
#ifndef P3_REP
#define P3_REP 0
#endif
    if (P3_MASK & 1) for (int it = bid; it < 2048; it += G) { gdn_prep_item(a, lds, it); if (P3_REP & 1) gdn_prep_item(a, lds, it); }
    if (P3_MASK & 2) {
#define IDX_MAP(j_, bb_, qb_) do { if (G == 256) { const int i_ = (j_) / G, c_ = (j_) % G, q0_ = (c_ >> 3) + 32 * (i_ >> 1); bb_ = c_ & 7; qb_ = (i_ & 1) ? 511 - q0_ : q0_; } else { bb_ = (j_) >> 9; qb_ = (j_) & 511; } } while (0)
        IdxPre P;
        const int tid_ = threadIdx.x, lane_ = tid_ & 63, wave_ = __builtin_amdgcn_readfirstlane(tid_ >> 6);
        int bb, qb;
        if (bid < 4096) { IDX_MAP(bid, bb, qb); idx_issue(a, bb, qb, wave_, lane_, P); }
        for (int j = bid; j < 4096; j += G) {
            IDX_MAP(j, bb, qb);
            int bn = 0, qn = 0; const bool hn = (j + G < 4096);
            if (hn) IDX_MAP(j + G, bn, qn);
            indexer_item(a, lds, bb, qb, P, hn, bn, qn);
            if (P3_REP & 2) { idx_issue(a, bb, qb, wave_, lane_, P); indexer_item(a, lds, bb, qb, P, false, 0, 0); if (hn) idx_issue(a, bn, qn, wave_, lane_, P); }
        }
#undef IDX_MAP
    }
    if (P3_MASK & 4) for (int it = bid; it < 256; it += G) kn_item(a, it);
}

constexpr int SC_ST = 0, SC_VNT = 34816, SC_O = 53248;
__device__ __forceinline__ v2u pack4(float a, float b, float c, float d) { v2u o; o.x = pk2(a, b); o.y = pk2(c, d); return o; }
__device__ __forceinline__ void scan_epilogue(const LAS float* OS, const v4u z0, const v4u z1, const LAS float* gainl, bf16* ydst, int tid) {
    const int row = tid >> 3, seg = tid & 7;
    float o[16];
#pragma unroll
    for (int q = 0; q < 4; ++q) { const f32x4 v = *(const LAS f32x4*)(OS + row * 132 + 16 * seg + 4 * q); o[4 * q] = v.x; o[4 * q + 1] = v.y; o[4 * q + 2] = v.z; o[4 * q + 3] = v.w; }
    float ss = 0.f;
#pragma unroll
    for (int i = 0; i < 16; ++i) ss += o[i] * o[i];
    ss += __shfl_xor(ss, 1); ss += __shfl_xor(ss, 2); ss += __shfl_xor(ss, 4);
    const float inv = rsqrtf(ss * (1.f / 128.f) + EPS);
    float z[16];
    z[0] = bflo(z0.x); z[1] = bfhi(z0.x); z[2] = bflo(z0.y); z[3] = bfhi(z0.y); z[4] = bflo(z0.z); z[5] = bfhi(z0.z); z[6] = bflo(z0.w); z[7] = bfhi(z0.w);
    z[8] = bflo(z1.x); z[9] = bfhi(z1.x); z[10] = bflo(z1.y); z[11] = bfhi(z1.y); z[12] = bflo(z1.z); z[13] = bfhi(z1.z); z[14] = bflo(z1.w); z[15] = bfhi(z1.w);
    float y[16];
#pragma unroll
    for (int q = 0; q < 4; ++q) { const f32x4 gq = *(const LAS f32x4*)(gainl + 16 * seg + 4 * q);
        y[4 * q] = o[4 * q] * inv * gq.x * silu_fast(z[4 * q]); y[4 * q + 1] = o[4 * q + 1] * inv * gq.y * silu_fast(z[4 * q + 1]); y[4 * q + 2] = o[4 * q + 2] * inv * gq.z * silu_fast(z[4 * q + 2]); y[4 * q + 3] = o[4 * q + 3] * inv * gq.w * silu_fast(z[4 * q + 3]); }
    v4u w0, w1;
    w0.x = pk2(y[0], y[1]); w0.y = pk2(y[2], y[3]); w0.z = pk2(y[4], y[5]); w0.w = pk2(y[6], y[7]);
    w1.x = pk2(y[8], y[9]); w1.y = pk2(y[10], y[11]); w1.z = pk2(y[12], y[13]); w1.w = pk2(y[14], y[15]);
    *(v4u*)(ydst) = w0; *(v4u*)(ydst + 8) = w1;
}
__device__ __forceinline__ void gdn_scan(const Args& a, LAS unsigned char* lds, int bh) {
    const int tid = threadIdx.x, lane = tid & 63, w = __builtin_amdgcn_readfirstlane(tid >> 6), r = lane & 15, g = lane >> 4;
    const int b = bh >> 2, h = bh & 3;
    LAS bf16* ST = (LAS bf16*)(lds + SC_ST); LAS bf16* VNT = (LAS bf16*)(lds + SC_VNT); LAS float* OS = (LAS float*)(lds + SC_O);
    const bf16* proj = (const bf16*)(a.ws + WS_PROJ); bf16* yab = (bf16*)(a.ws + WS_YAB);
    const float* GL = (const float*)(a.ws + WS_GL);
    for (int i = tid; i < 34816 / 4; i += 512) ((LAS unsigned*)ST)[i] = 0u;
    f32x4 S[8];
#pragma unroll
    for (int vt = 0; vt < 8; ++vt) S[vt] = (f32x4){0.f, 0.f, 0.f, 0.f};
    const int erow = tid >> 3, eseg = tid & 7;
    LAS float* gainl = (LAS float*)(lds + 87040);
    if (tid < 128) gainl[tid] = a.in[11][tid];
    const int ct = w & 3;
    const size_t cb = (size_t)bh * 64;
    const bf16* Wb = (const bf16*)((const unsigned char*)a.out + DO_W) + cb * 8192;
    const bf16* QDb = (const bf16*)((const unsigned char*)a.out + DO_QD) + cb * 8192;
    const bf16* KDTb = (const bf16*)((const unsigned char*)a.out + DO_KDT) + cb * 8192;
    const bf16* UTb = (const bf16*)((const unsigned char*)a.out + DO_UT) + cb * 8192;
    const bf16* Ab = (const bf16*)(a.ws + WS_GA) + cb * 4096;
    const bf16* Xb = (w < 4) ? Wb : QDb;
    const size_t tz = ((size_t)b * SEQ + erow) * PW + C_BZ + h * 128 + 16 * eseg;
    const size_t ty = ((size_t)b * SEQ + erow) * YW + 1024 + h * 128 + 16 * eseg;
    bf16x8 af[4], kd[2]; v4u xr[4]; float gl; v4u zh0, zh1;
#define SCAN_LOAD(n_, af_, kd_, xr_, gl_) do { \
        const bf16* X_ = Xb + (size_t)(n_) * 8192 + (ct * 4 * 64 + lane) * 8; \
        _Pragma("unroll") for (int ks = 0; ks < 4; ++ks) af_[ks] = *(const bf16x8*)(X_ + ks * 512); \
        const bf16* K_ = KDTb + (size_t)(n_) * 8192 + (w * 2 * 64 + lane) * 8; \
        kd_[0] = *(const bf16x8*)(K_); kd_[1] = *(const bf16x8*)(K_ + 512); \
        if (w >= 4) { const bf16* A_ = Ab + (size_t)(n_) * 4096 + (ct * 2 * 64 + lane) * 8; xr_[0] = *(const v4u*)(A_); xr_[1] = *(const v4u*)(A_ + 512); } \
        else { const bf16* U_ = UTb + (size_t)(n_) * 8192 + (ct * 8 * 64 + lane) * 4; _Pragma("unroll") for (int q_ = 0; q_ < 4; ++q_) { const v2u u0_ = *(const v2u*)(U_ + (2 * q_) * 256), u1_ = *(const v2u*)(U_ + (2 * q_ + 1) * 256); xr_[q_] = (v4u){u0_.x, u0_.y, u1_.x, u1_.y}; } } \
        gl_ = GL[cb + (n_)]; } while (0)
    SCAN_LOAD(0, af, kd, xr, gl);
    zh0 = (v4u){0u, 0u, 0u, 0u}; zh1 = zh0;
    __syncthreads();
    for (int n = 0; n < 64; ++n) {
        bf16x8 afn[4], kdn[2]; v4u xrn[4]; float gln;
        const int nn = (n < 63) ? n + 1 : 63;
        SCAN_LOAD(nn, afn, kdn, xrn, gln);
        const v4u zn0 = *(const v4u*)(proj + tz + (size_t)n * 64 * PW), zn1 = *(const v4u*)(proj + tz + (size_t)n * 64 * PW + 8);
        if (n > 0) scan_epilogue(OS, zh0, zh1, gainl, yab + ty + (size_t)(n - 1) * 64 * YW, tid);
        zh0 = zn0; zh1 = zn1;
        f32x4 acc[8];
#pragma unroll
        for (int vt = 0; vt < 8; ++vt) acc[vt] = (f32x4){0.f, 0.f, 0.f, 0.f};
#pragma unroll
        for (int ks = 0; ks < 4; ++ks) {
#pragma unroll
            for (int vt = 0; vt < 8; ++vt) {
                const bf16x8 bfr = *(const LAS bf16x8*)(ST + (16 * vt + r) * 136 + 32 * ks + 8 * g);
                acc[vt] = __builtin_amdgcn_mfma_f32_16x16x32_bf16(af[ks], bfr, acc[vt], 0, 0, 0);
            }
        }
        if (w < 4) {
#pragma unroll
            for (int vt = 0; vt < 8; ++vt) {
                const unsigned ux = (vt & 1) ? xr[vt >> 1].z : xr[vt >> 1].x, uy = (vt & 1) ? xr[vt >> 1].w : xr[vt >> 1].y;
                const v2u o = pack4(bflo(ux) - acc[vt][0], bfhi(ux) - acc[vt][1], bflo(uy) - acc[vt][2], bfhi(uy) - acc[vt][3]);
                *(LAS v2u*)(VNT + (16 * vt + r) * 72 + 16 * ct + 4 * g) = o;
            }
        }
        __syncthreads();
        if (w >= 4) {
#pragma unroll
            for (int ks = 0; ks < 2; ++ks)
#pragma unroll
                for (int vt = 0; vt < 8; ++vt) {
                    const bf16x8 vb = *(const LAS bf16x8*)(VNT + (16 * vt + r) * 72 + 32 * ks + 8 * g);
                    acc[vt] = __builtin_amdgcn_mfma_f32_16x16x32_bf16(__builtin_bit_cast(bf16x8, xr[ks]), vb, acc[vt], 0, 0, 0);
                }
#pragma unroll
            for (int vt = 0; vt < 8; ++vt)
#pragma unroll
                for (int rg = 0; rg < 4; ++rg) OS[(16 * ct + 4 * g + rg) * 132 + 16 * vt + r] = acc[vt][rg];
        }
#pragma unroll
        for (int vt = 0; vt < 8; ++vt) S[vt] = S[vt] * gl;
#pragma unroll
        for (int ks = 0; ks < 2; ++ks)
#pragma unroll
            for (int vt = 0; vt < 8; ++vt) {
                const bf16x8 vb = *(const LAS bf16x8*)(VNT + (16 * vt + r) * 72 + 32 * ks + 8 * g);
                S[vt] = __builtin_amdgcn_mfma_f32_16x16x32_bf16(kd[ks], vb, S[vt], 0, 0, 0);
            }
#pragma unroll
        for (int vt = 0; vt < 8; ++vt)
            *(LAS v2u*)(ST + (16 * vt + r) * 136 + 16 * w + 4 * g) = pack4(S[vt][0] + 0.f, S[vt][1] + 0.f, S[vt][2] + 0.f, S[vt][3] + 0.f);
#pragma unroll
        for (int ks = 0; ks < 4; ++ks) af[ks] = afn[ks];
        kd[0] = kdn[0]; kd[1] = kdn[1];
#pragma unroll
        for (int q = 0; q < 4; ++q) xr[q] = xrn[q];
        gl = gln;
        __syncthreads();
    }
    scan_epilogue(OS, zh0, zh1, gainl, yab + ty + (size_t)63 * 64 * YW, tid);
    __syncthreads();
#undef SCAN_LOAD
}

typedef short v4s __attribute__((ext_vector_type(4)));
constexpr int AQ_STRIDE = 272, AQ_WAVE_LDS = 64 * AQ_STRIDE + 512;
__device__ __forceinline__ void attn_query_q4(const Args& a, LAS unsigned char* wl, const LAS float* qgl, int t, int lane) {
    const bf16* proj = (const bf16*)(a.ws + WS_PROJ); const bf16* KN = (const bf16*)(a.ws + WS_KN);
    const unsigned short* SEL = (const unsigned short*)(a.ws + WS_SEL); bf16* yab = (bf16*)(a.ws + WS_YAB);
    LAS unsigned char* KT = wl; LAS unsigned short* SL = (LAS unsigned short*)(wl + 64 * AQ_STRIDE);
    const int r = lane & 15, g = lane >> 4;
    const int b = t >> 12, pos = t & 4095;
    const bf16* knb = KN + (size_t)b * SEQ * 128;
    *(LAS v2u*)(SL + 4 * lane) = *(const v2u*)(SEL + (size_t)t * 256 + 4 * lane);
    bf16x8 qf[4];
    {
        const bf16* qp = proj + (size_t)t * PW + C_AQ + (r & 7) * 128 + 8 * g;
        float f[32]; float ss = 0.f;
#pragma unroll
        for (int ks = 0; ks < 4; ++ks) { const v4u raw = *(const v4u*)(qp + 32 * ks);
            f[8 * ks] = bflo(raw.x); f[8 * ks + 1] = bfhi(raw.x); f[8 * ks + 2] = bflo(raw.y); f[8 * ks + 3] = bfhi(raw.y); f[8 * ks + 4] = bflo(raw.z); f[8 * ks + 5] = bfhi(raw.z); f[8 * ks + 6] = bflo(raw.w); f[8 * ks + 7] = bfhi(raw.w); }
#pragma unroll
        for (int i = 0; i < 32; ++i) ss += f[i] * f[i];
        ss += __shfl_xor(ss, 16); ss += __shfl_xor(ss, 32);
        float inv = rsqrtf(ss * (1.f / 128.f) + EPS) * 0.08838834764831845f;
        if (r >= 8) inv = 0.f;
#pragma unroll
        for (int ks = 0; ks < 4; ++ks) { const f32x4 ga = *(const LAS f32x4*)(qgl + 32 * ks + 8 * g), gb = *(const LAS f32x4*)(qgl + 32 * ks + 8 * g + 4);
            v4u o; o.x = pk2(f[8 * ks] * inv * ga.x, f[8 * ks + 1] * inv * ga.y); o.y = pk2(f[8 * ks + 2] * inv * ga.z, f[8 * ks + 3] * inv * ga.w);
            o.z = pk2(f[8 * ks + 4] * inv * gb.x, f[8 * ks + 5] * inv * gb.y); o.w = pk2(f[8 * ks + 6] * inv * gb.z, f[8 * ks + 7] * inv * gb.w);
            qf[ks] = __builtin_bit_cast(bf16x8, o); }
    }
    LDS_WAIT();
    const int cnt = (pos + 1 < 256) ? pos + 1 : 256, nq = (cnt + 63) >> 6;
    const float slope = exp2f(-(float)((r & 7) + 1));
    float m_run = -INFINITY, l_run = 0.f;
    f32x4 O[8];
#pragma unroll
    for (int dt = 0; dt < 8; ++dt) O[dt] = (f32x4){0.f, 0.f, 0.f, 0.f};
    bf16x8 ka[4][4], kb[4][4];
#define AQ_LOAD(q_, k_) do { _Pragma("unroll") for (int kt = 0; kt < 4; ++kt) { int ix_ = SL[64 * (q_) + 16 * kt + r]; ix_ = (ix_ == 0xFFFF) ? 0 : ix_; \
        const bf16* kp_ = knb + (size_t)ix_ * 128 + 8 * g; _Pragma("unroll") for (int ks = 0; ks < 4; ++ks) k_[kt][ks] = *(const bf16x8*)(kp_ + 32 * ks); } } while (0)
#define AQ_PASS(q_, k_) do { \
        f32x4 sc[4]; \
        _Pragma("unroll") for (int kt = 0; kt < 4; ++kt) { f32x4 acc = (f32x4){0.f, 0.f, 0.f, 0.f}; \
            _Pragma("unroll") for (int ks = 0; ks < 4; ++ks) { acc = __builtin_amdgcn_mfma_f32_16x16x32_bf16(k_[kt][ks], qf[ks], acc, 0, 0, 0); \
                *(LAS bf16x8*)(KT + (16 * kt + r) * AQ_STRIDE + (32 * ks + 8 * g) * 2) = k_[kt][ks]; } \
            sc[kt] = acc; } \
        float m = m_run; \
        _Pragma("unroll") for (int kt = 0; kt < 4; ++kt) { const v2u s4 = *(const LAS v2u*)(SL + 64 * (q_) + 16 * kt + 4 * g); \
            const int i0 = s4.x & 0xFFFF, i1 = s4.x >> 16, i2 = s4.y & 0xFFFF, i3 = s4.y >> 16; \
            sc[kt][0] = (i0 != 0xFFFF) ? sc[kt][0] - slope * (float)(pos - i0) : -INFINITY; sc[kt][1] = (i1 != 0xFFFF) ? sc[kt][1] - slope * (float)(pos - i1) : -INFINITY; \
            sc[kt][2] = (i2 != 0xFFFF) ? sc[kt][2] - slope * (float)(pos - i2) : -INFINITY; sc[kt][3] = (i3 != 0xFFFF) ? sc[kt][3] - slope * (float)(pos - i3) : -INFINITY; \
            m = fmaxf(fmaxf(m, fmaxf(sc[kt][0], sc[kt][1])), fmaxf(sc[kt][2], sc[kt][3])); } \
        m = fmaxf(m, __shfl_xor(m, 16)); m = fmaxf(m, __shfl_xor(m, 32)); \
        const float alpha = __expf(m_run - m); \
        float ls = 0.f; \
        _Pragma("unroll") for (int kt = 0; kt < 4; ++kt) _Pragma("unroll") for (int rg = 0; rg < 4; ++rg) { const float e = __expf(sc[kt][rg] - m); sc[kt][rg] = e; ls += e; } \
        ls += __shfl_xor(ls, 16); ls += __shfl_xor(ls, 32); \
        l_run = l_run * alpha + ls; m_run = m; \
        _Pragma("unroll") for (int rg = 0; rg < 4; ++rg) { const float ah = __shfl(alpha, 4 * g + rg); _Pragma("unroll") for (int dt = 0; dt < 8; ++dt) O[dt][rg] *= ah; } \
        _Pragma("unroll") for (int c = 0; c < 2; ++c) { v4u o_; o_.x = pk2(sc[2 * c][0], sc[2 * c][1]); o_.y = pk2(sc[2 * c][2], sc[2 * c][3]); o_.z = pk2(sc[2 * c + 1][0], sc[2 * c + 1][1]); o_.w = pk2(sc[2 * c + 1][2], sc[2 * c + 1][3]); \
            const bf16x8 pa = __builtin_bit_cast(bf16x8, o_); \
            _Pragma("unroll") for (int dt = 0; dt < 8; ++dt) { \
                const v4s b0 = __builtin_amdgcn_ds_read_tr16_b64_v4i16((LAS v4s*)(tb + (32 * c) * AQ_STRIDE + 32 * dt)); \
                const v4s b1 = __builtin_amdgcn_ds_read_tr16_b64_v4i16((LAS v4s*)(tb + (32 * c + 16) * AQ_STRIDE + 32 * dt)); \
                const bf16x8 bfr = __builtin_shufflevector(b0, b1, 0, 1, 2, 3, 4, 5, 6, 7); \
                O[dt] = __builtin_amdgcn_mfma_f32_16x16x32_bf16(pa, bfr, O[dt], 0, 0, 0); } } \
        __builtin_amdgcn_sched_barrier(0); } while (0)
    const LAS unsigned char* tb = KT + (4 * g + (r >> 2)) * AQ_STRIDE + 8 * (r & 3);
    AQ_LOAD(0, ka);
    AQ_LOAD(1, kb);
    AQ_PASS(0, ka);
    AQ_LOAD(2, ka);
    if (nq > 1) AQ_PASS(1, kb);
    AQ_LOAD(3, kb);
    if (nq > 2) AQ_PASS(2, ka);
    if (nq > 3) AQ_PASS(3, kb);
#undef AQ_LOAD
#undef AQ_PASS
    const float il = 1.f / l_run;
    if (true) {
        float ih[4];
#pragma unroll
        for (int rg = 0; rg < 4; ++rg) ih[rg] = __shfl(il, 4 * g + rg);
        if (g < 2) {
#pragma unroll
            for (int rg = 0; rg < 4; ++rg)
#pragma unroll
                for (int dt = 0; dt < 8; ++dt) yab[(size_t)t * YW + (4 * g + rg) * 128 + 16 * dt + r] = (bf16)f2bf(O[dt][rg] * ih[rg]);
        }
    }
    LDS_WAIT();
}

__device__ __forceinline__ void phase4(const Args& a, LAS unsigned char* lds) {
    const int bid = blockIdx.x, G = gridDim.x, tid = threadIdx.x, lane = tid & 63, wave = tid >> 6;
    const int nscan = (G >= 64) ? 32 : 0;
#ifndef P4_REP
#define P4_REP 0
#endif
    if (nscan && bid < 32) { gdn_scan(a, lds, bid); if (P4_REP & 1) { __syncthreads(); gdn_scan(a, lds, bid); } return; }
    if (!nscan) { for (int bh = bid; bh < 32; bh += G) gdn_scan(a, lds, bh); __syncthreads(); }
    LAS float* qg4 = (LAS float*)(lds + 8 * AQ_WAVE_LDS);
    if (tid < 128) qg4[tid] = a.in[5][tid];
    __syncthreads();
    LAS unsigned char* wl4 = lds + wave * AQ_WAVE_LDS;
    if (nscan == 32 && (G & 7) == 0) {
        const int bb = bid & 7, wl_i = ((bid - 32) >> 3) * 8 + wave, nwl = ((G - 32) >> 3) * 8;
        for (int p = wl_i; p < SEQ; p += nwl) attn_query_q4(a, wl4, qg4, bb * SEQ + p, lane);
        if (P4_REP & 2) for (int p = wl_i; p < SEQ; p += nwl) attn_query_q4(a, wl4, qg4, bb * SEQ + p, lane);
    } else {
        const int gw = (bid - nscan) * 8 + wave, NGW = (G - nscan) * 8;
        for (int t = gw; t < T_TOK; t += NGW) attn_query_q4(a, wl4, qg4, t, lane);
    }
}

#define INS16P(L, v_) do { float _x = (v_); \
    _Pragma("unroll") for (int _k = 0; _k < 16; ++_k) { const float _h = __builtin_fmaxf(L[_k], _x); _x = __builtin_fminf(L[_k], _x); L[_k] = _h; } } while (0)
#define CE_D(a_, b_) do { const float _h = __builtin_fmaxf(a_, b_), _l = __builtin_fminf(a_, b_); a_ = _h; b_ = _l; } while (0)
#define SORT16_DESC(A) do { \
    _Pragma("unroll") for (int k_ = 2; k_ <= 16; k_ <<= 1) \
    _Pragma("unroll") for (int j_ = k_ >> 1; j_ > 0; j_ >>= 1) \
    _Pragma("unroll") for (int i_ = 0; i_ < 16; ++i_) { const int l_ = i_ ^ j_; if (l_ > i_) { if ((i_ & k_) == 0) CE_D(A[i_], A[l_]); else CE_D(A[l_], A[i_]); } } } while (0)
#define MERGE16_TOP(L, B) do { \
    _Pragma("unroll") for (int i_ = 0; i_ < 16; ++i_) L[i_] = __builtin_fmaxf(L[i_], B[15 - i_]); \
    _Pragma("unroll") for (int j_ = 8; j_ > 0; j_ >>= 1) \
    _Pragma("unroll") for (int i_ = 0; i_ < 16; ++i_) { const int l_ = i_ ^ j_; if (l_ > i_) CE_D(L[i_], L[l_]); } } while (0)
__device__ __forceinline__ float packf(float v, unsigned id, unsigned mask) { return __uint_as_float((__float_as_uint(v) & ~mask) | id); }

__device__ __forceinline__ void peer_route_unit(const Args& a, LAS float* SC, int tt, int p, int lane) {
    const bf16* query = (const bf16*)(a.ws + WS_QUERY); const bf16* subk = (const bf16*)(a.ws + WS_SUBK);
    int* expid = (int*)(a.ws + WS_EXPID); float* gate = (float*)(a.ws + WS_GATE);
    const int r = lane & 15, g = lane >> 4;
    const int tok = lane & 31, ch = lane >> 5;
    float L1[16], L2[16];
#pragma unroll
    for (int k = 0; k < 16; ++k) { L1[k] = 0.f; L2[k] = 0.f; }
#pragma unroll 1
    for (int half = 0; half < 2; ++half) {
        bf16x8 bk[8][4];
        {
            const bf16* kp = subk + (size_t)((p * 2 + half) * 128 + r) * 128 + 8 * g;
#pragma unroll
            for (int nt = 0; nt < 8; ++nt)
#pragma unroll
                for (int ks = 0; ks < 4; ++ks) bk[nt][ks] = *(const bf16x8*)(kp + (size_t)nt * 16 * 128 + 32 * ks);
        }
        bf16x8 af[2][4];
#pragma unroll
        for (int mt = 0; mt < 2; ++mt) {
            const bf16* qp = query + (size_t)(tt * 32 + mt * 16 + r) * 2048 + p * 256 + half * 128 + 8 * g;
#pragma unroll
            for (int ks = 0; ks < 4; ++ks) af[mt][ks] = *(const bf16x8*)(qp + 32 * ks);
        }
#pragma unroll
        for (int mt = 0; mt < 2; ++mt) {
#pragma unroll
            for (int nt = 0; nt < 8; ++nt) {
                f32x4 acc = (f32x4){0.f, 0.f, 0.f, 0.f};
#pragma unroll
                for (int ks = 0; ks < 4; ++ks) acc = __builtin_amdgcn_mfma_f32_16x16x32_bf16(af[mt][ks], bk[nt][ks], acc, 0, 0, 0);
#pragma unroll
                for (int rg = 0; rg < 4; ++rg) SC[(mt * 16 + 4 * g + rg) * 132 + nt * 16 + r] = acc[rg];
            }
        }
        LDS_WAIT();
        float L[16];
#pragma unroll
        for (int c16 = 0; c16 < 4; ++c16) {
            float B[16];
#pragma unroll
            for (int c4 = 0; c4 < 4; ++c4) {
                const f32x4 v = *(const LAS f32x4*)(SC + tok * 132 + 64 * ch + 16 * c16 + 4 * c4);
                const unsigned n0 = 64 * ch + 16 * c16 + 4 * c4;
                B[4 * c4] = packf(v.x, n0, 127u); B[4 * c4 + 1] = packf(v.y, n0 + 1, 127u); B[4 * c4 + 2] = packf(v.z, n0 + 2, 127u); B[4 * c4 + 3] = packf(v.w, n0 + 3, 127u);
            }
            SORT16_DESC(B);
            if (c16 == 0) {
#pragma unroll
                for (int k = 0; k < 16; ++k) L[k] = B[k];
            } else MERGE16_TOP(L, B);
        }
        {
            float B[16];
#pragma unroll
            for (int k = 0; k < 16; ++k) B[k] = __shfl(L[k], tok + 32);
            MERGE16_TOP(L, B);
        }
#pragma unroll
        for (int k = 0; k < 16; ++k) { L1[k] = (half == 0) ? L[k] : L1[k]; L2[k] = (half == 0) ? L2[k] : L[k]; }
        LDS_WAIT();
    }
    float V1[16], V2[16];
#pragma unroll
    for (int k = 0; k < 16; ++k) { V1[k] = __uint_as_float(__float_as_uint(L1[k]) & ~127u); V2[k] = __uint_as_float(__float_as_uint(L2[k]) & ~127u); }
    float C[16];
#pragma unroll
    for (int k = 0; k < 16; ++k) C[k] = -INFINITY;
#pragma unroll
    for (int i = 0; i < 16; ++i)
#pragma unroll
        for (int j = 0; j < 16; ++j)
            if ((i + 1) * (j + 1) <= 16) INS16P(C, packf(V1[i] + V2[j], (unsigned)(i * 16 + j), 255u));
    if (ch == 0) {
        float e[16], sum = 0.f; int ex[16];
        const float c0 = __uint_as_float(__float_as_uint(C[0]) & ~255u);
#pragma unroll
        for (int k = 0; k < 16; ++k) {
            const unsigned cb = __float_as_uint(C[k]); const int ci = (cb >> 4) & 15, cj = cb & 15;
            int i1 = 0, i2 = 0;
#pragma unroll
            for (int m = 0; m < 16; ++m) { i1 = (ci == m) ? (int)(__float_as_uint(L1[m]) & 127u) : i1; i2 = (cj == m) ? (int)(__float_as_uint(L2[m]) & 127u) : i2; }
            ex[k] = i1 * 128 + i2;
            e[k] = expf(__uint_as_float(cb & ~255u) - c0); sum += e[k];
        }
        const float inv = 1.f / sum;
        const size_t base = ((size_t)(tt * 32 + tok) * 8 + p) * 16;
#pragma unroll
        for (int q = 0; q < 4; ++q) {
            *(v4u*)(expid + base + 4 * q) = (v4u){(unsigned)ex[4 * q], (unsigned)ex[4 * q + 1], (unsigned)ex[4 * q + 2], (unsigned)ex[4 * q + 3]};
            *(f32x4*)(gate + base + 4 * q) = (f32x4){e[4 * q] * inv, e[4 * q + 1] * inv, e[4 * q + 2] * inv, e[4 * q + 3] * inv};
        }
    }
}
__device__ __forceinline__ void phase8(const Args& a, LAS unsigned char* lds) {
    const int tid = threadIdx.x, lane = tid & 63, wave = tid >> 6;
    LAS float* SC = (LAS float*)(lds + wave * 16896);
    const int gw = blockIdx.x * 8 + wave, NGW = gridDim.x * 8;
#ifndef P8_REP
#define P8_REP 1
#endif
    for (int rep_ = 0; rep_ < P8_REP; ++rep_)
    for (int u = gw; u < 1024 * 8; u += NGW) peer_route_unit(a, SC, u >> 3, u & 7, lane);
}

typedef float f32x2 __attribute__((ext_vector_type(2)));
__device__ __forceinline__ void cvt8(const v4u u, float* f) { f[0] = bflo(u.x); f[1] = bfhi(u.x); f[2] = bflo(u.y); f[3] = bfhi(u.y); f[4] = bflo(u.z); f[5] = bfhi(u.z); f[6] = bflo(u.w); f[7] = bfhi(u.w); }
__device__ __forceinline__ void cvt16_fp8(const v4u u, float* f) {
#pragma unroll
    for (int q = 0; q < 4; ++q) { const f32x2 lo = __builtin_amdgcn_cvt_pk_f32_fp8((int)u[q], false), hi = __builtin_amdgcn_cvt_pk_f32_fp8((int)u[q], true);
        f[4 * q] = lo.x; f[4 * q + 1] = lo.y; f[4 * q + 2] = hi.x; f[4 * q + 3] = hi.y; }
}
#define DPPF(x_, ctrl_) __builtin_bit_cast(float, __builtin_amdgcn_update_dpp(0, __builtin_bit_cast(int, (x_)), (ctrl_), 0xF, 0xF, false))
__device__ __forceinline__ float reduce8(const float* d, int lane) {
    const bool b0 = lane & 1, b1 = lane & 2, b2 = lane & 4;
    float s1[4], s2[2];
#pragma unroll
    for (int i = 0; i < 4; ++i) { const float a = b0 ? d[2 * i + 1] : d[2 * i], b = b0 ? d[2 * i] : d[2 * i + 1]; s1[i] = a + DPPF(b, 0xB1); }
#pragma unroll
    for (int i = 0; i < 2; ++i) { const float a = b1 ? s1[2 * i + 1] : s1[2 * i], b = b1 ? s1[2 * i] : s1[2 * i + 1]; s2[i] = a + DPPF(b, 0x4E); }
    const float a3 = b2 ? s2[1] : s2[0], b3 = b2 ? s2[0] : s2[1];
    float s = a3 + DPPF(b3, 0x124);
    s += DPPF(s, 0x128);
    s += __shfl_xor(s, 16); s += __shfl_xor(s, 32);
    return s;
}
#ifndef P9L_G
#define P9L_G 8
#endif
constexpr int P9LG = P9L_G, P9LP = 128 + P9LG;
constexpr int P9L_WAVE = 4 * (P9LP * 4 * 3);
#ifndef P9L_SH
#define P9L_SH 12
#endif
constexpr int P9L_NS = 16384 >> P9L_SH;
__device__ __forceinline__ void phase9l(const Args& a, LAS unsigned char* lds) {
    const int tid = threadIdx.x, lane = tid & 63, wave = tid >> 6, G = gridDim.x;
    const unsigned char* UT = a.ws + WS_UT; const unsigned char* VT = a.ws + WS_VT;
    const float* SU = (const float*)(a.ws + WS_SU); const float* SV = (const float*)(a.ws + WS_SV);
    const int* expid = (const int*)(a.ws + WS_EXPID); const float* gate = (const float*)(a.ws + WS_GATE);
    const float* mod = (const float*)(a.ws + WS_MOD);
    LAS int* LE = (LAS int*)(lds + wave * P9L_WAVE);
    LAS float* LG = (LAS float*)(LE + 4 * P9LP);
    LAS float* LA = LG + 4 * P9LP;
    const bool isdiag = (lane >> 4) == ((lane & 15) >> 2);
    for (int rd = 0; ; ++rd) {
        const int tb = ((rd * G + (int)blockIdx.x) * 8 + wave) * 4;
        if (tb >= T_TOK) break;
        v4u h8[4]; float hsc[4]; int off[4][P9L_NS + 1];
#pragma unroll
        for (int i = 0; i < 4; ++i) {
            const size_t t = (size_t)(tb + i);
            h8[i] = *(const v4u*)(a.ws + WS_H8 + t * DM + 16 * lane); hsc[i] = ((const float*)(a.ws + WS_HS))[t];
            int e[2]; float gq[2];
#pragma unroll
            for (int q = 0; q < 2; ++q) { e[q] = expid[t * 128 + lane + 64 * q]; gq[q] = gate[t * 128 + lane + 64 * q]; }
            int base = 0;
#pragma unroll
            for (int s = 0; s < P9L_NS; ++s) {
                off[i][s] = base;
#pragma unroll
                for (int q = 0; q < 2; ++q) {
                    const bool in = (e[q] >> P9L_SH) == s;
                    const unsigned long long mk = __builtin_amdgcn_ballot_w64(in);
                    const int pos = base + __builtin_amdgcn_mbcnt_hi((unsigned)(mk >> 32), __builtin_amdgcn_mbcnt_lo((unsigned)mk, 0));
                    if (in) { LE[i * P9LP + pos] = e[q]; LG[i * P9LP + pos] = gq[q]; }
                    base += __builtin_popcountll(mk);
                }
            }
            off[i][P9L_NS] = 128;
            if (lane < P9LG) LE[i * P9LP + 128 + lane] = e[0];
        }
        LDS_WAIT();
#pragma unroll 1
        for (int s = 0; s < P9L_NS; ++s) {
#pragma unroll
            for (int i = 0; i < 4; ++i) {
                for (int g0 = off[i][s]; g0 < off[i][s + 1]; g0 += P9LG) {
                    const int n = off[i][s + 1] - g0;
                    const int ev = LE[i * P9LP + g0 + (lane & (P9LG - 1))];
                    v4u ua[P9LG];
#pragma unroll
                    for (int k = 0; k < P9LG; ++k) { const int e = __builtin_amdgcn_readlane(ev, k); ua[k] = *(const v4u*)(UT + (size_t)e * 1024 + 16 * lane); }
                    const long hlo = (long)(((unsigned long long)h8[i].y << 32) | h8[i].x), hhi = (long)(((unsigned long long)h8[i].w << 32) | h8[i].z);
#pragma unroll
                    for (int k8 = 0; k8 < P9LG; k8 += 8) {
                        float dd[8];
#pragma unroll
                        for (int k = 0; k < 8; ++k) {
                            f32x4 cacc = (f32x4){0.f, 0.f, 0.f, 0.f};
                            cacc = __builtin_amdgcn_mfma_f32_16x16x32_fp8_fp8((long)(((unsigned long long)ua[k8 + k].y << 32) | ua[k8 + k].x), hlo, cacc, 0, 0, 0);
                            cacc = __builtin_amdgcn_mfma_f32_16x16x32_fp8_fp8((long)(((unsigned long long)ua[k8 + k].w << 32) | ua[k8 + k].z), hhi, cacc, 0, 0, 0);
                            const float c01 = (lane & 1) ? cacc[1] : cacc[0], c23 = (lane & 1) ? cacc[3] : cacc[2];
                            dd[k] = isdiag ? ((lane & 2) ? c23 : c01) : 0.f;
                        }
                        const float tot = reduce8(dd, lane);
                        if (lane < 8 && k8 + lane < n) LA[i * P9LP + g0 + k8 + lane] = tot;
                        __builtin_amdgcn_sched_barrier(0);
                    }
                }
            }
        }
        LDS_WAIT();
#pragma unroll
        for (int i = 0; i < 4; ++i)
#pragma unroll
            for (int q = 0; q < 2; ++q) { const int ix = i * P9LP + lane + 64 * q; const int e = LE[ix];
                const float dq = LA[ix] * SU[e] * hsc[i];
                LA[ix] = 0.5f * dq * (1.f + erff(dq * 0.70710678118654752f)) * LG[ix] * SV[e]; }
        LDS_WAIT();
        float y[4][16];
#pragma unroll
        for (int i = 0; i < 4; ++i)
#pragma unroll
            for (int c = 0; c < 16; ++c) y[i][c] = 0.f;
#pragma unroll 1
        for (int s = 0; s < P9L_NS; ++s) {
#pragma unroll
            for (int i = 0; i < 4; ++i) {
                for (int g0 = off[i][s]; g0 < off[i][s + 1]; g0 += P9LG) {
                    const int n = off[i][s + 1] - g0;
                    const int ev = LE[i * P9LP + g0 + (lane & (P9LG - 1))];
                    const float av = ((lane & (P9LG - 1)) < n) ? LA[i * P9LP + g0 + (lane & (P9LG - 1))] : 0.f;
                    v4u va[P9LG];
#pragma unroll
                    for (int k = 0; k < P9LG; ++k) { const int e = __builtin_amdgcn_readlane(ev, k); va[k] = *(const v4u*)(VT + (size_t)e * 1024 + 16 * lane); }
#pragma unroll
                    for (int k = 0; k < P9LG; ++k) { const float aj = __builtin_bit_cast(float, __builtin_amdgcn_readlane(__builtin_bit_cast(int, av), k));
                        float f[16]; cvt16_fp8(va[k], f);
#pragma unroll
                        for (int c = 0; c < 16; ++c) y[i][c] = __builtin_fmaf(aj, f[c], y[i][c]);
                        if ((k & 3) == 3) __builtin_amdgcn_sched_barrier(0); }
                }
            }
        }
#pragma unroll
        for (int i = 0; i < 4; ++i) {
            const int t = tb + i, b = t >> 12;
            float* orow = a.out + (size_t)t * DM + 16 * lane; const float* g2 = mod + b * 6144 + 5120 + 16 * lane;
#pragma unroll
            for (int q4 = 0; q4 < 4; ++q4) {
                const f32x4 xv = *(const f32x4*)(orow + 4 * q4), gv = *(const f32x4*)(g2 + 4 * q4);
                const f32x4 yv = (f32x4){y[i][4 * q4], y[i][4 * q4 + 1], y[i][4 * q4 + 2], y[i][4 * q4 + 3]};
                *(f32x4*)(orow + 4 * q4) = xv + gv * yv;
            }
        }
        LDS_WAIT();
    }
}

#define XB_TMO      128
#define XB_XCNT(j)  (256  + 64 * (j))
#define XB_XSUB(j)  (1280 + 64 * (j))
#define XB_XGEN(j)  (2304 + 64 * (j))
#define XB_TOP      3328
#define XB_TOPGEN   3392
#define XCD_BAR_WORDS 3456
#define XB_SPIN_CAP (1u << 18)

__device__ __forceinline__ unsigned xb_ld(unsigned* p)              { return __hip_atomic_load(p, __ATOMIC_RELAXED, __HIP_MEMORY_SCOPE_AGENT); }
__device__ __forceinline__ unsigned xb_add(unsigned* p, unsigned v) { return __hip_atomic_fetch_add(p, v, __ATOMIC_RELAXED, __HIP_MEMORY_SCOPE_AGENT); }
__device__ __forceinline__ unsigned xb_xcc_id() { return (unsigned)__builtin_amdgcn_s_getreg((3 << 11) | 20) & 0xFu; }
#define XB_SPIN(cond, bar) do { unsigned _sp = 0; while (cond) { __builtin_amdgcn_s_sleep(1); \
    if ((++_sp & 255u) == 0u) { if (xb_ld(&(bar)[XB_TMO])) break; if (_sp > XB_SPIN_CAP) { atomicAdd(&(bar)[XB_TMO], 1u); break; } } } } while (0)

struct XcdBarrier {
    unsigned* bar; unsigned x;
    volatile LAS unsigned* st;
};

__device__ __forceinline__ XcdBarrier xcd_barrier_post(unsigned* bar, volatile LAS unsigned* st) {
    XcdBarrier b; b.bar = bar; b.x = xb_xcc_id(); b.st = st;
    if (threadIdx.x == 0) (void)xb_add(&bar[XB_XCNT(b.x)], 1u);
    return b;
}
__device__ __forceinline__ void xcd_barrier_complete(unsigned* bar, unsigned x, unsigned& nloc, unsigned& nx) {
    const unsigned G = gridDim.x * gridDim.y * gridDim.z;
    unsigned sum, cnt, mine, sp = 0u;
    for (;;) {
        sum = 0u; cnt = 0u; mine = 0u;
#pragma unroll
        for (unsigned j = 0; j < 16; ++j) { const unsigned c = xb_ld(&bar[XB_XCNT(j)]); sum += c; cnt += (c > 0u) ? 1u : 0u; mine = (j == x) ? c : mine; }
        if (sum == G) break;
        __builtin_amdgcn_s_sleep(1);
        if ((++sp & 255u) == 0u) { if (xb_ld(&bar[XB_TMO])) break; if (sp > XB_SPIN_CAP) { atomicAdd(&bar[XB_TMO], 1u); break; } }
    }
    nloc = mine > 0u ? mine : 1u; nx = cnt > 0u ? cnt : 1u;
}

__device__ __forceinline__ void xcd_barrier(const XcdBarrier& b) {
    asm volatile("s_waitcnt vmcnt(0)" ::: "memory");
    __syncthreads();
    if (threadIdx.x == 0) {
        unsigned* bar = b.bar;
        __builtin_amdgcn_s_waitcnt(0);
        unsigned nloc = b.st[0], nx = b.st[1];
        if (nloc == 0u) { xcd_barrier_complete(bar, b.x, nloc, nx); b.st[0] = nloc; b.st[1] = nx; }
        const unsigned old = xb_add(&bar[XB_XSUB(b.x)], 1u);
        const unsigned gen = old / nloc;
        if (old + 1u == (gen + 1u) * nloc) {
            __builtin_amdgcn_fence(__ATOMIC_RELEASE, "agent");
            asm volatile("s_waitcnt vmcnt(0)" ::: "memory");
            const unsigned og = xb_add(&bar[XB_TOP], 1u);
            const unsigned tg = og / nx;
            if (og + 1u == (tg + 1u) * nx) xb_add(&bar[XB_TOPGEN], 1u);
            else XB_SPIN(xb_ld(&bar[XB_TOPGEN]) == tg, bar);
            __builtin_amdgcn_fence(__ATOMIC_ACQUIRE, "agent");
            xb_add(&bar[XB_XGEN(b.x)], 1u);
            asm volatile("s_waitcnt vmcnt(0)" ::: "memory");
        } else {
            XB_SPIN(xb_ld(&bar[XB_XGEN(b.x)]) == gen, bar);
            __builtin_amdgcn_fence(__ATOMIC_ACQUIRE, "agent");
            asm volatile("s_waitcnt vmcnt(0)" ::: "memory");
        }
    }
    __syncthreads();
}

__global__ void __launch_bounds__(512, 2) mega_fwd(Args a) {
    extern __shared__ __attribute__((aligned(16))) unsigned char lds_raw[];
    LAS unsigned char* lds = (LAS unsigned char*)lds_raw;
    asm volatile("" : "+v"(lds));
    cg::grid_group grid = cg::this_grid();
#define MISC_PTR ((volatile LAS unsigned*)((LAS unsigned char*)lds_raw + (LDS_BYTES - 64)))
    if (threadIdx.x < 16) MISC_PTR[threadIdx.x] = 0u;
    __syncthreads();
    const unsigned xcc_id = xcd_barrier_post((unsigned*)(a.ws + WS_CTL) + 4096, MISC_PTR).x;
    grid.sync();
    unsigned char* ws = a.ws;
    const int lo = a.ph_lo, hi = a.ph_hi;
#ifndef PH_MASK
#define PH_MASK 0x3ff
#endif
#define IN(k) (((PH_MASK >> (k)) & 1) && lo <= (k) && (k) < hi)
#define SEAM(k) do { if (IN(k) && IN((k) + 1)) { if ((k) == 99) grid.sync(); else { XcdBarrier xb_; xb_.bar = (unsigned*)(a.ws + WS_CTL) + 4096; xb_.x = xcc_id; xb_.st = MISC_PTR; xcd_barrier(xb_); } } } while (0)
#ifndef REP_MASK
#define REP_MASK 0
#endif
#define RUNP(k, body) do { if (IN(k)) { body; if ((REP_MASK >> (k)) & 1) { grid.sync(); body; } } } while (0)
    RUNP(0, phase0(a, lds)); SEAM(0);
    RUNP(1, phase_norm(a.in[0], (const float*)(ws + WS_MOD), 0, 1024, (bf16*)(ws + WS_H))); SEAM(1);
    RUNP(2, ({
        pg8::Gemm g{(const pg8::bf16_t*)(ws + WS_H), (const pg8::bf16_t*)(ws + WS_WIN), T_TOK, PW, DM}; pg8::StaticOrder S; S.init(T_TOK, PW, gridDim.x, blockIdx.x);
        EpiBf E{(bf16*)(ws + WS_PROJ), PW};
        pg8::gemm_phase<EpiBf, pg8::StaticOrder>(lds, g, S, E, nullptr); })); SEAM(2);
#ifdef IDX_FP32
    if (IN(3)) { phase_idx32(a, lds); grid.sync(); }
#endif
    RUNP(3, phase3(a, lds)); SEAM(3);
    RUNP(4, phase4(a, lds)); SEAM(4);
    RUNP(5, ({
        pg8::Gemm g{(const pg8::bf16_t*)(ws + WS_YAB), (const pg8::bf16_t*)(ws + WS_BT2), T_TOK, DM, YW}; pg8::StaticOrder S; S.init(T_TOK, DM, gridDim.x, blockIdx.x);
        EpiX1 E{a.in[0], a.out, (const float*)(ws + WS_MOD)};
        pg8::gemm_phase<EpiX1, pg8::StaticOrder>(lds, g, S, E, nullptr); })); SEAM(5);
    RUNP(6, phase_norm(a.out, (const float*)(ws + WS_MOD), 3072, 4096, (bf16*)(ws + WS_H), ws + WS_H8, (float*)(ws + WS_HS))); SEAM(6);
    RUNP(7, ({
        pg8::Gemm g{(const pg8::bf16_t*)(ws + WS_H), (const pg8::bf16_t*)(ws + WS_WQ), T_TOK, 2048, DM}; pg8::StaticOrder S; S.init(T_TOK, 2048, gridDim.x, blockIdx.x);
        EpiBf E{(bf16*)(ws + WS_QUERY), 2048};
        pg8::gemm_phase<EpiBf, pg8::StaticOrder>(lds, g, S, E, nullptr); })); SEAM(7);
    RUNP(8, phase8(a, lds)); SEAM(8);
    if (IN(9)) { phase9l(a, lds); }
#undef IN
#undef SEAM
}

#ifndef MK_N_LAUNCHES
#define MK_N_LAUNCHES 1
#endif
extern "C" void kernel_launch(void* const* d_in, const int* in_sizes, int n_in, void* d_out, int out_size, void* d_ws, size_t ws_size, hipStream_t stream) {
    static int grid = 0;
    if (grid == 0) {
        int dev = 0, cus = 0, per_cu = 0;
        hipGetDevice(&dev);
        hipDeviceGetAttribute(&cus, hipDeviceAttributeMultiprocessorCount, dev);
        hipFuncSetAttribute((const void*)mega_fwd, hipFuncAttributeMaxDynamicSharedMemorySize, LDS_BYTES);
        hipOccupancyMaxActiveBlocksPerMultiprocessor(&per_cu, (const void*)mega_fwd, 512, LDS_BYTES);
        if (per_cu < 1) { fprintf(stderr, "kernel_launch: occupancy query says %d blocks per CU\n", per_cu); per_cu = 1; }
        grid = cus * 1;
        if (n_in != 17 || ws_size < WS_END) fprintf(stderr, "kernel_launch: unexpected n_in %d / ws_size %zu\n", n_in, ws_size);
    }
    (void)hipMemsetAsync((char*)d_ws + WS_CTL, 0, 65536, stream);
    Args a{};
    for (int i = 0; i < 17; ++i) a.in[i] = (const float*)d_in[i];
    a.out = (float*)d_out; a.ws = (unsigned char*)d_ws;
#if MK_N_LAUNCHES == 1
    a.ph_lo = 0; a.ph_hi = 10;
    void* args[] = {&a};
    hipError_t e = hipLaunchCooperativeKernel((const void*)mega_fwd, dim3(grid), dim3(512), args, LDS_BYTES, stream);
    if (e != hipSuccess) fprintf(stderr, "cooperative launch failed: %s (grid %d)\n", hipGetErrorString(e), grid);
#else
    for (int p = 0; p < 10; ++p) { a.ph_lo = p; a.ph_hi = p + 1; hipLaunchKernelGGL(mega_fwd, dim3(grid), dim3(512), LDS_BYTES, stream, a); }
#endif
}
```

```cpp
#include <hip/hip_runtime.h>
#include <hip/hip_cooperative_groups.h>
#include <cstdio>
#include <cstdint>
namespace cg = cooperative_groups;
namespace pg8 {
#define PG8_LAS __attribute__((address_space(3)))
typedef unsigned short bf16_t;
typedef short bf16x8 __attribute__((ext_vector_type(8)));
typedef float f32x4 __attribute__((ext_vector_type(4)));
typedef unsigned u32x4 __attribute__((ext_vector_type(4)));
constexpr int BM = 256, BK = 64, HALF = 128, HTB = HALF * BK * 2  , STAGE_BYTES = 8 * HTB, NXCD = 8, WGM = 8;

__host__ __device__ __forceinline__ int lds_byte(int r, int c) { const int st = (r >> 4) * 2 + (c >> 5), rr = r & 15, cc = c & 31, ob = rr * 64 + cc * 2; return st * 1024 + (ob ^ (((ob >> 9) & 1) << 5)); }
__host__ __device__ __forceinline__ void stage_rc(int b, int& R, int& C) { const int st = b / 1024, sb = b % 1024, swz = sb ^ (((sb >> 9) & 1) << 5); R = (st >> 1) * 16 + swz / 64; C = (st & 1) * 32 + (swz % 64) / 2; }
__host__ __device__ __forceinline__ int perm32(int rho) { const int n = rho >> 4, i = rho & 15; return 8 * (i >> 2) + 4 * n + (i & 3); }

struct Unit { int pm, pn; };
struct Gemm { const bf16_t* A; const bf16_t* Bt; int M, N, K; };

struct StaticOrder {
    int nM, nN, nwg, G, c;
    __host__ __device__ void init(int M, int N, int G_, int c_) { nM = M / BM; nN = N / BM; nwg = nM * nN; G = G_; c = c_; }
    __host__ __device__ bool next(int i, Unit& u) const {
        const long L = (long)i * G + c; if (L >= nwg) return false;
        int wgid = (int)L; { const int q = nwg / NXCD, r = nwg % NXCD, xcd = wgid % NXCD, off = wgid / NXCD; wgid = (xcd < r ? xcd * (q + 1) : r * (q + 1) + (xcd - r) * q) + off; }
        const int nig = WGM * nN, gid = wgid / nig, fm = gid * WGM, gsz = (nM - fm) < WGM ? (nM - fm) : WGM;
        u.pm = fm + ((wgid % nig) % gsz); u.pn = (wgid % nig) / gsz; return true;
    }
    __device__ __forceinline__ void a_ready(const Unit&) const {}
    __device__ __forceinline__ void done(const Unit&) const {}
};
__device__ __forceinline__ unsigned cvt_pk_bf16(float lo, float hi) { unsigned r; asm volatile("v_cvt_pk_bf16_f32 %0, %1, %2" : "=v"(r) : "v"(lo), "v"(hi)); return r; }
template <class Epi, class Sched, bool STAMP = false>
__device__ __forceinline__ void gemm_phase(PG8_LAS unsigned char* lds, const Gemm g, const Sched& S, const Epi& E, unsigned long long* stamps) {
    const int tid = threadIdx.x, wid = __builtin_amdgcn_readfirstlane(tid >> 6), lane = tid & 63, wr = wid >> 2, wc = wid & 3, fr = lane & 15, fq = lane >> 4;
    const int K = g.K, nt = K / BK;
    int ts_lo = 0, ts_hi = 0, nts = 0; const unsigned long long rt_entry = STAMP ? (unsigned long long)wall_clock64() : 0ull;
#define PG8_STAMP() do { if (STAMP && wid == 0 && nts < 64) { const unsigned long long _c = (unsigned long long)clock64(); \
        ts_lo = (lane == nts) ? (int)(unsigned)_c : ts_lo; ts_hi = (lane == nts) ? (int)(unsigned)(_c >> 32) : ts_hi; ++nts; } } while (0)
    PG8_STAMP();
    unsigned voffA[2], voffB[2];
#pragma unroll
    for (int i = 0; i < 2; ++i) { int R, C; stage_rc(tid * 16 + i * 8192, R, C); const int Rb = Epi::PERM ? ((R & ~31) + perm32(R & 31)) : R;
        voffA[i] = (unsigned)(R * K + C) * 2u; voffB[i] = (unsigned)(Rb * K + C) * 2u; }
    const size_t kstep = (size_t)(BK * 2);
    const size_t hstep = (size_t)HALF * K * 2;
    const size_t tstep = 2 * hstep;
    const unsigned ldsw = (unsigned)wid * 1024u;
    const int aoff = lds_byte(wr * 64 + fr, fq * 8), boff = lds_byte(wc * 32 + fr, fq * 8);
#define PG8_SA(b, h) (((b) * 2 + (h)) * HTB)
#define PG8_SB(b, h) ((4 + (b) * 2 + (h)) * HTB)
#define PG8_STAGE(bufoff, gbase, voff) do { _Pragma("unroll") for (int _i = 0; _i < 2; ++_i) \
        __builtin_amdgcn_global_load_lds((const unsigned*)((const char*)(gbase) + (voff)[_i]), (PG8_LAS unsigned*)(lds + (bufoff) + ldsw + _i * 8192), 16, 0, 0); } while (0)
#define PG8_LDA(dst, b, h) do { _Pragma("unroll") for (int m = 0; m < 4; ++m) _Pragma("unroll") for (int k = 0; k < 2; ++k) dst[m][k] = *(const PG8_LAS bf16x8*)(lds + PG8_SA(b, h) + aoff + m * 2048 + k * 1024); } while (0)
#define PG8_LDB(dst, b, h) do { _Pragma("unroll") for (int n = 0; n < 2; ++n) _Pragma("unroll") for (int k = 0; k < 2; ++k) dst[n][k] = *(const PG8_LAS bf16x8*)(lds + PG8_SB(b, h) + boff + n * 2048 + k * 1024); } while (0)
#define PG8_MMA(ai, bj, At, Bt) do { __builtin_amdgcn_s_setprio(1); _Pragma("unroll") for (int m = 0; m < 4; ++m) _Pragma("unroll") for (int n = 0; n < 2; ++n) _Pragma("unroll") for (int k = 0; k < 2; ++k) \
        acc[ai][bj][m][n] = __builtin_amdgcn_mfma_f32_16x16x32_bf16(Bt[n][k], At[m][k], acc[ai][bj][m][n], 0, 0, 0); __builtin_amdgcn_s_setprio(0); } while (0)
#define PG8_WAIT_V(n) asm volatile("s_waitcnt vmcnt(" #n ")" ::: "memory")
#define PG8_WAIT_L(n) asm volatile("s_waitcnt lgkmcnt(" #n ")" ::: "memory")
#define PG8_BAR __builtin_amdgcn_s_barrier()
#define PG8_SCHED __builtin_amdgcn_sched_barrier(0)
    Unit cur, nxt; int ui = 0;
    if (!S.next(0, cur)) return;
    f32x4 acc[2][2][4][2];
#pragma unroll
    for (int a = 0; a < 2; ++a)
#pragma unroll
        for (int b = 0; b < 2; ++b)
#pragma unroll
            for (int m = 0; m < 4; ++m)
#pragma unroll
                for (int n = 0; n < 2; ++n) acc[a][b][m][n] = (f32x4){0.f, 0.f, 0.f, 0.f};
    bf16x8 At[4][2], B0[2][2], B1[2][2];
    const char* cA = (const char*)g.A + (size_t)cur.pm * tstep; const char* cB = (const char*)g.Bt + (size_t)cur.pn * tstep;
    S.a_ready(cur);
    PG8_STAGE(PG8_SB(0, 0), cB, voffB); PG8_STAGE(PG8_SA(0, 0), cA, voffA); PG8_STAGE(PG8_SB(0, 1), cB + hstep, voffB); PG8_STAGE(PG8_SA(0, 1), cA + hstep, voffA);
    if (wr == 1) PG8_BAR;
    PG8_WAIT_V(4); PG8_BAR;
    PG8_STAGE(PG8_SB(1, 0), cB + kstep, voffB); PG8_STAGE(PG8_SA(1, 0), cA + kstep, voffA); PG8_STAGE(PG8_SB(1, 1), cB + hstep + kstep, voffB);
    PG8_WAIT_V(6); PG8_BAR;
    PG8_STAMP();
    for (;;) {
        const bool has_next = S.next(ui + 1, nxt);
        const char* nA = has_next ? (const char*)g.A + (size_t)nxt.pm * tstep : cA; const char* nB = has_next ? (const char*)g.Bt + (size_t)nxt.pn * tstep : cB;
        for (int t = 0; t < nt; t += 2) {
            const bool last = (t == nt - 2);
            const char* a1 = cA + (size_t)(t + 1) * kstep;
            const char* a2 = last ? nA : cA + (size_t)(t + 2) * kstep; const char* b2 = last ? nB : cB + (size_t)(t + 2) * kstep;
            const char* a3 = a2 + kstep; const char* b3 = b2 + kstep;
            if (last && has_next) S.a_ready(nxt);
            PG8_LDB(B0, 0, 0); PG8_SCHED; PG8_LDA(At, 0, 0); PG8_STAGE(PG8_SA(1, 1), a1 + hstep, voffA);
            PG8_WAIT_L(8); PG8_BAR; PG8_WAIT_L(0); PG8_MMA(0, 0, At, B0); PG8_BAR; PG8_SCHED;
            PG8_LDB(B1, 0, 1); PG8_STAGE(PG8_SB(0, 0), b2, voffB);
            PG8_BAR; PG8_WAIT_L(0); PG8_MMA(0, 1, At, B1); PG8_BAR;
            PG8_LDA(At, 0, 1); PG8_STAGE(PG8_SA(0, 0), a2, voffA);
            PG8_BAR; PG8_WAIT_L(0); PG8_MMA(1, 0, At, B0); PG8_BAR; PG8_SCHED;
            PG8_STAGE(PG8_SB(0, 1), b2 + hstep, voffB);
            PG8_WAIT_V(6); PG8_BAR; PG8_MMA(1, 1, At, B1); PG8_BAR;
            PG8_LDB(B0, 1, 0); PG8_SCHED; PG8_LDA(At, 1, 0); PG8_STAGE(PG8_SA(0, 1), a2 + hstep, voffA);
            PG8_WAIT_L(8); PG8_BAR; PG8_WAIT_L(0); PG8_MMA(0, 0, At, B0); PG8_BAR; PG8_SCHED;
            PG8_LDB(B1, 1, 1); PG8_STAGE(PG8_SB(1, 0), b3, voffB);
            PG8_BAR; PG8_WAIT_L(0); PG8_MMA(0, 1, At, B1); PG8_BAR;
            PG8_LDA(At, 1, 1); PG8_STAGE(PG8_SA(1, 0), a3, voffA);
            PG8_BAR; PG8_WAIT_L(0); PG8_MMA(1, 0, At, B0); PG8_BAR; PG8_SCHED;
            PG8_STAGE(PG8_SB(1, 1), b3 + hstep, voffB);
            PG8_WAIT_V(6); PG8_BAR; PG8_MMA(1, 1, At, B1); PG8_BAR;
        }
        PG8_STAMP();
        if constexpr (!Epi::AFTER_DRAIN) { E(acc, cur, wr, wc, fr, fq); S.done(cur); }
        PG8_STAMP();
        if (!has_next) break;
#pragma unroll
        for (int a = 0; a < 2; ++a)
#pragma unroll
            for (int b = 0; b < 2; ++b)
#pragma unroll
                for (int m = 0; m < 4; ++m)
#pragma unroll
                    for (int n = 0; n < 2; ++n) acc[a][b][m][n] = (f32x4){0.f, 0.f, 0.f, 0.f};
        cur = nxt; cA = nA; cB = nB; ++ui;
    }
    PG8_WAIT_V(0);
    if (wr == 0) PG8_BAR;
    PG8_BAR;
    if constexpr (Epi::AFTER_DRAIN) { E.fused(acc, cur, wr, wc, fr, fq, lds, wid, lane); S.done(cur); }
    PG8_STAMP();
    if (STAMP && wid == 0) { stamps[lane] = lane < nts ? (((unsigned long long)(unsigned)ts_hi << 32) | (unsigned)ts_lo) : 0ull;
        if (lane == 62) stamps[62] = rt_entry; if (lane == 63) stamps[63] = (unsigned long long)wall_clock64(); }
#undef PG8_STAMP
#undef PG8_SA
#undef PG8_SB
#undef PG8_STAGE
#undef PG8_LDA
#undef PG8_LDB
#undef PG8_MMA
#undef PG8_WAIT_V
#undef PG8_WAIT_L
#undef PG8_BAR
#undef PG8_SCHED
}
}

#define LAS __attribute__((address_space(3)))
typedef unsigned short bf16;
typedef unsigned v4u __attribute__((ext_vector_type(4)));
typedef unsigned v2u __attribute__((ext_vector_type(2)));
typedef float f32x4 __attribute__((ext_vector_type(4)));
typedef float f32x16 __attribute__((ext_vector_type(16)));
typedef short bf16x8 __attribute__((ext_vector_type(8)));

constexpr int T_TOK = 32768, DM = 1024, SEQ = 4096, NBATCH = 8;
constexpr int PW = 3584;
constexpr int IN_W = 3532;
constexpr int C_AQ = 0, C_AKV = 1024, C_IQ = 1152, C_IK = 1408, C_IW = 1472, C_BA = 1476, C_BB = 1480, C_BQ = 1536, C_BK = 2048, C_BV = 2560, C_BZ = 3072;
constexpr int YW = 1536;
constexpr int NCHUNK = 2048;
constexpr float EPS = 1e-6f;

constexpr size_t MiB = 1u << 20;
constexpr size_t WS_CTL = 0;
constexpr size_t WS_MOD = 1 * MiB;
constexpr size_t WS_GL = WS_MOD + 256 * 1024;
constexpr size_t WS_SU = WS_MOD + 512 * 1024;
constexpr size_t WS_SV = WS_MOD + 640 * 1024;
constexpr size_t WS_WIN = 2 * MiB;
constexpr size_t WS_BT2 = 9 * MiB;
constexpr size_t WS_WQ = 12 * MiB;
constexpr size_t WS_SUBK = 16 * MiB;
constexpr size_t WS_H = 18 * MiB;
constexpr size_t WS_KN = WS_H;
constexpr size_t WS_SEL = WS_H + 8 * MiB;
constexpr size_t WS_PROJ = 82 * MiB;
constexpr size_t WS_QUERY = WS_PROJ;
constexpr size_t WS_YAB = 306 * MiB;
constexpr size_t WS_EXPID = WS_YAB;
constexpr size_t WS_GATE = WS_YAB + 16 * MiB;
constexpr size_t WS_H8 = WS_YAB + 32 * MiB;
constexpr size_t WS_HS = WS_YAB + 64 * MiB;
constexpr size_t WS_GA = 402 * MiB;
constexpr size_t WS_UT = 418 * MiB;
constexpr size_t WS_VT = 450 * MiB;
constexpr size_t WS_END = 482 * MiB;
constexpr size_t DO_W = 0, DO_QD = 32 * MiB, DO_KDT = 64 * MiB, DO_UT = 96 * MiB;

constexpr int LDS_BYTES = 147456;

struct Args { const float* in[17]; float* out; unsigned char* ws; int ph_lo, ph_hi; };

__device__ __forceinline__ unsigned pk2(float lo, float hi) { unsigned r; asm("v_cvt_pk_bf16_f32 %0, %1, %2" : "=v"(r) : "v"(lo), "v"(hi)); return r; }
__device__ __forceinline__ unsigned f2bf(float f) { return pk2(f, f) & 0xffffu; }
__device__ __forceinline__ float bflo(unsigned u) { return __uint_as_float(u << 16); }
__device__ __forceinline__ float bfhi(unsigned u) { return __uint_as_float(u & 0xffff0000u); }
__device__ __forceinline__ float bf1(bf16 b) { return __uint_as_float(((unsigned)b) << 16); }
__device__ __forceinline__ float wave_sum(float v) {
#pragma unroll
    for (int o = 1; o < 64; o <<= 1) v += __shfl_xor(v, o);
    return v;
}
__device__ __forceinline__ float wave_max(float v) {
#pragma unroll
    for (int o = 1; o < 64; o <<= 1) v = fmaxf(v, __shfl_xor(v, o));
    return v;
}
__device__ __forceinline__ float silu_f(float v) { return v / (1.f + expf(-v)); }
__device__ __forceinline__ float silu_fast(float v) { return v * __builtin_amdgcn_rcpf(1.f + __expf(-v)); }
__device__ __forceinline__ float sigmoid_f(float v) { return 1.f / (1.f + expf(-v)); }
__device__ __forceinline__ float softplus_f(float v) { return fmaxf(v, 0.f) + log1pf(expf(-fabsf(v))); }
#define LDS_WAIT() asm volatile("s_waitcnt lgkmcnt(0)" ::: "memory")

__device__ __forceinline__ int win_srccol(int n) {
    if (n < 1476) return n;
    if (n < 1480) return 3524 + (n - 1476);
    if (n < 1484) return 3528 + (n - 1480);
    if (n < 1536) return -1;
    return 1476 + (n - 1536);
}
__device__ __forceinline__ void transpose_item(const float* W, int spitch, int k0, int sc, bf16* WT, int dpitch, int drow0, int dcol0, LAS float* scr, int lane) {
#pragma unroll 8
    for (int i = 0; i < 32; ++i) { const int kk = 2 * i + (lane >> 5); scr[kk * 33 + (lane & 31)] = (sc >= 0) ? W[(size_t)(k0 + kk) * spitch + sc] : 0.f; }
    LDS_WAIT();
    const int c = lane & 7;
#pragma unroll
    for (int j = 0; j < 4; ++j) { const int n = (lane >> 3) + 8 * j; const LAS float* s = scr + (8 * c) * 33 + n;
        v4u o; o.x = pk2(s[0 * 33], s[1 * 33]); o.y = pk2(s[2 * 33], s[3 * 33]); o.z = pk2(s[4 * 33], s[5 * 33]); o.w = pk2(s[6 * 33], s[7 * 33]);
        *(v4u*)(WT + (size_t)(drow0 + n) * dpitch + dcol0 + 8 * c) = o; }
    LDS_WAIT();
}

__device__ __forceinline__ void phase0(const Args& a, LAS unsigned char* lds) {
    const int tid = threadIdx.x, lane = tid & 63, wave = tid >> 6, bid = blockIdx.x, G = gridDim.x;
    unsigned char* ws = a.ws;
#ifndef P0_REP
#define P0_REP 0
#endif
    for (int rep0_ = 0; rep0_ < 1 + (P0_REP ? 1 : 0); ++rep0_) {
    if (rep0_ == 0 || (P0_REP & 1))
    for (int item = bid; item < 192; item += G) {
        LAS float* sc = (LAS float*)lds;
        LAS float* red = sc + 8192;
        const float* c = a.in[1];
        for (int i = tid; i < 8192; i += 512) sc[i] = silu_f(c[i]);
        __syncthreads();
        const int cc = tid & 31, kg = tid >> 5;
        const float* w = a.in[2] + item * 32 + cc;
        float acc[8];
#pragma unroll
        for (int b = 0; b < 8; ++b) acc[b] = 0.f;
        for (int k = kg; k < 1024; k += 16) { const float wv = w[(size_t)k * 6144];
#pragma unroll
            for (int b = 0; b < 8; ++b) acc[b] += sc[b * 1024 + k] * wv; }
#pragma unroll
        for (int b = 0; b < 8; ++b) red[(kg * 8 + b) * 32 + cc] = acc[b];
        __syncthreads();
        if (tid < 256) { const int b = tid >> 5; float s = 0.f;
            for (int k2 = 0; k2 < 16; ++k2) s += red[(k2 * 8 + b) * 32 + cc];
            ((float*)(ws + WS_MOD))[b * 6144 + item * 32 + cc] = s + a.in[3][item * 32 + cc]; }
        __syncthreads();
    }
    if (rep0_ == 0 || (P0_REP & 2)) {
        LAS float* scr = (LAS float*)(lds + 65536 + wave * 8704);
        const int gw = bid * 8 + wave, NGW = G * 8;
        constexpr int I_WIN = 16 * 112, I_WQ = 16 * 64, I_WO = 8 * 32;
        for (int it = gw; it < I_WIN + I_WQ + I_WO; it += NGW) {
            int r = it;
            if (r < I_WIN) { const int kb = r / 112, nb = r % 112; transpose_item(a.in[4], IN_W, 64 * kb, win_srccol(32 * nb + (lane & 31)), (bf16*)(ws + WS_WIN), 1024, 32 * nb, 64 * kb, scr, lane); continue; }
            r -= I_WIN;
            if (r < I_WQ) { const int kb = r / 64, nb = r % 64; transpose_item(a.in[13], 2048, 64 * kb, 32 * nb + (lane & 31), (bf16*)(ws + WS_WQ), 1024, 32 * nb, 64 * kb, scr, lane); continue; }
            r -= I_WQ;
            { const int kb = r / 32, nb = r % 32; transpose_item(a.in[12] + (size_t)512 * 1024, 1024, 64 * kb, 32 * nb + (lane & 31), (bf16*)(ws + WS_BT2), YW, 32 * nb, 1024 + 64 * kb, scr, lane); }
        }
    }
    if (rep0_ == 0 || (P0_REP & 4)) {
        const float* wuv = a.in[7]; const float* wout = a.in[12]; bf16* bt2 = (bf16*)(ws + WS_BT2);
        for (int it = bid * 512 + tid; it < 1024 * 128; it += G * 512) {
            const int n = it & 1023, kb = __builtin_amdgcn_readfirstlane(it >> 10);
            const int h = kb >> 4, r0 = (kb & 15) * 8;
            float acc[8];
#pragma unroll
            for (int j = 0; j < 8; ++j) acc[j] = 0.f;
            for (int v = 0; v < 64; ++v) { const float wo = wout[(size_t)(h * 64 + v) * 1024 + n];
#pragma unroll
                for (int j = 0; j < 8; ++j) acc[j] += wuv[(size_t)(h * 128 + r0 + j) * 64 + v] * wo; }
            v4u o; o.x = pk2(acc[0], acc[1]); o.y = pk2(acc[2], acc[3]); o.z = pk2(acc[4], acc[5]); o.w = pk2(acc[6], acc[7]);
            *(v4u*)(bt2 + (size_t)n * YW + h * 128 + r0) = o;
        }
    }
    if (rep0_ == 0 || (P0_REP & 8)) {
        const size_t gt = (size_t)bid * 512 + tid, GT = (size_t)G * 512;
        for (size_t i = gt; i < 262144 / 8; i += GT) {
            const f32x4 v0 = *(const f32x4*)(a.in[14] + i * 8), v1 = *(const f32x4*)(a.in[14] + i * 8 + 4);
            v4u o; o.x = pk2(v0.x, v0.y); o.y = pk2(v0.z, v0.w); o.z = pk2(v1.x, v1.y); o.w = pk2(v1.z, v1.w);
            *(v4u*)((bf16*)(ws + WS_SUBK) + i * 8) = o;
        }
        const int gw = bid * 8 + wave, NGW = G * 8;
        for (int row = gw; row < 2 * 16384; row += NGW) {
            const int tb = row >> 14, e = row & 16383;
            const float* src = (tb ? a.in[16] : a.in[15]) + (size_t)e * 1024 + 16 * lane;
            f32x4 v[4]; float mx = 0.f;
#pragma unroll
            for (int q = 0; q < 4; ++q) { v[q] = *(const f32x4*)(src + 4 * q); mx = fmaxf(fmaxf(mx, fmaxf(fabsf(v[q].x), fabsf(v[q].y))), fmaxf(fabsf(v[q].z), fabsf(v[q].w))); }
            mx = wave_max(mx);
            const float scale = (mx > 0.f) ? mx * (1.f / 240.f) : 1.f, inv = 1.f / scale;
            v4u o;
#pragma unroll
            for (int q = 0; q < 4; ++q) { int p = __builtin_amdgcn_cvt_pk_fp8_f32(v[q].x * inv, v[q].y * inv, 0, false); p = __builtin_amdgcn_cvt_pk_fp8_f32(v[q].z * inv, v[q].w * inv, p, true); o[q] = (unsigned)p; }
            *(v4u*)(ws + (tb ? WS_VT : WS_UT) + (size_t)e * 1024 + 16 * lane) = o;
            if (lane == 0) ((float*)(ws + (tb ? WS_SV : WS_SU)))[e] = scale;
        }
    }
    }
}

__device__ __forceinline__ void phase_norm(const float* x, const float* mod, int shift_off, int scale_off, bf16* hout, unsigned char* h8 = nullptr, float* hs = nullptr) {
    const int tid = threadIdx.x, lane = tid & 63, wave = tid >> 6;
    const int gw = blockIdx.x * 8 + wave, NGW = gridDim.x * 8;
    for (int m = gw; m < T_TOK; m += NGW) {
        const int b = m >> 12;
        const f32x4* xr = (const f32x4*)(x + (size_t)m * DM) + lane;
        f32x4 v[4]; float s = 0.f;
#pragma unroll
        for (int j = 0; j < 4; ++j) { v[j] = xr[64 * j]; s += (v[j].x * v[j].x + v[j].y * v[j].y) + (v[j].z * v[j].z + v[j].w * v[j].w); }
        const float inv = rsqrtf(wave_sum(s) * (1.f / DM) + EPS);
        const f32x4* sh = (const f32x4*)(mod + b * 6144 + shift_off) + lane;
        const f32x4* sc = (const f32x4*)(mod + b * 6144 + scale_off) + lane;
        v2u* o8 = (v2u*)(hout + (size_t)m * DM) + lane;
        float amax = 0.f;
#pragma unroll
        for (int j = 0; j < 4; ++j) { const f32x4 a = sh[64 * j], c = sc[64 * j];
            v[j].x = v[j].x * inv * (1.f + c.x) + a.x; v[j].y = v[j].y * inv * (1.f + c.y) + a.y; v[j].z = v[j].z * inv * (1.f + c.z) + a.z; v[j].w = v[j].w * inv * (1.f + c.w) + a.w;
            v2u o; o.x = pk2(v[j].x, v[j].y); o.y = pk2(v[j].z, v[j].w);
            o8[64 * j] = o;
            amax = fmaxf(fmaxf(amax, fmaxf(fabsf(v[j].x), fabsf(v[j].y))), fmaxf(fabsf(v[j].z), fabsf(v[j].w))); }
        if (h8) {
            amax = wave_max(amax);
            const float scale = (amax > 0.f) ? amax * (1.f / 240.f) : 1.f, qi = 1.f / scale;
#pragma unroll
            for (int j = 0; j < 4; ++j) { int p = __builtin_amdgcn_cvt_pk_fp8_f32(v[j].x * qi, v[j].y * qi, 0, false); p = __builtin_amdgcn_cvt_pk_fp8_f32(v[j].z * qi, v[j].w * qi, p, true);
                *(unsigned*)(h8 + (size_t)m * DM + 4 * (lane + 64 * j)) = (unsigned)p; }
            if (lane == 0) hs[m] = scale;
        }
    }
}

struct EpiX1 {
    static constexpr bool PERM = false, AFTER_DRAIN = false;
    const float* x; float* out; const float* mod;
    __device__ __forceinline__ void operator()(const pg8::f32x4 (&acc)[2][2][4][2], const pg8::Unit& u, int wr, int wc, int fr, int fq) const {
        const int row0 = u.pm * 256 + wr * 64 + fr, col0 = u.pn * 256 + wc * 32 + 4 * fq;
        const int b = (u.pm * 256) >> 12;
        f32x4 gv[2][2];
#pragma unroll
        for (int bj = 0; bj < 2; ++bj)
#pragma unroll
            for (int n = 0; n < 2; ++n) gv[bj][n] = *(const f32x4*)(mod + b * 6144 + 2048 + col0 + bj * 128 + n * 16);
#pragma unroll
        for (int ai = 0; ai < 2; ++ai)
#pragma unroll
            for (int m = 0; m < 4; ++m) { const size_t ro = (size_t)(row0 + ai * 128 + m * 16) * DM + col0;
#pragma unroll
                for (int bj = 0; bj < 2; ++bj)
#pragma unroll
                    for (int n = 0; n < 2; ++n) { const f32x4 xv = *(const f32x4*)(x + ro + bj * 128 + n * 16);
                        *(f32x4*)(out + ro + bj * 128 + n * 16) = xv + gv[bj][n] * acc[ai][bj][m][n]; } }
    }
};
struct EpiBf {
    static constexpr bool PERM = true, AFTER_DRAIN = false;
    bf16* O; int ldc;
    __device__ __forceinline__ void operator()(const pg8::f32x4 (&acc)[2][2][4][2], const pg8::Unit& u, int wr, int wc, int fr, int fq) const {
        const int row0 = u.pm * 256 + wr * 64 + fr, col0 = u.pn * 256 + wc * 32 + 8 * fq;
#pragma unroll
        for (int ai = 0; ai < 2; ++ai)
#pragma unroll
            for (int m = 0; m < 4; ++m) { bf16* rowp = O + (size_t)(row0 + ai * 128 + m * 16) * ldc + col0;
#pragma unroll
                for (int bj = 0; bj < 2; ++bj) { const pg8::f32x4 zz = (pg8::f32x4){0.f, 0.f, 0.f, 0.f}; const pg8::f32x4 v0 = acc[ai][bj][m][0] + zz, v1 = acc[ai][bj][m][1] + zz;
                    v4u w; w.x = pg8::cvt_pk_bf16(v0[0], v0[1]); w.y = pg8::cvt_pk_bf16(v0[2], v0[3]); w.z = pg8::cvt_pk_bf16(v1[0], v1[1]); w.w = pg8::cvt_pk_bf16(v1[2], v1[3]);
                    *(v4u*)(rowp + bj * 128) = w; } }
    }
};

constexpr int GP_QS = 0, GP_KS = 33792, GP_VS = 67584, GP_LS = 101376, GP_GV = 118784;
__device__ __forceinline__ void gdn_prep_item(const Args& a, LAS unsigned char* lds, int chunk) {
    int tid = threadIdx.x; asm volatile("" : "+v"(tid));
    const int lane = tid & 63, wave = __builtin_amdgcn_readfirstlane(tid >> 6);
    unsigned char* ws = a.ws;
    const bf16* proj = (const bf16*)(ws + WS_PROJ);
    const int bh = chunk >> 6, n = chunk & 63, b = bh >> 2, h = bh & 3;
    const int t0 = b * SEQ + n * 64;
    LAS float* QS = (LAS float*)(lds + GP_QS); LAS float* KS = (LAS float*)(lds + GP_KS); LAS float* VS = (LAS float*)(lds + GP_VS);
    LAS float* LS = (LAS float*)(lds + GP_LS); LAS float* GV = (LAS float*)(lds + GP_GV);
#ifndef GP_MASK
#define GP_MASK 31
#endif
#ifndef GP_REP
#define GP_REP 0
#endif
    for (int rep_ = 0; rep_ < 1 + (GP_REP & 1); ++rep_)
    if ((GP_MASK & 1) && tid < 384) {
        const int cg = tid % 48, rs = tid / 48;
        const int sec = cg >> 4, c8 = (cg & 15) * 8;
        const int pcol = C_BQ + sec * 512 + h * 128 + c8;
        const float* cw = a.in[8] + sec * 512 + h * 128 + c8;
        float wt[4][8];
#pragma unroll
        for (int i = 0; i < 4; ++i) { const f32x4 w0 = *(const f32x4*)(cw + i * 1536), w1 = *(const f32x4*)(cw + i * 1536 + 4);
            wt[i][0] = w0.x; wt[i][1] = w0.y; wt[i][2] = w0.z; wt[i][3] = w0.w; wt[i][4] = w1.x; wt[i][5] = w1.y; wt[i][6] = w1.z; wt[i][7] = w1.w; }
        LAS float* XS = (sec == 0) ? QS : (sec == 1 ? KS : VS);
        v4u raw[11];
#pragma unroll
        for (int j = 0; j < 11; ++j) { const int rr = 8 * rs - 3 + j;
            raw[j] = (rr >= 0 || n > 0) ? *(const v4u*)(proj + (size_t)(t0 + rr) * PW + pcol) : (v4u){0u, 0u, 0u, 0u}; }
#pragma unroll
        for (int j = 0; j < 8; ++j) {
            float y[8];
#pragma unroll
            for (int c = 0; c < 8; ++c) y[c] = 0.f;
#pragma unroll
            for (int i = 0; i < 4; ++i) { float xv[8]; const v4u u = raw[j + i];
                xv[0] = bflo(u.x); xv[1] = bfhi(u.x); xv[2] = bflo(u.y); xv[3] = bfhi(u.y); xv[4] = bflo(u.z); xv[5] = bfhi(u.z); xv[6] = bflo(u.w); xv[7] = bfhi(u.w);
#pragma unroll
                for (int c = 0; c < 8; ++c) y[c] += wt[i][c] * xv[c]; }
            f32x4 o0, o1;
            o0.x = silu_fast(y[0]); o0.y = silu_fast(y[1]); o0.z = silu_fast(y[2]); o0.w = silu_fast(y[3]); o1.x = silu_fast(y[4]); o1.y = silu_fast(y[5]); o1.z = silu_fast(y[6]); o1.w = silu_fast(y[7]);
            *(LAS f32x4*)(XS + (8 * rs + j) * 132 + c8) = o0; *(LAS f32x4*)(XS + (8 * rs + j) * 132 + c8 + 4) = o1;
        }
    }
    if (wave == 7) {
        const int i = lane;
        const float av = bf1(proj[(size_t)(t0 + i) * PW + C_BA + h]), bv = bf1(proj[(size_t)(t0 + i) * PW + C_BB + h]);
        const float beta = sigmoid_f(bv);
        const float g = -expf(a.in[9][h]) * softplus_f(av + a.in[10][h]);
        float G = g;
#pragma unroll
        for (int o = 1; o < 64; o <<= 1) { const float t = __shfl_up(G, o); if (lane >= o) G += t; }
        const float Glast = __shfl(G, 63);
        GV[i] = G; GV[64 + i] = expf(G); GV[128 + i] = beta; GV[192 + i] = expf(Glast - G); GV[256 + i] = beta * expf(G);
        if (lane == 0) ((float*)(ws + WS_GL))[chunk] = expf(Glast);
    }
    __syncthreads();
    if (GP_MASK & 2) {
#pragma unroll
        for (int rr = 0; rr < 16; ++rr) {
            const int row = wave * 16 + rr;
            LAS float* X = (row < 64) ? (QS + row * 132) : (KS + (row - 64) * 132);
            const float v0 = X[lane], v1 = X[lane + 64];
            const float ss = wave_sum(v0 * v0 + v1 * v1);
            const float sc = rsqrtf(ss + EPS) * ((row < 64) ? 0.08838834764831845f : 1.f);
            X[lane] = v0 * sc; X[lane + 64] = v1 * sc;
        }
    }
    __syncthreads();
    for (int rep_ = 0; rep_ < 1 + ((GP_REP >> 2) & 1); ++rep_)
    if (GP_MASK & 4) {
        const int gram = wave >> 2, ti = wave & 3, r = lane & 15, g = lane >> 4;
        const LAS float* X = gram ? QS : KS;
        f32x4 acc[4];
#pragma unroll
        for (int tj = 0; tj < 4; ++tj) acc[tj] = (f32x4){0.f, 0.f, 0.f, 0.f};
#pragma unroll 2
        for (int kk = 0; kk < 8; ++kk) {
            const f32x4 xa = *(const LAS f32x4*)(X + (16 * ti + r) * 132 + 16 * kk + 4 * g);
#pragma unroll
            for (int tj = 0; tj < 4; ++tj) {
                if (tj <= ti) {
                    const f32x4 kb = *(const LAS f32x4*)(KS + (16 * tj + r) * 132 + 16 * kk + 4 * g);
                    acc[tj] = __builtin_amdgcn_mfma_f32_16x16x4f32(xa.x, kb.x, acc[tj], 0, 0, 0);
                    acc[tj] = __builtin_amdgcn_mfma_f32_16x16x4f32(xa.y, kb.y, acc[tj], 0, 0, 0);
                    acc[tj] = __builtin_amdgcn_mfma_f32_16x16x4f32(xa.z, kb.z, acc[tj], 0, 0, 0);
                    acc[tj] = __builtin_amdgcn_mfma_f32_16x16x4f32(xa.w, kb.w, acc[tj], 0, 0, 0);
                }
            }
        }
        bf16* Aout = (bf16*)(ws + WS_GA) + (size_t)chunk * 4096;
#pragma unroll
        for (int tj = 0; tj < 4; ++tj)
#pragma unroll
            for (int rg = 0; rg < 4; ++rg) {
                const int i = 16 * ti + 4 * g + rg, j = 16 * tj + r;
                const float dec = (j <= i) ? __expf(GV[i] - GV[j]) : 0.f;
                if (gram == 0) { if (tj <= ti) LS[i * 68 + j] = (j < i) ? GV[128 + i] * acc[tj][rg] * dec : 0.f; }
                else Aout[((((i >> 4) * 2 + (j >> 5)) * 64 + (i & 15) + 16 * ((j >> 3) & 3)) << 3) + (j & 7)] = (bf16)f2bf((tj <= ti) ? acc[tj][rg] * dec : 0.f);
            }
    }
    __syncthreads();
    {
        bf16* QD = (bf16*)((unsigned char*)a.out + DO_QD) + (size_t)chunk * 8192;
        bf16* KDT = (bf16*)((unsigned char*)a.out + DO_KDT) + (size_t)chunk * 8192;
#pragma unroll
        for (int m = 0; m < 2; ++m) {
            const int p = tid + 512 * m;
            { const int i = p >> 4, k8 = (p & 15) * 8; const float e = GV[64 + i]; const LAS float* sq = QS + i * 132 + k8;
              v4u o; o.x = pk2(sq[0] * e, sq[1] * e); o.y = pk2(sq[2] * e, sq[3] * e); o.z = pk2(sq[4] * e, sq[5] * e); o.w = pk2(sq[6] * e, sq[7] * e);
              *(v4u*)(QD + ((((i >> 4) * 4 + ((p & 15) >> 2)) * 64 + (i & 15) + 16 * (p & 3)) << 3)) = o; }
            { const int k = p >> 3, i8 = (p & 7) * 8; float v[8];
#pragma unroll
              for (int j = 0; j < 8; ++j) v[j] = KS[(i8 + j) * 132 + k] * GV[192 + i8 + j];
              v4u o; o.x = pk2(v[0], v[1]); o.y = pk2(v[2], v[3]); o.z = pk2(v[4], v[5]); o.w = pk2(v[6], v[7]);
              *(v4u*)(KDT + ((((k >> 4) * 2 + ((p & 7) >> 2)) * 64 + (k & 15) + 16 * (p & 3)) << 3)) = o; }
        }
    }
    __syncthreads();
    {
#pragma unroll
        for (int m = 0; m < 4; ++m) {
            const int p = tid + 512 * m, i = p >> 5, c4 = (p & 31) * 4;
            const float mu = GV[128 + i], mw = GV[256 + i];
            f32x4 v = *(LAS f32x4*)(VS + i * 132 + c4); v.x *= mu; v.y *= mu; v.z *= mu; v.w *= mu; *(LAS f32x4*)(VS + i * 132 + c4) = v;
            f32x4 k = *(LAS f32x4*)(KS + i * 132 + c4); k.x *= mw; k.y *= mw; k.z *= mw; k.w *= mw; *(LAS f32x4*)(KS + i * 132 + c4) = k;
        }
    }
    __syncthreads();
    {
        const int r = lane & 15, g = lane >> 4;
#pragma unroll 1
        for (int I = 0; I < 4; ++I) {
            if (I > 0) {
#pragma unroll
                for (int tt = 0; tt < 2; ++tt) {
                    const int ct = 2 * wave + tt;
                    LAS float* XB = ((ct < 8) ? VS : KS) + (ct & 7) * 16 + r;
                    f32x4 acc;
#pragma unroll
                    for (int rg = 0; rg < 4; ++rg) acc[rg] = XB[(16 * I + 4 * g + rg) * 132];
                    for (int J = 0; J < I; ++J) {
#pragma unroll
                        for (int ks = 0; ks < 4; ++ks) {
                            const float la = -LS[(16 * I + r) * 68 + 16 * J + 4 * ks + g];
                            const float xb = XB[(16 * J + 4 * ks + g) * 132];
                            acc = __builtin_amdgcn_mfma_f32_16x16x4f32(la, xb, acc, 0, 0, 0);
                        }
                    }
#pragma unroll
                    for (int rg = 0; rg < 4; ++rg) XB[(16 * I + 4 * g + rg) * 132] = acc[rg];
                }
                __syncthreads();
            }
            if (tid < 256) {
                LAS float* XC = ((tid < 128) ? VS : KS) + (tid & 127);
                float x[16];
#pragma unroll
                for (int rr = 0; rr < 16; ++rr) {
                    float a0 = XC[(16 * I + rr) * 132], a1 = 0.f, a2 = 0.f, a3 = 0.f;
#pragma unroll
                    for (int j4 = 0; j4 < (rr + 3) / 4; ++j4) {
                        const f32x4 l = *(const LAS f32x4*)(LS + (16 * I + rr) * 68 + 16 * I + 4 * j4);
                        if (4 * j4 + 0 < rr) a0 -= l.x * x[4 * j4 + 0];
                        if (4 * j4 + 1 < rr) a1 -= l.y * x[4 * j4 + 1];
                        if (4 * j4 + 2 < rr) a2 -= l.z * x[4 * j4 + 2];
                        if (4 * j4 + 3 < rr) a3 -= l.w * x[4 * j4 + 3];
                    }
                    x[rr] = (a0 + a1) + (a2 + a3);
                }
#pragma unroll
                for (int rr = 0; rr < 16; ++rr) XC[(16 * I + rr) * 132] = x[rr];
            }
            __syncthreads();
        }
    }
    {
        bf16* W = (bf16*)((unsigned char*)a.out + DO_W) + (size_t)chunk * 8192;
        bf16* UT = (bf16*)((unsigned char*)a.out + DO_UT) + (size_t)chunk * 8192;
#pragma unroll
        for (int m = 0; m < 2; ++m) {
            const int p = tid + 512 * m, i = p >> 4, k8 = p & 15;
            const f32x4 x0 = *(const LAS f32x4*)(KS + i * 132 + 8 * k8), x1 = *(const LAS f32x4*)(KS + i * 132 + 8 * k8 + 4);
            v4u o; o.x = pk2(x0.x, x0.y); o.y = pk2(x0.z, x0.w); o.z = pk2(x1.x, x1.y); o.w = pk2(x1.z, x1.w);
            *(v4u*)(W + ((((i >> 4) * 4 + (k8 >> 2)) * 64 + (i & 15) + 16 * (k8 & 3)) << 3)) = o;
        }
#pragma unroll
        for (int m = 0; m < 4; ++m) {
            const int p = tid + 512 * m, v = p & 127, q = p >> 7;
            v2u o; o.x = pk2(VS[(4 * q) * 132 + v], VS[(4 * q + 1) * 132 + v]); o.y = pk2(VS[(4 * q + 2) * 132 + v], VS[(4 * q + 3) * 132 + v]);
            *(v2u*)(UT + ((((q >> 2) * 8 + (v >> 4)) * 64 + (v & 15) + 16 * (q & 3)) << 2)) = o;
        }
    }
    __syncthreads();
}

__device__ __forceinline__ void kn_item(const Args& a, int item) {
    const int tid = threadIdx.x, lane = tid & 63, wave = tid >> 6;
    const bf16* proj = (const bf16*)(a.ws + WS_PROJ); bf16* KN = (bf16*)(a.ws + WS_KN);
    const float g0 = a.in[6][2 * lane], g1 = a.in[6][2 * lane + 1];
    for (int rr = 0; rr < 16; ++rr) {
        const int t = item * 128 + wave * 16 + rr;
        const unsigned u = *(const unsigned*)(proj + (size_t)t * PW + C_AKV + 2 * lane);
        const float v0 = bflo(u), v1 = bfhi(u);
        const float inv = rsqrtf(wave_sum(v0 * v0 + v1 * v1) * (1.f / 128.f) + EPS);
        *(unsigned*)(KN + (size_t)t * 128 + 2 * lane) = pk2(v0 * inv * g0, v1 * inv * g1);
    }
}


#ifdef IDX_FP32
__device__ __forceinline__ void phase_idx32(const Args& a, LAS unsigned char* lds) {
    const int tid = threadIdx.x, lane = tid & 63, wave = tid >> 6;
    LAS float* HS = (LAS float*)lds;
    float* IDX32 = (float*)(a.ws + WS_YAB);
    const float* mod = (const float*)(a.ws + WS_MOD);
    for (int tile = blockIdx.x; tile < 1024; tile += gridDim.x) {
        const int t0 = tile * 32, b = t0 >> 12;
        for (int rr = 0; rr < 4; ++rr) {
            const int m = t0 + wave * 4 + rr;
            const f32x4* xr = (const f32x4*)(a.in[0] + (size_t)m * DM) + lane;
            f32x4 v[4]; float s = 0.f;
#pragma unroll
            for (int j = 0; j < 4; ++j) { v[j] = xr[64 * j]; s += (v[j].x * v[j].x + v[j].y * v[j].y) + (v[j].z * v[j].z + v[j].w * v[j].w); }
            const float inv = rsqrtf(wave_sum(s) * (1.f / DM) + EPS);
            const f32x4* sh = (const f32x4*)(mod + b * 6144) + lane; const f32x4* sc = (const f32x4*)(mod + b * 6144 + 1024) + lane;
#pragma unroll
            for (int j = 0; j < 4; ++j) { const f32x4 aa = sh[64 * j], c = sc[64 * j];
                f32x4 o; o.x = v[j].x * inv * (1.f + c.x) + aa.x; o.y = v[j].y * inv * (1.f + c.y) + aa.y; o.z = v[j].z * inv * (1.f + c.z) + aa.z; o.w = v[j].w * inv * (1.f + c.w) + aa.w;
                *(LAS f32x4*)(HS + (wave * 4 + rr) * 1028 + 4 * (lane + 64 * j)) = o; }
        }
        __syncthreads();
        if (tid < 324) {
            const float* w = a.in[4] + 1152 + tid;
            float acc[32];
#pragma unroll
            for (int t = 0; t < 32; ++t) acc[t] = 0.f;
            for (int k4 = 0; k4 < 256; ++k4) {
                const float w0 = w[(size_t)(4 * k4) * IN_W], w1 = w[(size_t)(4 * k4 + 1) * IN_W], w2 = w[(size_t)(4 * k4 + 2) * IN_W], w3 = w[(size_t)(4 * k4 + 3) * IN_W];
#pragma unroll
                for (int t = 0; t < 32; ++t) { const f32x4 hv = *(const LAS f32x4*)(HS + t * 1028 + 4 * k4); acc[t] += hv.x * w0 + hv.y * w1 + hv.z * w2 + hv.w * w3; }
            }
#pragma unroll
            for (int t = 0; t < 32; ++t) IDX32[(size_t)(t0 + t) * 384 + tid] = acc[t];
        }
        __syncthreads();
    }
}
#endif
__device__ __forceinline__ unsigned sortable(float f) { const unsigned u = __float_as_uint(f + 0.f); return (u & 0x80000000u) ? ~u : (u | 0x80000000u); }
__device__ __forceinline__ int wave_sum_dpp(int x) {
    x += __builtin_amdgcn_update_dpp(0, x, 0xB1, 0xF, 0xF, false);
    x += __builtin_amdgcn_update_dpp(0, x, 0x4E, 0xF, 0xF, false);
    x += __builtin_amdgcn_update_dpp(0, x, 0x141, 0xF, 0xF, false);
    x += __builtin_amdgcn_update_dpp(0, x, 0x140, 0xF, 0xF, false);
    return __builtin_amdgcn_readlane(x, 0) + __builtin_amdgcn_readlane(x, 16) + __builtin_amdgcn_readlane(x, 32) + __builtin_amdgcn_readlane(x, 48);
}
#define CNT8(OP, acc_, k_, s_, c_) asm("v_cmp_" OP "_u32 s[36:37], %1, %9\n\tv_cmp_" OP "_u32 s[38:39], %2, %9\n\tv_cmp_" OP "_u32 s[40:41], %3, %9\n\tv_cmp_" OP "_u32 s[42:43], %4, %9\n\t" \
        "v_cmp_" OP "_u32 s[44:45], %5, %9\n\tv_cmp_" OP "_u32 s[46:47], %6, %9\n\tv_cmp_" OP "_u32 s[48:49], %7, %9\n\tv_cmp_" OP "_u32 s[50:51], %8, %9\n\t" \
        "v_addc_co_u32 %0, s[36:37], 0, %0, s[36:37]\n\tv_addc_co_u32 %0, s[38:39], 0, %0, s[38:39]\n\tv_addc_co_u32 %0, s[40:41], 0, %0, s[40:41]\n\tv_addc_co_u32 %0, s[42:43], 0, %0, s[42:43]\n\t" \
        "v_addc_co_u32 %0, s[44:45], 0, %0, s[44:45]\n\tv_addc_co_u32 %0, s[46:47], 0, %0, s[46:47]\n\tv_addc_co_u32 %0, s[48:49], 0, %0, s[48:49]\n\tv_addc_co_u32 %0, s[50:51], 0, %0, s[50:51]" \
        : "+v"(acc_) : "v"(k_[(s_)]), "v"(k_[(s_) + 1]), "v"(k_[(s_) + 2]), "v"(k_[(s_) + 3]), "v"(k_[(s_) + 4]), "v"(k_[(s_) + 5]), "v"(k_[(s_) + 6]), "v"(k_[(s_) + 7]), "v"(c_) \
        : "s36", "s37", "s38", "s39", "s40", "s41", "s42", "s43", "s44", "s45", "s46", "s47", "s48", "s49", "s50", "s51")
template <int NS> __device__ __forceinline__ void topk_select(LAS float* row, int n, int lane, unsigned short* out) {
    asm volatile("" : "+v"(lane));
    unsigned key[NS];
#pragma unroll
    for (int s = 0; s < NS; ++s) key[s] = __float_as_uint(row[s * 64 + lane]);
#pragma unroll
    for (int s = 0; s < NS; ++s) { const int idx = s * 64 + lane; const unsigned k = sortable(__uint_as_float(key[s])); key[s] = (idx < n) ? k : 0u; }
    LAS unsigned short* sel_l = (LAS unsigned short*)row;
    unsigned thr = 0u;
    for (int bit = 31; bit >= 0; --bit) {
        const unsigned cand = thr | (1u << bit);
        int c0 = 0, c1 = 0;
#pragma unroll
        for (int s = 0; s < NS; s += 16) { CNT8("ge", c0, key, s, cand); CNT8("ge", c1, key, s + 8, cand); }
        const int cnt = wave_sum_dpp(c0 + c1);
        if (cnt >= 256) thr = cand;
        if (cnt == 256) break;
    }
    int g0 = 0, e0 = 0;
#pragma unroll
    for (int s = 0; s < NS; s += 8) { CNT8("gt", g0, key, s, thr); CNT8("eq", e0, key, s, thr); }
    const int cgt = wave_sum_dpp(g0), ceq = wave_sum_dpp(e0);
    const int need_eq = 256 - cgt;
    asm volatile("" : "+v"(thr));
    asm volatile("" : "+v"(lane));
    int pos_out = 0;
    if (ceq == need_eq) {
#pragma unroll
        for (int s = 0; s < NS; ++s) {
            const bool take = key[s] >= thr;
            const unsigned long long mt = __builtin_amdgcn_ballot_w64(take);
            const int pre = __builtin_amdgcn_mbcnt_hi((unsigned)(mt >> 32), __builtin_amdgcn_mbcnt_lo((unsigned)mt, 0));
            sel_l[take ? pos_out + pre : 256] = (unsigned short)(s * 64 + lane);
            pos_out += __builtin_popcountll(mt);
        }
    } else {
        const unsigned long long ltmask = (1ull << lane) - 1ull;
        int eq_seen = 0;
#pragma unroll
        for (int s = 0; s < NS; ++s) {
            const bool gt = key[s] > thr, eq = key[s] == thr;
            const unsigned long long meq = __builtin_amdgcn_ballot_w64(eq);
            const bool take = gt || (eq && (eq_seen + __builtin_popcountll(meq & ltmask) < need_eq));
            const unsigned long long mt = __builtin_amdgcn_ballot_w64(take);
            if (take) sel_l[pos_out + __builtin_popcountll(mt & ltmask)] = (unsigned short)(s * 64 + lane);
            pos_out += __builtin_popcountll(mt); eq_seen += __builtin_popcountll(meq);
            if ((s & 3) == 3) __builtin_amdgcn_sched_barrier(0);
        }
    }
    LDS_WAIT();
    *(v2u*)(out + 4 * lane) = *(const LAS v2u*)(sel_l + 4 * lane);
}
struct IdxPre { bf16x8 af[4]; v2u wqr[4]; bf16x8 bfr[4][4]; };
__device__ __forceinline__ void idx_issue(const Args& a, int b, int qblk, int wave, int lane, IdxPre& P) {
    const bf16* proj = (const bf16*)(a.ws + WS_PROJ);
    const int p0 = qblk * 8, r = lane & 31, hh = lane >> 5;
    const size_t rowb = (size_t)b * SEQ;
    if (p0 + 7 < 256) return;
    { const bf16* qp = proj + (rowb + p0 + (r & 7)) * PW + C_IQ + (r >> 3) * 64 + 32 * hh;
#pragma unroll
      for (int s = 0; s < 4; ++s) P.af[s] = *(const bf16x8*)(qp + 8 * s); }
#pragma unroll
    for (int i = 0; i < 4; ++i) P.wqr[i] = *(const v2u*)(proj + (rowb + p0 + 4 * hh + i) * PW + C_IW);
    const int ntiles = (p0 + 7) / 32 + 1;
#pragma unroll
    for (int u = 0; u < 4; ++u) {
        const int kt = (wave + 8 * u < ntiles) ? wave + 8 * u : 0;
        const bf16* kp = proj + (rowb + (size_t)kt * 32 + r) * PW + C_IK + 32 * hh;
#pragma unroll
        for (int s = 0; s < 4; ++s) P.bfr[u][s] = *(const bf16x8*)(kp + 8 * s);
    }
}
__device__ __forceinline__ void indexer_item(const Args& a, LAS unsigned char* lds, int b, int qblk, IdxPre& P, bool has_next, int b_next, int qblk_next) {
    int tid = threadIdx.x; asm volatile("" : "+v"(tid));
    const int lane = tid & 63, wave = __builtin_amdgcn_readfirstlane(tid >> 6);
    const bf16* proj = (const bf16*)(a.ws + WS_PROJ);
    unsigned short* SEL = (unsigned short*)(a.ws + WS_SEL);
    LAS float* SC = (LAS float*)lds;
    const int p0 = qblk * 8;
    const int r = lane & 31, hh = lane >> 5;
    const size_t rowb = (size_t)b * SEQ;
#ifdef IDX_FP32
    if (p0 + 7 >= 256) {
        const float* IDX32 = (const float*)(a.ws + WS_YAB);
        LAS float* IQS = (LAS float*)(lds + 131072);
        for (int i = tid; i < 2048; i += 512) IQS[i] = IDX32[(rowb + p0 + (i >> 8)) * 384 + (i & 255)];
        float wq8[8][4];
#pragma unroll
        for (int q = 0; q < 8; ++q)
#pragma unroll
            for (int hd = 0; hd < 4; ++hd) wq8[q][hd] = IDX32[(rowb + p0 + q) * 384 + 320 + hd];
        __syncthreads();
        for (int s = tid; s <= p0 + 7; s += 512) {
            float kf[64];
#pragma unroll
            for (int d4 = 0; d4 < 16; ++d4) { const f32x4 v = *(const f32x4*)(IDX32 + (rowb + s) * 384 + 256 + 4 * d4); kf[4 * d4] = v.x; kf[4 * d4 + 1] = v.y; kf[4 * d4 + 2] = v.z; kf[4 * d4 + 3] = v.w; }
#pragma unroll 1
            for (int q = 0; q < 8; ++q) {
                float sc = 0.f;
#pragma unroll
                for (int hd = 0; hd < 4; ++hd) {
                    float lg = 0.f;
#pragma unroll
                    for (int d4 = 0; d4 < 16; ++d4) { const f32x4 qv = *(const LAS f32x4*)(IQS + q * 256 + hd * 64 + 4 * d4); lg += kf[4 * d4] * qv.x + kf[4 * d4 + 1] * qv.y + kf[4 * d4 + 2] * qv.z + kf[4 * d4 + 3] * qv.w; }
                    sc += fmaxf(lg, 0.f) * wq8[q][hd];
                }
                SC[q * 4096 + s] = sc * 0.0625f;
            }
        }
    }
#else
    if (p0 + 7 >= 256) {
        float wq[4][4];
#pragma unroll
        for (int i = 0; i < 4; ++i) { wq[i][0] = bflo(P.wqr[i].x) * 0.0625f; wq[i][1] = bfhi(P.wqr[i].x) * 0.0625f; wq[i][2] = bflo(P.wqr[i].y) * 0.0625f; wq[i][3] = bfhi(P.wqr[i].y) * 0.0625f; }
        const int ntiles = (p0 + 7) / 32 + 1;
        for (int kt0 = wave; kt0 < ntiles; kt0 += 32) {
            bf16x8 nxt[4][4];
            const bool more = kt0 + 32 < ntiles;
            if (more) {
#pragma unroll
                for (int u = 0; u < 4; ++u) {
                    const int kt = (kt0 + 32 + 8 * u < ntiles) ? kt0 + 32 + 8 * u : kt0;
                    const bf16* kp = proj + (rowb + (size_t)kt * 32 + r) * PW + C_IK + 32 * hh;
#pragma unroll
                    for (int s = 0; s < 4; ++s) nxt[u][s] = *(const bf16x8*)(kp + 8 * s);
                }
            }
#pragma unroll
            for (int u = 0; u < 4; ++u) {
                const int kt = kt0 + 8 * u;
                if (kt < ntiles) {
                    f32x16 acc;
#pragma unroll
                    for (int i = 0; i < 16; ++i) acc[i] = 0.f;
#pragma unroll
                    for (int s = 0; s < 4; ++s) acc = __builtin_amdgcn_mfma_f32_32x32x16_bf16(P.af[s], P.bfr[u][s], acc, 0, 0, 0);
#pragma unroll
                    for (int i = 0; i < 4; ++i) {
                        float s = 0.f;
#pragma unroll
                        for (int hd = 0; hd < 4; ++hd) s += wq[i][hd] * fmaxf(acc[i + 4 * hd], 0.f);
                        SC[(4 * hh + i) * 4096 + kt * 32 + r] = s;
                    }
                }
            }
            if (more) {
#pragma unroll
                for (int u = 0; u < 4; ++u)
#pragma unroll
                    for (int s = 0; s < 4; ++s) P.bfr[u][s] = nxt[u][s];
            }
        }
    }
#endif
    __syncthreads();
#ifndef IDX_FP32
    if (has_next) idx_issue(a, b_next, qblk_next, wave, lane, P);
#endif
    {
        const int pos = p0 + wave, n = pos + 1;
        unsigned short* out = SEL + (rowb + pos) * 256;
        if (n <= 256) {
#pragma unroll
            for (int q = 0; q < 4; ++q) { const int j = lane + 64 * q; out[j] = (unsigned short)((j < n) ? j : 0xFFFF); }
        } else {
            LAS float* row = SC + wave * 4096;
            const int nslots = (n + 63) >> 6;
#ifndef IDX_REP_SELECT
#define IDX_REP_SELECT 1
#endif
            float* bk_ = (float*)(a.ws + WS_YAB) + ((size_t)blockIdx.x * 8 + wave) * 4096;
            if (IDX_REP_SELECT > 1) for (int i_ = lane; i_ < 4096; i_ += 64) bk_[i_] = row[i_];
            for (int rep_ = 0; rep_ < IDX_REP_SELECT; ++rep_) {
            if (rep_ > 0) { for (int i_ = lane; i_ < 4096; i_ += 64) row[i_] = bk_[i_]; LDS_WAIT(); }
            if (nslots <= 16) topk_select<16>(row, n, lane, out);
            else if (nslots <= 32) topk_select<32>(row, n, lane, out);
            else if (nslots <= 48) topk_select<48>(row, n, lane, out);
            else topk_select<64>(row, n, lane, out);
            }
        }
    }
    __syncthreads();
}

__device__ __forceinline__ void phase3(const Args& a, LAS unsigned char* lds) {
    const int bid = blockIdx.x, G = gridDim.x;
#ifndef P3_MASK
#define P3_MASK 7
#endif
#ifndef P3_REP
#define P3_REP 0
#endif
    if (P3_MASK & 1) for (int it = bid; it < 2048; it += G) { gdn_prep_item(a, lds, it); if (P3_REP & 1) gdn_prep_item(a, lds, it); }
    if (P3_MASK & 2) {
#define IDX_MAP(j_, bb_, qb_) do { if (G == 256) { const int i_ = (j_) / G, c_ = (j_) % G, q0_ = (c_ >> 3) + 32 * (i_ >> 1); bb_ = c_ & 7; qb_ = (i_ & 1) ? 511 - q0_ : q0_; } else { bb_ = (j_) >> 9; qb_ = (j_) & 511; } } while (0)
        IdxPre P;
        const int tid_ = threadIdx.x, lane_ = tid_ & 63, wave_ = __builtin_amdgcn_readfirstlane(tid_ >> 6);
        int bb, qb;
        if (bid < 4096) { IDX_MAP(bid, bb, qb); idx_issue(a, bb, qb, wave_, lane_, P); }
        for (int j = bid; j < 4096; j += G) {
            IDX_MAP(j, bb, qb);
            int bn = 0, qn = 0; const bool hn = (j + G < 4096);
            if (hn) IDX_MAP(j + G, bn, qn);
            indexer_item(a, lds, bb, qb, P, hn, bn, qn);
            if (P3_REP & 2) { idx_issue(a, bb, qb, wave_, lane_, P); indexer_item(a, lds, bb, qb, P, false, 0, 0); if (hn) idx_issue(a, bn, qn, wave_, lane_, P); }
        }
#undef IDX_MAP
    }
    if (P3_MASK & 4) for (int it = bid; it < 256; it += G) kn_item(a, it);
}

constexpr int SC_ST = 0, SC_VNT = 34816, SC_O = 53248;
__device__ __forceinline__ v2u pack4(float a, float b, float c, float d) { v2u o; o.x = pk2(a, b); o.y = pk2(c, d); return o; }
__device__ __forceinline__ void scan_epilogue(const LAS float* OS, const v4u z0, const v4u z1, const LAS float* gainl, bf16* ydst, int tid) {
    const int row = tid >> 3, seg = tid & 7;
    float o[16];
#pragma unroll
    for (int q = 0; q < 4; ++q) { const f32x4 v = *(const LAS f32x4*)(OS + row * 132 + 16 * seg + 4 * q); o[4 * q] = v.x; o[4 * q + 1] = v.y; o[4 * q + 2] = v.z; o[4 * q + 3] = v.w; }
    float ss = 0.f;
#pragma unroll
    for (int i = 0; i < 16; ++i) ss += o[i] * o[i];
    ss += __shfl_xor(ss, 1); ss += __shfl_xor(ss, 2); ss += __shfl_xor(ss, 4);
    const float inv = rsqrtf(ss * (1.f / 128.f) + EPS);
    float z[16];
    z[0] = bflo(z0.x); z[1] = bfhi(z0.x); z[2] = bflo(z0.y); z[3] = bfhi(z0.y); z[4] = bflo(z0.z); z[5] = bfhi(z0.z); z[6] = bflo(z0.w); z[7] = bfhi(z0.w);
    z[8] = bflo(z1.x); z[9] = bfhi(z1.x); z[10] = bflo(z1.y); z[11] = bfhi(z1.y); z[12] = bflo(z1.z); z[13] = bfhi(z1.z); z[14] = bflo(z1.w); z[15] = bfhi(z1.w);
    float y[16];
#pragma unroll
    for (int q = 0; q < 4; ++q) { const f32x4 gq = *(const LAS f32x4*)(gainl + 16 * seg + 4 * q);
        y[4 * q] = o[4 * q] * inv * gq.x * silu_fast(z[4 * q]); y[4 * q + 1] = o[4 * q + 1] * inv * gq.y * silu_fast(z[4 * q + 1]); y[4 * q + 2] = o[4 * q + 2] * inv * gq.z * silu_fast(z[4 * q + 2]); y[4 * q + 3] = o[4 * q + 3] * inv * gq.w * silu_fast(z[4 * q + 3]); }
    v4u w0, w1;
    w0.x = pk2(y[0], y[1]); w0.y = pk2(y[2], y[3]); w0.z = pk2(y[4], y[5]); w0.w = pk2(y[6], y[7]);
    w1.x = pk2(y[8], y[9]); w1.y = pk2(y[10], y[11]); w1.z = pk2(y[12], y[13]); w1.w = pk2(y[14], y[15]);
    *(v4u*)(ydst) = w0; *(v4u*)(ydst + 8) = w1;
}
__device__ __forceinline__ void gdn_scan(const Args& a, LAS unsigned char* lds, int bh) {
    const int tid = threadIdx.x, lane = tid & 63, w = __builtin_amdgcn_readfirstlane(tid >> 6), r = lane & 15, g = lane >> 4;
    const int b = bh >> 2, h = bh & 3;
    LAS bf16* ST = (LAS bf16*)(lds + SC_ST); LAS bf16* VNT = (LAS bf16*)(lds + SC_VNT); LAS float* OS = (LAS float*)(lds + SC_O);
    const bf16* proj = (const bf16*)(a.ws + WS_PROJ); bf16* yab = (bf16*)(a.ws + WS_YAB);
    const float* GL = (const float*)(a.ws + WS_GL);
    for (int i = tid; i < 34816 / 4; i += 512) ((LAS unsigned*)ST)[i] = 0u;
    f32x4 S[8];
#pragma unroll
    for (int vt = 0; vt < 8; ++vt) S[vt] = (f32x4){0.f, 0.f, 0.f, 0.f};
    const int erow = tid >> 3, eseg = tid & 7;
    LAS float* gainl = (LAS float*)(lds + 87040);
    if (tid < 128) gainl[tid] = a.in[11][tid];
    const int ct = w & 3;
    const size_t cb = (size_t)bh * 64;
    const bf16* Wb = (const bf16*)((const unsigned char*)a.out + DO_W) + cb * 8192;
    const bf16* QDb = (const bf16*)((const unsigned char*)a.out + DO_QD) + cb * 8192;
    const bf16* KDTb = (const bf16*)((const unsigned char*)a.out + DO_KDT) + cb * 8192;
    const bf16* UTb = (const bf16*)((const unsigned char*)a.out + DO_UT) + cb * 8192;
    const bf16* Ab = (const bf16*)(a.ws + WS_GA) + cb * 4096;
    const bf16* Xb = (w < 4) ? Wb : QDb;
    const size_t tz = ((size_t)b * SEQ + erow) * PW + C_BZ + h * 128 + 16 * eseg;
    const size_t ty = ((size_t)b * SEQ + erow) * YW + 1024 + h * 128 + 16 * eseg;
    bf16x8 af[4], kd[2]; v4u xr[4]; float gl; v4u zh0, zh1;
#define SCAN_LOAD(n_, af_, kd_, xr_, gl_) do { \
        const bf16* X_ = Xb + (size_t)(n_) * 8192 + (ct * 4 * 64 + lane) * 8; \
        _Pragma("unroll") for (int ks = 0; ks < 4; ++ks) af_[ks] = *(const bf16x8*)(X_ + ks * 512); \
        const bf16* K_ = KDTb + (size_t)(n_) * 8192 + (w * 2 * 64 + lane) * 8; \
        kd_[0] = *(const bf16x8*)(K_); kd_[1] = *(const bf16x8*)(K_ + 512); \
        if (w >= 4) { const bf16* A_ = Ab + (size_t)(n_) * 4096 + (ct * 2 * 64 + lane) * 8; xr_[0] = *(const v4u*)(A_); xr_[1] = *(const v4u*)(A_ + 512); } \
        else { const bf16* U_ = UTb + (size_t)(n_) * 8192 + (ct * 8 * 64 + lane) * 4; _Pragma("unroll") for (int q_ = 0; q_ < 4; ++q_) { const v2u u0_ = *(const v2u*)(U_ + (2 * q_) * 256), u1_ = *(const v2u*)(U_ + (2 * q_ + 1) * 256); xr_[q_] = (v4u){u0_.x, u0_.y, u1_.x, u1_.y}; } } \
        gl_ = GL[cb + (n_)]; } while (0)
    SCAN_LOAD(0, af, kd, xr, gl);
    zh0 = (v4u){0u, 0u, 0u, 0u}; zh1 = zh0;
    __syncthreads();
    for (int n = 0; n < 64; ++n) {
        bf16x8 afn[4], kdn[2]; v4u xrn[4]; float gln;
        const int nn = (n < 63) ? n + 1 : 63;
        SCAN_LOAD(nn, afn, kdn, xrn, gln);
        const v4u zn0 = *(const v4u*)(proj + tz + (size_t)n * 64 * PW), zn1 = *(const v4u*)(proj + tz + (size_t)n * 64 * PW + 8);
        if (n > 0) scan_epilogue(OS, zh0, zh1, gainl, yab + ty + (size_t)(n - 1) * 64 * YW, tid);
        zh0 = zn0; zh1 = zn1;
        f32x4 acc[8];
#pragma unroll
        for (int vt = 0; vt < 8; ++vt) acc[vt] = (f32x4){0.f, 0.f, 0.f, 0.f};
#pragma unroll
        for (int ks = 0; ks < 4; ++ks) {
#pragma unroll
            for (int vt = 0; vt < 8; ++vt) {
                const bf16x8 bfr = *(const LAS bf16x8*)(ST + (16 * vt + r) * 136 + 32 * ks + 8 * g);
                acc[vt] = __builtin_amdgcn_mfma_f32_16x16x32_bf16(af[ks], bfr, acc[vt], 0, 0, 0);
            }
        }
        if (w < 4) {
#pragma unroll
            for (int vt = 0; vt < 8; ++vt) {
                const unsigned ux = (vt & 1) ? xr[vt >> 1].z : xr[vt >> 1].x, uy = (vt & 1) ? xr[vt >> 1].w : xr[vt >> 1].y;
                const v2u o = pack4(bflo(ux) - acc[vt][0], bfhi(ux) - acc[vt][1], bflo(uy) - acc[vt][2], bfhi(uy) - acc[vt][3]);
                *(LAS v2u*)(VNT + (16 * vt + r) * 72 + 16 * ct + 4 * g) = o;
            }
        }
        __syncthreads();
        if (w >= 4) {
#pragma unroll
            for (int ks = 0; ks < 2; ++ks)
#pragma unroll
                for (int vt = 0; vt < 8; ++vt) {
                    const bf16x8 vb = *(const LAS bf16x8*)(VNT + (16 * vt + r) * 72 + 32 * ks + 8 * g);
                    acc[vt] = __builtin_amdgcn_mfma_f32_16x16x32_bf16(__builtin_bit_cast(bf16x8, xr[ks]), vb, acc[vt], 0, 0, 0);
                }
#pragma unroll
            for (int vt = 0; vt < 8; ++vt)
#pragma unroll
                for (int rg = 0; rg < 4; ++rg) OS[(16 * ct + 4 * g + rg) * 132 + 16 * vt + r] = acc[vt][rg];
        }
#pragma unroll
        for (int vt = 0; vt < 8; ++vt) S[vt] = S[vt] * gl;
#pragma unroll
        for (int ks = 0; ks < 2; ++ks)
#pragma unroll
            for (int vt = 0; vt < 8; ++vt) {
                const bf16x8 vb = *(const LAS bf16x8*)(VNT + (16 * vt + r) * 72 + 32 * ks + 8 * g);
                S[vt] = __builtin_amdgcn_mfma_f32_16x16x32_bf16(kd[ks], vb, S[vt], 0, 0, 0);
            }
#pragma unroll
        for (int vt = 0; vt < 8; ++vt)
            *(LAS v2u*)(ST + (16 * vt + r) * 136 + 16 * w + 4 * g) = pack4(S[vt][0] + 0.f, S[vt][1] + 0.f, S[vt][2] + 0.f, S[vt][3] + 0.f);
#pragma unroll
        for (int ks = 0; ks < 4; ++ks) af[ks] = afn[ks];
        kd[0] = kdn[0]; kd[1] = kdn[1];
#pragma unroll
        for (int q = 0; q < 4; ++q) xr[q] = xrn[q];
        gl = gln;
        __syncthreads();
    }
    scan_epilogue(OS, zh0, zh1, gainl, yab + ty + (size_t)63 * 64 * YW, tid);
    __syncthreads();
#undef SCAN_LOAD
}

typedef short v4s __attribute__((ext_vector_type(4)));
constexpr int AQ_STRIDE = 272, AQ_WAVE_LDS = 64 * AQ_STRIDE + 512;
__device__ __forceinline__ void attn_query_q4(const Args& a, LAS unsigned char* wl, const LAS float* qgl, int t, int lane) {
    const bf16* proj = (const bf16*)(a.ws + WS_PROJ); const bf16* KN = (const bf16*)(a.ws + WS_KN);
    const unsigned short* SEL = (const unsigned short*)(a.ws + WS_SEL); bf16* yab = (bf16*)(a.ws + WS_YAB);
    LAS unsigned char* KT = wl; LAS unsigned short* SL = (LAS unsigned short*)(wl + 64 * AQ_STRIDE);
    const int r = lane & 15, g = lane >> 4;
    const int b = t >> 12, pos = t & 4095;
    const bf16* knb = KN + (size_t)b * SEQ * 128;
    *(LAS v2u*)(SL + 4 * lane) = *(const v2u*)(SEL + (size_t)t * 256 + 4 * lane);
    bf16x8 qf[4];
    {
        const bf16* qp = proj + (size_t)t * PW + C_AQ + (r & 7) * 128 + 8 * g;
        float f[32]; float ss = 0.f;
#pragma unroll
        for (int ks = 0; ks < 4; ++ks) { const v4u raw = *(const v4u*)(qp + 32 * ks);
            f[8 * ks] = bflo(raw.x); f[8 * ks + 1] = bfhi(raw.x); f[8 * ks + 2] = bflo(raw.y); f[8 * ks + 3] = bfhi(raw.y); f[8 * ks + 4] = bflo(raw.z); f[8 * ks + 5] = bfhi(raw.z); f[8 * ks + 6] = bflo(raw.w); f[8 * ks + 7] = bfhi(raw.w); }
#pragma unroll
        for (int i = 0; i < 32; ++i) ss += f[i] * f[i];
        ss += __shfl_xor(ss, 16); ss += __shfl_xor(ss, 32);
        float inv = rsqrtf(ss * (1.f / 128.f) + EPS) * 0.08838834764831845f;
        if (r >= 8) inv = 0.f;
#pragma unroll
        for (int ks = 0; ks < 4; ++ks) { const f32x4 ga = *(const LAS f32x4*)(qgl + 32 * ks + 8 * g), gb = *(const LAS f32x4*)(qgl + 32 * ks + 8 * g + 4);
            v4u o; o.x = pk2(f[8 * ks] * inv * ga.x, f[8 * ks + 1] * inv * ga.y); o.y = pk2(f[8 * ks + 2] * inv * ga.z, f[8 * ks + 3] * inv * ga.w);
            o.z = pk2(f[8 * ks + 4] * inv * gb.x, f[8 * ks + 5] * inv * gb.y); o.w = pk2(f[8 * ks + 6] * inv * gb.z, f[8 * ks + 7] * inv * gb.w);
            qf[ks] = __builtin_bit_cast(bf16x8, o); }
    }
    LDS_WAIT();
    const int cnt = (pos + 1 < 256) ? pos + 1 : 256, nq = (cnt + 63) >> 6;
    const float slope = exp2f(-(float)((r & 7) + 1));
    float m_run = -INFINITY, l_run = 0.f;
    f32x4 O[8];
#pragma unroll
    for (int dt = 0; dt < 8; ++dt) O[dt] = (f32x4){0.f, 0.f, 0.f, 0.f};
    bf16x8 ka[4][4], kb[4][4];
#define AQ_LOAD(q_, k_) do { _Pragma("unroll") for (int kt = 0; kt < 4; ++kt) { int ix_ = SL[64 * (q_) + 16 * kt + r]; ix_ = (ix_ == 0xFFFF) ? 0 : ix_; \
        const bf16* kp_ = knb + (size_t)ix_ * 128 + 8 * g; _Pragma("unroll") for (int ks = 0; ks < 4; ++ks) k_[kt][ks] = *(const bf16x8*)(kp_ + 32 * ks); } } while (0)
#define AQ_PASS(q_, k_) do { \
        f32x4 sc[4]; \
        _Pragma("unroll") for (int kt = 0; kt < 4; ++kt) { f32x4 acc = (f32x4){0.f, 0.f, 0.f, 0.f}; \
            _Pragma("unroll") for (int ks = 0; ks < 4; ++ks) { acc = __builtin_amdgcn_mfma_f32_16x16x32_bf16(k_[kt][ks], qf[ks], acc, 0, 0, 0); \
                *(LAS bf16x8*)(KT + (16 * kt + r) * AQ_STRIDE + (32 * ks + 8 * g) * 2) = k_[kt][ks]; } \
            sc[kt] = acc; } \
        float m = m_run; \
        _Pragma("unroll") for (int kt = 0; kt < 4; ++kt) { const v2u s4 = *(const LAS v2u*)(SL + 64 * (q_) + 16 * kt + 4 * g); \
            const int i0 = s4.x & 0xFFFF, i1 = s4.x >> 16, i2 = s4.y & 0xFFFF, i3 = s4.y >> 16; \
            sc[kt][0] = (i0 != 0xFFFF) ? sc[kt][0] - slope * (float)(pos - i0) : -INFINITY; sc[kt][1] = (i1 != 0xFFFF) ? sc[kt][1] - slope * (float)(pos - i1) : -INFINITY; \
            sc[kt][2] = (i2 != 0xFFFF) ? sc[kt][2] - slope * (float)(pos - i2) : -INFINITY; sc[kt][3] = (i3 != 0xFFFF) ? sc[kt][3] - slope * (float)(pos - i3) : -INFINITY; \
            m = fmaxf(fmaxf(m, fmaxf(sc[kt][0], sc[kt][1])), fmaxf(sc[kt][2], sc[kt][3])); } \
        m = fmaxf(m, __shfl_xor(m, 16)); m = fmaxf(m, __shfl_xor(m, 32)); \
        const float alpha = __expf(m_run - m); \
        float ls = 0.f; \
        _Pragma("unroll") for (int kt = 0; kt < 4; ++kt) _Pragma("unroll") for (int rg = 0; rg < 4; ++rg) { const float e = __expf(sc[kt][rg] - m); sc[kt][rg] = e; ls += e; } \
        ls += __shfl_xor(ls, 16); ls += __shfl_xor(ls, 32); \
        l_run = l_run * alpha + ls; m_run = m; \
        _Pragma("unroll") for (int rg = 0; rg < 4; ++rg) { const float ah = __shfl(alpha, 4 * g + rg); _Pragma("unroll") for (int dt = 0; dt < 8; ++dt) O[dt][rg] *= ah; } \
        _Pragma("unroll") for (int c = 0; c < 2; ++c) { v4u o_; o_.x = pk2(sc[2 * c][0], sc[2 * c][1]); o_.y = pk2(sc[2 * c][2], sc[2 * c][3]); o_.z = pk2(sc[2 * c + 1][0], sc[2 * c + 1][1]); o_.w = pk2(sc[2 * c + 1][2], sc[2 * c + 1][3]); \
            const bf16x8 pa = __builtin_bit_cast(bf16x8, o_); \
            _Pragma("unroll") for (int dt = 0; dt < 8; ++dt) { \
                const v4s b0 = __builtin_amdgcn_ds_read_tr16_b64_v4i16((LAS v4s*)(tb + (32 * c) * AQ_STRIDE + 32 * dt)); \
                const v4s b1 = __builtin_amdgcn_ds_read_tr16_b64_v4i16((LAS v4s*)(tb + (32 * c + 16) * AQ_STRIDE + 32 * dt)); \
                const bf16x8 bfr = __builtin_shufflevector(b0, b1, 0, 1, 2, 3, 4, 5, 6, 7); \
                O[dt] = __builtin_amdgcn_mfma_f32_16x16x32_bf16(pa, bfr, O[dt], 0, 0, 0); } } \
        __builtin_amdgcn_sched_barrier(0); } while (0)
    const LAS unsigned char* tb = KT + (4 * g + (r >> 2)) * AQ_STRIDE + 8 * (r & 3);
    AQ_LOAD(0, ka);
    AQ_LOAD(1, kb);
    AQ_PASS(0, ka);
    AQ_LOAD(2, ka);
    if (nq > 1) AQ_PASS(1, kb);
    AQ_LOAD(3, kb);
    if (nq > 2) AQ_PASS(2, ka);
    if (nq > 3) AQ_PASS(3, kb);
#undef AQ_LOAD
#undef AQ_PASS
    const float il = 1.f / l_run;
    if (true) {
        float ih[4];
#pragma unroll
        for (int rg = 0; rg < 4; ++rg) ih[rg] = __shfl(il, 4 * g + rg);
        if (g < 2) {
#pragma unroll
            for (int rg = 0; rg < 4; ++rg)
#pragma unroll
                for (int dt = 0; dt < 8; ++dt) yab[(size_t)t * YW + (4 * g + rg) * 128 + 16 * dt + r] = (bf16)f2bf(O[dt][rg] * ih[rg]);
        }
    }
    LDS_WAIT();
}

__device__ __forceinline__ void phase4(const Args& a, LAS unsigned char* lds) {
    const int bid = blockIdx.x, G = gridDim.x, tid = threadIdx.x, lane = tid & 63, wave = tid >> 6;
    const int nscan = (G >= 64) ? 32 : 0;
#ifndef P4_REP
#define P4_REP 0
#endif
    if (nscan && bid < 32) { gdn_scan(a, lds, bid); if (P4_REP & 1) { __syncthreads(); gdn_scan(a, lds, bid); } return; }
    if (!nscan) { for (int bh = bid; bh < 32; bh += G) gdn_scan(a, lds, bh); __syncthreads(); }
    LAS float* qg4 = (LAS float*)(lds + 8 * AQ_WAVE_LDS);
    if (tid < 128) qg4[tid] = a.in[5][tid];
    __syncthreads();
    LAS unsigned char* wl4 = lds + wave * AQ_WAVE_LDS;
    if (nscan == 32 && (G & 7) == 0) {
        const int bb = bid & 7, wl_i = ((bid - 32) >> 3) * 8 + wave, nwl = ((G - 32) >> 3) * 8;
        for (int p = wl_i; p < SEQ; p += nwl) attn_query_q4(a, wl4, qg4, bb * SEQ + p, lane);
        if (P4_REP & 2) for (int p = wl_i; p < SEQ; p += nwl) attn_query_q4(a, wl4, qg4, bb * SEQ + p, lane);
    } else {
        const int gw = (bid - nscan) * 8 + wave, NGW = (G - nscan) * 8;
        for (int t = gw; t < T_TOK; t += NGW) attn_query_q4(a, wl4, qg4, t, lane);
    }
}

#define INS16P(L, v_) do { float _x = (v_); \
    _Pragma("unroll") for (int _k = 0; _k < 16; ++_k) { const float _h = __builtin_fmaxf(L[_k], _x); _x = __builtin_fminf(L[_k], _x); L[_k] = _h; } } while (0)
#define CE_D(a_, b_) do { const float _h = __builtin_fmaxf(a_, b_), _l = __builtin_fminf(a_, b_); a_ = _h; b_ = _l; } while (0)
#define SORT16_DESC(A) do { \
    _Pragma("unroll") for (int k_ = 2; k_ <= 16; k_ <<= 1) \
    _Pragma("unroll") for (int j_ = k_ >> 1; j_ > 0; j_ >>= 1) \
    _Pragma("unroll") for (int i_ = 0; i_ < 16; ++i_) { const int l_ = i_ ^ j_; if (l_ > i_) { if ((i_ & k_) == 0) CE_D(A[i_], A[l_]); else CE_D(A[l_], A[i_]); } } } while (0)
#define MERGE16_TOP(L, B) do { \
    _Pragma("unroll") for (int i_ = 0; i_ < 16; ++i_) L[i_] = __builtin_fmaxf(L[i_], B[15 - i_]); \
    _Pragma("unroll") for (int j_ = 8; j_ > 0; j_ >>= 1) \
    _Pragma("unroll") for (int i_ = 0; i_ < 16; ++i_) { const int l_ = i_ ^ j_; if (l_ > i_) CE_D(L[i_], L[l_]); } } while (0)
__device__ __forceinline__ float packf(float v, unsigned id, unsigned mask) { return __uint_as_float((__float_as_uint(v) & ~mask) | id); }

__device__ __forceinline__ void peer_route_unit(const Args& a, LAS float* SC, int tt, int p, int lane) {
    const bf16* query = (const bf16*)(a.ws + WS_QUERY); const bf16* subk = (const bf16*)(a.ws + WS_SUBK);
    int* expid = (int*)(a.ws + WS_EXPID); float* gate = (float*)(a.ws + WS_GATE);
    const int r = lane & 15, g = lane >> 4;
    const int tok = lane & 31, ch = lane >> 5;
    float L1[16], L2[16];
#pragma unroll
    for (int k = 0; k < 16; ++k) { L1[k] = 0.f; L2[k] = 0.f; }
#pragma unroll 1
    for (int half = 0; half < 2; ++half) {
        bf16x8 bk[8][4];
        {
            const bf16* kp = subk + (size_t)((p * 2 + half) * 128 + r) * 128 + 8 * g;
#pragma unroll
            for (int nt = 0; nt < 8; ++nt)
#pragma unroll
                for (int ks = 0; ks < 4; ++ks) bk[nt][ks] = *(const bf16x8*)(kp + (size_t)nt * 16 * 128 + 32 * ks);
        }
        bf16x8 af[2][4];
#pragma unroll
        for (int mt = 0; mt < 2; ++mt) {
            const bf16* qp = query + (size_t)(tt * 32 + mt * 16 + r) * 2048 + p * 256 + half * 128 + 8 * g;
#pragma unroll
            for (int ks = 0; ks < 4; ++ks) af[mt][ks] = *(const bf16x8*)(qp + 32 * ks);
        }
#pragma unroll
        for (int mt = 0; mt < 2; ++mt) {
#pragma unroll
            for (int nt = 0; nt < 8; ++nt) {
                f32x4 acc = (f32x4){0.f, 0.f, 0.f, 0.f};
#pragma unroll
                for (int ks = 0; ks < 4; ++ks) acc = __builtin_amdgcn_mfma_f32_16x16x32_bf16(af[mt][ks], bk[nt][ks], acc, 0, 0, 0);
#pragma unroll
                for (int rg = 0; rg < 4; ++rg) SC[(mt * 16 + 4 * g + rg) * 132 + nt * 16 + r] = acc[rg];
            }
        }
        LDS_WAIT();
        float L[16];
#pragma unroll
        for (int c16 = 0; c16 < 4; ++c16) {
            float B[16];
#pragma unroll
            for (int c4 = 0; c4 < 4; ++c4) {
                const f32x4 v = *(const LAS f32x4*)(SC + tok * 132 + 64 * ch + 16 * c16 + 4 * c4);
                const unsigned n0 = 64 * ch + 16 * c16 + 4 * c4;
                B[4 * c4] = packf(v.x, n0, 127u); B[4 * c4 + 1] = packf(v.y, n0 + 1, 127u); B[4 * c4 + 2] = packf(v.z, n0 + 2, 127u); B[4 * c4 + 3] = packf(v.w, n0 + 3, 127u);
            }
            SORT16_DESC(B);
            if (c16 == 0) {
#pragma unroll
                for (int k = 0; k < 16; ++k) L[k] = B[k];
            } else MERGE16_TOP(L, B);
        }
        {
            float B[16];
#pragma unroll
            for (int k = 0; k < 16; ++k) B[k] = __shfl(L[k], tok + 32);
            MERGE16_TOP(L, B);
        }
#pragma unroll
        for (int k = 0; k < 16; ++k) { L1[k] = (half == 0) ? L[k] : L1[k]; L2[k] = (half == 0) ? L2[k] : L[k]; }
        LDS_WAIT();
    }
    float V1[16], V2[16];
#pragma unroll
    for (int k = 0; k < 16; ++k) { V1[k] = __uint_as_float(__float_as_uint(L1[k]) & ~127u); V2[k] = __uint_as_float(__float_as_uint(L2[k]) & ~127u); }
    float C[16];
#pragma unroll
    for (int k = 0; k < 16; ++k) C[k] = -INFINITY;
#pragma unroll
    for (int i = 0; i < 16; ++i)
#pragma unroll
        for (int j = 0; j < 16; ++j)
            if ((i + 1) * (j + 1) <= 16) INS16P(C, packf(V1[i] + V2[j], (unsigned)(i * 16 + j), 255u));
    if (ch == 0) {
        float e[16], sum = 0.f; int ex[16];
        const float c0 = __uint_as_float(__float_as_uint(C[0]) & ~255u);
#pragma unroll
        for (int k = 0; k < 16; ++k) {
            const unsigned cb = __float_as_uint(C[k]); const int ci = (cb >> 4) & 15, cj = cb & 15;
            int i1 = 0, i2 = 0;
#pragma unroll
            for (int m = 0; m < 16; ++m) { i1 = (ci == m) ? (int)(__float_as_uint(L1[m]) & 127u) : i1; i2 = (cj == m) ? (int)(__float_as_uint(L2[m]) & 127u) : i2; }
            ex[k] = i1 * 128 + i2;
            e[k] = __expf(__uint_as_float(cb & ~255u) - c0); sum += e[k];
        }
        const float inv = 1.f / sum;
        const size_t base = ((size_t)(tt * 32 + tok) * 8 + p) * 16;
#pragma unroll
        for (int q = 0; q < 4; ++q) {
            *(v4u*)(expid + base + 4 * q) = (v4u){(unsigned)ex[4 * q], (unsigned)ex[4 * q + 1], (unsigned)ex[4 * q + 2], (unsigned)ex[4 * q + 3]};
            *(f32x4*)(gate + base + 4 * q) = (f32x4){e[4 * q] * inv, e[4 * q + 1] * inv, e[4 * q + 2] * inv, e[4 * q + 3] * inv};
        }
    }
}
__device__ __forceinline__ void phase8(const Args& a, LAS unsigned char* lds) {
    const int tid = threadIdx.x, lane = tid & 63, wave = tid >> 6;
    LAS float* SC = (LAS float*)(lds + wave * 16896);
    const int gw = blockIdx.x * 8 + wave, NGW = gridDim.x * 8;
#ifndef P8_REP
#define P8_REP 1
#endif
    for (int rep_ = 0; rep_ < P8_REP; ++rep_)
    for (int u = gw; u < 1024 * 8; u += NGW) peer_route_unit(a, SC, u >> 3, u & 7, lane);
}

typedef float f32x2 __attribute__((ext_vector_type(2)));
__device__ __forceinline__ void cvt8(const v4u u, float* f) { f[0] = bflo(u.x); f[1] = bfhi(u.x); f[2] = bflo(u.y); f[3] = bfhi(u.y); f[4] = bflo(u.z); f[5] = bfhi(u.z); f[6] = bflo(u.w); f[7] = bfhi(u.w); }
__device__ __forceinline__ void cvt16_fp8(const v4u u, float* f) {
#pragma unroll
    for (int q = 0; q < 4; ++q) { const f32x2 lo = __builtin_amdgcn_cvt_pk_f32_fp8((int)u[q], false), hi = __builtin_amdgcn_cvt_pk_f32_fp8((int)u[q], true);
        f[4 * q] = lo.x; f[4 * q + 1] = lo.y; f[4 * q + 2] = hi.x; f[4 * q + 3] = hi.y; }
}
#define DPPF(x_, ctrl_) __builtin_bit_cast(float, __builtin_amdgcn_update_dpp(0, __builtin_bit_cast(int, (x_)), (ctrl_), 0xF, 0xF, false))
__device__ __forceinline__ float reduce8(const float* d, int lane) {
    const bool b0 = lane & 1, b1 = lane & 2, b2 = lane & 4;
    float s1[4], s2[2];
#pragma unroll
    for (int i = 0; i < 4; ++i) { const float a = b0 ? d[2 * i + 1] : d[2 * i], b = b0 ? d[2 * i] : d[2 * i + 1]; s1[i] = a + DPPF(b, 0xB1); }
#pragma unroll
    for (int i = 0; i < 2; ++i) { const float a = b1 ? s1[2 * i + 1] : s1[2 * i], b = b1 ? s1[2 * i] : s1[2 * i + 1]; s2[i] = a + DPPF(b, 0x4E); }
    const float a3 = b2 ? s2[1] : s2[0], b3 = b2 ? s2[0] : s2[1];
    float s = a3 + DPPF(b3, 0x124);
    s += DPPF(s, 0x128);
    s += __shfl_xor(s, 16); s += __shfl_xor(s, 32);
    return s;
}
#ifndef P9L_G
#define P9L_G 8
#endif
constexpr int P9LG = P9L_G, P9LP = 128 + P9LG;
constexpr int P9L_WAVE = 4 * (P9LP * 4 * 3);
#ifndef P9L_SH
#define P9L_SH 12
#endif
constexpr int P9L_NS = 16384 >> P9L_SH;
__device__ __forceinline__ void phase9l(const Args& a, LAS unsigned char* lds) {
    const int tid = threadIdx.x, lane = tid & 63, wave = tid >> 6, G = gridDim.x;
    const unsigned char* UT = a.ws + WS_UT; const unsigned char* VT = a.ws + WS_VT;
    const float* SU = (const float*)(a.ws + WS_SU); const float* SV = (const float*)(a.ws + WS_SV);
    const int* expid = (const int*)(a.ws + WS_EXPID); const float* gate = (const float*)(a.ws + WS_GATE);
    const float* mod = (const float*)(a.ws + WS_MOD);
    LAS int* LE = (LAS int*)(lds + wave * P9L_WAVE);
    LAS float* LG = (LAS float*)(LE + 4 * P9LP);
    LAS float* LA = LG + 4 * P9LP;
    const bool isdiag = (lane >> 4) == ((lane & 15) >> 2);
    for (int rd = 0; ; ++rd) {
        const int tb = ((rd * G + (int)blockIdx.x) * 8 + wave) * 4;
        if (tb >= T_TOK) break;
        v4u h8[4]; float hsc[4]; int off[4][P9L_NS + 1];
#pragma unroll
        for (int i = 0; i < 4; ++i) {
            const size_t t = (size_t)(tb + i);
            h8[i] = *(const v4u*)(a.ws + WS_H8 + t * DM + 16 * lane); hsc[i] = ((const float*)(a.ws + WS_HS))[t];
            int e[2]; float gq[2];
#pragma unroll
            for (int q = 0; q < 2; ++q) { e[q] = expid[t * 128 + lane + 64 * q]; gq[q] = gate[t * 128 + lane + 64 * q]; }
            int base = 0;
#pragma unroll
            for (int s = 0; s < P9L_NS; ++s) {
                off[i][s] = base;
#pragma unroll
                for (int q = 0; q < 2; ++q) {
                    const bool in = (e[q] >> P9L_SH) == s;
                    const unsigned long long mk = __builtin_amdgcn_ballot_w64(in);
                    const int pos = base + __builtin_amdgcn_mbcnt_hi((unsigned)(mk >> 32), __builtin_amdgcn_mbcnt_lo((unsigned)mk, 0));
                    if (in) { LE[i * P9LP + pos] = e[q]; LG[i * P9LP + pos] = gq[q]; }
                    base += __builtin_popcountll(mk);
                }
            }
            off[i][P9L_NS] = 128;
            if (lane < P9LG) LE[i * P9LP + 128 + lane] = e[0];
        }
        LDS_WAIT();
#pragma unroll 1
        for (int s = 0; s < P9L_NS; ++s) {
#pragma unroll
            for (int i = 0; i < 4; ++i) {
                for (int g0 = off[i][s]; g0 < off[i][s + 1]; g0 += P9LG) {
                    const int n = off[i][s + 1] - g0;
                    const int ev = LE[i * P9LP + g0 + (lane & (P9LG - 1))];
                    v4u ua[P9LG];
#pragma unroll
                    for (int k = 0; k < P9LG; ++k) { const int e = __builtin_amdgcn_readlane(ev, k); ua[k] = *(const v4u*)(UT + (size_t)e * 1024 + 16 * lane); }
                    const long hlo = (long)(((unsigned long long)h8[i].y << 32) | h8[i].x), hhi = (long)(((unsigned long long)h8[i].w << 32) | h8[i].z);
#pragma unroll
                    for (int k8 = 0; k8 < P9LG; k8 += 8) {
                        float dd[8];
#pragma unroll
                        for (int k = 0; k < 8; ++k) {
                            f32x4 cacc = (f32x4){0.f, 0.f, 0.f, 0.f};
                            cacc = __builtin_amdgcn_mfma_f32_16x16x32_fp8_fp8((long)(((unsigned long long)ua[k8 + k].y << 32) | ua[k8 + k].x), hlo, cacc, 0, 0, 0);
                            cacc = __builtin_amdgcn_mfma_f32_16x16x32_fp8_fp8((long)(((unsigned long long)ua[k8 + k].w << 32) | ua[k8 + k].z), hhi, cacc, 0, 0, 0);
                            const float c01 = (lane & 1) ? cacc[1] : cacc[0], c23 = (lane & 1) ? cacc[3] : cacc[2];
                            dd[k] = isdiag ? ((lane & 2) ? c23 : c01) : 0.f;
                        }
                        const float tot = reduce8(dd, lane);
                        if (lane < 8 && k8 + lane < n) LA[i * P9LP + g0 + k8 + lane] = tot;
                        __builtin_amdgcn_sched_barrier(0);
                    }
                }
            }
        }
        LDS_WAIT();
#pragma unroll
        for (int i = 0; i < 4; ++i)
#pragma unroll
            for (int q = 0; q < 2; ++q) { const int ix = i * P9LP + lane + 64 * q; const int e = LE[ix];
                const float dq = LA[ix] * SU[e] * hsc[i];
                LA[ix] = 0.5f * dq * (1.f + erff(dq * 0.70710678118654752f)) * LG[ix] * SV[e]; }
        LDS_WAIT();
        float y[4][16];
#pragma unroll
        for (int i = 0; i < 4; ++i)
#pragma unroll
            for (int c = 0; c < 16; ++c) y[i][c] = 0.f;
#pragma unroll 1
        for (int s = 0; s < P9L_NS; ++s) {
#pragma unroll
            for (int i = 0; i < 4; ++i) {
                for (int g0 = off[i][s]; g0 < off[i][s + 1]; g0 += P9LG) {
                    const int n = off[i][s + 1] - g0;
                    const int ev = LE[i * P9LP + g0 + (lane & (P9LG - 1))];
                    const float av = ((lane & (P9LG - 1)) < n) ? LA[i * P9LP + g0 + (lane & (P9LG - 1))] : 0.f;
                    v4u va[P9LG];
#pragma unroll
                    for (int k = 0; k < P9LG; ++k) { const int e = __builtin_amdgcn_readlane(ev, k); va[k] = *(const v4u*)(VT + (size_t)e * 1024 + 16 * lane); }
#pragma unroll
                    for (int k = 0; k < P9LG; ++k) { const float aj = __builtin_bit_cast(float, __builtin_amdgcn_readlane(__builtin_bit_cast(int, av), k));
                        float f[16]; cvt16_fp8(va[k], f);
#pragma unroll
                        for (int c = 0; c < 16; ++c) y[i][c] = __builtin_fmaf(aj, f[c], y[i][c]);
                        if ((k & 3) == 3) __builtin_amdgcn_sched_barrier(0); }
                }
            }
        }
#pragma unroll
        for (int i = 0; i < 4; ++i) {
            const int t = tb + i, b = t >> 12;
            float* orow = a.out + (size_t)t * DM + 16 * lane; const float* g2 = mod + b * 6144 + 5120 + 16 * lane;
#pragma unroll
            for (int q4 = 0; q4 < 4; ++q4) {
                const f32x4 xv = *(const f32x4*)(orow + 4 * q4), gv = *(const f32x4*)(g2 + 4 * q4);
                const f32x4 yv = (f32x4){y[i][4 * q4], y[i][4 * q4 + 1], y[i][4 * q4 + 2], y[i][4 * q4 + 3]};
                *(f32x4*)(orow + 4 * q4) = xv + gv * yv;
            }
        }
        LDS_WAIT();
    }
}

#define XB_TMO      128
#define XB_XCNT(j)  (256  + 64 * (j))
#define XB_XSUB(j)  (1280 + 64 * (j))
#define XB_XGEN(j)  (2304 + 64 * (j))
#define XB_TOP      3328
#define XB_TOPGEN   3392
#define XCD_BAR_WORDS 3456
#define XB_SPIN_CAP (1u << 18)

__device__ __forceinline__ unsigned xb_ld(unsigned* p)              { return __hip_atomic_load(p, __ATOMIC_RELAXED, __HIP_MEMORY_SCOPE_AGENT); }
__device__ __forceinline__ unsigned xb_add(unsigned* p, unsigned v) { return __hip_atomic_fetch_add(p, v, __ATOMIC_RELAXED, __HIP_MEMORY_SCOPE_AGENT); }
__device__ __forceinline__ unsigned xb_xcc_id() { return (unsigned)__builtin_amdgcn_s_getreg((3 << 11) | 20) & 0xFu; }
#define XB_SPIN(cond, bar) do { unsigned _sp = 0; while (cond) { __builtin_amdgcn_s_sleep(1); \
    if ((++_sp & 255u) == 0u) { if (xb_ld(&(bar)[XB_TMO])) break; if (_sp > XB_SPIN_CAP) { atomicAdd(&(bar)[XB_TMO], 1u); break; } } } } while (0)

struct XcdBarrier {
    unsigned* bar; unsigned x;
    volatile LAS unsigned* st;
};

__device__ __forceinline__ XcdBarrier xcd_barrier_post(unsigned* bar, volatile LAS unsigned* st) {
    XcdBarrier b; b.bar = bar; b.x = xb_xcc_id(); b.st = st;
    if (threadIdx.x == 0) (void)xb_add(&bar[XB_XCNT(b.x)], 1u);
    return b;
}
__device__ __forceinline__ void xcd_barrier_complete(unsigned* bar, unsigned x, unsigned& nloc, unsigned& nx) {
    const unsigned G = gridDim.x * gridDim.y * gridDim.z;
    unsigned sum, cnt, mine, sp = 0u;
    for (;;) {
        sum = 0u; cnt = 0u; mine = 0u;
#pragma unroll
        for (unsigned j = 0; j < 16; ++j) { const unsigned c = xb_ld(&bar[XB_XCNT(j)]); sum += c; cnt += (c > 0u) ? 1u : 0u; mine = (j == x) ? c : mine; }
        if (sum == G) break;
        __builtin_amdgcn_s_sleep(1);
        if ((++sp & 255u) == 0u) { if (xb_ld(&bar[XB_TMO])) break; if (sp > XB_SPIN_CAP) { atomicAdd(&bar[XB_TMO], 1u); break; } }
    }
    nloc = mine > 0u ? mine : 1u; nx = cnt > 0u ? cnt : 1u;
}

__device__ __forceinline__ void xcd_barrier(const XcdBarrier& b) {
    asm volatile("s_waitcnt vmcnt(0)" ::: "memory");
    __syncthreads();
    if (threadIdx.x == 0) {
        unsigned* bar = b.bar;
        __builtin_amdgcn_s_waitcnt(0);
        unsigned nloc = b.st[0], nx = b.st[1];
        if (nloc == 0u) { xcd_barrier_complete(bar, b.x, nloc, nx); b.st[0] = nloc; b.st[1] = nx; }
        const unsigned old = xb_add(&bar[XB_XSUB(b.x)], 1u);
        const unsigned gen = old / nloc;
        if (old + 1u == (gen + 1u) * nloc) {
            __builtin_amdgcn_fence(__ATOMIC_RELEASE, "agent");
            asm volatile("s_waitcnt vmcnt(0)" ::: "memory");
            const unsigned og = xb_add(&bar[XB_TOP], 1u);
            const unsigned tg = og / nx;
            if (og + 1u == (tg + 1u) * nx) xb_add(&bar[XB_TOPGEN], 1u);
            else XB_SPIN(xb_ld(&bar[XB_TOPGEN]) == tg, bar);
            __builtin_amdgcn_fence(__ATOMIC_ACQUIRE, "agent");
            xb_add(&bar[XB_XGEN(b.x)], 1u);
            asm volatile("s_waitcnt vmcnt(0)" ::: "memory");
        } else {
            XB_SPIN(xb_ld(&bar[XB_XGEN(b.x)]) == gen, bar);
            __builtin_amdgcn_fence(__ATOMIC_ACQUIRE, "agent");
            asm volatile("s_waitcnt vmcnt(0)" ::: "memory");
        }
    }
    __syncthreads();
}

__global__ void __launch_bounds__(512, 2) mega_fwd(Args a) {
    extern __shared__ __attribute__((aligned(16))) unsigned char lds_raw[];
    LAS unsigned char* lds = (LAS unsigned char*)lds_raw;
    asm volatile("" : "+v"(lds));
    cg::grid_group grid = cg::this_grid();
#define MISC_PTR ((volatile LAS unsigned*)((LAS unsigned char*)lds_raw + (LDS_BYTES - 64)))
    if (threadIdx.x < 16) MISC_PTR[threadIdx.x] = 0u;
    __syncthreads();
    const unsigned xcc_id = xcd_barrier_post((unsigned*)(a.ws + WS_CTL) + 4096, MISC_PTR).x;
    grid.sync();
    unsigned char* ws = a.ws;
    const int lo = a.ph_lo, hi = a.ph_hi;
#ifndef PH_MASK
#define PH_MASK 0x3ff
#endif
#define IN(k) (((PH_MASK >> (k)) & 1) && lo <= (k) && (k) < hi)
#define SEAM(k) do { if (IN(k) && IN((k) + 1)) { if ((k) == 99) grid.sync(); else { XcdBarrier xb_; xb_.bar = (unsigned*)(a.ws + WS_CTL) + 4096; xb_.x = xcc_id; xb_.st = MISC_PTR; xcd_barrier(xb_); } } } while (0)
#ifndef REP_MASK
#define REP_MASK 0
#endif
#define RUNP(k, body) do { if (IN(k)) { body; if ((REP_MASK >> (k)) & 1) { grid.sync(); body; } } } while (0)
    RUNP(0, phase0(a, lds)); SEAM(0);
    RUNP(1, phase_norm(a.in[0], (const float*)(ws + WS_MOD), 0, 1024, (bf16*)(ws + WS_H))); SEAM(1);
    RUNP(2, ({
        pg8::Gemm g{(const pg8::bf16_t*)(ws + WS_H), (const pg8::bf16_t*)(ws + WS_WIN), T_TOK, PW, DM}; pg8::StaticOrder S; S.init(T_TOK, PW, gridDim.x, blockIdx.x);
        EpiBf E{(bf16*)(ws + WS_PROJ), PW};
        pg8::gemm_phase<EpiBf, pg8::StaticOrder>(lds, g, S, E, nullptr); })); SEAM(2);
#ifdef IDX_FP32
    if (IN(3)) { phase_idx32(a, lds); grid.sync(); }
#endif
    RUNP(3, phase3(a, lds)); SEAM(3);
    RUNP(4, phase4(a, lds)); SEAM(4);
    RUNP(5, ({
        pg8::Gemm g{(const pg8::bf16_t*)(ws + WS_YAB), (const pg8::bf16_t*)(ws + WS_BT2), T_TOK, DM, YW}; pg8::StaticOrder S; S.init(T_TOK, DM, gridDim.x, blockIdx.x);
        EpiX1 E{a.in[0], a.out, (const float*)(ws + WS_MOD)};
        pg8::gemm_phase<EpiX1, pg8::StaticOrder>(lds, g, S, E, nullptr); })); SEAM(5);
    RUNP(6, phase_norm(a.out, (const float*)(ws + WS_MOD), 3072, 4096, (bf16*)(ws + WS_H), ws + WS_H8, (float*)(ws + WS_HS))); SEAM(6);
    RUNP(7, ({
        pg8::Gemm g{(const pg8::bf16_t*)(ws + WS_H), (const pg8::bf16_t*)(ws + WS_WQ), T_TOK, 2048, DM}; pg8::StaticOrder S; S.init(T_TOK, 2048, gridDim.x, blockIdx.x);
        EpiBf E{(bf16*)(ws + WS_QUERY), 2048};
        pg8::gemm_phase<EpiBf, pg8::StaticOrder>(lds, g, S, E, nullptr); })); SEAM(7);
    RUNP(8, phase8(a, lds)); SEAM(8);
    if (IN(9)) { phase9l(a, lds); }
#undef IN
#undef SEAM
}

#ifndef MK_N_LAUNCHES
#define MK_N_LAUNCHES 1
#endif
extern "C" void kernel_launch(void* const* d_in, const int* in_sizes, int n_in, void* d_out, int out_size, void* d_ws, size_t ws_size, hipStream_t stream) {
    static int grid = 0;
    if (grid == 0) {
        int dev = 0, cus = 0, per_cu = 0;
        hipGetDevice(&dev);
        hipDeviceGetAttribute(&cus, hipDeviceAttributeMultiprocessorCount, dev);
        hipFuncSetAttribute((const void*)mega_fwd, hipFuncAttributeMaxDynamicSharedMemorySize, LDS_BYTES);
        hipOccupancyMaxActiveBlocksPerMultiprocessor(&per_cu, (const void*)mega_fwd, 512, LDS_BYTES);
        if (per_cu < 1) { fprintf(stderr, "kernel_launch: occupancy query says %d blocks per CU\n", per_cu); per_cu = 1; }
        grid = cus * 1;
        if (n_in != 17 || ws_size < WS_END) fprintf(stderr, "kernel_launch: unexpected n_in %d / ws_size %zu\n", n_in, ws_size);
    }
    (void)hipMemsetAsync((char*)d_ws + WS_CTL, 0, 65536, stream);
    Args a{};
    for (int i = 0; i < 17; ++i) a.in[i] = (const float*)d_in[i];
    a.out = (float*)d_out; a.ws = (unsigned char*)d_ws;
#if MK_N_LAUNCHES == 1
    a.ph_lo = 0; a.ph_hi = 10;
    void* args[] = {&a};
    hipError_t e = hipLaunchCooperativeKernel((const void*)mega_fwd, dim3(grid), dim3(512), args, LDS_BYTES, stream);
    if (e != hipSuccess) fprintf(stderr, "cooperative launch failed: %s (grid %d)\n", hipGetErrorString(e), grid);
#else
    for (int p = 0; p < 10; ++p) { a.ph_lo = p; a.ph_hi = p + 1; hipLaunchKernelGGL(mega_fwd, dim3(grid), dim3(512), LDS_BYTES, stream, a); }
#endif
}
```

```cpp
#include <hip/hip_runtime.h>
#include <hip/hip_cooperative_groups.h>
#include <cstdio>
#include <cstdint>
namespace cg = cooperative_groups;
namespace pg8 {
#define PG8_LAS __attribute__((address_space(3)))
typedef unsigned short bf16_t;
typedef short bf16x8 __attribute__((ext_vector_type(8)));
typedef float f32x4 __attribute__((ext_vector_type(4)));
typedef unsigned u32x4 __attribute__((ext_vector_type(4)));
constexpr int BM = 256, BK = 64, HALF = 128, HTB = HALF * BK * 2  , STAGE_BYTES = 8 * HTB, NXCD = 8, WGM = 8;

__host__ __device__ __forceinline__ int lds_byte(int r, int c) { const int st = (r >> 4) * 2 + (c >> 5), rr = r & 15, cc = c & 31, ob = rr * 64 + cc * 2; return st * 1024 + (ob ^ (((ob >> 9) & 1) << 5)); }
__host__ __device__ __forceinline__ void stage_rc(int b, int& R, int& C) { const int st = b / 1024, sb = b % 1024, swz = sb ^ (((sb >> 9) & 1) << 5); R = (st >> 1) * 16 + swz / 64; C = (st & 1) * 32 + (swz % 64) / 2; }
__host__ __device__ __forceinline__ int perm32(int rho) { const int n = rho >> 4, i = rho & 15; return 8 * (i >> 2) + 4 * n + (i & 3); }

struct Unit { int pm, pn; };
struct Gemm { const bf16_t* A; const bf16_t* Bt; int M, N, K; };

struct StaticOrder {
    int nM, nN, nwg, G, c;
    __host__ __device__ void init(int M, int N, int G_, int c_) { nM = M / BM; nN = N / BM; nwg = nM * nN; G = G_; c = c_; }
    __host__ __device__ bool next(int i, Unit& u) const {
        const long L = (long)i * G + c; if (L >= nwg) return false;
        int wgid = (int)L; { const int q = nwg / NXCD, r = nwg % NXCD, xcd = wgid % NXCD, off = wgid / NXCD; wgid = (xcd < r ? xcd * (q + 1) : r * (q + 1) + (xcd - r) * q) + off; }
        const int nig = WGM * nN, gid = wgid / nig, fm = gid * WGM, gsz = (nM - fm) < WGM ? (nM - fm) : WGM;
        u.pm = fm + ((wgid % nig) % gsz); u.pn = (wgid % nig) / gsz; return true;
    }
    __device__ __forceinline__ void a_ready(const Unit&) const {}
    __device__ __forceinline__ void done(const Unit&) const {}
};
__device__ __forceinline__ unsigned cvt_pk_bf16(float lo, float hi) { unsigned r; asm volatile("v_cvt_pk_bf16_f32 %0, %1, %2" : "=v"(r) : "v"(lo), "v"(hi)); return r; }
template <class Epi, class Sched, bool ALIGN_EPI = false, bool SP2 = false>
__device__ __forceinline__ void gemm_phase(PG8_LAS unsigned char* lds, const Gemm g, const Sched& S, const Epi& E) {
    const int tid = threadIdx.x, wid = __builtin_amdgcn_readfirstlane(tid >> 6), lane = tid & 63, wr = wid >> 2, wc = wid & 3, fr = lane & 15, fq = lane >> 4;
    const int K = g.K, nt = K / BK;
    unsigned voffA[2], voffB[2];
#pragma unroll
    for (int i = 0; i < 2; ++i) { int R, C; stage_rc(tid * 16 + i * 8192, R, C); const int Rb = Epi::PERM ? ((R & ~31) + perm32(R & 31)) : R;
        voffA[i] = (unsigned)(R * K + C) * 2u; voffB[i] = (unsigned)(Rb * K + C) * 2u; }
    const size_t kstep = (size_t)(BK * 2);
    const size_t hstep = (size_t)HALF * K * 2;
    const size_t tstep = 2 * hstep;
    const unsigned ldsw = (unsigned)wid * 1024u;
    const int aoff = lds_byte(wr * 64 + fr, fq * 8), boff = lds_byte(wc * 32 + fr, fq * 8);
#define PG8_SA(b, h) (((b) * 2 + (h)) * HTB)
#define PG8_SB(b, h) ((4 + (b) * 2 + (h)) * HTB)
#define PG8_STAGE(bufoff, gbase, voff) do { _Pragma("unroll") for (int _i = 0; _i < 2; ++_i) \
        __builtin_amdgcn_global_load_lds((const unsigned*)((const char*)(gbase) + (voff)[_i]), (PG8_LAS unsigned*)(lds + (bufoff) + ldsw + _i * 8192), 16, 0, 0); } while (0)
#define PG8_LDA(dst, b, h) do { _Pragma("unroll") for (int m = 0; m < 4; ++m) _Pragma("unroll") for (int k = 0; k < 2; ++k) dst[m][k] = *(const PG8_LAS bf16x8*)(lds + PG8_SA(b, h) + aoff + m * 2048 + k * 1024); } while (0)
#define PG8_LDB(dst, b, h) do { _Pragma("unroll") for (int n = 0; n < 2; ++n) _Pragma("unroll") for (int k = 0; k < 2; ++k) dst[n][k] = *(const PG8_LAS bf16x8*)(lds + PG8_SB(b, h) + boff + n * 2048 + k * 1024); } while (0)
#define PG8_MMA(ai, bj, At, Bt) do { __builtin_amdgcn_s_setprio(1); _Pragma("unroll") for (int m = 0; m < 4; ++m) _Pragma("unroll") for (int n = 0; n < 2; ++n) _Pragma("unroll") for (int k = 0; k < 2; ++k) \
        acc[ai][bj][m][n] = __builtin_amdgcn_mfma_f32_16x16x32_bf16(Bt[n][k], At[m][k], acc[ai][bj][m][n], 0, 0, 0); __builtin_amdgcn_s_setprio(0); } while (0)
#define PG8_WAIT_V(n) asm volatile("s_waitcnt vmcnt(" #n ")" ::: "memory")
#define PG8_WAIT_L(n) asm volatile("s_waitcnt lgkmcnt(" #n ")" ::: "memory")
#define PG8_BAR __builtin_amdgcn_s_barrier()
#define PG8_SCHED __builtin_amdgcn_sched_barrier(0)
    Unit cur, nxt; int ui = 0;
    if (!S.next(0, cur)) return;
    f32x4 acc[2][2][4][2];
#pragma unroll
    for (int a = 0; a < 2; ++a)
#pragma unroll
        for (int b = 0; b < 2; ++b)
#pragma unroll
            for (int m = 0; m < 4; ++m)
#pragma unroll
                for (int n = 0; n < 2; ++n) acc[a][b][m][n] = (f32x4){0.f, 0.f, 0.f, 0.f};
    bf16x8 At[4][2], B0[2][2], B1[2][2];
    const char* cA = (const char*)g.A + (size_t)cur.pm * tstep; const char* cB = (const char*)g.Bt + (size_t)cur.pn * tstep;
    S.a_ready(cur);
    if constexpr (SP2) {
        PG8_STAGE(PG8_SB(0, 0), cB, voffB); PG8_STAGE(PG8_SB(0, 1), cB + hstep, voffB); PG8_STAGE(PG8_SA(0, 0), cA, voffA); PG8_STAGE(PG8_SA(0, 1), cA + hstep, voffA);
        if (wr == 1) PG8_BAR;
        PG8_WAIT_V(2); PG8_BAR;
        PG8_STAGE(PG8_SB(1, 0), cB + kstep, voffB); PG8_STAGE(PG8_SA(1, 0), cA + kstep, voffA); PG8_STAGE(PG8_SB(1, 1), cB + hstep + kstep, voffB);
        PG8_WAIT_V(6); PG8_BAR;
    } else {
        PG8_STAGE(PG8_SB(0, 0), cB, voffB); PG8_STAGE(PG8_SA(0, 0), cA, voffA); PG8_STAGE(PG8_SB(0, 1), cB + hstep, voffB); PG8_STAGE(PG8_SA(0, 1), cA + hstep, voffA);
        if (wr == 1) PG8_BAR;
        PG8_WAIT_V(4); PG8_BAR;
        PG8_STAGE(PG8_SB(1, 0), cB + kstep, voffB); PG8_STAGE(PG8_SA(1, 0), cA + kstep, voffA); PG8_STAGE(PG8_SB(1, 1), cB + hstep + kstep, voffB);
        PG8_WAIT_V(6); PG8_BAR;
    }
    for (;;) {
        const bool has_next = S.next(ui + 1, nxt);
        const char* nA = has_next ? (const char*)g.A + (size_t)nxt.pm * tstep : cA; const char* nB = has_next ? (const char*)g.Bt + (size_t)nxt.pn * tstep : cB;
        for (int t = 0; t < nt; t += 2) {
            const bool last = (t == nt - 2);
            const char* a1 = cA + (size_t)(t + 1) * kstep;
            const char* a2 = last ? nA : cA + (size_t)(t + 2) * kstep; const char* b2 = last ? nB : cB + (size_t)(t + 2) * kstep;
            const char* a3 = a2 + kstep; const char* b3 = b2 + kstep;
            if (last && has_next) S.a_ready(nxt);
            if constexpr (SP2) {
            PG8_LDB(B0, 0, 0); PG8_LDB(B1, 0, 1); PG8_SCHED; PG8_LDA(At, 0, 0); PG8_STAGE(PG8_SA(1, 1), a1 + hstep, voffA);
            PG8_WAIT_V(8); PG8_WAIT_L(0); PG8_BAR; PG8_MMA(0, 0, At, B0); PG8_MMA(0, 1, At, B1); PG8_BAR; PG8_SCHED;
            PG8_LDA(At, 0, 1); PG8_STAGE(PG8_SB(0, 0), b2, voffB); PG8_STAGE(PG8_SB(0, 1), b2 + hstep, voffB); PG8_STAGE(PG8_SA(0, 0), a2, voffA);
            PG8_WAIT_V(8); PG8_WAIT_L(0); PG8_BAR; PG8_MMA(1, 0, At, B0); PG8_MMA(1, 1, At, B1); PG8_BAR; PG8_SCHED;
            PG8_LDB(B0, 1, 0); PG8_LDB(B1, 1, 1); PG8_SCHED; PG8_LDA(At, 1, 0); PG8_STAGE(PG8_SA(0, 1), a2 + hstep, voffA);
            PG8_WAIT_V(8); PG8_WAIT_L(0); PG8_BAR; PG8_MMA(0, 0, At, B0); PG8_MMA(0, 1, At, B1); PG8_BAR; PG8_SCHED;
            PG8_LDA(At, 1, 1); PG8_STAGE(PG8_SB(1, 0), b3, voffB); PG8_STAGE(PG8_SB(1, 1), b3 + hstep, voffB); PG8_STAGE(PG8_SA(1, 0), a3, voffA);
            PG8_WAIT_V(8); PG8_WAIT_L(0); PG8_BAR; PG8_MMA(1, 0, At, B0); PG8_MMA(1, 1, At, B1); PG8_BAR; PG8_SCHED;
            } else {
            PG8_LDB(B0, 0, 0); PG8_SCHED; PG8_LDA(At, 0, 0); PG8_STAGE(PG8_SA(1, 1), a1 + hstep, voffA);
            PG8_WAIT_L(8); PG8_BAR; PG8_WAIT_L(0); PG8_MMA(0, 0, At, B0); PG8_BAR; PG8_SCHED;
            PG8_LDB(B1, 0, 1); PG8_STAGE(PG8_SB(0, 0), b2, voffB);
            PG8_BAR; PG8_WAIT_L(0); PG8_MMA(0, 1, At, B1); PG8_BAR;
            PG8_LDA(At, 0, 1); PG8_STAGE(PG8_SA(0, 0), a2, voffA);
            PG8_BAR; PG8_WAIT_L(0); PG8_MMA(1, 0, At, B0); PG8_BAR; PG8_SCHED;
            PG8_STAGE(PG8_SB(0, 1), b2 + hstep, voffB);
            PG8_WAIT_V(6); PG8_BAR; PG8_MMA(1, 1, At, B1); PG8_BAR;
            PG8_LDB(B0, 1, 0); PG8_SCHED; PG8_LDA(At, 1, 0); PG8_STAGE(PG8_SA(0, 1), a2 + hstep, voffA);
            PG8_WAIT_L(8); PG8_BAR; PG8_WAIT_L(0); PG8_MMA(0, 0, At, B0); PG8_BAR; PG8_SCHED;
            PG8_LDB(B1, 1, 1); PG8_STAGE(PG8_SB(1, 0), b3, voffB);
            PG8_BAR; PG8_WAIT_L(0); PG8_MMA(0, 1, At, B1); PG8_BAR;
            PG8_LDA(At, 1, 1); PG8_STAGE(PG8_SA(1, 0), a3, voffA);
            PG8_BAR; PG8_WAIT_L(0); PG8_MMA(1, 0, At, B0); PG8_BAR; PG8_SCHED;
            PG8_STAGE(PG8_SB(1, 1), b3 + hstep, voffB);
            PG8_WAIT_V(6); PG8_BAR; PG8_MMA(1, 1, At, B1); PG8_BAR;
            }
        }
        if constexpr (ALIGN_EPI) { if (wr == 0) PG8_BAR; }
        if constexpr (!Epi::AFTER_DRAIN) { E(acc, cur, wr, wc, fr, fq); S.done(cur); }
        if (!has_next) break;
#pragma unroll
        for (int a = 0; a < 2; ++a)
#pragma unroll
            for (int b = 0; b < 2; ++b)
#pragma unroll
                for (int m = 0; m < 4; ++m)
#pragma unroll
                    for (int n = 0; n < 2; ++n) acc[a][b][m][n] = (f32x4){0.f, 0.f, 0.f, 0.f};
        cur = nxt; cA = nA; cB = nB; ++ui;
        if constexpr (ALIGN_EPI) { if (wr == 1) PG8_BAR; }
    }
    PG8_WAIT_V(0);
    if constexpr (!ALIGN_EPI) { if (wr == 0) PG8_BAR; }
    PG8_BAR;
    if constexpr (Epi::AFTER_DRAIN) { E.fused(acc, cur, wr, wc, fr, fq, lds, wid, lane); S.done(cur); }
#undef PG8_SA
#undef PG8_SB
#undef PG8_STAGE
#undef PG8_LDA
#undef PG8_LDB
#undef PG8_MMA
#undef PG8_WAIT_V
#undef PG8_WAIT_L
#undef PG8_BAR
#undef PG8_SCHED
}
}


#define LAS __attribute__((address_space(3)))
typedef unsigned short bf16;
typedef unsigned v4u __attribute__((ext_vector_type(4)));
typedef unsigned v2u __attribute__((ext_vector_type(2)));
typedef float f32x4 __attribute__((ext_vector_type(4)));
typedef float f32x16 __attribute__((ext_vector_type(16)));
typedef short bf16x8 __attribute__((ext_vector_type(8)));

constexpr int T_TOK = 32768, DM = 1024, SEQ = 4096, NBATCH = 8;
constexpr int PW = 3584;
constexpr int IN_W = 3532;
constexpr int C_AQ = 0, C_AKV = 1024, C_IQ = 1152, C_IK = 1408, C_IW = 1472, C_BA = 1476, C_BB = 1480, C_BQ = 1536, C_BK = 2048, C_BV = 2560, C_BZ = 3072;
constexpr int YW = 1536;
constexpr int NCHUNK = 2048;
constexpr float EPS = 1e-6f;

constexpr size_t MiB = 1u << 20;
constexpr size_t WS_CTL = 0;
constexpr size_t WS_MOD = 1 * MiB;
constexpr size_t WS_GL = WS_MOD + 256 * 1024;
constexpr size_t WS_SU = WS_MOD + 512 * 1024;
constexpr size_t WS_SV = WS_MOD + 640 * 1024;
constexpr size_t WS_WIN = 2 * MiB;
constexpr size_t WS_BT2 = 9 * MiB;
constexpr size_t WS_WQ = 12 * MiB;
constexpr size_t WS_SUBK = 16 * MiB;
constexpr size_t WS_H = 18 * MiB;
constexpr size_t WS_KN = WS_H;
constexpr size_t WS_SEL = WS_H + 8 * MiB;
constexpr size_t WS_PROJ = 82 * MiB;
constexpr size_t WS_QUERY = WS_PROJ;
constexpr size_t WS_YAB = 306 * MiB;
constexpr size_t WS_EXPID = WS_YAB;
constexpr size_t WS_GATE = WS_YAB + 16 * MiB;
constexpr size_t WS_H8 = WS_YAB + 32 * MiB;
constexpr size_t WS_HS = WS_YAB + 64 * MiB;
constexpr size_t WS_GA = 402 * MiB;
constexpr size_t WS_UT = 418 * MiB;
constexpr size_t WS_VT = 450 * MiB;
constexpr size_t WS_END = 482 * MiB;
constexpr size_t DO_W = 0, DO_QD = 32 * MiB, DO_KDT = 64 * MiB, DO_UT = 96 * MiB;

constexpr int LDS_BYTES = 147456;

struct Args { const float* in[17]; float* out; unsigned char* ws; int ph_lo, ph_hi; };

__device__ __forceinline__ unsigned pk2(float lo, float hi) { unsigned r; asm("v_cvt_pk_bf16_f32 %0, %1, %2" : "=v"(r) : "v"(lo), "v"(hi)); return r; }
__device__ __forceinline__ unsigned f2bf(float f) { return pk2(f, f) & 0xffffu; }
__device__ __forceinline__ float bflo(unsigned u) { return __uint_as_float(u << 16); }
__device__ __forceinline__ float bfhi(unsigned u) { return __uint_as_float(u & 0xffff0000u); }
__device__ __forceinline__ float bf1(bf16 b) { return __uint_as_float(((unsigned)b) << 16); }
__device__ __forceinline__ float wave_sum(float v) {
#pragma unroll
    for (int o = 1; o < 64; o <<= 1) v += __shfl_xor(v, o);
    return v;
}
__device__ __forceinline__ float wave_max(float v) {
#pragma unroll
    for (int o = 1; o < 64; o <<= 1) v = fmaxf(v, __shfl_xor(v, o));
    return v;
}
__device__ __forceinline__ float silu_f(float v) { return v / (1.f + expf(-v)); }
__device__ __forceinline__ float silu_fast(float v) { return v * __builtin_amdgcn_rcpf(1.f + __expf(-v)); }
__device__ __forceinline__ float sigmoid_f(float v) { return 1.f / (1.f + expf(-v)); }
__device__ __forceinline__ float softplus_f(float v) { return fmaxf(v, 0.f) + log1pf(expf(-fabsf(v))); }
#define LDS_WAIT() asm volatile("s_waitcnt lgkmcnt(0)" ::: "memory")

__device__ __forceinline__ int win_srccol(int n) {
    if (n < 1476) return n;
    if (n < 1480) return 3524 + (n - 1476);
    if (n < 1484) return 3528 + (n - 1480);
    if (n < 1536) return -1;
    return 1476 + (n - 1536);
}
__device__ __forceinline__ void transpose_item(const float* W, int spitch, int k0, int sc, bf16* WT, int dpitch, int drow0, int dcol0, LAS float* scr, int lane) {
#pragma unroll 8
    for (int i = 0; i < 32; ++i) { const int kk = 2 * i + (lane >> 5); scr[kk * 33 + (lane & 31)] = (sc >= 0) ? W[(size_t)(k0 + kk) * spitch + sc] : 0.f; }
    LDS_WAIT();
    const int c = lane & 7;
#pragma unroll
    for (int j = 0; j < 4; ++j) { const int n = (lane >> 3) + 8 * j; const LAS float* s = scr + (8 * c) * 33 + n;
        v4u o; o.x = pk2(s[0 * 33], s[1 * 33]); o.y = pk2(s[2 * 33], s[3 * 33]); o.z = pk2(s[4 * 33], s[5 * 33]); o.w = pk2(s[6 * 33], s[7 * 33]);
        *(v4u*)(WT + (size_t)(drow0 + n) * dpitch + dcol0 + 8 * c) = o; }
    LDS_WAIT();
}

__device__ __forceinline__ void phase0(const Args& a, LAS unsigned char* lds) {
    const int tid = threadIdx.x, lane = tid & 63, wave = tid >> 6, bid = blockIdx.x, G = gridDim.x;
    unsigned char* ws = a.ws;
#ifndef P0_REP
#define P0_REP 0
#endif
    for (int rep0_ = 0; rep0_ < 1 + (P0_REP ? 1 : 0); ++rep0_) {
    if (rep0_ == 0 || (P0_REP & 1))
    for (int item = bid; item < 192; item += G) {
        LAS float* sc = (LAS float*)lds;
        LAS float* red = sc + 8192;
        const float* c = a.in[1];
        for (int i = tid; i < 8192; i += 512) sc[i] = silu_f(c[i]);
        __syncthreads();
        const int cc = tid & 31, kg = tid >> 5;
        const float* w = a.in[2] + item * 32 + cc;
        float acc[8];
#pragma unroll
        for (int b = 0; b < 8; ++b) acc[b] = 0.f;
        for (int k = kg; k < 1024; k += 16) { const float wv = w[(size_t)k * 6144];
#pragma unroll
            for (int b = 0; b < 8; ++b) acc[b] += sc[b * 1024 + k] * wv; }
#pragma unroll
        for (int b = 0; b < 8; ++b) red[(kg * 8 + b) * 32 + cc] = acc[b];
        __syncthreads();
        if (tid < 256) { const int b = tid >> 5; float s = 0.f;
            for (int k2 = 0; k2 < 16; ++k2) s += red[(k2 * 8 + b) * 32 + cc];
            ((float*)(ws + WS_MOD))[b * 6144 + item * 32 + cc] = s + a.in[3][item * 32 + cc]; }
        __syncthreads();
    }
    if (rep0_ == 0 || (P0_REP & 2)) {
        LAS float* scr = (LAS float*)(lds + 65536 + wave * 8704);
        const int gw = bid * 8 + wave, NGW = G * 8;
        constexpr int I_WIN = 16 * 112, I_WQ = 16 * 64, I_WO = 8 * 32;
        for (int it = gw; it < I_WIN + I_WQ + I_WO; it += NGW) {
            int r = it;
            if (r < I_WIN) { const int kb = r / 112, nb = r % 112; transpose_item(a.in[4], IN_W, 64 * kb, win_srccol(32 * nb + (lane & 31)), (bf16*)(ws + WS_WIN), 1024, 32 * nb, 64 * kb, scr, lane); continue; }
            r -= I_WIN;
            if (r < I_WQ) { const int kb = r / 64, nb = r % 64; transpose_item(a.in[13], 2048, 64 * kb, 32 * nb + (lane & 31), (bf16*)(ws + WS_WQ), 1024, 32 * nb, 64 * kb, scr, lane); continue; }
            r -= I_WQ;
            { const int kb = r / 32, nb = r % 32; transpose_item(a.in[12] + (size_t)512 * 1024, 1024, 64 * kb, 32 * nb + (lane & 31), (bf16*)(ws + WS_BT2), YW, 32 * nb, 1024 + 64 * kb, scr, lane); }
        }
    }
    if (rep0_ == 0 || (P0_REP & 4)) {
        const float* wuv = a.in[7]; const float* wout = a.in[12]; bf16* bt2 = (bf16*)(ws + WS_BT2);
        for (int it = bid * 512 + tid; it < 1024 * 128; it += G * 512) {
            const int n = it & 1023, kb = __builtin_amdgcn_readfirstlane(it >> 10);
            const int h = kb >> 4, r0 = (kb & 15) * 8;
            float acc[8];
#pragma unroll
            for (int j = 0; j < 8; ++j) acc[j] = 0.f;
            for (int v = 0; v < 64; ++v) { const float wo = wout[(size_t)(h * 64 + v) * 1024 + n];
#pragma unroll
                for (int j = 0; j < 8; ++j) acc[j] += wuv[(size_t)(h * 128 + r0 + j) * 64 + v] * wo; }
            v4u o; o.x = pk2(acc[0], acc[1]); o.y = pk2(acc[2], acc[3]); o.z = pk2(acc[4], acc[5]); o.w = pk2(acc[6], acc[7]);
            *(v4u*)(bt2 + (size_t)n * YW + h * 128 + r0) = o;
        }
    }
    if (rep0_ == 0 || (P0_REP & 8)) {
        const size_t gt = (size_t)bid * 512 + tid, GT = (size_t)G * 512;
        for (size_t i = gt; i < 262144 / 8; i += GT) {
            const f32x4 v0 = *(const f32x4*)(a.in[14] + i * 8), v1 = *(const f32x4*)(a.in[14] + i * 8 + 4);
            v4u o; o.x = pk2(v0.x, v0.y); o.y = pk2(v0.z, v0.w); o.z = pk2(v1.x, v1.y); o.w = pk2(v1.z, v1.w);
            *(v4u*)((bf16*)(ws + WS_SUBK) + i * 8) = o;
        }
        const int gw = bid * 8 + wave, NGW = G * 8;
        for (int row = gw; row < 2 * 16384; row += NGW) {
            const int tb = row >> 14, e = row & 16383;
            const float* src = (tb ? a.in[16] : a.in[15]) + (size_t)e * 1024 + 16 * lane;
            f32x4 v[4]; float mx = 0.f;
#pragma unroll
            for (int q = 0; q < 4; ++q) { v[q] = *(const f32x4*)(src + 4 * q); mx = fmaxf(fmaxf(mx, fmaxf(fabsf(v[q].x), fabsf(v[q].y))), fmaxf(fabsf(v[q].z), fabsf(v[q].w))); }
            mx = wave_max(mx);
            const float scale = (mx > 0.f) ? mx * (1.f / 240.f) : 1.f, inv = 1.f / scale;
            v4u o;
#pragma unroll
            for (int q = 0; q < 4; ++q) { int p = __builtin_amdgcn_cvt_pk_fp8_f32(v[q].x * inv, v[q].y * inv, 0, false); p = __builtin_amdgcn_cvt_pk_fp8_f32(v[q].z * inv, v[q].w * inv, p, true); o[q] = (unsigned)p; }
            *(v4u*)(ws + (tb ? WS_VT : WS_UT) + (size_t)e * 1024 + 16 * lane) = o;
            if (lane == 0) ((float*)(ws + (tb ? WS_SV : WS_SU)))[e] = scale;
        }
    }
    }
}

__device__ __forceinline__ void phase_norm(const float* x, const float* mod, int shift_off, int scale_off, bf16* hout, unsigned char* h8 = nullptr, float* hs = nullptr) {
    const int tid = threadIdx.x, lane = tid & 63, wave = tid >> 6;
    const int gw = blockIdx.x * 8 + wave, NGW = gridDim.x * 8;
    for (int m = gw; m < T_TOK; m += NGW) {
        const int b = m >> 12;
        const f32x4* xr = (const f32x4*)(x + (size_t)m * DM) + lane;
        f32x4 v[4]; float s = 0.f;
#pragma unroll
        for (int j = 0; j < 4; ++j) { v[j] = xr[64 * j]; s += (v[j].x * v[j].x + v[j].y * v[j].y) + (v[j].z * v[j].z + v[j].w * v[j].w); }
        const float inv = rsqrtf(wave_sum(s) * (1.f / DM) + EPS);
        const f32x4* sh = (const f32x4*)(mod + b * 6144 + shift_off) + lane;
        const f32x4* sc = (const f32x4*)(mod + b * 6144 + scale_off) + lane;
        v2u* o8 = (v2u*)(hout + (size_t)m * DM) + lane;
        float amax = 0.f;
#pragma unroll
        for (int j = 0; j < 4; ++j) { const f32x4 a = sh[64 * j], c = sc[64 * j];
            v[j].x = v[j].x * inv * (1.f + c.x) + a.x; v[j].y = v[j].y * inv * (1.f + c.y) + a.y; v[j].z = v[j].z * inv * (1.f + c.z) + a.z; v[j].w = v[j].w * inv * (1.f + c.w) + a.w;
            v2u o; o.x = pk2(v[j].x, v[j].y); o.y = pk2(v[j].z, v[j].w);
            o8[64 * j] = o;
            amax = fmaxf(fmaxf(amax, fmaxf(fabsf(v[j].x), fabsf(v[j].y))), fmaxf(fabsf(v[j].z), fabsf(v[j].w))); }
        if (h8) {
            amax = wave_max(amax);
            const float scale = (amax > 0.f) ? amax * (1.f / 240.f) : 1.f, qi = 1.f / scale;
#pragma unroll
            for (int j = 0; j < 4; ++j) { int p = __builtin_amdgcn_cvt_pk_fp8_f32(v[j].x * qi, v[j].y * qi, 0, false); p = __builtin_amdgcn_cvt_pk_fp8_f32(v[j].z * qi, v[j].w * qi, p, true);
                *(unsigned*)(h8 + (size_t)m * DM + 4 * (lane + 64 * j)) = (unsigned)p; }
            if (lane == 0) hs[m] = scale;
        }
    }
}

struct EpiX1 {
    static constexpr bool PERM = false, AFTER_DRAIN = false;
    const float* x; float* out; const float* mod;
    __device__ __forceinline__ void operator()(const pg8::f32x4 (&acc)[2][2][4][2], const pg8::Unit& u, int wr, int wc, int fr, int fq) const {
        const int row0 = u.pm * 256 + wr * 64 + fr, col0 = u.pn * 256 + wc * 32 + 4 * fq;
        const int b = (u.pm * 256) >> 12;
        f32x4 gv[2][2];
#pragma unroll
        for (int bj = 0; bj < 2; ++bj)
#pragma unroll
            for (int n = 0; n < 2; ++n) gv[bj][n] = *(const f32x4*)(mod + b * 6144 + 2048 + col0 + bj * 128 + n * 16);
#pragma unroll
        for (int ai = 0; ai < 2; ++ai)
#pragma unroll
            for (int m = 0; m < 4; ++m) { const size_t ro = (size_t)(row0 + ai * 128 + m * 16) * DM + col0;
#pragma unroll
                for (int bj = 0; bj < 2; ++bj)
#pragma unroll
                    for (int n = 0; n < 2; ++n) { const f32x4 xv = *(const f32x4*)(x + ro + bj * 128 + n * 16);
                        *(f32x4*)(out + ro + bj * 128 + n * 16) = xv + gv[bj][n] * acc[ai][bj][m][n]; } }
    }
};
struct EpiBf {
    static constexpr bool PERM = true, AFTER_DRAIN = false;
    bf16* O; int ldc;
    __device__ __forceinline__ void operator()(const pg8::f32x4 (&acc)[2][2][4][2], const pg8::Unit& u, int wr, int wc, int fr, int fq) const {
        const int row0 = u.pm * 256 + wr * 64 + fr, col0 = u.pn * 256 + wc * 32 + 8 * fq;
#pragma unroll
        for (int ai = 0; ai < 2; ++ai)
#pragma unroll
            for (int m = 0; m < 4; ++m) { bf16* rowp = O + (size_t)(row0 + ai * 128 + m * 16) * ldc + col0;
#pragma unroll
                for (int bj = 0; bj < 2; ++bj) { const pg8::f32x4 zz = (pg8::f32x4){0.f, 0.f, 0.f, 0.f}; const pg8::f32x4 v0 = acc[ai][bj][m][0] + zz, v1 = acc[ai][bj][m][1] + zz;
                    v4u w; w.x = pg8::cvt_pk_bf16(v0[0], v0[1]); w.y = pg8::cvt_pk_bf16(v0[2], v0[3]); w.z = pg8::cvt_pk_bf16(v1[0], v1[1]); w.w = pg8::cvt_pk_bf16(v1[2], v1[3]);
                    *(v4u*)(rowp + bj * 128) = w; } }
    }
};

constexpr int GP_QS = 0, GP_KS = 33792, GP_VS = 67584, GP_LS = 101376, GP_GV = 118784;
__device__ __forceinline__ void gdn_prep_item(const Args& a, LAS unsigned char* lds, int chunk) {
    int tid = threadIdx.x; asm volatile("" : "+v"(tid));
    const int lane = tid & 63, wave = __builtin_amdgcn_readfirstlane(tid >> 6);
    unsigned char* ws = a.ws;
    const bf16* proj = (const bf16*)(ws + WS_PROJ);
    const int bh = chunk >> 6, n = chunk & 63, b = bh >> 2, h = bh & 3;
    const int t0 = b * SEQ + n * 64;
    LAS float* QS = (LAS float*)(lds + GP_QS); LAS float* KS = (LAS float*)(lds + GP_KS); LAS float* VS = (LAS float*)(lds + GP_VS);
    LAS float* LS = (LAS float*)(lds + GP_LS); LAS float* GV = (LAS float*)(lds + GP_GV);
#ifndef GP_MASK
#define GP_MASK 31
#endif
#ifndef GP_REP
#define GP_REP 0
#endif
    for (int rep_ = 0; rep_ < 1 + (GP_REP & 1); ++rep_)
    if ((GP_MASK & 1) && tid < 384) {
        const int cg = tid % 48, rs = tid / 48;
        const int sec = cg >> 4, c8 = (cg & 15) * 8;
        const int pcol = C_BQ + sec * 512 + h * 128 + c8;
        const float* cw = a.in[8] + sec * 512 + h * 128 + c8;
        float wt[4][8];
#pragma unroll
        for (int i = 0; i < 4; ++i) { const f32x4 w0 = *(const f32x4*)(cw + i * 1536), w1 = *(const f32x4*)(cw + i * 1536 + 4);
            wt[i][0] = w0.x; wt[i][1] = w0.y; wt[i][2] = w0.z; wt[i][3] = w0.w; wt[i][4] = w1.x; wt[i][5] = w1.y; wt[i][6] = w1.z; wt[i][7] = w1.w; }
        LAS float* XS = (sec == 0) ? QS : (sec == 1 ? KS : VS);
        v4u raw[11];
#pragma unroll
        for (int j = 0; j < 11; ++j) { const int rr = 8 * rs - 3 + j;
            raw[j] = (rr >= 0 || n > 0) ? *(const v4u*)(proj + (size_t)(t0 + rr) * PW + pcol) : (v4u){0u, 0u, 0u, 0u}; }
#pragma unroll
        for (int j = 0; j < 8; ++j) {
            float y[8];
#pragma unroll
            for (int c = 0; c < 8; ++c) y[c] = 0.f;
#pragma unroll
            for (int i = 0; i < 4; ++i) { float xv[8]; const v4u u = raw[j + i];
                xv[0] = bflo(u.x); xv[1] = bfhi(u.x); xv[2] = bflo(u.y); xv[3] = bfhi(u.y); xv[4] = bflo(u.z); xv[5] = bfhi(u.z); xv[6] = bflo(u.w); xv[7] = bfhi(u.w);
#pragma unroll
                for (int c = 0; c < 8; ++c) y[c] += wt[i][c] * xv[c]; }
            f32x4 o0, o1;
            o0.x = silu_fast(y[0]); o0.y = silu_fast(y[1]); o0.z = silu_fast(y[2]); o0.w = silu_fast(y[3]); o1.x = silu_fast(y[4]); o1.y = silu_fast(y[5]); o1.z = silu_fast(y[6]); o1.w = silu_fast(y[7]);
            *(LAS f32x4*)(XS + (8 * rs + j) * 132 + c8) = o0; *(LAS f32x4*)(XS + (8 * rs + j) * 132 + c8 + 4) = o1;
        }
    }
    if (wave == 7) {
        const int i = lane;
        const float av = bf1(proj[(size_t)(t0 + i) * PW + C_BA + h]), bv = bf1(proj[(size_t)(t0 + i) * PW + C_BB + h]);
        const float beta = sigmoid_f(bv);
        const float g = -expf(a.in[9][h]) * softplus_f(av + a.in[10][h]);
        float G = g;
#pragma unroll
        for (int o = 1; o < 64; o <<= 1) { const float t = __shfl_up(G, o); if (lane >= o) G += t; }
        const float Glast = __shfl(G, 63);
        GV[i] = G; GV[64 + i] = expf(G); GV[128 + i] = beta; GV[192 + i] = expf(Glast - G); GV[256 + i] = beta * expf(G);
        if (lane == 0) ((float*)(ws + WS_GL))[chunk] = expf(Glast);
    }
    __syncthreads();
    if (GP_MASK & 2) {
#pragma unroll
        for (int rr = 0; rr < 16; ++rr) {
            const int row = wave * 16 + rr;
            LAS float* X = (row < 64) ? (QS + row * 132) : (KS + (row - 64) * 132);
            const float v0 = X[lane], v1 = X[lane + 64];
            const float ss = wave_sum(v0 * v0 + v1 * v1);
            const float sc = rsqrtf(ss + EPS) * ((row < 64) ? 0.08838834764831845f : 1.f);
            X[lane] = v0 * sc; X[lane + 64] = v1 * sc;
        }
    }
    __syncthreads();
    for (int rep_ = 0; rep_ < 1 + ((GP_REP >> 2) & 1); ++rep_)
    if (GP_MASK & 4) {
        const int gram = wave >> 2, ti = wave & 3, r = lane & 15, g = lane >> 4;
        const LAS float* X = gram ? QS : KS;
        f32x4 acc[4];
#pragma unroll
        for (int tj = 0; tj < 4; ++tj) acc[tj] = (f32x4){0.f, 0.f, 0.f, 0.f};
#pragma unroll 2
        for (int kk = 0; kk < 8; ++kk) {
            const f32x4 xa = *(const LAS f32x4*)(X + (16 * ti + r) * 132 + 16 * kk + 4 * g);
#pragma unroll
            for (int tj = 0; tj < 4; ++tj) {
                if (tj <= ti) {
                    const f32x4 kb = *(const LAS f32x4*)(KS + (16 * tj + r) * 132 + 16 * kk + 4 * g);
                    acc[tj] = __builtin_amdgcn_mfma_f32_16x16x4f32(xa.x, kb.x, acc[tj], 0, 0, 0);
                    acc[tj] = __builtin_amdgcn_mfma_f32_16x16x4f32(xa.y, kb.y, acc[tj], 0, 0, 0);
                    acc[tj] = __builtin_amdgcn_mfma_f32_16x16x4f32(xa.z, kb.z, acc[tj], 0, 0, 0);
                    acc[tj] = __builtin_amdgcn_mfma_f32_16x16x4f32(xa.w, kb.w, acc[tj], 0, 0, 0);
                }
            }
        }
        bf16* Aout = (bf16*)(ws + WS_GA) + (size_t)chunk * 4096;
#pragma unroll
        for (int tj = 0; tj < 4; ++tj)
#pragma unroll
            for (int rg = 0; rg < 4; ++rg) {
                const int i = 16 * ti + 4 * g + rg, j = 16 * tj + r;
                const float dec = (j <= i) ? __expf(GV[i] - GV[j]) : 0.f;
                if (gram == 0) { if (tj <= ti) LS[i * 68 + j] = (j < i) ? GV[128 + i] * acc[tj][rg] * dec : 0.f; }
                else Aout[((((i >> 4) * 2 + (j >> 5)) * 64 + (i & 15) + 16 * ((j >> 3) & 3)) << 3) + (j & 7)] = (bf16)f2bf((tj <= ti) ? acc[tj][rg] * dec : 0.f);
            }
    }
    __syncthreads();
    {
        bf16* QD = (bf16*)((unsigned char*)a.out + DO_QD) + (size_t)chunk * 8192;
        bf16* KDT = (bf16*)((unsigned char*)a.out + DO_KDT) + (size_t)chunk * 8192;
#pragma unroll
        for (int m = 0; m < 2; ++m) {
            const int p = tid + 512 * m;
            { const int i = p >> 4, k8 = (p & 15) * 8; const float e = GV[64 + i]; const LAS float* sq = QS + i * 132 + k8;
              v4u o; o.x = pk2(sq[0] * e, sq[1] * e); o.y = pk2(sq[2] * e, sq[3] * e); o.z = pk2(sq[4] * e, sq[5] * e); o.w = pk2(sq[6] * e, sq[7] * e);
              *(v4u*)(QD + ((((i >> 4) * 4 + ((p & 15) >> 2)) * 64 + (i & 15) + 16 * (p & 3)) << 3)) = o; }
            { const int k = p >> 3, i8 = (p & 7) * 8; float v[8];
#pragma unroll
              for (int j = 0; j < 8; ++j) v[j] = KS[(i8 + j) * 132 + k] * GV[192 + i8 + j];
              v4u o; o.x = pk2(v[0], v[1]); o.y = pk2(v[2], v[3]); o.z = pk2(v[4], v[5]); o.w = pk2(v[6], v[7]);
              *(v4u*)(KDT + ((((k >> 4) * 2 + ((p & 7) >> 2)) * 64 + (k & 15) + 16 * (p & 3)) << 3)) = o; }
        }
    }
    __syncthreads();
    {
#pragma unroll
        for (int m = 0; m < 4; ++m) {
            const int p = tid + 512 * m, i = p >> 5, c4 = (p & 31) * 4;
            const float mu = GV[128 + i], mw = GV[256 + i];
            f32x4 v = *(LAS f32x4*)(VS + i * 132 + c4); v.x *= mu; v.y *= mu; v.z *= mu; v.w *= mu; *(LAS f32x4*)(VS + i * 132 + c4) = v;
            f32x4 k = *(LAS f32x4*)(KS + i * 132 + c4); k.x *= mw; k.y *= mw; k.z *= mw; k.w *= mw; *(LAS f32x4*)(KS + i * 132 + c4) = k;
        }
    }
    __syncthreads();
    {
        const int r = lane & 15, g = lane >> 4;
#pragma unroll 1
        for (int I = 0; I < 4; ++I) {
            if (I > 0) {
#pragma unroll
                for (int tt = 0; tt < 2; ++tt) {
                    const int ct = 2 * wave + tt;
                    LAS float* XB = ((ct < 8) ? VS : KS) + (ct & 7) * 16 + r;
                    f32x4 acc;
#pragma unroll
                    for (int rg = 0; rg < 4; ++rg) acc[rg] = XB[(16 * I + 4 * g + rg) * 132];
                    for (int J = 0; J < I; ++J) {
#pragma unroll
                        for (int ks = 0; ks < 4; ++ks) {
                            const float la = -LS[(16 * I + r) * 68 + 16 * J + 4 * ks + g];
                            const float xb = XB[(16 * J + 4 * ks + g) * 132];
                            acc = __builtin_amdgcn_mfma_f32_16x16x4f32(la, xb, acc, 0, 0, 0);
                        }
                    }
#pragma unroll
                    for (int rg = 0; rg < 4; ++rg) XB[(16 * I + 4 * g + rg) * 132] = acc[rg];
                }
                __syncthreads();
            }
            if (tid < 256) {
                LAS float* XC = ((tid < 128) ? VS : KS) + (tid & 127);
                float x[16];
#pragma unroll
                for (int rr = 0; rr < 16; ++rr) {
                    float a0 = XC[(16 * I + rr) * 132], a1 = 0.f, a2 = 0.f, a3 = 0.f;
#pragma unroll
                    for (int j4 = 0; j4 < (rr + 3) / 4; ++j4) {
                        const f32x4 l = *(const LAS f32x4*)(LS + (16 * I + rr) * 68 + 16 * I + 4 * j4);
                        if (4 * j4 + 0 < rr) a0 -= l.x * x[4 * j4 + 0];
                        if (4 * j4 + 1 < rr) a1 -= l.y * x[4 * j4 + 1];
                        if (4 * j4 + 2 < rr) a2 -= l.z * x[4 * j4 + 2];
                        if (4 * j4 + 3 < rr) a3 -= l.w * x[4 * j4 + 3];
                    }
                    x[rr] = (a0 + a1) + (a2 + a3);
                }
#pragma unroll
                for (int rr = 0; rr < 16; ++rr) XC[(16 * I + rr) * 132] = x[rr];
            }
            __syncthreads();
        }
    }
    {
        bf16* W = (bf16*)((unsigned char*)a.out + DO_W) + (size_t)chunk * 8192;
        bf16* UT = (bf16*)((unsigned char*)a.out + DO_UT) + (size_t)chunk * 8192;
#pragma unroll
        for (int m = 0; m < 2; ++m) {
            const int p = tid + 512 * m, i = p >> 4, k8 = p & 15;
            const f32x4 x0 = *(const LAS f32x4*)(KS + i * 132 + 8 * k8), x1 = *(const LAS f32x4*)(KS + i * 132 + 8 * k8 + 4);
            v4u o; o.x = pk2(x0.x, x0.y); o.y = pk2(x0.z, x0.w); o.z = pk2(x1.x, x1.y); o.w = pk2(x1.z, x1.w);
            *(v4u*)(W + ((((i >> 4) * 4 + (k8 >> 2)) * 64 + (i & 15) + 16 * (k8 & 3)) << 3)) = o;
        }
#pragma unroll
        for (int m = 0; m < 4; ++m) {
            const int p = tid + 512 * m, v = p & 127, q = p >> 7;
            v2u o; o.x = pk2(VS[(4 * q) * 132 + v], VS[(4 * q + 1) * 132 + v]); o.y = pk2(VS[(4 * q + 2) * 132 + v], VS[(4 * q + 3) * 132 + v]);
            *(v2u*)(UT + ((((q >> 2) * 8 + (v >> 4)) * 64 + (v & 15) + 16 * (q & 3)) << 2)) = o;
        }
    }
    __syncthreads();
}

__device__ __forceinline__ void kn_item(const Args& a, int item) {
    const int tid = threadIdx.x, lane = tid & 63, wave = tid >> 6;
    const bf16* proj = (const bf16*)(a.ws + WS_PROJ); bf16* KN = (bf16*)(a.ws + WS_KN);
    const float g0 = a.in[6][2 * lane], g1 = a.in[6][2 * lane + 1];
    for (int rr = 0; rr < 16; ++rr) {
        const int t = item * 128 + wave * 16 + rr;
        const unsigned u = *(const unsigned*)(proj + (size_t)t * PW + C_AKV + 2 * lane);
        const float v0 = bflo(u), v1 = bfhi(u);
        const float inv = rsqrtf(wave_sum(v0 * v0 + v1 * v1) * (1.f / 128.f) + EPS);
        *(unsigned*)(KN + (size_t)t * 128 + 2 * lane) = pk2(v0 * inv * g0, v1 * inv * g1);
    }
}


#ifdef IDX_FP32
__device__ __forceinline__ void phase_idx32(const Args& a, LAS unsigned char* lds) {
    const int tid = threadIdx.x, lane = tid & 63, wave = tid >> 6;
    LAS float* HS = (LAS float*)lds;
    float* IDX32 = (float*)(a.ws + WS_YAB);
    const float* mod = (const float*)(a.ws + WS_MOD);
    for (int tile = blockIdx.x; tile < 1024; tile += gridDim.x) {
        const int t0 = tile * 32, b = t0 >> 12;
        for (int rr = 0; rr < 4; ++rr) {
            const int m = t0 + wave * 4 + rr;
            const f32x4* xr = (const f32x4*)(a.in[0] + (size_t)m * DM) + lane;
            f32x4 v[4]; float s = 0.f;
#pragma unroll
            for (int j = 0; j < 4; ++j) { v[j] = xr[64 * j]; s += (v[j].x * v[j].x + v[j].y * v[j].y) + (v[j].z * v[j].z + v[j].w * v[j].w); }
            const float inv = rsqrtf(wave_sum(s) * (1.f / DM) + EPS);
            const f32x4* sh = (const f32x4*)(mod + b * 6144) + lane; const f32x4* sc = (const f32x4*)(mod + b * 6144 + 1024) + lane;
#pragma unroll
            for (int j = 0; j < 4; ++j) { const f32x4 aa = sh[64 * j], c = sc[64 * j];
                f32x4 o; o.x = v[j].x * inv * (1.f + c.x) + aa.x; o.y = v[j].y * inv * (1.f + c.y) + aa.y; o.z = v[j].z * inv * (1.f + c.z) + aa.z; o.w = v[j].w * inv * (1.f + c.w) + aa.w;
                *(LAS f32x4*)(HS + (wave * 4 + rr) * 1028 + 4 * (lane + 64 * j)) = o; }
        }
        __syncthreads();
        if (tid < 324) {
            const float* w = a.in[4] + 1152 + tid;
            float acc[32];
#pragma unroll
            for (int t = 0; t < 32; ++t) acc[t] = 0.f;
            for (int k4 = 0; k4 < 256; ++k4) {
                const float w0 = w[(size_t)(4 * k4) * IN_W], w1 = w[(size_t)(4 * k4 + 1) * IN_W], w2 = w[(size_t)(4 * k4 + 2) * IN_W], w3 = w[(size_t)(4 * k4 + 3) * IN_W];
#pragma unroll
                for (int t = 0; t < 32; ++t) { const f32x4 hv = *(const LAS f32x4*)(HS + t * 1028 + 4 * k4); acc[t] += hv.x * w0 + hv.y * w1 + hv.z * w2 + hv.w * w3; }
            }
#pragma unroll
            for (int t = 0; t < 32; ++t) IDX32[(size_t)(t0 + t) * 384 + tid] = acc[t];
        }
        __syncthreads();
    }
}
#endif
__device__ __forceinline__ unsigned sortable(float f) { const unsigned u = __float_as_uint(f + 0.f); return (u & 0x80000000u) ? ~u : (u | 0x80000000u); }
__device__ __forceinline__ int wave_sum_dpp(int x) {
    x += __builtin_amdgcn_update_dpp(0, x, 0xB1, 0xF, 0xF, false);
    x += __builtin_amdgcn_update_dpp(0, x, 0x4E, 0xF, 0xF, false);
    x += __builtin_amdgcn_update_dpp(0, x, 0x141, 0xF, 0xF, false);
    x += __builtin_amdgcn_update_dpp(0, x, 0x140, 0xF, 0xF, false);
    return __builtin_amdgcn_readlane(x, 0) + __builtin_amdgcn_readlane(x, 16) + __builtin_amdgcn_readlane(x, 32) + __builtin_amdgcn_readlane(x, 48);
}
#define CNT8(OP, acc_, k_, s_, c_) asm("v_cmp_" OP "_u32 s[36:37], %1, %9\n\tv_cmp_" OP "_u32 s[38:39], %2, %9\n\tv_cmp_" OP "_u32 s[40:41], %3, %9\n\tv_cmp_" OP "_u32 s[42:43], %4, %9\n\t" \
        "v_cmp_" OP "_u32 s[44:45], %5, %9\n\tv_cmp_" OP "_u32 s[46:47], %6, %9\n\tv_cmp_" OP "_u32 s[48:49], %7, %9\n\tv_cmp_" OP "_u32 s[50:51], %8, %9\n\t" \
        "v_addc_co_u32 %0, s[36:37], 0, %0, s[36:37]\n\tv_addc_co_u32 %0, s[38:39], 0, %0, s[38:39]\n\tv_addc_co_u32 %0, s[40:41], 0, %0, s[40:41]\n\tv_addc_co_u32 %0, s[42:43], 0, %0, s[42:43]\n\t" \
        "v_addc_co_u32 %0, s[44:45], 0, %0, s[44:45]\n\tv_addc_co_u32 %0, s[46:47], 0, %0, s[46:47]\n\tv_addc_co_u32 %0, s[48:49], 0, %0, s[48:49]\n\tv_addc_co_u32 %0, s[50:51], 0, %0, s[50:51]" \
        : "+v"(acc_) : "v"(k_[(s_)]), "v"(k_[(s_) + 1]), "v"(k_[(s_) + 2]), "v"(k_[(s_) + 3]), "v"(k_[(s_) + 4]), "v"(k_[(s_) + 5]), "v"(k_[(s_) + 6]), "v"(k_[(s_) + 7]), "v"(c_) \
        : "s36", "s37", "s38", "s39", "s40", "s41", "s42", "s43", "s44", "s45", "s46", "s47", "s48", "s49", "s50", "s51")
template <int NS> __device__ __forceinline__ void topk_select(LAS float* row, int n, int lane, unsigned short* out) {
    asm volatile("" : "+v"(lane));
    unsigned key[NS];
#pragma unroll
    for (int s = 0; s < NS; ++s) key[s] = __float_as_uint(row[s * 64 + lane]);
#pragma unroll
    for (int s = 0; s < NS; ++s) { const int idx = s * 64 + lane; const unsigned k = sortable(__uint_as_float(key[s])); key[s] = (idx < n) ? k : 0u; }
    LAS unsigned short* sel_l = (LAS unsigned short*)row;
    unsigned thr = 0u;
    for (int bit = 31; bit >= 0; --bit) {
        const unsigned cand = thr | (1u << bit);
        int c0 = 0, c1 = 0;
#pragma unroll
        for (int s = 0; s < NS; s += 16) { CNT8("ge", c0, key, s, cand); CNT8("ge", c1, key, s + 8, cand); }
        const int cnt = wave_sum_dpp(c0 + c1);
        if (cnt >= 256) thr = cand;
        if (cnt == 256) break;
    }
    int g0 = 0, e0 = 0;
#pragma unroll
    for (int s = 0; s < NS; s += 8) { CNT8("gt", g0, key, s, thr); CNT8("eq", e0, key, s, thr); }
    const int cgt = wave_sum_dpp(g0), ceq = wave_sum_dpp(e0);
    const int need_eq = 256 - cgt;
    asm volatile("" : "+v"(thr));
    asm volatile("" : "+v"(lane));
    int pos_out = 0;
    if (ceq == need_eq) {
#pragma unroll
        for (int s = 0; s < NS; ++s) {
            const bool take = key[s] >= thr;
            const unsigned long long mt = __builtin_amdgcn_ballot_w64(take);
            const int pre = __builtin_amdgcn_mbcnt_hi((unsigned)(mt >> 32), __builtin_amdgcn_mbcnt_lo((unsigned)mt, 0));
            sel_l[take ? pos_out + pre : 256] = (unsigned short)(s * 64 + lane);
            pos_out += __builtin_popcountll(mt);
        }
    } else {
        const unsigned long long ltmask = (1ull << lane) - 1ull;
        int eq_seen = 0;
#pragma unroll
        for (int s = 0; s < NS; ++s) {
            const bool gt = key[s] > thr, eq = key[s] == thr;
            const unsigned long long meq = __builtin_amdgcn_ballot_w64(eq);
            const bool take = gt || (eq && (eq_seen + __builtin_popcountll(meq & ltmask) < need_eq));
            const unsigned long long mt = __builtin_amdgcn_ballot_w64(take);
            if (take) sel_l[pos_out + __builtin_popcountll(mt & ltmask)] = (unsigned short)(s * 64 + lane);
            pos_out += __builtin_popcountll(mt); eq_seen += __builtin_popcountll(meq);
            if ((s & 3) == 3) __builtin_amdgcn_sched_barrier(0);
        }
    }
    LDS_WAIT();
    *(v2u*)(out + 4 * lane) = *(const LAS v2u*)(sel_l + 4 * lane);
}
struct IdxPre { bf16x8 af[4]; v2u wqr[4]; bf16x8 bfr[4][4]; };
__device__ __forceinline__ void idx_issue(const Args& a, int b, int qblk, int wave, int lane, IdxPre& P) {
    const bf16* proj = (const bf16*)(a.ws + WS_PROJ);
    const int p0 = qblk * 8, r = lane & 31, hh = lane >> 5;
    const size_t rowb = (size_t)b * SEQ;
    if (p0 + 7 < 256) return;
    { const bf16* qp = proj + (rowb + p0 + (r & 7)) * PW + C_IQ + (r >> 3) * 64 + 32 * hh;
#pragma unroll
      for (int s = 0; s < 4; ++s) P.af[s] = *(const bf16x8*)(qp + 8 * s); }
#pragma unroll
    for (int i = 0; i < 4; ++i) P.wqr[i] = *(const v2u*)(proj + (rowb + p0 + 4 * hh + i) * PW + C_IW);
    const int ntiles = (p0 + 7) / 32 + 1;
#pragma unroll
    for (int u = 0; u < 4; ++u) {
        const int kt = (wave + 8 * u < ntiles) ? wave + 8 * u : 0;
        const bf16* kp = proj + (rowb + (size_t)kt * 32 + r) * PW + C_IK + 32 * hh;
#pragma unroll
        for (int s = 0; s < 4; ++s) P.bfr[u][s] = *(const bf16x8*)(kp + 8 * s);
    }
}
__device__ __forceinline__ void indexer_item(const Args& a, LAS unsigned char* lds, int b, int qblk, IdxPre& P, bool has_next, int b_next, int qblk_next) {
    int tid = threadIdx.x; asm volatile("" : "+v"(tid));
    const int lane = tid & 63, wave = __builtin_amdgcn_readfirstlane(tid >> 6);
    const bf16* proj = (const bf16*)(a.ws + WS_PROJ);
    unsigned short* SEL = (unsigned short*)(a.ws + WS_SEL);
    LAS float* SC = (LAS float*)lds;
    const int p0 = qblk * 8;
    const int r = lane & 31, hh = lane >> 5;
    const size_t rowb = (size_t)b * SEQ;
#ifdef IDX_FP32
    if (p0 + 7 >= 256) {
        const float* IDX32 = (const float*)(a.ws + WS_YAB);
        LAS float* IQS = (LAS float*)(lds + 131072);
        for (int i = tid; i < 2048; i += 512) IQS[i] = IDX32[(rowb + p0 + (i >> 8)) * 384 + (i & 255)];
        float wq8[8][4];
#pragma unroll
        for (int q = 0; q < 8; ++q)
#pragma unroll
            for (int hd = 0; hd < 4; ++hd) wq8[q][hd] = IDX32[(rowb + p0 + q) * 384 + 320 + hd];
        __syncthreads();
        for (int s = tid; s <= p0 + 7; s += 512) {
            float kf[64];
#pragma unroll
            for (int d4 = 0; d4 < 16; ++d4) { const f32x4 v = *(const f32x4*)(IDX32 + (rowb + s) * 384 + 256 + 4 * d4); kf[4 * d4] = v.x; kf[4 * d4 + 1] = v.y; kf[4 * d4 + 2] = v.z; kf[4 * d4 + 3] = v.w; }
#pragma unroll 1
            for (int q = 0; q < 8; ++q) {
                float sc = 0.f;
#pragma unroll
                for (int hd = 0; hd < 4; ++hd) {
                    float lg = 0.f;
#pragma unroll
                    for (int d4 = 0; d4 < 16; ++d4) { const f32x4 qv = *(const LAS f32x4*)(IQS + q * 256 + hd * 64 + 4 * d4); lg += kf[4 * d4] * qv.x + kf[4 * d4 + 1] * qv.y + kf[4 * d4 + 2] * qv.z + kf[4 * d4 + 3] * qv.w; }
                    sc += fmaxf(lg, 0.f) * wq8[q][hd];
                }
                SC[q * 4096 + s] = sc * 0.0625f;
            }
        }
    }
#else
    if (p0 + 7 >= 256) {
        float wq[4][4];
#pragma unroll
        for (int i = 0; i < 4; ++i) { wq[i][0] = bflo(P.wqr[i].x) * 0.0625f; wq[i][1] = bfhi(P.wqr[i].x) * 0.0625f; wq[i][2] = bflo(P.wqr[i].y) * 0.0625f; wq[i][3] = bfhi(P.wqr[i].y) * 0.0625f; }
        const int ntiles = (p0 + 7) / 32 + 1;
        for (int kt0 = wave; kt0 < ntiles; kt0 += 32) {
            bf16x8 nxt[4][4];
            const bool more = kt0 + 32 < ntiles;
            if (more) {
#pragma unroll
                for (int u = 0; u < 4; ++u) {
                    const int kt = (kt0 + 32 + 8 * u < ntiles) ? kt0 + 32 + 8 * u : kt0;
                    const bf16* kp = proj + (rowb + (size_t)kt * 32 + r) * PW + C_IK + 32 * hh;
#pragma unroll
                    for (int s = 0; s < 4; ++s) nxt[u][s] = *(const bf16x8*)(kp + 8 * s);
                }
            }
#pragma unroll
            for (int u = 0; u < 4; ++u) {
                const int kt = kt0 + 8 * u;
                if (kt < ntiles) {
                    f32x16 acc;
#pragma unroll
                    for (int i = 0; i < 16; ++i) acc[i] = 0.f;
#pragma unroll
                    for (int s = 0; s < 4; ++s) acc = __builtin_amdgcn_mfma_f32_32x32x16_bf16(P.af[s], P.bfr[u][s], acc, 0, 0, 0);
#pragma unroll
                    for (int i = 0; i < 4; ++i) {
                        float s = 0.f;
#pragma unroll
                        for (int hd = 0; hd < 4; ++hd) s += wq[i][hd] * fmaxf(acc[i + 4 * hd], 0.f);
                        SC[(4 * hh + i) * 4096 + kt * 32 + r] = s;
                    }
                }
            }
            if (more) {
#pragma unroll
                for (int u = 0; u < 4; ++u)
#pragma unroll
                    for (int s = 0; s < 4; ++s) P.bfr[u][s] = nxt[u][s];
            }
        }
    }
#endif
    __syncthreads();
#ifndef IDX_FP32
    if (has_next) idx_issue(a, b_next, qblk_next, wave, lane, P);
#endif
    {
        const int pos = p0 + wave, n = pos + 1;
        unsigned short* out = SEL + (rowb + pos) * 256;
        if (n <= 256) {
#pragma unroll
            for (int q = 0; q < 4; ++q) { const int j = lane + 64 * q; out[j] = (unsigned short)((j < n) ? j : 0xFFFF); }
        } else {
            LAS float* row = SC + wave * 4096;
            const int nslots = (n + 63) >> 6;
#ifndef IDX_REP_SELECT
#define IDX_REP_SELECT 1
#endif
            float* bk_ = (float*)(a.ws + WS_YAB) + ((size_t)blockIdx.x * 8 + wave) * 4096;
            if (IDX_REP_SELECT > 1) for (int i_ = lane; i_ < 4096; i_ += 64) bk_[i_] = row[i_];
            for (int rep_ = 0; rep_ < IDX_REP_SELECT; ++rep_) {
            if (rep_ > 0) { for (int i_ = lane; i_ < 4096; i_ += 64) row[i_] = bk_[i_]; LDS_WAIT(); }
            if (nslots <= 16) topk_select<16>(row, n, lane, out);
            else if (nslots <= 32) topk_select<32>(row, n, lane, out);
            else if (nslots <= 48) topk_select<48>(row, n, lane, out);
            else topk_select<64>(row, n, lane, out);
            }
        }
    }
    __syncthreads();
}

__device__ __forceinline__ void phase3(const Args& a, LAS unsigned char* lds) {
    const int bid = blockIdx.x, G = gridDim.x;
#ifndef P3_MASK
#define P3_MASK 7
#endif
#ifndef P3_REP
#define P3_REP 0
#endif
    if (P3_MASK & 1) for (int it = bid; it < 2048; it += G) { gdn_prep_item(a, lds, it); if (P3_REP & 1) gdn_prep_item(a, lds, it); }
    if (P3_MASK & 2) {
#define IDX_MAP(j_, bb_, qb_) do { if (G == 256) { const int i_ = (j_) / G, c_ = (j_) % G, q0_ = (c_ >> 3) + 32 * (i_ >> 1); bb_ = c_ & 7; qb_ = (i_ & 1) ? 511 - q0_ : q0_; } else { bb_ = (j_) >> 9; qb_ = (j_) & 511; } } while (0)
        IdxPre P;
        const int tid_ = threadIdx.x, lane_ = tid_ & 63, wave_ = __builtin_amdgcn_readfirstlane(tid_ >> 6);
        int bb, qb;
        if (bid < 4096) { IDX_MAP(bid, bb, qb); idx_issue(a, bb, qb, wave_, lane_, P); }
        for (int j = bid; j < 4096; j += G) {
            IDX_MAP(j, bb, qb);
            int bn = 0, qn = 0; const bool hn = (j + G < 4096);
            if (hn) IDX_MAP(j + G, bn, qn);
            indexer_item(a, lds, bb, qb, P, hn, bn, qn);
            if (P3_REP & 2) { idx_issue(a, bb, qb, wave_, lane_, P); indexer_item(a, lds, bb, qb, P, false, 0, 0); if (hn) idx_issue(a, bn, qn, wave_, lane_, P); }
        }
#undef IDX_MAP
    }
    if (P3_MASK & 4) for (int it = bid; it < 256; it += G) kn_item(a, it);
}

constexpr int SC_ST = 0, SC_VNT = 34816, SC_O = 53248;
__device__ __forceinline__ v2u pack4(float a, float b, float c, float d) { v2u o; o.x = pk2(a, b); o.y = pk2(c, d); return o; }
__device__ __forceinline__ void scan_epilogue(const LAS float* OS, const v4u z0, const v4u z1, const LAS float* gainl, bf16* ydst, int tid) {
    const int row = tid >> 3, seg = tid & 7;
    float o[16];
#pragma unroll
    for (int q = 0; q < 4; ++q) { const f32x4 v = *(const LAS f32x4*)(OS + row * 132 + 16 * seg + 4 * q); o[4 * q] = v.x; o[4 * q + 1] = v.y; o[4 * q + 2] = v.z; o[4 * q + 3] = v.w; }
    float ss = 0.f;
#pragma unroll
    for (int i = 0; i < 16; ++i) ss += o[i] * o[i];
    ss += __shfl_xor(ss, 1); ss += __shfl_xor(ss, 2); ss += __shfl_xor(ss, 4);
    const float inv = rsqrtf(ss * (1.f / 128.f) + EPS);
    float z[16];
    z[0] = bflo(z0.x); z[1] = bfhi(z0.x); z[2] = bflo(z0.y); z[3] = bfhi(z0.y); z[4] = bflo(z0.z); z[5] = bfhi(z0.z); z[6] = bflo(z0.w); z[7] = bfhi(z0.w);
    z[8] = bflo(z1.x); z[9] = bfhi(z1.x); z[10] = bflo(z1.y); z[11] = bfhi(z1.y); z[12] = bflo(z1.z); z[13] = bfhi(z1.z); z[14] = bflo(z1.w); z[15] = bfhi(z1.w);
    float y[16];
#pragma unroll
    for (int q = 0; q < 4; ++q) { const f32x4 gq = *(const LAS f32x4*)(gainl + 16 * seg + 4 * q);
        y[4 * q] = o[4 * q] * inv * gq.x * silu_fast(z[4 * q]); y[4 * q + 1] = o[4 * q + 1] * inv * gq.y * silu_fast(z[4 * q + 1]); y[4 * q + 2] = o[4 * q + 2] * inv * gq.z * silu_fast(z[4 * q + 2]); y[4 * q + 3] = o[4 * q + 3] * inv * gq.w * silu_fast(z[4 * q + 3]); }
    v4u w0, w1;
    w0.x = pk2(y[0], y[1]); w0.y = pk2(y[2], y[3]); w0.z = pk2(y[4], y[5]); w0.w = pk2(y[6], y[7]);
    w1.x = pk2(y[8], y[9]); w1.y = pk2(y[10], y[11]); w1.z = pk2(y[12], y[13]); w1.w = pk2(y[14], y[15]);
    *(v4u*)(ydst) = w0; *(v4u*)(ydst + 8) = w1;
}
__device__ __forceinline__ void gdn_scan(const Args& a, LAS unsigned char* lds, int bh) {
    const int tid = threadIdx.x, lane = tid & 63, w = __builtin_amdgcn_readfirstlane(tid >> 6), r = lane & 15, g = lane >> 4;
    const int b = bh >> 2, h = bh & 3;
    LAS bf16* ST = (LAS bf16*)(lds + SC_ST); LAS bf16* VNT = (LAS bf16*)(lds + SC_VNT); LAS float* OS = (LAS float*)(lds + SC_O);
    const bf16* proj = (const bf16*)(a.ws + WS_PROJ); bf16* yab = (bf16*)(a.ws + WS_YAB);
    const float* GL = (const float*)(a.ws + WS_GL);
    for (int i = tid; i < 34816 / 4; i += 512) ((LAS unsigned*)ST)[i] = 0u;
    f32x4 S[8];
#pragma unroll
    for (int vt = 0; vt < 8; ++vt) S[vt] = (f32x4){0.f, 0.f, 0.f, 0.f};
    const int erow = tid >> 3, eseg = tid & 7;
    LAS float* gainl = (LAS float*)(lds + 87040);
    if (tid < 128) gainl[tid] = a.in[11][tid];
    const int ct = w & 3;
    const size_t cb = (size_t)bh * 64;
    const bf16* Wb = (const bf16*)((const unsigned char*)a.out + DO_W) + cb * 8192;
    const bf16* QDb = (const bf16*)((const unsigned char*)a.out + DO_QD) + cb * 8192;
    const bf16* KDTb = (const bf16*)((const unsigned char*)a.out + DO_KDT) + cb * 8192;
    const bf16* UTb = (const bf16*)((const unsigned char*)a.out + DO_UT) + cb * 8192;
    const bf16* Ab = (const bf16*)(a.ws + WS_GA) + cb * 4096;
    const bf16* Xb = (w < 4) ? Wb : QDb;
    const size_t tz = ((size_t)b * SEQ + erow) * PW + C_BZ + h * 128 + 16 * eseg;
    const size_t ty = ((size_t)b * SEQ + erow) * YW + 1024 + h * 128 + 16 * eseg;
    bf16x8 af[4], kd[2]; v4u xr[4]; float gl; v4u zh0, zh1;
#define SCAN_LOAD(n_, af_, kd_, xr_, gl_) do { \
        const bf16* X_ = Xb + (size_t)(n_) * 8192 + (ct * 4 * 64 + lane) * 8; \
        _Pragma("unroll") for (int ks = 0; ks < 4; ++ks) af_[ks] = *(const bf16x8*)(X_ + ks * 512); \
        const bf16* K_ = KDTb + (size_t)(n_) * 8192 + (w * 2 * 64 + lane) * 8; \
        kd_[0] = *(const bf16x8*)(K_); kd_[1] = *(const bf16x8*)(K_ + 512); \
        if (w >= 4) { const bf16* A_ = Ab + (size_t)(n_) * 4096 + (ct * 2 * 64 + lane) * 8; xr_[0] = *(const v4u*)(A_); xr_[1] = *(const v4u*)(A_ + 512); } \
        else { const bf16* U_ = UTb + (size_t)(n_) * 8192 + (ct * 8 * 64 + lane) * 4; _Pragma("unroll") for (int q_ = 0; q_ < 4; ++q_) { const v2u u0_ = *(const v2u*)(U_ + (2 * q_) * 256), u1_ = *(const v2u*)(U_ + (2 * q_ + 1) * 256); xr_[q_] = (v4u){u0_.x, u0_.y, u1_.x, u1_.y}; } } \
        gl_ = GL[cb + (n_)]; } while (0)
    SCAN_LOAD(0, af, kd, xr, gl);
    zh0 = (v4u){0u, 0u, 0u, 0u}; zh1 = zh0;
    __syncthreads();
    for (int n = 0; n < 64; ++n) {
        bf16x8 afn[4], kdn[2]; v4u xrn[4]; float gln;
        const int nn = (n < 63) ? n + 1 : 63;
        SCAN_LOAD(nn, afn, kdn, xrn, gln);
        const v4u zn0 = *(const v4u*)(proj + tz + (size_t)n * 64 * PW), zn1 = *(const v4u*)(proj + tz + (size_t)n * 64 * PW + 8);
        if (n > 0) scan_epilogue(OS, zh0, zh1, gainl, yab + ty + (size_t)(n - 1) * 64 * YW, tid);
        zh0 = zn0; zh1 = zn1;
        f32x4 acc[8];
#pragma unroll
        for (int vt = 0; vt < 8; ++vt) acc[vt] = (f32x4){0.f, 0.f, 0.f, 0.f};
#pragma unroll
        for (int ks = 0; ks < 4; ++ks) {
#pragma unroll
            for (int vt = 0; vt < 8; ++vt) {
                const bf16x8 bfr = *(const LAS bf16x8*)(ST + (16 * vt + r) * 136 + 32 * ks + 8 * g);
                acc[vt] = __builtin_amdgcn_mfma_f32_16x16x32_bf16(af[ks], bfr, acc[vt], 0, 0, 0);
            }
        }
        if (w < 4) {
#pragma unroll
            for (int vt = 0; vt < 8; ++vt) {
                const unsigned ux = (vt & 1) ? xr[vt >> 1].z : xr[vt >> 1].x, uy = (vt & 1) ? xr[vt >> 1].w : xr[vt >> 1].y;
                const v2u o = pack4(bflo(ux) - acc[vt][0], bfhi(ux) - acc[vt][1], bflo(uy) - acc[vt][2], bfhi(uy) - acc[vt][3]);
                *(LAS v2u*)(VNT + (16 * vt + r) * 72 + 16 * ct + 4 * g) = o;
            }
        }
        __syncthreads();
        if (w >= 4) {
#pragma unroll
            for (int ks = 0; ks < 2; ++ks)
#pragma unroll
                for (int vt = 0; vt < 8; ++vt) {
                    const bf16x8 vb = *(const LAS bf16x8*)(VNT + (16 * vt + r) * 72 + 32 * ks + 8 * g);
                    acc[vt] = __builtin_amdgcn_mfma_f32_16x16x32_bf16(__builtin_bit_cast(bf16x8, xr[ks]), vb, acc[vt], 0, 0, 0);
                }
#pragma unroll
            for (int vt = 0; vt < 8; ++vt)
#pragma unroll
                for (int rg = 0; rg < 4; ++rg) OS[(16 * ct + 4 * g + rg) * 132 + 16 * vt + r] = acc[vt][rg];
        }
#pragma unroll
        for (int vt = 0; vt < 8; ++vt) S[vt] = S[vt] * gl;
#pragma unroll
        for (int ks = 0; ks < 2; ++ks)
#pragma unroll
            for (int vt = 0; vt < 8; ++vt) {
                const bf16x8 vb = *(const LAS bf16x8*)(VNT + (16 * vt + r) * 72 + 32 * ks + 8 * g);
                S[vt] = __builtin_amdgcn_mfma_f32_16x16x32_bf16(kd[ks], vb, S[vt], 0, 0, 0);
            }
#pragma unroll
        for (int vt = 0; vt < 8; ++vt)
            *(LAS v2u*)(ST + (16 * vt + r) * 136 + 16 * w + 4 * g) = pack4(S[vt][0] + 0.f, S[vt][1] + 0.f, S[vt][2] + 0.f, S[vt][3] + 0.f);
#pragma unroll
        for (int ks = 0; ks < 4; ++ks) af[ks] = afn[ks];
        kd[0] = kdn[0]; kd[1] = kdn[1];
#pragma unroll
        for (int q = 0; q < 4; ++q) xr[q] = xrn[q];
        gl = gln;
        __syncthreads();
    }
    scan_epilogue(OS, zh0, zh1, gainl, yab + ty + (size_t)63 * 64 * YW, tid);
    __syncthreads();
#undef SCAN_LOAD
}

typedef short v4s __attribute__((ext_vector_type(4)));
constexpr int AQ_STRIDE = 272, AQ_WAVE_LDS = 64 * AQ_STRIDE + 512;
__device__ __forceinline__ void attn_query_q4(const Args& a, LAS unsigned char* wl, const LAS float* qgl, int t, int lane) {
    const bf16* proj = (const bf16*)(a.ws + WS_PROJ); const bf16* KN = (const bf16*)(a.ws + WS_KN);
    const unsigned short* SEL = (const unsigned short*)(a.ws + WS_SEL); bf16* yab = (bf16*)(a.ws + WS_YAB);
    LAS unsigned char* KT = wl; LAS unsigned short* SL = (LAS unsigned short*)(wl + 64 * AQ_STRIDE);
    const int r = lane & 15, g = lane >> 4;
    const int b = t >> 12, pos = t & 4095;
    const bf16* knb = KN + (size_t)b * SEQ * 128;
    *(LAS v2u*)(SL + 4 * lane) = *(const v2u*)(SEL + (size_t)t * 256 + 4 * lane);
    bf16x8 qf[4];
    {
        const bf16* qp = proj + (size_t)t * PW + C_AQ + (r & 7) * 128 + 8 * g;
        float f[32]; float ss = 0.f;
#pragma unroll
        for (int ks = 0; ks < 4; ++ks) { const v4u raw = *(const v4u*)(qp + 32 * ks);
            f[8 * ks] = bflo(raw.x); f[8 * ks + 1] = bfhi(raw.x); f[8 * ks + 2] = bflo(raw.y); f[8 * ks + 3] = bfhi(raw.y); f[8 * ks + 4] = bflo(raw.z); f[8 * ks + 5] = bfhi(raw.z); f[8 * ks + 6] = bflo(raw.w); f[8 * ks + 7] = bfhi(raw.w); }
#pragma unroll
        for (int i = 0; i < 32; ++i) ss += f[i] * f[i];
        ss += __shfl_xor(ss, 16); ss += __shfl_xor(ss, 32);
        float inv = rsqrtf(ss * (1.f / 128.f) + EPS) * 0.08838834764831845f;
        if (r >= 8) inv = 0.f;
#pragma unroll
        for (int ks = 0; ks < 4; ++ks) { const f32x4 ga = *(const LAS f32x4*)(qgl + 32 * ks + 8 * g), gb = *(const LAS f32x4*)(qgl + 32 * ks + 8 * g + 4);
            v4u o; o.x = pk2(f[8 * ks] * inv * ga.x, f[8 * ks + 1] * inv * ga.y); o.y = pk2(f[8 * ks + 2] * inv * ga.z, f[8 * ks + 3] * inv * ga.w);
            o.z = pk2(f[8 * ks + 4] * inv * gb.x, f[8 * ks + 5] * inv * gb.y); o.w = pk2(f[8 * ks + 6] * inv * gb.z, f[8 * ks + 7] * inv * gb.w);
            qf[ks] = __builtin_bit_cast(bf16x8, o); }
    }
    LDS_WAIT();
    const int cnt = (pos + 1 < 256) ? pos + 1 : 256, nq = (cnt + 63) >> 6;
    const float slope = exp2f(-(float)((r & 7) + 1));
    float m_run = -INFINITY, l_run = 0.f;
    f32x4 O[8];
#pragma unroll
    for (int dt = 0; dt < 8; ++dt) O[dt] = (f32x4){0.f, 0.f, 0.f, 0.f};
    bf16x8 ka[4][4], kb[4][4];
#define AQ_LOAD(q_, k_) do { _Pragma("unroll") for (int kt = 0; kt < 4; ++kt) { int ix_ = SL[64 * (q_) + 16 * kt + r]; ix_ = (ix_ == 0xFFFF) ? 0 : ix_; \
        const bf16* kp_ = knb + (size_t)ix_ * 128 + 8 * g; _Pragma("unroll") for (int ks = 0; ks < 4; ++ks) k_[kt][ks] = *(const bf16x8*)(kp_ + 32 * ks); } } while (0)
#define AQ_PASS(q_, k_) do { \
        f32x4 sc[4]; \
        _Pragma("unroll") for (int kt = 0; kt < 4; ++kt) { f32x4 acc = (f32x4){0.f, 0.f, 0.f, 0.f}; \
            _Pragma("unroll") for (int ks = 0; ks < 4; ++ks) { acc = __builtin_amdgcn_mfma_f32_16x16x32_bf16(k_[kt][ks], qf[ks], acc, 0, 0, 0); \
                *(LAS bf16x8*)(KT + (16 * kt + r) * AQ_STRIDE + (32 * ks + 8 * g) * 2) = k_[kt][ks]; } \
            sc[kt] = acc; } \
        float m = m_run; \
        _Pragma("unroll") for (int kt = 0; kt < 4; ++kt) { const v2u s4 = *(const LAS v2u*)(SL + 64 * (q_) + 16 * kt + 4 * g); \
            const int i0 = s4.x & 0xFFFF, i1 = s4.x >> 16, i2 = s4.y & 0xFFFF, i3 = s4.y >> 16; \
            sc[kt][0] = (i0 != 0xFFFF) ? sc[kt][0] - slope * (float)(pos - i0) : -INFINITY; sc[kt][1] = (i1 != 0xFFFF) ? sc[kt][1] - slope * (float)(pos - i1) : -INFINITY; \
            sc[kt][2] = (i2 != 0xFFFF) ? sc[kt][2] - slope * (float)(pos - i2) : -INFINITY; sc[kt][3] = (i3 != 0xFFFF) ? sc[kt][3] - slope * (float)(pos - i3) : -INFINITY; \
            m = fmaxf(fmaxf(m, fmaxf(sc[kt][0], sc[kt][1])), fmaxf(sc[kt][2], sc[kt][3])); } \
        m = fmaxf(m, __shfl_xor(m, 16)); m = fmaxf(m, __shfl_xor(m, 32)); \
        const float alpha = __expf(m_run - m); \
        float ls = 0.f; \
        _Pragma("unroll") for (int kt = 0; kt < 4; ++kt) _Pragma("unroll") for (int rg = 0; rg < 4; ++rg) { const float e = __expf(sc[kt][rg] - m); sc[kt][rg] = e; ls += e; } \
        ls += __shfl_xor(ls, 16); ls += __shfl_xor(ls, 32); \
        l_run = l_run * alpha + ls; m_run = m; \
        _Pragma("unroll") for (int rg = 0; rg < 4; ++rg) { const float ah = __shfl(alpha, 4 * g + rg); _Pragma("unroll") for (int dt = 0; dt < 8; ++dt) O[dt][rg] *= ah; } \
        _Pragma("unroll") for (int c = 0; c < 2; ++c) { v4u o_; o_.x = pk2(sc[2 * c][0], sc[2 * c][1]); o_.y = pk2(sc[2 * c][2], sc[2 * c][3]); o_.z = pk2(sc[2 * c + 1][0], sc[2 * c + 1][1]); o_.w = pk2(sc[2 * c + 1][2], sc[2 * c + 1][3]); \
            const bf16x8 pa = __builtin_bit_cast(bf16x8, o_); \
            _Pragma("unroll") for (int dt = 0; dt < 8; ++dt) { \
                const v4s b0 = __builtin_amdgcn_ds_read_tr16_b64_v4i16((LAS v4s*)(tb + (32 * c) * AQ_STRIDE + 32 * dt)); \
                const v4s b1 = __builtin_amdgcn_ds_read_tr16_b64_v4i16((LAS v4s*)(tb + (32 * c + 16) * AQ_STRIDE + 32 * dt)); \
                const bf16x8 bfr = __builtin_shufflevector(b0, b1, 0, 1, 2, 3, 4, 5, 6, 7); \
                O[dt] = __builtin_amdgcn_mfma_f32_16x16x32_bf16(pa, bfr, O[dt], 0, 0, 0); } } \
        __builtin_amdgcn_sched_barrier(0); } while (0)
    const LAS unsigned char* tb = KT + (4 * g + (r >> 2)) * AQ_STRIDE + 8 * (r & 3);
    AQ_LOAD(0, ka);
    AQ_LOAD(1, kb);
    AQ_PASS(0, ka);
    AQ_LOAD(2, ka);
    if (nq > 1) AQ_PASS(1, kb);
    AQ_LOAD(3, kb);
    if (nq > 2) AQ_PASS(2, ka);
    if (nq > 3) AQ_PASS(3, kb);
#undef AQ_LOAD
#undef AQ_PASS
    const float il = 1.f / l_run;
    if (true) {
        float ih[4];
#pragma unroll
        for (int rg = 0; rg < 4; ++rg) ih[rg] = __shfl(il, 4 * g + rg);
        if (g < 2) {
#pragma unroll
            for (int rg = 0; rg < 4; ++rg)
#pragma unroll
                for (int dt = 0; dt < 8; ++dt) yab[(size_t)t * YW + (4 * g + rg) * 128 + 16 * dt + r] = (bf16)f2bf(O[dt][rg] * ih[rg]);
        }
    }
    LDS_WAIT();
}

__device__ __forceinline__ void phase4(const Args& a, LAS unsigned char* lds) {
    const int bid = blockIdx.x, G = gridDim.x, tid = threadIdx.x, lane = tid & 63, wave = tid >> 6;
    const int nscan = (G >= 64) ? 32 : 0;
#ifndef P4_REP
#define P4_REP 0
#endif
    if (nscan && bid < 32) { gdn_scan(a, lds, bid); if (P4_REP & 1) { __syncthreads(); gdn_scan(a, lds, bid); } return; }
    if (!nscan) { for (int bh = bid; bh < 32; bh += G) gdn_scan(a, lds, bh); __syncthreads(); }
    LAS float* qg4 = (LAS float*)(lds + 8 * AQ_WAVE_LDS);
    if (tid < 128) qg4[tid] = a.in[5][tid];
    __syncthreads();
    LAS unsigned char* wl4 = lds + wave * AQ_WAVE_LDS;
    if (nscan == 32 && (G & 7) == 0) {
        const int bb = bid & 7, wl_i = ((bid - 32) >> 3) * 8 + wave, nwl = ((G - 32) >> 3) * 8;
        for (int p = wl_i; p < SEQ; p += nwl) attn_query_q4(a, wl4, qg4, bb * SEQ + p, lane);
        if (P4_REP & 2) for (int p = wl_i; p < SEQ; p += nwl) attn_query_q4(a, wl4, qg4, bb * SEQ + p, lane);
    } else {
        const int gw = (bid - nscan) * 8 + wave, NGW = (G - nscan) * 8;
        for (int t = gw; t < T_TOK; t += NGW) attn_query_q4(a, wl4, qg4, t, lane);
    }
}

#define INS16P(L, v_) do { float _x = (v_); \
    _Pragma("unroll") for (int _k = 0; _k < 16; ++_k) { const float _h = __builtin_fmaxf(L[_k], _x); _x = __builtin_fminf(L[_k], _x); L[_k] = _h; } } while (0)
#define CE_D(a_, b_) do { const float _h = __builtin_fmaxf(a_, b_), _l = __builtin_fminf(a_, b_); a_ = _h; b_ = _l; } while (0)
#define SORT16_DESC(A) do { \
    _Pragma("unroll") for (int k_ = 2; k_ <= 16; k_ <<= 1) \
    _Pragma("unroll") for (int j_ = k_ >> 1; j_ > 0; j_ >>= 1) \
    _Pragma("unroll") for (int i_ = 0; i_ < 16; ++i_) { const int l_ = i_ ^ j_; if (l_ > i_) { if ((i_ & k_) == 0) CE_D(A[i_], A[l_]); else CE_D(A[l_], A[i_]); } } } while (0)
#define MERGE16_TOP(L, B) do { \
    _Pragma("unroll") for (int i_ = 0; i_ < 16; ++i_) L[i_] = __builtin_fmaxf(L[i_], B[15 - i_]); \
    _Pragma("unroll") for (int j_ = 8; j_ > 0; j_ >>= 1) \
    _Pragma("unroll") for (int i_ = 0; i_ < 16; ++i_) { const int l_ = i_ ^ j_; if (l_ > i_) CE_D(L[i_], L[l_]); } } while (0)
__device__ __forceinline__ float packf(float v, unsigned id, unsigned mask) { return __uint_as_float((__float_as_uint(v) & ~mask) | id); }

__device__ __forceinline__ void peer_route_unit(const Args& a, LAS float* SC, int tt, int p, int lane) {
    const bf16* query = (const bf16*)(a.ws + WS_QUERY); const bf16* subk = (const bf16*)(a.ws + WS_SUBK);
    int* expid = (int*)(a.ws + WS_EXPID); float* gate = (float*)(a.ws + WS_GATE);
    const int r = lane & 15, g = lane >> 4;
    const int tok = lane & 31, ch = lane >> 5;
    float L1[16], L2[16];
#pragma unroll
    for (int k = 0; k < 16; ++k) { L1[k] = 0.f; L2[k] = 0.f; }
#pragma unroll 1
    for (int half = 0; half < 2; ++half) {
        bf16x8 bk[8][4];
        {
            const bf16* kp = subk + (size_t)((p * 2 + half) * 128 + r) * 128 + 8 * g;
#pragma unroll
            for (int nt = 0; nt < 8; ++nt)
#pragma unroll
                for (int ks = 0; ks < 4; ++ks) bk[nt][ks] = *(const bf16x8*)(kp + (size_t)nt * 16 * 128 + 32 * ks);
        }
        bf16x8 af[2][4];
#pragma unroll
        for (int mt = 0; mt < 2; ++mt) {
            const bf16* qp = query + (size_t)(tt * 32 + mt * 16 + r) * 2048 + p * 256 + half * 128 + 8 * g;
#pragma unroll
            for (int ks = 0; ks < 4; ++ks) af[mt][ks] = *(const bf16x8*)(qp + 32 * ks);
        }
#pragma unroll
        for (int mt = 0; mt < 2; ++mt) {
#pragma unroll
            for (int nt = 0; nt < 8; ++nt) {
                f32x4 acc = (f32x4){0.f, 0.f, 0.f, 0.f};
#pragma unroll
                for (int ks = 0; ks < 4; ++ks) acc = __builtin_amdgcn_mfma_f32_16x16x32_bf16(af[mt][ks], bk[nt][ks], acc, 0, 0, 0);
#pragma unroll
                for (int rg = 0; rg < 4; ++rg) SC[(mt * 16 + 4 * g + rg) * 132 + nt * 16 + r] = acc[rg];
            }
        }
        LDS_WAIT();
        float L[16];
#pragma unroll
        for (int c16 = 0; c16 < 4; ++c16) {
            float B[16];
#pragma unroll
            for (int c4 = 0; c4 < 4; ++c4) {
                const f32x4 v = *(const LAS f32x4*)(SC + tok * 132 + 64 * ch + 16 * c16 + 4 * c4);
                const unsigned n0 = 64 * ch + 16 * c16 + 4 * c4;
                B[4 * c4] = packf(v.x, n0, 127u); B[4 * c4 + 1] = packf(v.y, n0 + 1, 127u); B[4 * c4 + 2] = packf(v.z, n0 + 2, 127u); B[4 * c4 + 3] = packf(v.w, n0 + 3, 127u);
            }
            SORT16_DESC(B);
            if (c16 == 0) {
#pragma unroll
                for (int k = 0; k < 16; ++k) L[k] = B[k];
            } else MERGE16_TOP(L, B);
        }
        {
            float B[16];
#pragma unroll
            for (int k = 0; k < 16; ++k) B[k] = __shfl(L[k], tok + 32);
            MERGE16_TOP(L, B);
        }
#pragma unroll
        for (int k = 0; k < 16; ++k) { L1[k] = (half == 0) ? L[k] : L1[k]; L2[k] = (half == 0) ? L2[k] : L[k]; }
        LDS_WAIT();
    }
    float V1[16], V2[16];
#pragma unroll
    for (int k = 0; k < 16; ++k) { V1[k] = __uint_as_float(__float_as_uint(L1[k]) & ~127u); V2[k] = __uint_as_float(__float_as_uint(L2[k]) & ~127u); }
    float C[16];
#pragma unroll
    for (int k = 0; k < 16; ++k) C[k] = -INFINITY;
#pragma unroll
    for (int i = 0; i < 16; ++i)
#pragma unroll
        for (int j = 0; j < 16; ++j)
            if ((i + 1) * (j + 1) <= 16) INS16P(C, packf(V1[i] + V2[j], (unsigned)(i * 16 + j), 255u));
    if (ch == 0) {
        float e[16], sum = 0.f; int ex[16];
        const float c0 = __uint_as_float(__float_as_uint(C[0]) & ~255u);
#pragma unroll
        for (int k = 0; k < 16; ++k) {
            const unsigned cb = __float_as_uint(C[k]); const int ci = (cb >> 4) & 15, cj = cb & 15;
            int i1 = 0, i2 = 0;
#pragma unroll
            for (int m = 0; m < 16; ++m) { i1 = (ci == m) ? (int)(__float_as_uint(L1[m]) & 127u) : i1; i2 = (cj == m) ? (int)(__float_as_uint(L2[m]) & 127u) : i2; }
            ex[k] = i1 * 128 + i2;
            e[k] = __expf(__uint_as_float(cb & ~255u) - c0); sum += e[k];
        }
        const float inv = 1.f / sum;
        const size_t base = ((size_t)(tt * 32 + tok) * 8 + p) * 16;
#pragma unroll
        for (int q = 0; q < 4; ++q) {
            *(v4u*)(expid + base + 4 * q) = (v4u){(unsigned)ex[4 * q], (unsigned)ex[4 * q + 1], (unsigned)ex[4 * q + 2], (unsigned)ex[4 * q + 3]};
            *(f32x4*)(gate + base + 4 * q) = (f32x4){e[4 * q] * inv, e[4 * q + 1] * inv, e[4 * q + 2] * inv, e[4 * q + 3] * inv};
        }
    }
}
__device__ __forceinline__ void phase8(const Args& a, LAS unsigned char* lds) {
    const int tid = threadIdx.x, lane = tid & 63, wave = tid >> 6;
    LAS float* SC = (LAS float*)(lds + wave * 16896);
    const int gw = blockIdx.x * 8 + wave, NGW = gridDim.x * 8;
#ifndef P8_REP
#define P8_REP 1
#endif
    for (int rep_ = 0; rep_ < P8_REP; ++rep_)
    for (int u = gw; u < 1024 * 8; u += NGW) peer_route_unit(a, SC, u >> 3, u & 7, lane);
}

typedef float f32x2 __attribute__((ext_vector_type(2)));
__device__ __forceinline__ void cvt8(const v4u u, float* f) { f[0] = bflo(u.x); f[1] = bfhi(u.x); f[2] = bflo(u.y); f[3] = bfhi(u.y); f[4] = bflo(u.z); f[5] = bfhi(u.z); f[6] = bflo(u.w); f[7] = bfhi(u.w); }
__device__ __forceinline__ void cvt16_fp8(const v4u u, float* f) {
#pragma unroll
    for (int q = 0; q < 4; ++q) { const f32x2 lo = __builtin_amdgcn_cvt_pk_f32_fp8((int)u[q], false), hi = __builtin_amdgcn_cvt_pk_f32_fp8((int)u[q], true);
        f[4 * q] = lo.x; f[4 * q + 1] = lo.y; f[4 * q + 2] = hi.x; f[4 * q + 3] = hi.y; }
}
#define DPPF(x_, ctrl_) __builtin_bit_cast(float, __builtin_amdgcn_update_dpp(0, __builtin_bit_cast(int, (x_)), (ctrl_), 0xF, 0xF, false))
__device__ __forceinline__ float reduce8(const float* d, int lane) {
    const bool b0 = lane & 1, b1 = lane & 2, b2 = lane & 4;
    float s1[4], s2[2];
#pragma unroll
    for (int i = 0; i < 4; ++i) { const float a = b0 ? d[2 * i + 1] : d[2 * i], b = b0 ? d[2 * i] : d[2 * i + 1]; s1[i] = a + DPPF(b, 0xB1); }
#pragma unroll
    for (int i = 0; i < 2; ++i) { const float a = b1 ? s1[2 * i + 1] : s1[2 * i], b = b1 ? s1[2 * i] : s1[2 * i + 1]; s2[i] = a + DPPF(b, 0x4E); }
    const float a3 = b2 ? s2[1] : s2[0], b3 = b2 ? s2[0] : s2[1];
    float s = a3 + DPPF(b3, 0x124);
    s += DPPF(s, 0x128);
    s += __shfl_xor(s, 16); s += __shfl_xor(s, 32);
    return s;
}
#ifndef P9L_G
#define P9L_G 8
#endif
constexpr int P9LG = P9L_G, P9LP = 128 + P9LG;
constexpr int P9L_WAVE = 4 * (P9LP * 4 * 3);
#ifndef P9L_SH
#define P9L_SH 12
#endif
constexpr int P9L_NS = 16384 >> P9L_SH;
__device__ __forceinline__ void phase9l(const Args& a, LAS unsigned char* lds) {
    const int tid = threadIdx.x, lane = tid & 63, wave = tid >> 6, G = gridDim.x;
    const unsigned char* UT = a.ws + WS_UT; const unsigned char* VT = a.ws + WS_VT;
    const float* SU = (const float*)(a.ws + WS_SU); const float* SV = (const float*)(a.ws + WS_SV);
    const int* expid = (const int*)(a.ws + WS_EXPID); const float* gate = (const float*)(a.ws + WS_GATE);
    const float* mod = (const float*)(a.ws + WS_MOD);
    LAS int* LE = (LAS int*)(lds + wave * P9L_WAVE);
    LAS float* LG = (LAS float*)(LE + 4 * P9LP);
    LAS float* LA = LG + 4 * P9LP;
    const bool isdiag = (lane >> 4) == ((lane & 15) >> 2);
    for (int rd = 0; ; ++rd) {
        const int tb = ((rd * G + (int)blockIdx.x) * 8 + wave) * 4;
        if (tb >= T_TOK) break;
        v4u h8[4]; float hsc[4]; int off[4][P9L_NS + 1];
#pragma unroll
        for (int i = 0; i < 4; ++i) {
            const size_t t = (size_t)(tb + i);
            h8[i] = *(const v4u*)(a.ws + WS_H8 + t * DM + 16 * lane); hsc[i] = ((const float*)(a.ws + WS_HS))[t];
            int e[2]; float gq[2];
#pragma unroll
            for (int q = 0; q < 2; ++q) { e[q] = expid[t * 128 + lane + 64 * q]; gq[q] = gate[t * 128 + lane + 64 * q]; }
            int base = 0;
#pragma unroll
            for (int s = 0; s < P9L_NS; ++s) {
                off[i][s] = base;
#pragma unroll
                for (int q = 0; q < 2; ++q) {
                    const bool in = (e[q] >> P9L_SH) == s;
                    const unsigned long long mk = __builtin_amdgcn_ballot_w64(in);
                    const int pos = base + __builtin_amdgcn_mbcnt_hi((unsigned)(mk >> 32), __builtin_amdgcn_mbcnt_lo((unsigned)mk, 0));
                    if (in) { LE[i * P9LP + pos] = e[q]; LG[i * P9LP + pos] = gq[q]; }
                    base += __builtin_popcountll(mk);
                }
            }
            off[i][P9L_NS] = 128;
            if (lane < P9LG) LE[i * P9LP + 128 + lane] = e[0];
        }
        LDS_WAIT();
#pragma unroll 1
        for (int s = 0; s < P9L_NS; ++s) {
#pragma unroll
            for (int i = 0; i < 4; ++i) {
                for (int g0 = off[i][s]; g0 < off[i][s + 1]; g0 += P9LG) {
                    const int n = off[i][s + 1] - g0;
                    const int ev = LE[i * P9LP + g0 + (lane & (P9LG - 1))];
                    v4u ua[P9LG];
#pragma unroll
                    for (int k = 0; k < P9LG; ++k) { const int e = __builtin_amdgcn_readlane(ev, k); ua[k] = *(const v4u*)(UT + (size_t)e * 1024 + 16 * lane); }
                    const long hlo = (long)(((unsigned long long)h8[i].y << 32) | h8[i].x), hhi = (long)(((unsigned long long)h8[i].w << 32) | h8[i].z);
#pragma unroll
                    for (int k8 = 0; k8 < P9LG; k8 += 8) {
                        float dd[8];
#pragma unroll
                        for (int k = 0; k < 8; ++k) {
                            f32x4 cacc = (f32x4){0.f, 0.f, 0.f, 0.f};
                            cacc = __builtin_amdgcn_mfma_f32_16x16x32_fp8_fp8((long)(((unsigned long long)ua[k8 + k].y << 32) | ua[k8 + k].x), hlo, cacc, 0, 0, 0);
                            cacc = __builtin_amdgcn_mfma_f32_16x16x32_fp8_fp8((long)(((unsigned long long)ua[k8 + k].w << 32) | ua[k8 + k].z), hhi, cacc, 0, 0, 0);
                            const float c01 = (lane & 1) ? cacc[1] : cacc[0], c23 = (lane & 1) ? cacc[3] : cacc[2];
                            dd[k] = isdiag ? ((lane & 2) ? c23 : c01) : 0.f;
                        }
                        const float tot = reduce8(dd, lane);
                        if (lane < 8 && k8 + lane < n) LA[i * P9LP + g0 + k8 + lane] = tot;
                        __builtin_amdgcn_sched_barrier(0);
                    }
                }
            }
        }
        LDS_WAIT();
#pragma unroll
        for (int i = 0; i < 4; ++i)
#pragma unroll
            for (int q = 0; q < 2; ++q) { const int ix = i * P9LP + lane + 64 * q; const int e = LE[ix];
                const float dq = LA[ix] * SU[e] * hsc[i];
                LA[ix] = 0.5f * dq * (1.f + erff(dq * 0.70710678118654752f)) * LG[ix] * SV[e]; }
        LDS_WAIT();
        float y[4][16];
#pragma unroll
        for (int i = 0; i < 4; ++i)
#pragma unroll
            for (int c = 0; c < 16; ++c) y[i][c] = 0.f;
#pragma unroll 1
        for (int s = 0; s < P9L_NS; ++s) {
#pragma unroll
            for (int i = 0; i < 4; ++i) {
                for (int g0 = off[i][s]; g0 < off[i][s + 1]; g0 += P9LG) {
                    const int n = off[i][s + 1] - g0;
                    const int ev = LE[i * P9LP + g0 + (lane & (P9LG - 1))];
                    const float av = ((lane & (P9LG - 1)) < n) ? LA[i * P9LP + g0 + (lane & (P9LG - 1))] : 0.f;
                    v4u va[P9LG];
#pragma unroll
                    for (int k = 0; k < P9LG; ++k) { const int e = __builtin_amdgcn_readlane(ev, k); va[k] = *(const v4u*)(VT + (size_t)e * 1024 + 16 * lane); }
#pragma unroll
                    for (int k = 0; k < P9LG; ++k) { const float aj = __builtin_bit_cast(float, __builtin_amdgcn_readlane(__builtin_bit_cast(int, av), k));
                        float f[16]; cvt16_fp8(va[k], f);
#pragma unroll
                        for (int c = 0; c < 16; ++c) y[i][c] = __builtin_fmaf(aj, f[c], y[i][c]);
                        if ((k & 3) == 3) __builtin_amdgcn_sched_barrier(0); }
                }
            }
        }
#pragma unroll
        for (int i = 0; i < 4; ++i) {
            const int t = tb + i, b = t >> 12;
            float* orow = a.out + (size_t)t * DM + 16 * lane; const float* g2 = mod + b * 6144 + 5120 + 16 * lane;
#pragma unroll
            for (int q4 = 0; q4 < 4; ++q4) {
                const f32x4 xv = *(const f32x4*)(orow + 4 * q4), gv = *(const f32x4*)(g2 + 4 * q4);
                const f32x4 yv = (f32x4){y[i][4 * q4], y[i][4 * q4 + 1], y[i][4 * q4 + 2], y[i][4 * q4 + 3]};
                *(f32x4*)(orow + 4 * q4) = xv + gv * yv;
            }
        }
        LDS_WAIT();
    }
}

#define XB_TMO      128
#define XB_XCNT(j)  (256  + 64 * (j))
#define XB_XSUB(j)  (1280 + 64 * (j))
#define XB_XGEN(j)  (2304 + 64 * (j))
#define XB_TOP      3328
#define XB_TOPGEN   3392
#define XCD_BAR_WORDS 3456
#define XB_SPIN_CAP (1u << 18)

__device__ __forceinline__ unsigned xb_ld(unsigned* p)              { return __hip_atomic_load(p, __ATOMIC_RELAXED, __HIP_MEMORY_SCOPE_AGENT); }
__device__ __forceinline__ unsigned xb_add(unsigned* p, unsigned v) { return __hip_atomic_fetch_add(p, v, __ATOMIC_RELAXED, __HIP_MEMORY_SCOPE_AGENT); }
__device__ __forceinline__ unsigned xb_xcc_id() { return (unsigned)__builtin_amdgcn_s_getreg((3 << 11) | 20) & 0xFu; }
#define XB_SPIN(cond, bar) do { unsigned _sp = 0; while (cond) { __builtin_amdgcn_s_sleep(1); \
    if ((++_sp & 255u) == 0u) { if (xb_ld(&(bar)[XB_TMO])) break; if (_sp > XB_SPIN_CAP) { atomicAdd(&(bar)[XB_TMO], 1u); break; } } } } while (0)

struct XcdBarrier {
    unsigned* bar; unsigned x;
    volatile LAS unsigned* st;
};

__device__ __forceinline__ XcdBarrier xcd_barrier_post(unsigned* bar, volatile LAS unsigned* st) {
    XcdBarrier b; b.bar = bar; b.x = xb_xcc_id(); b.st = st;
    if (threadIdx.x == 0) (void)xb_add(&bar[XB_XCNT(b.x)], 1u);
    return b;
}
__device__ __forceinline__ void xcd_barrier_complete(unsigned* bar, unsigned x, unsigned& nloc, unsigned& nx) {
    const unsigned G = gridDim.x * gridDim.y * gridDim.z;
    unsigned sum, cnt, mine, sp = 0u;
    for (;;) {
        sum = 0u; cnt = 0u; mine = 0u;
#pragma unroll
        for (unsigned j = 0; j < 16; ++j) { const unsigned c = xb_ld(&bar[XB_XCNT(j)]); sum += c; cnt += (c > 0u) ? 1u : 0u; mine = (j == x) ? c : mine; }
        if (sum == G) break;
        __builtin_amdgcn_s_sleep(1);
        if ((++sp & 255u) == 0u) { if (xb_ld(&bar[XB_TMO])) break; if (sp > XB_SPIN_CAP) { atomicAdd(&bar[XB_TMO], 1u); break; } }
    }
    nloc = mine > 0u ? mine : 1u; nx = cnt > 0u ? cnt : 1u;
}

__device__ __forceinline__ void xcd_barrier(const XcdBarrier& b) {
    asm volatile("s_waitcnt vmcnt(0)" ::: "memory");
    __syncthreads();
    if (threadIdx.x == 0) {
        unsigned* bar = b.bar;
        __builtin_amdgcn_s_waitcnt(0);
        unsigned nloc = b.st[0], nx = b.st[1];
        if (nloc == 0u) { xcd_barrier_complete(bar, b.x, nloc, nx); b.st[0] = nloc; b.st[1] = nx; }
        const unsigned old = xb_add(&bar[XB_XSUB(b.x)], 1u);
        const unsigned gen = old / nloc;
        if (old + 1u == (gen + 1u) * nloc) {
            __builtin_amdgcn_fence(__ATOMIC_RELEASE, "agent");
            asm volatile("s_waitcnt vmcnt(0)" ::: "memory");
            const unsigned og = xb_add(&bar[XB_TOP], 1u);
            const unsigned tg = og / nx;
            if (og + 1u == (tg + 1u) * nx) xb_add(&bar[XB_TOPGEN], 1u);
            else XB_SPIN(xb_ld(&bar[XB_TOPGEN]) == tg, bar);
            __builtin_amdgcn_fence(__ATOMIC_ACQUIRE, "agent");
            xb_add(&bar[XB_XGEN(b.x)], 1u);
            asm volatile("s_waitcnt vmcnt(0)" ::: "memory");
        } else {
            XB_SPIN(xb_ld(&bar[XB_XGEN(b.x)]) == gen, bar);
            __builtin_amdgcn_fence(__ATOMIC_ACQUIRE, "agent");
            asm volatile("s_waitcnt vmcnt(0)" ::: "memory");
        }
    }
    __syncthreads();
}

__global__ void __launch_bounds__(512, 2) mega_fwd(Args a) {
    extern __shared__ __attribute__((aligned(16))) unsigned char lds_raw[];
    LAS unsigned char* lds = (LAS unsigned char*)lds_raw;
    asm volatile("" : "+v"(lds));
    cg::grid_group grid = cg::this_grid();
#define MISC_PTR ((volatile LAS unsigned*)((LAS unsigned char*)lds_raw + (LDS_BYTES - 64)))
    if (threadIdx.x < 16) MISC_PTR[threadIdx.x] = 0u;
    __syncthreads();
    const unsigned xcc_id = xcd_barrier_post((unsigned*)(a.ws + WS_CTL) + 4096, MISC_PTR).x;
    grid.sync();
    unsigned char* ws = a.ws;
    const int lo = a.ph_lo, hi = a.ph_hi;
#ifndef PH_MASK
#define PH_MASK 0x3ff
#endif
#define IN(k) (((PH_MASK >> (k)) & 1) && lo <= (k) && (k) < hi)
#define SEAM(k) do { if (IN(k) && IN((k) + 1)) { if ((k) == 99) grid.sync(); else { XcdBarrier xb_; xb_.bar = (unsigned*)(a.ws + WS_CTL) + 4096; xb_.x = xcc_id; xb_.st = MISC_PTR; xcd_barrier(xb_); } } } while (0)
#ifndef REP_MASK
#define REP_MASK 0
#endif
#define RUNP(k, body) do { if (IN(k)) { body; if ((REP_MASK >> (k)) & 1) { grid.sync(); body; } } } while (0)
    RUNP(0, phase0(a, lds)); SEAM(0);
    RUNP(1, phase_norm(a.in[0], (const float*)(ws + WS_MOD), 0, 1024, (bf16*)(ws + WS_H))); SEAM(1);
    RUNP(2, ({
        pg8::Gemm g{(const pg8::bf16_t*)(ws + WS_H), (const pg8::bf16_t*)(ws + WS_WIN), T_TOK, PW, DM}; pg8::StaticOrder S; S.init(T_TOK, PW, gridDim.x, blockIdx.x);
        EpiBf E{(bf16*)(ws + WS_PROJ), PW};
        pg8::gemm_phase<EpiBf, pg8::StaticOrder, true, true>(lds, g, S, E); })); SEAM(2);
#ifdef IDX_FP32
    if (IN(3)) { phase_idx32(a, lds); grid.sync(); }
#endif
    RUNP(3, phase3(a, lds)); SEAM(3);
    RUNP(4, phase4(a, lds)); SEAM(4);
    RUNP(5, ({
        pg8::Gemm g{(const pg8::bf16_t*)(ws + WS_YAB), (const pg8::bf16_t*)(ws + WS_BT2), T_TOK, DM, YW}; pg8::StaticOrder S; S.init(T_TOK, DM, gridDim.x, blockIdx.x);
        EpiX1 E{a.in[0], a.out, (const float*)(ws + WS_MOD)};
        pg8::gemm_phase<EpiX1, pg8::StaticOrder, true, true>(lds, g, S, E); })); SEAM(5);
    RUNP(6, phase_norm(a.out, (const float*)(ws + WS_MOD), 3072, 4096, (bf16*)(ws + WS_H), ws + WS_H8, (float*)(ws + WS_HS))); SEAM(6);
    RUNP(7, ({
        pg8::Gemm g{(const pg8::bf16_t*)(ws + WS_H), (const pg8::bf16_t*)(ws + WS_WQ), T_TOK, 2048, DM}; pg8::StaticOrder S; S.init(T_TOK, 2048, gridDim.x, blockIdx.x);
        EpiBf E{(bf16*)(ws + WS_QUERY), 2048};
        pg8::gemm_phase<EpiBf, pg8::StaticOrder, true, true>(lds, g, S, E); })); SEAM(7);
    RUNP(8, phase8(a, lds)); SEAM(8);
    if (IN(9)) { phase9l(a, lds); }
#undef IN
#undef SEAM
}

#ifndef MK_N_LAUNCHES
#define MK_N_LAUNCHES 1
#endif
extern "C" void kernel_launch(void* const* d_in, const int* in_sizes, int n_in, void* d_out, int out_size, void* d_ws, size_t ws_size, hipStream_t stream) {
    static int grid = 0;
    if (grid == 0) {
        int dev = 0, cus = 0, per_cu = 0;
        hipGetDevice(&dev);
        hipDeviceGetAttribute(&cus, hipDeviceAttributeMultiprocessorCount, dev);
        hipFuncSetAttribute((const void*)mega_fwd, hipFuncAttributeMaxDynamicSharedMemorySize, LDS_BYTES);
        hipOccupancyMaxActiveBlocksPerMultiprocessor(&per_cu, (const void*)mega_fwd, 512, LDS_BYTES);
        if (per_cu < 1) { fprintf(stderr, "kernel_launch: occupancy query says %d blocks per CU\n", per_cu); per_cu = 1; }
        grid = cus * 1;
        if (n_in != 17 || ws_size < WS_END) fprintf(stderr, "kernel_launch: unexpected n_in %d / ws_size %zu\n", n_in, ws_size);
    }
    (void)hipMemsetAsync((char*)d_ws + WS_CTL, 0, 65536, stream);
    Args a{};
    for (int i = 0; i < 17; ++i) a.in[i] = (const float*)d_in[i];
    a.out = (float*)d_out; a.ws = (unsigned char*)d_ws;
#if MK_N_LAUNCHES == 1
    a.ph_lo = 0; a.ph_hi = 10;
    void* args[] = {&a};
    hipError_t e = hipLaunchCooperativeKernel((const void*)mega_fwd, dim3(grid), dim3(512), args, LDS_BYTES, stream);
    if (e != hipSuccess) fprintf(stderr, "cooperative launch failed: %s (grid %d)\n", hipGetErrorString(e), grid);
#else
    for (int p = 0; p < 10; ++p) { a.ph_lo = p; a.ph_hi = p + 1; hipLaunchKernelGGL(mega_fwd, dim3(grid), dim3(512), LDS_BYTES, stream, a); }
#endif
}
```

```cpp
#include <hip/hip_runtime.h>
#include <hip/hip_cooperative_groups.h>
#include <cstdio>
#include <cstdint>
namespace cg = cooperative_groups;
namespace pg8 {
#define PG8_LAS __attribute__((address_space(3)))
typedef unsigned short bf16_t;
typedef short bf16x8 __attribute__((ext_vector_type(8)));
typedef float f32x4 __attribute__((ext_vector_type(4)));
typedef unsigned u32x4 __attribute__((ext_vector_type(4)));
constexpr int BM = 256, BK = 64, HALF = 128, HTB = HALF * BK * 2  , STAGE_BYTES = 8 * HTB, NXCD = 8, WGM = 8;

__host__ __device__ __forceinline__ int lds_byte(int r, int c) { const int st = (r >> 4) * 2 + (c >> 5), rr = r & 15, cc = c & 31, ob = rr * 64 + cc * 2; return st * 1024 + (ob ^ (((ob >> 9) & 1) << 5)); }
__host__ __device__ __forceinline__ void stage_rc(int b, int& R, int& C) { const int st = b / 1024, sb = b % 1024, swz = sb ^ (((sb >> 9) & 1) << 5); R = (st >> 1) * 16 + swz / 64; C = (st & 1) * 32 + (swz % 64) / 2; }
__host__ __device__ __forceinline__ int perm32(int rho) { const int n = rho >> 4, i = rho & 15; return 8 * (i >> 2) + 4 * n + (i & 3); }

struct Unit { int pm, pn; };
struct Gemm { const bf16_t* A; const bf16_t* Bt; int M, N, K; };

struct StaticOrder {
    int nM, nN, nwg, G, c;
    __host__ __device__ void init(int M, int N, int G_, int c_) { nM = M / BM; nN = N / BM; nwg = nM * nN; G = G_; c = c_; }
    __host__ __device__ bool next(int i, Unit& u) const {
        const long L = (long)i * G + c; if (L >= nwg) return false;
        int wgid = (int)L; { const int q = nwg / NXCD, r = nwg % NXCD, xcd = wgid % NXCD, off = wgid / NXCD; wgid = (xcd < r ? xcd * (q + 1) : r * (q + 1) + (xcd - r) * q) + off; }
        const int nig = WGM * nN, gid = wgid / nig, fm = gid * WGM, gsz = (nM - fm) < WGM ? (nM - fm) : WGM;
        u.pm = fm + ((wgid % nig) % gsz); u.pn = (wgid % nig) / gsz; return true;
    }
    __device__ __forceinline__ void a_ready(const Unit&) const {}
    __device__ __forceinline__ void done(const Unit&) const {}
};
__device__ __forceinline__ unsigned cvt_pk_bf16(float lo, float hi) { unsigned r; asm volatile("v_cvt_pk_bf16_f32 %0, %1, %2" : "=v"(r) : "v"(lo), "v"(hi)); return r; }
template <class Epi, class Sched, bool ALIGN_EPI = false, bool SP2 = false>
__device__ __forceinline__ void gemm_phase(PG8_LAS unsigned char* lds, const Gemm g, const Sched& S, const Epi& E) {
    const int tid = threadIdx.x, wid = __builtin_amdgcn_readfirstlane(tid >> 6), lane = tid & 63, wr = wid >> 2, wc = wid & 3, fr = lane & 15, fq = lane >> 4;
    const int K = g.K, nt = K / BK;
    unsigned voffA[2], voffB[2];
#pragma unroll
    for (int i = 0; i < 2; ++i) { int R, C; stage_rc(tid * 16 + i * 8192, R, C); const int Rb = Epi::PERM ? ((R & ~31) + perm32(R & 31)) : R;
        voffA[i] = (unsigned)(R * K + C) * 2u; voffB[i] = (unsigned)(Rb * K + C) * 2u; }
    const size_t kstep = (size_t)(BK * 2);
    const size_t hstep = (size_t)HALF * K * 2;
    const size_t tstep = 2 * hstep;
    const unsigned ldsw = (unsigned)wid * 1024u;
    const int aoff = lds_byte(wr * 64 + fr, fq * 8), boff = lds_byte(wc * 32 + fr, fq * 8);
#define PG8_SA(b, h) (((b) * 2 + (h)) * HTB)
#define PG8_SB(b, h) ((4 + (b) * 2 + (h)) * HTB)
#define PG8_STAGE(bufoff, gbase, voff) do { _Pragma("unroll") for (int _i = 0; _i < 2; ++_i) \
        __builtin_amdgcn_global_load_lds((const unsigned*)((const char*)(gbase) + (voff)[_i]), (PG8_LAS unsigned*)(lds + (bufoff) + ldsw + _i * 8192), 16, 0, 0); } while (0)
#define PG8_LDA(dst, b, h) do { _Pragma("unroll") for (int m = 0; m < 4; ++m) _Pragma("unroll") for (int k = 0; k < 2; ++k) dst[m][k] = *(const PG8_LAS bf16x8*)(lds + PG8_SA(b, h) + aoff + m * 2048 + k * 1024); } while (0)
#define PG8_LDB(dst, b, h) do { _Pragma("unroll") for (int n = 0; n < 2; ++n) _Pragma("unroll") for (int k = 0; k < 2; ++k) dst[n][k] = *(const PG8_LAS bf16x8*)(lds + PG8_SB(b, h) + boff + n * 2048 + k * 1024); } while (0)
#define PG8_MMA(ai, bj, At, Bt) do { __builtin_amdgcn_s_setprio(1); _Pragma("unroll") for (int m = 0; m < 4; ++m) _Pragma("unroll") for (int n = 0; n < 2; ++n) _Pragma("unroll") for (int k = 0; k < 2; ++k) \
        acc[ai][bj][m][n] = __builtin_amdgcn_mfma_f32_16x16x32_bf16(Bt[n][k], At[m][k], acc[ai][bj][m][n], 0, 0, 0); __builtin_amdgcn_s_setprio(0); } while (0)
#define PG8_WAIT_V(n) asm volatile("s_waitcnt vmcnt(" #n ")" ::: "memory")
#define PG8_WAIT_L(n) asm volatile("s_waitcnt lgkmcnt(" #n ")" ::: "memory")
#define PG8_BAR __builtin_amdgcn_s_barrier()
#define PG8_SCHED __builtin_amdgcn_sched_barrier(0)
    Unit cur, nxt; int ui = 0;
    if (!S.next(0, cur)) return;
    f32x4 acc[2][2][4][2];
#pragma unroll
    for (int a = 0; a < 2; ++a)
#pragma unroll
        for (int b = 0; b < 2; ++b)
#pragma unroll
            for (int m = 0; m < 4; ++m)
#pragma unroll
                for (int n = 0; n < 2; ++n) acc[a][b][m][n] = (f32x4){0.f, 0.f, 0.f, 0.f};
    bf16x8 At[4][2], B0[2][2], B1[2][2];
    const char* cA = (const char*)g.A + (size_t)cur.pm * tstep; const char* cB = (const char*)g.Bt + (size_t)cur.pn * tstep;
    S.a_ready(cur);
    if constexpr (SP2) {
        PG8_STAGE(PG8_SB(0, 0), cB, voffB); PG8_STAGE(PG8_SB(0, 1), cB + hstep, voffB); PG8_STAGE(PG8_SA(0, 0), cA, voffA); PG8_STAGE(PG8_SA(0, 1), cA + hstep, voffA);
        if (wr == 1) PG8_BAR;
        PG8_WAIT_V(2); PG8_BAR;
        PG8_STAGE(PG8_SB(1, 0), cB + kstep, voffB); PG8_STAGE(PG8_SA(1, 0), cA + kstep, voffA); PG8_STAGE(PG8_SB(1, 1), cB + hstep + kstep, voffB);
        PG8_WAIT_V(6); PG8_BAR;
    } else {
        PG8_STAGE(PG8_SB(0, 0), cB, voffB); PG8_STAGE(PG8_SA(0, 0), cA, voffA); PG8_STAGE(PG8_SB(0, 1), cB + hstep, voffB); PG8_STAGE(PG8_SA(0, 1), cA + hstep, voffA);
        if (wr == 1) PG8_BAR;
        PG8_WAIT_V(4); PG8_BAR;
        PG8_STAGE(PG8_SB(1, 0), cB + kstep, voffB); PG8_STAGE(PG8_SA(1, 0), cA + kstep, voffA); PG8_STAGE(PG8_SB(1, 1), cB + hstep + kstep, voffB);
        PG8_WAIT_V(6); PG8_BAR;
    }
    for (;;) {
        const bool has_next = S.next(ui + 1, nxt);
        const char* nA = has_next ? (const char*)g.A + (size_t)nxt.pm * tstep : cA; const char* nB = has_next ? (const char*)g.Bt + (size_t)nxt.pn * tstep : cB;
        for (int t = 0; t < nt; t += 2) {
            const bool last = (t == nt - 2);
            const char* a1 = cA + (size_t)(t + 1) * kstep;
            const char* a2 = last ? nA : cA + (size_t)(t + 2) * kstep; const char* b2 = last ? nB : cB + (size_t)(t + 2) * kstep;
            const char* a3 = a2 + kstep; const char* b3 = b2 + kstep;
            if (last && has_next) S.a_ready(nxt);
            if constexpr (SP2) {
            PG8_LDB(B0, 0, 0); PG8_LDB(B1, 0, 1); PG8_SCHED; PG8_LDA(At, 0, 0); PG8_STAGE(PG8_SA(1, 1), a1 + hstep, voffA);
            PG8_WAIT_V(8); PG8_WAIT_L(0); PG8_BAR; PG8_MMA(0, 0, At, B0); PG8_MMA(0, 1, At, B1); PG8_BAR; PG8_SCHED;
            PG8_LDA(At, 0, 1); PG8_STAGE(PG8_SB(0, 0), b2, voffB); PG8_STAGE(PG8_SB(0, 1), b2 + hstep, voffB); PG8_STAGE(PG8_SA(0, 0), a2, voffA);
            PG8_WAIT_V(8); PG8_WAIT_L(0); PG8_BAR; PG8_MMA(1, 0, At, B0); PG8_MMA(1, 1, At, B1); PG8_BAR; PG8_SCHED;
            PG8_LDB(B0, 1, 0); PG8_LDB(B1, 1, 1); PG8_SCHED; PG8_LDA(At, 1, 0); PG8_STAGE(PG8_SA(0, 1), a2 + hstep, voffA);
            PG8_WAIT_V(8); PG8_WAIT_L(0); PG8_BAR; PG8_MMA(0, 0, At, B0); PG8_MMA(0, 1, At, B1); PG8_BAR; PG8_SCHED;
            PG8_LDA(At, 1, 1); PG8_STAGE(PG8_SB(1, 0), b3, voffB); PG8_STAGE(PG8_SB(1, 1), b3 + hstep, voffB); PG8_STAGE(PG8_SA(1, 0), a3, voffA);
            PG8_WAIT_V(8); PG8_WAIT_L(0); PG8_BAR; PG8_MMA(1, 0, At, B0); PG8_MMA(1, 1, At, B1); PG8_BAR; PG8_SCHED;
            } else {
            PG8_LDB(B0, 0, 0); PG8_SCHED; PG8_LDA(At, 0, 0); PG8_STAGE(PG8_SA(1, 1), a1 + hstep, voffA);
            PG8_WAIT_L(8); PG8_BAR; PG8_WAIT_L(0); PG8_MMA(0, 0, At, B0); PG8_BAR; PG8_SCHED;
            PG8_LDB(B1, 0, 1); PG8_STAGE(PG8_SB(0, 0), b2, voffB);
            PG8_BAR; PG8_WAIT_L(0); PG8_MMA(0, 1, At, B1); PG8_BAR;
            PG8_LDA(At, 0, 1); PG8_STAGE(PG8_SA(0, 0), a2, voffA);
            PG8_BAR; PG8_WAIT_L(0); PG8_MMA(1, 0, At, B0); PG8_BAR; PG8_SCHED;
            PG8_STAGE(PG8_SB(0, 1), b2 + hstep, voffB);
            PG8_WAIT_V(6); PG8_BAR; PG8_MMA(1, 1, At, B1); PG8_BAR;
            PG8_LDB(B0, 1, 0); PG8_SCHED; PG8_LDA(At, 1, 0); PG8_STAGE(PG8_SA(0, 1), a2 + hstep, voffA);
            PG8_WAIT_L(8); PG8_BAR; PG8_WAIT_L(0); PG8_MMA(0, 0, At, B0); PG8_BAR; PG8_SCHED;
            PG8_LDB(B1, 1, 1); PG8_STAGE(PG8_SB(1, 0), b3, voffB);
            PG8_BAR; PG8_WAIT_L(0); PG8_MMA(0, 1, At, B1); PG8_BAR;
            PG8_LDA(At, 1, 1); PG8_STAGE(PG8_SA(1, 0), a3, voffA);
            PG8_BAR; PG8_WAIT_L(0); PG8_MMA(1, 0, At, B0); PG8_BAR; PG8_SCHED;
            PG8_STAGE(PG8_SB(1, 1), b3 + hstep, voffB);
            PG8_WAIT_V(6); PG8_BAR; PG8_MMA(1, 1, At, B1); PG8_BAR;
            }
        }
        if constexpr (ALIGN_EPI) { if (wr == 0) PG8_BAR; }
        if constexpr (!Epi::AFTER_DRAIN) { E(acc, cur, wr, wc, fr, fq); S.done(cur); }
        if (!has_next) break;
#pragma unroll
        for (int a = 0; a < 2; ++a)
#pragma unroll
            for (int b = 0; b < 2; ++b)
#pragma unroll
                for (int m = 0; m < 4; ++m)
#pragma unroll
                    for (int n = 0; n < 2; ++n) acc[a][b][m][n] = (f32x4){0.f, 0.f, 0.f, 0.f};
        cur = nxt; cA = nA; cB = nB; ++ui;
        if constexpr (ALIGN_EPI) { if (wr == 1) PG8_BAR; }
    }
    PG8_WAIT_V(0);
    if constexpr (!ALIGN_EPI) { if (wr == 0) PG8_BAR; }
    PG8_BAR;
    if constexpr (Epi::AFTER_DRAIN) { E.fused(acc, cur, wr, wc, fr, fq, lds, wid, lane); S.done(cur); }
#undef PG8_SA
#undef PG8_SB
#undef PG8_STAGE
#undef PG8_LDA
#undef PG8_LDB
#undef PG8_MMA
#undef PG8_WAIT_V
#undef PG8_WAIT_L
#undef PG8_BAR
#undef PG8_SCHED
}
}


#define LAS __attribute__((address_space(3)))
typedef unsigned short bf16;
typedef unsigned v4u __attribute__((ext_vector_type(4)));
typedef unsigned v2u __attribute__((ext_vector_type(2)));
typedef float f32x4 __attribute__((ext_vector_type(4)));
typedef float f32x16 __attribute__((ext_vector_type(16)));
typedef short bf16x8 __attribute__((ext_vector_type(8)));

constexpr int T_TOK = 32768, DM = 1024, SEQ = 4096, NBATCH = 8;
constexpr int PW = 3584;
constexpr int IN_W = 3532;
constexpr int C_AQ = 0, C_AKV = 1024, C_IQ = 1152, C_IK = 1408, C_IW = 1472, C_BA = 1476, C_BB = 1480, C_BQ = 1536, C_BK = 2048, C_BV = 2560, C_BZ = 3072;
constexpr int YW = 1536;
constexpr int NCHUNK = 2048;
constexpr float EPS = 1e-6f;

constexpr size_t MiB = 1u << 20;
constexpr size_t WS_CTL = 0;
constexpr size_t WS_MOD = 1 * MiB;
constexpr size_t WS_GL = WS_MOD + 256 * 1024;
constexpr size_t WS_SU = WS_MOD + 512 * 1024;
constexpr size_t WS_SV = WS_MOD + 640 * 1024;
constexpr size_t WS_WIN = 2 * MiB;
constexpr size_t WS_BT2 = 9 * MiB;
constexpr size_t WS_WQ = 12 * MiB;
constexpr size_t WS_SUBK = 16 * MiB;
constexpr size_t WS_H = 18 * MiB;
constexpr size_t WS_KN = WS_H;
constexpr size_t WS_SEL = WS_H + 8 * MiB;
constexpr size_t WS_PROJ = 82 * MiB;
constexpr size_t WS_QUERY = WS_PROJ;
constexpr size_t WS_YAB = 306 * MiB;
constexpr size_t WS_EXPID = WS_YAB;
constexpr size_t WS_GATE = WS_YAB + 16 * MiB;
constexpr size_t WS_H8 = WS_YAB + 32 * MiB;
constexpr size_t WS_HS = WS_YAB + 64 * MiB;
constexpr size_t WS_GA = 402 * MiB;
constexpr size_t WS_UT = 418 * MiB;
constexpr size_t WS_VT = 450 * MiB;
constexpr size_t WS_END = 482 * MiB;
constexpr size_t DO_W = 0, DO_QD = 32 * MiB, DO_KDT = 64 * MiB, DO_UT = 96 * MiB;

constexpr int LDS_BYTES = 147456;

struct Args { const float* in[17]; float* out; unsigned char* ws; int ph_lo, ph_hi; };

__device__ __forceinline__ unsigned pk2(float lo, float hi) { unsigned r; asm("v_cvt_pk_bf16_f32 %0, %1, %2" : "=v"(r) : "v"(lo), "v"(hi)); return r; }
__device__ __forceinline__ unsigned f2bf(float f) { return pk2(f, f) & 0xffffu; }
__device__ __forceinline__ float bflo(unsigned u) { return __uint_as_float(u << 16); }
__device__ __forceinline__ float bfhi(unsigned u) { return __uint_as_float(u & 0xffff0000u); }
__device__ __forceinline__ float bf1(bf16 b) { return __uint_as_float(((unsigned)b) << 16); }
__device__ __forceinline__ float wave_sum(float v) {
#pragma unroll
    for (int o = 1; o < 64; o <<= 1) v += __shfl_xor(v, o);
    return v;
}
__device__ __forceinline__ float wave_max(float v) {
#pragma unroll
    for (int o = 1; o < 64; o <<= 1) v = fmaxf(v, __shfl_xor(v, o));
    return v;
}
__device__ __forceinline__ float silu_f(float v) { return v / (1.f + expf(-v)); }
__device__ __forceinline__ float silu_fast(float v) { return v * __builtin_amdgcn_rcpf(1.f + __expf(-v)); }
__device__ __forceinline__ float sigmoid_f(float v) { return 1.f / (1.f + expf(-v)); }
__device__ __forceinline__ float softplus_f(float v) { return fmaxf(v, 0.f) + log1pf(expf(-fabsf(v))); }
#define LDS_WAIT() asm volatile("s_waitcnt lgkmcnt(0)" ::: "memory")

__device__ __forceinline__ int win_srccol(int n) {
    if (n < 1476) return n;
    if (n < 1480) return 3524 + (n - 1476);
    if (n < 1484) return 3528 + (n - 1480);
    if (n < 1536) return -1;
    return 1476 + (n - 1536);
}
__device__ __forceinline__ void transpose_item(const float* W, int spitch, int k0, int sc, bf16* WT, int dpitch, int drow0, int dcol0, LAS float* scr, int lane) {
    float tv[32];
#pragma unroll
    for (int i = 0; i < 32; ++i) { const int kk = 2 * i + (lane >> 5); tv[i] = W[(size_t)(k0 + kk) * spitch + ((sc >= 0) ? sc : 0)]; }
#pragma unroll
    for (int i = 0; i < 32; ++i) { const int kk = 2 * i + (lane >> 5); scr[kk * 33 + (lane & 31)] = (sc >= 0) ? tv[i] : 0.f; }
    LDS_WAIT();
    const int c = lane & 7;
#pragma unroll
    for (int j = 0; j < 4; ++j) { const int n = (lane >> 3) + 8 * j; const LAS float* s = scr + (8 * c) * 33 + n;
        v4u o; o.x = pk2(s[0 * 33], s[1 * 33]); o.y = pk2(s[2 * 33], s[3 * 33]); o.z = pk2(s[4 * 33], s[5 * 33]); o.w = pk2(s[6 * 33], s[7 * 33]);
        *(v4u*)(WT + (size_t)(drow0 + n) * dpitch + dcol0 + 8 * c) = o; }
    LDS_WAIT();
}

__device__ __forceinline__ void phase0(const Args& a, LAS unsigned char* lds) {
    const int tid = threadIdx.x, lane = tid & 63, wave = tid >> 6, bid = blockIdx.x, G = gridDim.x;
    unsigned char* ws = a.ws;
#ifndef P0_REP
#define P0_REP 0
#endif
    for (int rep0_ = 0; rep0_ < 1 + (P0_REP ? 1 : 0); ++rep0_) {
    if (rep0_ == 0 || (P0_REP & 1))
    for (int item = bid; item < 192; item += G) {
        LAS float* sc = (LAS float*)lds;
        LAS float* red = sc + 8192;
        const float* c = a.in[1];
        for (int i = tid; i < 8192; i += 512) sc[i] = silu_f(c[i]);
        __syncthreads();
        const int cc = tid & 31, kg = tid >> 5;
        const float* w = a.in[2] + item * 32 + cc;
        float acc[8];
#pragma unroll
        for (int b = 0; b < 8; ++b) acc[b] = 0.f;
#pragma unroll 16
        for (int k = kg; k < 1024; k += 16) { const float wv = w[(size_t)k * 6144];
#pragma unroll
            for (int b = 0; b < 8; ++b) acc[b] += sc[b * 1024 + k] * wv; }
#pragma unroll
        for (int b = 0; b < 8; ++b) red[(kg * 8 + b) * 32 + cc] = acc[b];
        __syncthreads();
        if (tid < 256) { const int b = tid >> 5; float s = 0.f;
            for (int k2 = 0; k2 < 16; ++k2) s += red[(k2 * 8 + b) * 32 + cc];
            ((float*)(ws + WS_MOD))[b * 6144 + item * 32 + cc] = s + a.in[3][item * 32 + cc]; }
        __syncthreads();
    }
    if (rep0_ == 0 || (P0_REP & 2)) {
        LAS float* scr = (LAS float*)(lds + 65536 + wave * 8704);
        const int gw = bid * 8 + wave, NGW = G * 8;
        constexpr int I_WIN = 16 * 112, I_WQ = 16 * 64, I_WO = 8 * 32;
        for (int it = gw; it < I_WIN + I_WQ + I_WO; it += NGW) {
            int r = it;
            if (r < I_WIN) { const int kb = r / 112, nb = r % 112; transpose_item(a.in[4], IN_W, 64 * kb, win_srccol(32 * nb + (lane & 31)), (bf16*)(ws + WS_WIN), 1024, 32 * nb, 64 * kb, scr, lane); continue; }
            r -= I_WIN;
            if (r < I_WQ) { const int kb = r / 64, nb = r % 64; transpose_item(a.in[13], 2048, 64 * kb, 32 * nb + (lane & 31), (bf16*)(ws + WS_WQ), 1024, 32 * nb, 64 * kb, scr, lane); continue; }
            r -= I_WQ;
            { const int kb = r / 32, nb = r % 32; transpose_item(a.in[12] + (size_t)512 * 1024, 1024, 64 * kb, 32 * nb + (lane & 31), (bf16*)(ws + WS_BT2), YW, 32 * nb, 1024 + 64 * kb, scr, lane); }
        }
    }
    if (rep0_ == 0 || (P0_REP & 4)) {
        const float* wuv = a.in[7]; const float* wout = a.in[12]; bf16* bt2 = (bf16*)(ws + WS_BT2);
        for (int it = bid * 512 + tid; it < 1024 * 128; it += G * 512) {
            const int n = it & 1023, kb = __builtin_amdgcn_readfirstlane(it >> 10);
            const int h = kb >> 4, r0 = (kb & 15) * 8;
            float acc[8];
#pragma unroll
            for (int j = 0; j < 8; ++j) acc[j] = 0.f;
#pragma unroll 16
            for (int v = 0; v < 64; ++v) { const float wo = wout[(size_t)(h * 64 + v) * 1024 + n];
#pragma unroll
                for (int j = 0; j < 8; ++j) acc[j] += wuv[(size_t)(h * 128 + r0 + j) * 64 + v] * wo; }
            v4u o; o.x = pk2(acc[0], acc[1]); o.y = pk2(acc[2], acc[3]); o.z = pk2(acc[4], acc[5]); o.w = pk2(acc[6], acc[7]);
            *(v4u*)(bt2 + (size_t)n * YW + h * 128 + r0) = o;
        }
    }
    if (rep0_ == 0 || (P0_REP & 8)) {
        const size_t gt = (size_t)bid * 512 + tid, GT = (size_t)G * 512;
        for (size_t i = gt; i < 262144 / 8; i += GT) {
            const f32x4 v0 = *(const f32x4*)(a.in[14] + i * 8), v1 = *(const f32x4*)(a.in[14] + i * 8 + 4);
            v4u o; o.x = pk2(v0.x, v0.y); o.y = pk2(v0.z, v0.w); o.z = pk2(v1.x, v1.y); o.w = pk2(v1.z, v1.w);
            *(v4u*)((bf16*)(ws + WS_SUBK) + i * 8) = o;
        }
        const int gw = bid * 8 + wave, NGW = G * 8;
        f32x4 v[4], vn[4];
        if (gw < 2 * 16384) { const float* s0 = ((gw >> 14) ? a.in[16] : a.in[15]) + (size_t)(gw & 16383) * 1024 + 16 * lane;
#pragma unroll
            for (int q = 0; q < 4; ++q) v[q] = *(const f32x4*)(s0 + 4 * q); }
        for (int row = gw; row < 2 * 16384; row += NGW) {
            const int tb = row >> 14, e = row & 16383;
            { const int rn = (row + NGW < 2 * 16384) ? row + NGW : row;
              const float* sn = ((rn >> 14) ? a.in[16] : a.in[15]) + (size_t)(rn & 16383) * 1024 + 16 * lane;
#pragma unroll
              for (int q = 0; q < 4; ++q) vn[q] = *(const f32x4*)(sn + 4 * q); }
            float mx = 0.f;
#pragma unroll
            for (int q = 0; q < 4; ++q) mx = fmaxf(fmaxf(mx, fmaxf(fabsf(v[q].x), fabsf(v[q].y))), fmaxf(fabsf(v[q].z), fabsf(v[q].w)));
            mx = wave_max(mx);
            const float scale = (mx > 0.f) ? mx * (1.f / 240.f) : 1.f, inv = 1.f / scale;
            v4u o;
#pragma unroll
            for (int q = 0; q < 4; ++q) { int p = __builtin_amdgcn_cvt_pk_fp8_f32(v[q].x * inv, v[q].y * inv, 0, false); p = __builtin_amdgcn_cvt_pk_fp8_f32(v[q].z * inv, v[q].w * inv, p, true); o[q] = (unsigned)p; }
            *(v4u*)(ws + (tb ? WS_VT : WS_UT) + (size_t)e * 1024 + 16 * lane) = o;
            if (lane == 0) ((float*)(ws + (tb ? WS_SV : WS_SU)))[e] = scale;
#pragma unroll
            for (int q = 0; q < 4; ++q) v[q] = vn[q];
        }
    }
    }
}

__device__ __forceinline__ void phase_norm(const float* x, const float* mod, int shift_off, int scale_off, bf16* hout, unsigned char* h8 = nullptr, float* hs = nullptr) {
    const int tid = threadIdx.x, lane = tid & 63, wave = tid >> 6;
    const int gw = blockIdx.x * 8 + wave, NGW = gridDim.x * 8;
    f32x4 v[4], vn[4];
    if (gw < T_TOK) {
#pragma unroll
        for (int j = 0; j < 4; ++j) v[j] = ((const f32x4*)(x + (size_t)gw * DM) + lane)[64 * j];
    }
    for (int m = gw; m < T_TOK; m += NGW) {
        const int b = m >> 12;
        { const int mn = (m + NGW < T_TOK) ? m + NGW : m;
#pragma unroll
          for (int j = 0; j < 4; ++j) vn[j] = ((const f32x4*)(x + (size_t)mn * DM) + lane)[64 * j]; }
        float s = 0.f;
#pragma unroll
        for (int j = 0; j < 4; ++j) s += (v[j].x * v[j].x + v[j].y * v[j].y) + (v[j].z * v[j].z + v[j].w * v[j].w);
        const float inv = rsqrtf(wave_sum(s) * (1.f / DM) + EPS);
        const f32x4* sh = (const f32x4*)(mod + b * 6144 + shift_off) + lane;
        const f32x4* sc = (const f32x4*)(mod + b * 6144 + scale_off) + lane;
        v2u* o8 = (v2u*)(hout + (size_t)m * DM) + lane;
        float amax = 0.f;
#pragma unroll
        for (int j = 0; j < 4; ++j) { const f32x4 a = sh[64 * j], c = sc[64 * j];
            v[j].x = v[j].x * inv * (1.f + c.x) + a.x; v[j].y = v[j].y * inv * (1.f + c.y) + a.y; v[j].z = v[j].z * inv * (1.f + c.z) + a.z; v[j].w = v[j].w * inv * (1.f + c.w) + a.w;
            v2u o; o.x = pk2(v[j].x, v[j].y); o.y = pk2(v[j].z, v[j].w);
            o8[64 * j] = o;
            amax = fmaxf(fmaxf(amax, fmaxf(fabsf(v[j].x), fabsf(v[j].y))), fmaxf(fabsf(v[j].z), fabsf(v[j].w))); }
        if (h8) {
            amax = wave_max(amax);
            const float scale = (amax > 0.f) ? amax * (1.f / 240.f) : 1.f, qi = 1.f / scale;
#pragma unroll
            for (int j = 0; j < 4; ++j) { int p = __builtin_amdgcn_cvt_pk_fp8_f32(v[j].x * qi, v[j].y * qi, 0, false); p = __builtin_amdgcn_cvt_pk_fp8_f32(v[j].z * qi, v[j].w * qi, p, true);
                *(unsigned*)(h8 + (size_t)m * DM + 4 * (lane + 64 * j)) = (unsigned)p; }
            if (lane == 0) hs[m] = scale;
        }
#pragma unroll
        for (int j = 0; j < 4; ++j) v[j] = vn[j];
    }
}

struct EpiX1 {
    static constexpr bool PERM = false, AFTER_DRAIN = false;
    const float* x; float* out; const float* mod;
    __device__ __forceinline__ void operator()(const pg8::f32x4 (&acc)[2][2][4][2], const pg8::Unit& u, int wr, int wc, int fr, int fq) const {
        const int row0 = u.pm * 256 + wr * 64 + fr, col0 = u.pn * 256 + wc * 32 + 4 * fq;
        const int b = (u.pm * 256) >> 12;
        f32x4 gv[2][2];
#pragma unroll
        for (int bj = 0; bj < 2; ++bj)
#pragma unroll
            for (int n = 0; n < 2; ++n) gv[bj][n] = *(const f32x4*)(mod + b * 6144 + 2048 + col0 + bj * 128 + n * 16);
#pragma unroll
        for (int ai = 0; ai < 2; ++ai)
#pragma unroll
            for (int m = 0; m < 4; ++m) { const size_t ro = (size_t)(row0 + ai * 128 + m * 16) * DM + col0;
#pragma unroll
                for (int bj = 0; bj < 2; ++bj)
#pragma unroll
                    for (int n = 0; n < 2; ++n) { const f32x4 xv = *(const f32x4*)(x + ro + bj * 128 + n * 16);
                        *(f32x4*)(out + ro + bj * 128 + n * 16) = xv + gv[bj][n] * acc[ai][bj][m][n]; } }
    }
};
struct EpiBf {
    static constexpr bool PERM = true, AFTER_DRAIN = false;
    bf16* O; int ldc;
    __device__ __forceinline__ void operator()(const pg8::f32x4 (&acc)[2][2][4][2], const pg8::Unit& u, int wr, int wc, int fr, int fq) const {
        const int row0 = u.pm * 256 + wr * 64 + fr, col0 = u.pn * 256 + wc * 32 + 8 * fq;
#pragma unroll
        for (int ai = 0; ai < 2; ++ai)
#pragma unroll
            for (int m = 0; m < 4; ++m) { bf16* rowp = O + (size_t)(row0 + ai * 128 + m * 16) * ldc + col0;
#pragma unroll
                for (int bj = 0; bj < 2; ++bj) { const pg8::f32x4 zz = (pg8::f32x4){0.f, 0.f, 0.f, 0.f}; const pg8::f32x4 v0 = acc[ai][bj][m][0] + zz, v1 = acc[ai][bj][m][1] + zz;
                    v4u w; w.x = pg8::cvt_pk_bf16(v0[0], v0[1]); w.y = pg8::cvt_pk_bf16(v0[2], v0[3]); w.z = pg8::cvt_pk_bf16(v1[0], v1[1]); w.w = pg8::cvt_pk_bf16(v1[2], v1[3]);
                    *(v4u*)(rowp + bj * 128) = w; } }
    }
};

constexpr int GP_QS = 0, GP_KS = 33792, GP_VS = 67584, GP_LS = 101376, GP_GV = 118784;
__device__ __forceinline__ void gdn_prep_item(const Args& a, LAS unsigned char* lds, int chunk) {
    int tid = threadIdx.x; asm volatile("" : "+v"(tid));
    const int lane = tid & 63, wave = __builtin_amdgcn_readfirstlane(tid >> 6);
    unsigned char* ws = a.ws;
    const bf16* proj = (const bf16*)(ws + WS_PROJ);
    const int bh = chunk >> 6, n = chunk & 63, b = bh >> 2, h = bh & 3;
    const int t0 = b * SEQ + n * 64;
    LAS float* QS = (LAS float*)(lds + GP_QS); LAS float* KS = (LAS float*)(lds + GP_KS); LAS float* VS = (LAS float*)(lds + GP_VS);
    LAS float* LS = (LAS float*)(lds + GP_LS); LAS float* GV = (LAS float*)(lds + GP_GV);
#ifndef GP_MASK
#define GP_MASK 31
#endif
#ifndef GP_REP
#define GP_REP 0
#endif
    for (int rep_ = 0; rep_ < 1 + (GP_REP & 1); ++rep_)
    if ((GP_MASK & 1) && tid < 384) {
        const int cg = tid % 48, rs = tid / 48;
        const int sec = cg >> 4, c8 = (cg & 15) * 8;
        const int pcol = C_BQ + sec * 512 + h * 128 + c8;
        const float* cw = a.in[8] + sec * 512 + h * 128 + c8;
        float wt[4][8];
#pragma unroll
        for (int i = 0; i < 4; ++i) { const f32x4 w0 = *(const f32x4*)(cw + i * 1536), w1 = *(const f32x4*)(cw + i * 1536 + 4);
            wt[i][0] = w0.x; wt[i][1] = w0.y; wt[i][2] = w0.z; wt[i][3] = w0.w; wt[i][4] = w1.x; wt[i][5] = w1.y; wt[i][6] = w1.z; wt[i][7] = w1.w; }
        LAS float* XS = (sec == 0) ? QS : (sec == 1 ? KS : VS);
        v4u raw[11];
#pragma unroll
        for (int j = 0; j < 11; ++j) { const int rr = 8 * rs - 3 + j;
            raw[j] = (rr >= 0 || n > 0) ? *(const v4u*)(proj + (size_t)(t0 + rr) * PW + pcol) : (v4u){0u, 0u, 0u, 0u}; }
#pragma unroll
        for (int j = 0; j < 8; ++j) {
            float y[8];
#pragma unroll
            for (int c = 0; c < 8; ++c) y[c] = 0.f;
#pragma unroll
            for (int i = 0; i < 4; ++i) { float xv[8]; const v4u u = raw[j + i];
                xv[0] = bflo(u.x); xv[1] = bfhi(u.x); xv[2] = bflo(u.y); xv[3] = bfhi(u.y); xv[4] = bflo(u.z); xv[5] = bfhi(u.z); xv[6] = bflo(u.w); xv[7] = bfhi(u.w);
#pragma unroll
                for (int c = 0; c < 8; ++c) y[c] += wt[i][c] * xv[c]; }
            f32x4 o0, o1;
            o0.x = silu_fast(y[0]); o0.y = silu_fast(y[1]); o0.z = silu_fast(y[2]); o0.w = silu_fast(y[3]); o1.x = silu_fast(y[4]); o1.y = silu_fast(y[5]); o1.z = silu_fast(y[6]); o1.w = silu_fast(y[7]);
            *(LAS f32x4*)(XS + (8 * rs + j) * 132 + c8) = o0; *(LAS f32x4*)(XS + (8 * rs + j) * 132 + c8 + 4) = o1;
        }
    }
    if (wave == 7) {
        const int i = lane;
        const float av = bf1(proj[(size_t)(t0 + i) * PW + C_BA + h]), bv = bf1(proj[(size_t)(t0 + i) * PW + C_BB + h]);
        const float beta = sigmoid_f(bv);
        const float g = -expf(a.in[9][h]) * softplus_f(av + a.in[10][h]);
        float G = g;
#pragma unroll
        for (int o = 1; o < 64; o <<= 1) { const float t = __shfl_up(G, o); if (lane >= o) G += t; }
        const float Glast = __shfl(G, 63);
        GV[i] = G; GV[64 + i] = expf(G); GV[128 + i] = beta; GV[192 + i] = expf(Glast - G); GV[256 + i] = beta * expf(G);
        if (lane == 0) ((float*)(ws + WS_GL))[chunk] = expf(Glast);
    }
    __syncthreads();
    if (GP_MASK & 2) {
#pragma unroll
        for (int rr = 0; rr < 16; ++rr) {
            const int row = wave * 16 + rr;
            LAS float* X = (row < 64) ? (QS + row * 132) : (KS + (row - 64) * 132);
            const float v0 = X[lane], v1 = X[lane + 64];
            const float ss = wave_sum(v0 * v0 + v1 * v1);
            const float sc = rsqrtf(ss + EPS) * ((row < 64) ? 0.08838834764831845f : 1.f);
            X[lane] = v0 * sc; X[lane + 64] = v1 * sc;
        }
    }
    __syncthreads();
    for (int rep_ = 0; rep_ < 1 + ((GP_REP >> 2) & 1); ++rep_)
    if (GP_MASK & 4) {
        const int gram = wave >> 2, ti = wave & 3, r = lane & 15, g = lane >> 4;
        const LAS float* X = gram ? QS : KS;
        f32x4 acc[4];
#pragma unroll
        for (int tj = 0; tj < 4; ++tj) acc[tj] = (f32x4){0.f, 0.f, 0.f, 0.f};
#pragma unroll 2
        for (int kk = 0; kk < 8; ++kk) {
            const f32x4 xa = *(const LAS f32x4*)(X + (16 * ti + r) * 132 + 16 * kk + 4 * g);
#pragma unroll
            for (int tj = 0; tj < 4; ++tj) {
                if (tj <= ti) {
                    const f32x4 kb = *(const LAS f32x4*)(KS + (16 * tj + r) * 132 + 16 * kk + 4 * g);
                    acc[tj] = __builtin_amdgcn_mfma_f32_16x16x4f32(xa.x, kb.x, acc[tj], 0, 0, 0);
                    acc[tj] = __builtin_amdgcn_mfma_f32_16x16x4f32(xa.y, kb.y, acc[tj], 0, 0, 0);
                    acc[tj] = __builtin_amdgcn_mfma_f32_16x16x4f32(xa.z, kb.z, acc[tj], 0, 0, 0);
                    acc[tj] = __builtin_amdgcn_mfma_f32_16x16x4f32(xa.w, kb.w, acc[tj], 0, 0, 0);
                }
            }
        }
        bf16* Aout = (bf16*)(ws + WS_GA) + (size_t)chunk * 4096;
#pragma unroll
        for (int tj = 0; tj < 4; ++tj)
#pragma unroll
            for (int rg = 0; rg < 4; ++rg) {
                const int i = 16 * ti + 4 * g + rg, j = 16 * tj + r;
                const float dec = (j <= i) ? __expf(GV[i] - GV[j]) : 0.f;
                if (gram == 0) { if (tj <= ti) LS[i * 68 + j] = (j < i) ? GV[128 + i] * acc[tj][rg] * dec : 0.f; }
                else Aout[((((i >> 4) * 2 + (j >> 5)) * 64 + (i & 15) + 16 * ((j >> 3) & 3)) << 3) + (j & 7)] = (bf16)f2bf((tj <= ti) ? acc[tj][rg] * dec : 0.f);
            }
    }
    __syncthreads();
    {
        bf16* QD = (bf16*)((unsigned char*)a.out + DO_QD) + (size_t)chunk * 8192;
        bf16* KDT = (bf16*)((unsigned char*)a.out + DO_KDT) + (size_t)chunk * 8192;
#pragma unroll
        for (int m = 0; m < 2; ++m) {
            const int p = tid + 512 * m;
            { const int i = p >> 4, k8 = (p & 15) * 8; const float e = GV[64 + i]; const LAS float* sq = QS + i * 132 + k8;
              v4u o; o.x = pk2(sq[0] * e, sq[1] * e); o.y = pk2(sq[2] * e, sq[3] * e); o.z = pk2(sq[4] * e, sq[5] * e); o.w = pk2(sq[6] * e, sq[7] * e);
              *(v4u*)(QD + ((((i >> 4) * 4 + ((p & 15) >> 2)) * 64 + (i & 15) + 16 * (p & 3)) << 3)) = o; }
            { const int k = p >> 3, i8 = (p & 7) * 8; float v[8];
#pragma unroll
              for (int j = 0; j < 8; ++j) v[j] = KS[(i8 + j) * 132 + k] * GV[192 + i8 + j];
              v4u o; o.x = pk2(v[0], v[1]); o.y = pk2(v[2], v[3]); o.z = pk2(v[4], v[5]); o.w = pk2(v[6], v[7]);
              *(v4u*)(KDT + ((((k >> 4) * 2 + ((p & 7) >> 2)) * 64 + (k & 15) + 16 * (p & 3)) << 3)) = o; }
        }
    }
    __syncthreads();
    {
#pragma unroll
        for (int m = 0; m < 4; ++m) {
            const int p = tid + 512 * m, i = p >> 5, c4 = (p & 31) * 4;
            const float mu = GV[128 + i], mw = GV[256 + i];
            f32x4 v = *(LAS f32x4*)(VS + i * 132 + c4); v.x *= mu; v.y *= mu; v.z *= mu; v.w *= mu; *(LAS f32x4*)(VS + i * 132 + c4) = v;
            f32x4 k = *(LAS f32x4*)(KS + i * 132 + c4); k.x *= mw; k.y *= mw; k.z *= mw; k.w *= mw; *(LAS f32x4*)(KS + i * 132 + c4) = k;
        }
    }
    __syncthreads();
    {
        const int r = lane & 15, g = lane >> 4;
#pragma unroll 1
        for (int I = 0; I < 4; ++I) {
            if (I > 0) {
#pragma unroll
                for (int tt = 0; tt < 2; ++tt) {
                    const int ct = 2 * wave + tt;
                    LAS float* XB = ((ct < 8) ? VS : KS) + (ct & 7) * 16 + r;
                    f32x4 acc;
#pragma unroll
                    for (int rg = 0; rg < 4; ++rg) acc[rg] = XB[(16 * I + 4 * g + rg) * 132];
                    for (int J = 0; J < I; ++J) {
#pragma unroll
                        for (int ks = 0; ks < 4; ++ks) {
                            const float la = -LS[(16 * I + r) * 68 + 16 * J + 4 * ks + g];
                            const float xb = XB[(16 * J + 4 * ks + g) * 132];
                            acc = __builtin_amdgcn_mfma_f32_16x16x4f32(la, xb, acc, 0, 0, 0);
                        }
                    }
#pragma unroll
                    for (int rg = 0; rg < 4; ++rg) XB[(16 * I + 4 * g + rg) * 132] = acc[rg];
                }
                __syncthreads();
            }
            if (tid < 256) {
                LAS float* XC = ((tid < 128) ? VS : KS) + (tid & 127);
                float x[16];
#pragma unroll
                for (int rr = 0; rr < 16; ++rr) {
                    float a0 = XC[(16 * I + rr) * 132], a1 = 0.f, a2 = 0.f, a3 = 0.f;
#pragma unroll
                    for (int j4 = 0; j4 < (rr + 3) / 4; ++j4) {
                        const f32x4 l = *(const LAS f32x4*)(LS + (16 * I + rr) * 68 + 16 * I + 4 * j4);
                        if (4 * j4 + 0 < rr) a0 -= l.x * x[4 * j4 + 0];
                        if (4 * j4 + 1 < rr) a1 -= l.y * x[4 * j4 + 1];
                        if (4 * j4 + 2 < rr) a2 -= l.z * x[4 * j4 + 2];
                        if (4 * j4 + 3 < rr) a3 -= l.w * x[4 * j4 + 3];
                    }
                    x[rr] = (a0 + a1) + (a2 + a3);
                }
#pragma unroll
                for (int rr = 0; rr < 16; ++rr) XC[(16 * I + rr) * 132] = x[rr];
            }
            __syncthreads();
        }
    }
    {
        bf16* W = (bf16*)((unsigned char*)a.out + DO_W) + (size_t)chunk * 8192;
        bf16* UT = (bf16*)((unsigned char*)a.out + DO_UT) + (size_t)chunk * 8192;
#pragma unroll
        for (int m = 0; m < 2; ++m) {
            const int p = tid + 512 * m, i = p >> 4, k8 = p & 15;
            const f32x4 x0 = *(const LAS f32x4*)(KS + i * 132 + 8 * k8), x1 = *(const LAS f32x4*)(KS + i * 132 + 8 * k8 + 4);
            v4u o; o.x = pk2(x0.x, x0.y); o.y = pk2(x0.z, x0.w); o.z = pk2(x1.x, x1.y); o.w = pk2(x1.z, x1.w);
            *(v4u*)(W + ((((i >> 4) * 4 + (k8 >> 2)) * 64 + (i & 15) + 16 * (k8 & 3)) << 3)) = o;
        }
#pragma unroll
        for (int m = 0; m < 4; ++m) {
            const int p = tid + 512 * m, v = p & 127, q = p >> 7;
            v2u o; o.x = pk2(VS[(4 * q) * 132 + v], VS[(4 * q + 1) * 132 + v]); o.y = pk2(VS[(4 * q + 2) * 132 + v], VS[(4 * q + 3) * 132 + v]);
            *(v2u*)(UT + ((((q >> 2) * 8 + (v >> 4)) * 64 + (v & 15) + 16 * (q & 3)) << 2)) = o;
        }
    }
    __syncthreads();
}

__device__ __forceinline__ void kn_item(const Args& a, int item) {
    const int tid = threadIdx.x, lane = tid & 63, wave = tid >> 6;
    const bf16* proj = (const bf16*)(a.ws + WS_PROJ); bf16* KN = (bf16*)(a.ws + WS_KN);
    const float g0 = a.in[6][2 * lane], g1 = a.in[6][2 * lane + 1];
    unsigned u[16];
#pragma unroll
    for (int rr = 0; rr < 16; ++rr) u[rr] = *(const unsigned*)(proj + (size_t)(item * 128 + wave * 16 + rr) * PW + C_AKV + 2 * lane);
#pragma unroll
    for (int rr = 0; rr < 16; ++rr) {
        const int t = item * 128 + wave * 16 + rr;
        const float v0 = bflo(u[rr]), v1 = bfhi(u[rr]);
        const float inv = rsqrtf(wave_sum(v0 * v0 + v1 * v1) * (1.f / 128.f) + EPS);
        *(unsigned*)(KN + (size_t)t * 128 + 2 * lane) = pk2(v0 * inv * g0, v1 * inv * g1);
    }
}


#ifdef IDX_FP32
__device__ __forceinline__ void phase_idx32(const Args& a, LAS unsigned char* lds) {
    const int tid = threadIdx.x, lane = tid & 63, wave = tid >> 6;
    LAS float* HS = (LAS float*)lds;
    float* IDX32 = (float*)(a.ws + WS_YAB);
    const float* mod = (const float*)(a.ws + WS_MOD);
    for (int tile = blockIdx.x; tile < 1024; tile += gridDim.x) {
        const int t0 = tile * 32, b = t0 >> 12;
        for (int rr = 0; rr < 4; ++rr) {
            const int m = t0 + wave * 4 + rr;
            const f32x4* xr = (const f32x4*)(a.in[0] + (size_t)m * DM) + lane;
            f32x4 v[4]; float s = 0.f;
#pragma unroll
            for (int j = 0; j < 4; ++j) { v[j] = xr[64 * j]; s += (v[j].x * v[j].x + v[j].y * v[j].y) + (v[j].z * v[j].z + v[j].w * v[j].w); }
            const float inv = rsqrtf(wave_sum(s) * (1.f / DM) + EPS);
            const f32x4* sh = (const f32x4*)(mod + b * 6144) + lane; const f32x4* sc = (const f32x4*)(mod + b * 6144 + 1024) + lane;
#pragma unroll
            for (int j = 0; j < 4; ++j) { const f32x4 aa = sh[64 * j], c = sc[64 * j];
                f32x4 o; o.x = v[j].x * inv * (1.f + c.x) + aa.x; o.y = v[j].y * inv * (1.f + c.y) + aa.y; o.z = v[j].z * inv * (1.f + c.z) + aa.z; o.w = v[j].w * inv * (1.f + c.w) + aa.w;
                *(LAS f32x4*)(HS + (wave * 4 + rr) * 1028 + 4 * (lane + 64 * j)) = o; }
        }
        __syncthreads();
        if (tid < 324) {
            const float* w = a.in[4] + 1152 + tid;
            float acc[32];
#pragma unroll
            for (int t = 0; t < 32; ++t) acc[t] = 0.f;
            for (int k4 = 0; k4 < 256; ++k4) {
                const float w0 = w[(size_t)(4 * k4) * IN_W], w1 = w[(size_t)(4 * k4 + 1) * IN_W], w2 = w[(size_t)(4 * k4 + 2) * IN_W], w3 = w[(size_t)(4 * k4 + 3) * IN_W];
#pragma unroll
                for (int t = 0; t < 32; ++t) { const f32x4 hv = *(const LAS f32x4*)(HS + t * 1028 + 4 * k4); acc[t] += hv.x * w0 + hv.y * w1 + hv.z * w2 + hv.w * w3; }
            }
#pragma unroll
            for (int t = 0; t < 32; ++t) IDX32[(size_t)(t0 + t) * 384 + tid] = acc[t];
        }
        __syncthreads();
    }
}
#endif
__device__ __forceinline__ unsigned sortable(float f) { const unsigned u = __float_as_uint(f + 0.f); return (u & 0x80000000u) ? ~u : (u | 0x80000000u); }
__device__ __forceinline__ int wave_sum_dpp(int x) {
    x += __builtin_amdgcn_update_dpp(0, x, 0xB1, 0xF, 0xF, false);
    x += __builtin_amdgcn_update_dpp(0, x, 0x4E, 0xF, 0xF, false);
    x += __builtin_amdgcn_update_dpp(0, x, 0x141, 0xF, 0xF, false);
    x += __builtin_amdgcn_update_dpp(0, x, 0x140, 0xF, 0xF, false);
    return __builtin_amdgcn_readlane(x, 0) + __builtin_amdgcn_readlane(x, 16) + __builtin_amdgcn_readlane(x, 32) + __builtin_amdgcn_readlane(x, 48);
}
#define CNT8(OP, acc_, k_, s_, c_) asm("v_cmp_" OP "_u32 s[36:37], %1, %9\n\tv_cmp_" OP "_u32 s[38:39], %2, %9\n\tv_cmp_" OP "_u32 s[40:41], %3, %9\n\tv_cmp_" OP "_u32 s[42:43], %4, %9\n\t" \
        "v_cmp_" OP "_u32 s[44:45], %5, %9\n\tv_cmp_" OP "_u32 s[46:47], %6, %9\n\tv_cmp_" OP "_u32 s[48:49], %7, %9\n\tv_cmp_" OP "_u32 s[50:51], %8, %9\n\t" \
        "v_addc_co_u32 %0, s[36:37], 0, %0, s[36:37]\n\tv_addc_co_u32 %0, s[38:39], 0, %0, s[38:39]\n\tv_addc_co_u32 %0, s[40:41], 0, %0, s[40:41]\n\tv_addc_co_u32 %0, s[42:43], 0, %0, s[42:43]\n\t" \
        "v_addc_co_u32 %0, s[44:45], 0, %0, s[44:45]\n\tv_addc_co_u32 %0, s[46:47], 0, %0, s[46:47]\n\tv_addc_co_u32 %0, s[48:49], 0, %0, s[48:49]\n\tv_addc_co_u32 %0, s[50:51], 0, %0, s[50:51]" \
        : "+v"(acc_) : "v"(k_[(s_)]), "v"(k_[(s_) + 1]), "v"(k_[(s_) + 2]), "v"(k_[(s_) + 3]), "v"(k_[(s_) + 4]), "v"(k_[(s_) + 5]), "v"(k_[(s_) + 6]), "v"(k_[(s_) + 7]), "v"(c_) \
        : "s36", "s37", "s38", "s39", "s40", "s41", "s42", "s43", "s44", "s45", "s46", "s47", "s48", "s49", "s50", "s51")
template <int NS> __device__ __forceinline__ void topk_select(LAS float* row, int n, int lane, unsigned short* out) {
    asm volatile("" : "+v"(lane));
    unsigned key[NS];
#pragma unroll
    for (int s = 0; s < NS; ++s) key[s] = __float_as_uint(row[s * 64 + lane]);
#pragma unroll
    for (int s = 0; s < NS; ++s) { const int idx = s * 64 + lane; const unsigned k = sortable(__uint_as_float(key[s])); key[s] = (idx < n) ? k : 0u; }
    LAS unsigned short* sel_l = (LAS unsigned short*)row;
    unsigned thr = 0u;
    for (int bit = 31; bit >= 0; --bit) {
        const unsigned cand = thr | (1u << bit);
        int c0 = 0, c1 = 0;
#pragma unroll
        for (int s = 0; s < NS; s += 16) { CNT8("ge", c0, key, s, cand); CNT8("ge", c1, key, s + 8, cand); }
        const int cnt = wave_sum_dpp(c0 + c1);
        if (cnt >= 256) thr = cand;
        if (cnt == 256) break;
    }
    int g0 = 0, e0 = 0;
#pragma unroll
    for (int s = 0; s < NS; s += 8) { CNT8("gt", g0, key, s, thr); CNT8("eq", e0, key, s, thr); }
    const int cgt = wave_sum_dpp(g0), ceq = wave_sum_dpp(e0);
    const int need_eq = 256 - cgt;
    asm volatile("" : "+v"(thr));
    asm volatile("" : "+v"(lane));
    int pos_out = 0;
    if (ceq == need_eq) {
#pragma unroll
        for (int s = 0; s < NS; ++s) {
            const bool take = key[s] >= thr;
            const unsigned long long mt = __builtin_amdgcn_ballot_w64(take);
            const int pre = __builtin_amdgcn_mbcnt_hi((unsigned)(mt >> 32), __builtin_amdgcn_mbcnt_lo((unsigned)mt, 0));
            sel_l[take ? pos_out + pre : 256] = (unsigned short)(s * 64 + lane);
            pos_out += __builtin_popcountll(mt);
        }
    } else {
        const unsigned long long ltmask = (1ull << lane) - 1ull;
        int eq_seen = 0;
#pragma unroll
        for (int s = 0; s < NS; ++s) {
            const bool gt = key[s] > thr, eq = key[s] == thr;
            const unsigned long long meq = __builtin_amdgcn_ballot_w64(eq);
            const bool take = gt || (eq && (eq_seen + __builtin_popcountll(meq & ltmask) < need_eq));
            const unsigned long long mt = __builtin_amdgcn_ballot_w64(take);
            if (take) sel_l[pos_out + __builtin_popcountll(mt & ltmask)] = (unsigned short)(s * 64 + lane);
            pos_out += __builtin_popcountll(mt); eq_seen += __builtin_popcountll(meq);
            if ((s & 3) == 3) __builtin_amdgcn_sched_barrier(0);
        }
    }
    LDS_WAIT();
    *(v2u*)(out + 4 * lane) = *(const LAS v2u*)(sel_l + 4 * lane);
}
struct IdxPre { bf16x8 af[4]; v2u wqr[4]; bf16x8 bfr[4][4]; };
__device__ __forceinline__ void idx_issue(const Args& a, int b, int qblk, int wave, int lane, IdxPre& P) {
    const bf16* proj = (const bf16*)(a.ws + WS_PROJ);
    const int p0 = qblk * 8, r = lane & 31, hh = lane >> 5;
    const size_t rowb = (size_t)b * SEQ;
    if (p0 + 7 < 256) return;
    { const bf16* qp = proj + (rowb + p0 + (r & 7)) * PW + C_IQ + (r >> 3) * 64 + 32 * hh;
#pragma unroll
      for (int s = 0; s < 4; ++s) P.af[s] = *(const bf16x8*)(qp + 8 * s); }
#pragma unroll
    for (int i = 0; i < 4; ++i) P.wqr[i] = *(const v2u*)(proj + (rowb + p0 + 4 * hh + i) * PW + C_IW);
    const int ntiles = (p0 + 7) / 32 + 1;
#pragma unroll
    for (int u = 0; u < 4; ++u) {
        const int kt = (wave + 8 * u < ntiles) ? wave + 8 * u : 0;
        const bf16* kp = proj + (rowb + (size_t)kt * 32 + r) * PW + C_IK + 32 * hh;
#pragma unroll
        for (int s = 0; s < 4; ++s) P.bfr[u][s] = *(const bf16x8*)(kp + 8 * s);
    }
}
__device__ __forceinline__ void indexer_item(const Args& a, LAS unsigned char* lds, int b, int qblk, IdxPre& P, bool has_next, int b_next, int qblk_next) {
    int tid = threadIdx.x; asm volatile("" : "+v"(tid));
    const int lane = tid & 63, wave = __builtin_amdgcn_readfirstlane(tid >> 6);
    const bf16* proj = (const bf16*)(a.ws + WS_PROJ);
    unsigned short* SEL = (unsigned short*)(a.ws + WS_SEL);
    LAS float* SC = (LAS float*)lds;
    const int p0 = qblk * 8;
    const int r = lane & 31, hh = lane >> 5;
    const size_t rowb = (size_t)b * SEQ;
#ifdef IDX_FP32
    if (p0 + 7 >= 256) {
        const float* IDX32 = (const float*)(a.ws + WS_YAB);
        LAS float* IQS = (LAS float*)(lds + 131072);
        for (int i = tid; i < 2048; i += 512) IQS[i] = IDX32[(rowb + p0 + (i >> 8)) * 384 + (i & 255)];
        float wq8[8][4];
#pragma unroll
        for (int q = 0; q < 8; ++q)
#pragma unroll
            for (int hd = 0; hd < 4; ++hd) wq8[q][hd] = IDX32[(rowb + p0 + q) * 384 + 320 + hd];
        __syncthreads();
        for (int s = tid; s <= p0 + 7; s += 512) {
            float kf[64];
#pragma unroll
            for (int d4 = 0; d4 < 16; ++d4) { const f32x4 v = *(const f32x4*)(IDX32 + (rowb + s) * 384 + 256 + 4 * d4); kf[4 * d4] = v.x; kf[4 * d4 + 1] = v.y; kf[4 * d4 + 2] = v.z; kf[4 * d4 + 3] = v.w; }
#pragma unroll 1
            for (int q = 0; q < 8; ++q) {
                float sc = 0.f;
#pragma unroll
                for (int hd = 0; hd < 4; ++hd) {
                    float lg = 0.f;
#pragma unroll
                    for (int d4 = 0; d4 < 16; ++d4) { const f32x4 qv = *(const LAS f32x4*)(IQS + q * 256 + hd * 64 + 4 * d4); lg += kf[4 * d4] * qv.x + kf[4 * d4 + 1] * qv.y + kf[4 * d4 + 2] * qv.z + kf[4 * d4 + 3] * qv.w; }
                    sc += fmaxf(lg, 0.f) * wq8[q][hd];
                }
                SC[q * 4096 + s] = sc * 0.0625f;
            }
        }
    }
#else
    if (p0 + 7 >= 256) {
        float wq[4][4];
#pragma unroll
        for (int i = 0; i < 4; ++i) { wq[i][0] = bflo(P.wqr[i].x) * 0.0625f; wq[i][1] = bfhi(P.wqr[i].x) * 0.0625f; wq[i][2] = bflo(P.wqr[i].y) * 0.0625f; wq[i][3] = bfhi(P.wqr[i].y) * 0.0625f; }
        const int ntiles = (p0 + 7) / 32 + 1;
        for (int kt0 = wave; kt0 < ntiles; kt0 += 32) {
            bf16x8 nxt[4][4];
            const bool more = kt0 + 32 < ntiles;
            if (more) {
#pragma unroll
                for (int u = 0; u < 4; ++u) {
                    const int kt = (kt0 + 32 + 8 * u < ntiles) ? kt0 + 32 + 8 * u : kt0;
                    const bf16* kp = proj + (rowb + (size_t)kt * 32 + r) * PW + C_IK + 32 * hh;
#pragma unroll
                    for (int s = 0; s < 4; ++s) nxt[u][s] = *(const bf16x8*)(kp + 8 * s);
                }
            }
#pragma unroll
            for (int u = 0; u < 4; ++u) {
                const int kt = kt0 + 8 * u;
                if (kt < ntiles) {
                    f32x16 acc;
#pragma unroll
                    for (int i = 0; i < 16; ++i) acc[i] = 0.f;
#pragma unroll
                    for (int s = 0; s < 4; ++s) acc = __builtin_amdgcn_mfma_f32_32x32x16_bf16(P.af[s], P.bfr[u][s], acc, 0, 0, 0);
#pragma unroll
                    for (int i = 0; i < 4; ++i) {
                        float s = 0.f;
#pragma unroll
                        for (int hd = 0; hd < 4; ++hd) s += wq[i][hd] * fmaxf(acc[i + 4 * hd], 0.f);
                        SC[(4 * hh + i) * 4096 + kt * 32 + r] = s;
                    }
                }
            }
            if (more) {
#pragma unroll
                for (int u = 0; u < 4; ++u)
#pragma unroll
                    for (int s = 0; s < 4; ++s) P.bfr[u][s] = nxt[u][s];
            }
        }
    }
#endif
    __syncthreads();
#ifndef IDX_FP32
    if (has_next) idx_issue(a, b_next, qblk_next, wave, lane, P);
#endif
    {
        const int pos = p0 + wave, n = pos + 1;
        unsigned short* out = SEL + (rowb + pos) * 256;
        if (n <= 256) {
#pragma unroll
            for (int q = 0; q < 4; ++q) { const int j = lane + 64 * q; out[j] = (unsigned short)((j < n) ? j : 0xFFFF); }
        } else {
            LAS float* row = SC + wave * 4096;
            const int nslots = (n + 63) >> 6;
#ifndef IDX_REP_SELECT
#define IDX_REP_SELECT 1
#endif
            float* bk_ = (float*)(a.ws + WS_YAB) + ((size_t)blockIdx.x * 8 + wave) * 4096;
            if (IDX_REP_SELECT > 1) for (int i_ = lane; i_ < 4096; i_ += 64) bk_[i_] = row[i_];
            for (int rep_ = 0; rep_ < IDX_REP_SELECT; ++rep_) {
            if (rep_ > 0) { for (int i_ = lane; i_ < 4096; i_ += 64) row[i_] = bk_[i_]; LDS_WAIT(); }
            if (nslots <= 16) topk_select<16>(row, n, lane, out);
            else if (nslots <= 32) topk_select<32>(row, n, lane, out);
            else if (nslots <= 48) topk_select<48>(row, n, lane, out);
            else topk_select<64>(row, n, lane, out);
            }
        }
    }
    __syncthreads();
}

__device__ __forceinline__ void phase3(const Args& a, LAS unsigned char* lds) {
    const int bid = blockIdx.x, G = gridDim.x;
#ifndef P3_MASK
#define P3_MASK 7
#endif
#ifndef P3_REP
#define P3_REP 0
#endif
    if (P3_MASK & 1) for (int it = bid; it < 2048; it += G) { gdn_prep_item(a, lds, it); if (P3_REP & 1) gdn_prep_item(a, lds, it); }
    if (P3_MASK & 2) {
#define IDX_MAP(j_, bb_, qb_) do { if (G == 256) { const int i_ = (j_) / G, c_ = (j_) % G, q0_ = (c_ >> 3) + 32 * (i_ >> 1); bb_ = c_ & 7; qb_ = (i_ & 1) ? 511 - q0_ : q0_; } else { bb_ = (j_) >> 9; qb_ = (j_) & 511; } } while (0)
        IdxPre P;
        const int tid_ = threadIdx.x, lane_ = tid_ & 63, wave_ = __builtin_amdgcn_readfirstlane(tid_ >> 6);
        int bb, qb;
        if (bid < 4096) { IDX_MAP(bid, bb, qb); idx_issue(a, bb, qb, wave_, lane_, P); }
        for (int j = bid; j < 4096; j += G) {
            IDX_MAP(j, bb, qb);
            int bn = 0, qn = 0; const bool hn = (j + G < 4096);
            if (hn) IDX_MAP(j + G, bn, qn);
            indexer_item(a, lds, bb, qb, P, hn, bn, qn);
            if (P3_REP & 2) { idx_issue(a, bb, qb, wave_, lane_, P); indexer_item(a, lds, bb, qb, P, false, 0, 0); if (hn) idx_issue(a, bn, qn, wave_, lane_, P); }
        }
#undef IDX_MAP
    }
    if (P3_MASK & 4) for (int it = bid; it < 256; it += G) kn_item(a, it);
}

constexpr int SC_ST = 0, SC_VNT = 34816, SC_O = 53248;
__device__ __forceinline__ v2u pack4(float a, float b, float c, float d) { v2u o; o.x = pk2(a, b); o.y = pk2(c, d); return o; }
__device__ __forceinline__ void scan_epilogue(const LAS float* OS, const v4u z0, const v4u z1, const LAS float* gainl, bf16* ydst, int tid) {
    const int row = tid >> 3, seg = tid & 7;
    float o[16];
#pragma unroll
    for (int q = 0; q < 4; ++q) { const f32x4 v = *(const LAS f32x4*)(OS + row * 132 + 16 * seg + 4 * q); o[4 * q] = v.x; o[4 * q + 1] = v.y; o[4 * q + 2] = v.z; o[4 * q + 3] = v.w; }
    float ss = 0.f;
#pragma unroll
    for (int i = 0; i < 16; ++i) ss += o[i] * o[i];
    ss += __shfl_xor(ss, 1); ss += __shfl_xor(ss, 2); ss += __shfl_xor(ss, 4);
    const float inv = rsqrtf(ss * (1.f / 128.f) + EPS);
    float z[16];
    z[0] = bflo(z0.x); z[1] = bfhi(z0.x); z[2] = bflo(z0.y); z[3] = bfhi(z0.y); z[4] = bflo(z0.z); z[5] = bfhi(z0.z); z[6] = bflo(z0.w); z[7] = bfhi(z0.w);
    z[8] = bflo(z1.x); z[9] = bfhi(z1.x); z[10] = bflo(z1.y); z[11] = bfhi(z1.y); z[12] = bflo(z1.z); z[13] = bfhi(z1.z); z[14] = bflo(z1.w); z[15] = bfhi(z1.w);
    float y[16];
#pragma unroll
    for (int q = 0; q < 4; ++q) { const f32x4 gq = *(const LAS f32x4*)(gainl + 16 * seg + 4 * q);
        y[4 * q] = o[4 * q] * inv * gq.x * silu_fast(z[4 * q]); y[4 * q + 1] = o[4 * q + 1] * inv * gq.y * silu_fast(z[4 * q + 1]); y[4 * q + 2] = o[4 * q + 2] * inv * gq.z * silu_fast(z[4 * q + 2]); y[4 * q + 3] = o[4 * q + 3] * inv * gq.w * silu_fast(z[4 * q + 3]); }
    v4u w0, w1;
    w0.x = pk2(y[0], y[1]); w0.y = pk2(y[2], y[3]); w0.z = pk2(y[4], y[5]); w0.w = pk2(y[6], y[7]);
    w1.x = pk2(y[8], y[9]); w1.y = pk2(y[10], y[11]); w1.z = pk2(y[12], y[13]); w1.w = pk2(y[14], y[15]);
    *(v4u*)(ydst) = w0; *(v4u*)(ydst + 8) = w1;
}
__device__ __forceinline__ void gdn_scan(const Args& a, LAS unsigned char* lds, int bh) {
    const int tid = threadIdx.x, lane = tid & 63, w = __builtin_amdgcn_readfirstlane(tid >> 6), r = lane & 15, g = lane >> 4;
    const int b = bh >> 2, h = bh & 3;
    LAS bf16* ST = (LAS bf16*)(lds + SC_ST); LAS bf16* VNT = (LAS bf16*)(lds + SC_VNT); LAS float* OS = (LAS float*)(lds + SC_O);
    const bf16* proj = (const bf16*)(a.ws + WS_PROJ); bf16* yab = (bf16*)(a.ws + WS_YAB);
    const float* GL = (const float*)(a.ws + WS_GL);
    for (int i = tid; i < 34816 / 4; i += 512) ((LAS unsigned*)ST)[i] = 0u;
    f32x4 S[8];
#pragma unroll
    for (int vt = 0; vt < 8; ++vt) S[vt] = (f32x4){0.f, 0.f, 0.f, 0.f};
    const int erow = tid >> 3, eseg = tid & 7;
    LAS float* gainl = (LAS float*)(lds + 87040);
    if (tid < 128) gainl[tid] = a.in[11][tid];
    const int ct = w & 3;
    const size_t cb = (size_t)bh * 64;
    const bf16* Wb = (const bf16*)((const unsigned char*)a.out + DO_W) + cb * 8192;
    const bf16* QDb = (const bf16*)((const unsigned char*)a.out + DO_QD) + cb * 8192;
    const bf16* KDTb = (const bf16*)((const unsigned char*)a.out + DO_KDT) + cb * 8192;
    const bf16* UTb = (const bf16*)((const unsigned char*)a.out + DO_UT) + cb * 8192;
    const bf16* Ab = (const bf16*)(a.ws + WS_GA) + cb * 4096;
    const bf16* Xb = (w < 4) ? Wb : QDb;
    const size_t tz = ((size_t)b * SEQ + erow) * PW + C_BZ + h * 128 + 16 * eseg;
    const size_t ty = ((size_t)b * SEQ + erow) * YW + 1024 + h * 128 + 16 * eseg;
    bf16x8 af[4], kd[2]; v4u xr[4]; float gl; v4u zh0, zh1;
#define SCAN_LOAD(n_, af_, kd_, xr_, gl_) do { \
        const bf16* X_ = Xb + (size_t)(n_) * 8192 + (ct * 4 * 64 + lane) * 8; \
        _Pragma("unroll") for (int ks = 0; ks < 4; ++ks) af_[ks] = *(const bf16x8*)(X_ + ks * 512); \
        const bf16* K_ = KDTb + (size_t)(n_) * 8192 + (w * 2 * 64 + lane) * 8; \
        kd_[0] = *(const bf16x8*)(K_); kd_[1] = *(const bf16x8*)(K_ + 512); \
        if (w >= 4) { const bf16* A_ = Ab + (size_t)(n_) * 4096 + (ct * 2 * 64 + lane) * 8; xr_[0] = *(const v4u*)(A_); xr_[1] = *(const v4u*)(A_ + 512); } \
        else { const bf16* U_ = UTb + (size_t)(n_) * 8192 + (ct * 8 * 64 + lane) * 4; _Pragma("unroll") for (int q_ = 0; q_ < 4; ++q_) { const v2u u0_ = *(const v2u*)(U_ + (2 * q_) * 256), u1_ = *(const v2u*)(U_ + (2 * q_ + 1) * 256); xr_[q_] = (v4u){u0_.x, u0_.y, u1_.x, u1_.y}; } } \
        gl_ = GL[cb + (n_)]; } while (0)
    SCAN_LOAD(0, af, kd, xr, gl);
    zh0 = (v4u){0u, 0u, 0u, 0u}; zh1 = zh0;
    __syncthreads();
    for (int n = 0; n < 64; ++n) {
        bf16x8 afn[4], kdn[2]; v4u xrn[4]; float gln;
        const int nn = (n < 63) ? n + 1 : 63;
        SCAN_LOAD(nn, afn, kdn, xrn, gln);
        const v4u zn0 = *(const v4u*)(proj + tz + (size_t)n * 64 * PW), zn1 = *(const v4u*)(proj + tz + (size_t)n * 64 * PW + 8);
        if (n > 0) scan_epilogue(OS, zh0, zh1, gainl, yab + ty + (size_t)(n - 1) * 64 * YW, tid);
        zh0 = zn0; zh1 = zn1;
        f32x4 acc[8];
#pragma unroll
        for (int vt = 0; vt < 8; ++vt) acc[vt] = (f32x4){0.f, 0.f, 0.f, 0.f};
#pragma unroll
        for (int ks = 0; ks < 4; ++ks) {
#pragma unroll
            for (int vt = 0; vt < 8; ++vt) {
                const bf16x8 bfr = *(const LAS bf16x8*)(ST + (16 * vt + r) * 136 + 32 * ks + 8 * g);
                acc[vt] = __builtin_amdgcn_mfma_f32_16x16x32_bf16(af[ks], bfr, acc[vt], 0, 0, 0);
            }
        }
        if (w < 4) {
#pragma unroll
            for (int vt = 0; vt < 8; ++vt) {
                const unsigned ux = (vt & 1) ? xr[vt >> 1].z : xr[vt >> 1].x, uy = (vt & 1) ? xr[vt >> 1].w : xr[vt >> 1].y;
                const v2u o = pack4(bflo(ux) - acc[vt][0], bfhi(ux) - acc[vt][1], bflo(uy) - acc[vt][2], bfhi(uy) - acc[vt][3]);
                *(LAS v2u*)(VNT + (16 * vt + r) * 72 + 16 * ct + 4 * g) = o;
            }
        }
        __syncthreads();
        if (w >= 4) {
#pragma unroll
            for (int ks = 0; ks < 2; ++ks)
#pragma unroll
                for (int vt = 0; vt < 8; ++vt) {
                    const bf16x8 vb = *(const LAS bf16x8*)(VNT + (16 * vt + r) * 72 + 32 * ks + 8 * g);
                    acc[vt] = __builtin_amdgcn_mfma_f32_16x16x32_bf16(__builtin_bit_cast(bf16x8, xr[ks]), vb, acc[vt], 0, 0, 0);
                }
#pragma unroll
            for (int vt = 0; vt < 8; ++vt)
#pragma unroll
                for (int rg = 0; rg < 4; ++rg) OS[(16 * ct + 4 * g + rg) * 132 + 16 * vt + r] = acc[vt][rg];
        }
#pragma unroll
        for (int vt = 0; vt < 8; ++vt) S[vt] = S[vt] * gl;
#pragma unroll
        for (int ks = 0; ks < 2; ++ks)
#pragma unroll
            for (int vt = 0; vt < 8; ++vt) {
                const bf16x8 vb = *(const LAS bf16x8*)(VNT + (16 * vt + r) * 72 + 32 * ks + 8 * g);
                S[vt] = __builtin_amdgcn_mfma_f32_16x16x32_bf16(kd[ks], vb, S[vt], 0, 0, 0);
            }
#pragma unroll
        for (int vt = 0; vt < 8; ++vt)
            *(LAS v2u*)(ST + (16 * vt + r) * 136 + 16 * w + 4 * g) = pack4(S[vt][0] + 0.f, S[vt][1] + 0.f, S[vt][2] + 0.f, S[vt][3] + 0.f);
#pragma unroll
        for (int ks = 0; ks < 4; ++ks) af[ks] = afn[ks];
        kd[0] = kdn[0]; kd[1] = kdn[1];
#pragma unroll
        for (int q = 0; q < 4; ++q) xr[q] = xrn[q];
        gl = gln;
        __syncthreads();
    }
    scan_epilogue(OS, zh0, zh1, gainl, yab + ty + (size_t)63 * 64 * YW, tid);
    __syncthreads();
#undef SCAN_LOAD
}

typedef short v4s __attribute__((ext_vector_type(4)));
constexpr int AQ_STRIDE = 272, AQ_WAVE_LDS = 64 * AQ_STRIDE + 512;
__device__ __forceinline__ void attn_query_q4(const Args& a, LAS unsigned char* wl, const LAS float* qgl, int t, int lane) {
    const bf16* proj = (const bf16*)(a.ws + WS_PROJ); const bf16* KN = (const bf16*)(a.ws + WS_KN);
    const unsigned short* SEL = (const unsigned short*)(a.ws + WS_SEL); bf16* yab = (bf16*)(a.ws + WS_YAB);
    LAS unsigned char* KT = wl; LAS unsigned short* SL = (LAS unsigned short*)(wl + 64 * AQ_STRIDE);
    const int r = lane & 15, g = lane >> 4;
    const int b = t >> 12, pos = t & 4095;
    const bf16* knb = KN + (size_t)b * SEQ * 128;
    *(LAS v2u*)(SL + 4 * lane) = *(const v2u*)(SEL + (size_t)t * 256 + 4 * lane);
    bf16x8 qf[4];
    {
        const bf16* qp = proj + (size_t)t * PW + C_AQ + (r & 7) * 128 + 8 * g;
        float f[32]; float ss = 0.f;
#pragma unroll
        for (int ks = 0; ks < 4; ++ks) { const v4u raw = *(const v4u*)(qp + 32 * ks);
            f[8 * ks] = bflo(raw.x); f[8 * ks + 1] = bfhi(raw.x); f[8 * ks + 2] = bflo(raw.y); f[8 * ks + 3] = bfhi(raw.y); f[8 * ks + 4] = bflo(raw.z); f[8 * ks + 5] = bfhi(raw.z); f[8 * ks + 6] = bflo(raw.w); f[8 * ks + 7] = bfhi(raw.w); }
#pragma unroll
        for (int i = 0; i < 32; ++i) ss += f[i] * f[i];
        ss += __shfl_xor(ss, 16); ss += __shfl_xor(ss, 32);
        float inv = rsqrtf(ss * (1.f / 128.f) + EPS) * 0.08838834764831845f;
        if (r >= 8) inv = 0.f;
#pragma unroll
        for (int ks = 0; ks < 4; ++ks) { const f32x4 ga = *(const LAS f32x4*)(qgl + 32 * ks + 8 * g), gb = *(const LAS f32x4*)(qgl + 32 * ks + 8 * g + 4);
            v4u o; o.x = pk2(f[8 * ks] * inv * ga.x, f[8 * ks + 1] * inv * ga.y); o.y = pk2(f[8 * ks + 2] * inv * ga.z, f[8 * ks + 3] * inv * ga.w);
            o.z = pk2(f[8 * ks + 4] * inv * gb.x, f[8 * ks + 5] * inv * gb.y); o.w = pk2(f[8 * ks + 6] * inv * gb.z, f[8 * ks + 7] * inv * gb.w);
            qf[ks] = __builtin_bit_cast(bf16x8, o); }
    }
    LDS_WAIT();
    const int cnt = (pos + 1 < 256) ? pos + 1 : 256, nq = (cnt + 63) >> 6;
    const float slope = exp2f(-(float)((r & 7) + 1));
    float m_run = -INFINITY, l_run = 0.f;
    f32x4 O[8];
#pragma unroll
    for (int dt = 0; dt < 8; ++dt) O[dt] = (f32x4){0.f, 0.f, 0.f, 0.f};
    bf16x8 ka[4][4], kb[4][4];
#define AQ_LOAD(q_, k_) do { _Pragma("unroll") for (int kt = 0; kt < 4; ++kt) { int ix_ = SL[64 * (q_) + 16 * kt + r]; ix_ = (ix_ == 0xFFFF) ? 0 : ix_; \
        const bf16* kp_ = knb + (size_t)ix_ * 128 + 8 * g; _Pragma("unroll") for (int ks = 0; ks < 4; ++ks) k_[kt][ks] = *(const bf16x8*)(kp_ + 32 * ks); } } while (0)
#define AQ_PASS(q_, k_) do { \
        f32x4 sc[4]; \
        _Pragma("unroll") for (int kt = 0; kt < 4; ++kt) { f32x4 acc = (f32x4){0.f, 0.f, 0.f, 0.f}; \
            _Pragma("unroll") for (int ks = 0; ks < 4; ++ks) { acc = __builtin_amdgcn_mfma_f32_16x16x32_bf16(k_[kt][ks], qf[ks], acc, 0, 0, 0); \
                *(LAS bf16x8*)(KT + (16 * kt + r) * AQ_STRIDE + (32 * ks + 8 * g) * 2) = k_[kt][ks]; } \
            sc[kt] = acc; } \
        float m = m_run; \
        _Pragma("unroll") for (int kt = 0; kt < 4; ++kt) { const v2u s4 = *(const LAS v2u*)(SL + 64 * (q_) + 16 * kt + 4 * g); \
            const int i0 = s4.x & 0xFFFF, i1 = s4.x >> 16, i2 = s4.y & 0xFFFF, i3 = s4.y >> 16; \
            sc[kt][0] = (i0 != 0xFFFF) ? sc[kt][0] - slope * (float)(pos - i0) : -INFINITY; sc[kt][1] = (i1 != 0xFFFF) ? sc[kt][1] - slope * (float)(pos - i1) : -INFINITY; \
            sc[kt][2] = (i2 != 0xFFFF) ? sc[kt][2] - slope * (float)(pos - i2) : -INFINITY; sc[kt][3] = (i3 != 0xFFFF) ? sc[kt][3] - slope * (float)(pos - i3) : -INFINITY; \
            m = fmaxf(fmaxf(m, fmaxf(sc[kt][0], sc[kt][1])), fmaxf(sc[kt][2], sc[kt][3])); } \
        m = fmaxf(m, __shfl_xor(m, 16)); m = fmaxf(m, __shfl_xor(m, 32)); \
        const float alpha = __expf(m_run - m); \
        float ls = 0.f; \
        _Pragma("unroll") for (int kt = 0; kt < 4; ++kt) _Pragma("unroll") for (int rg = 0; rg < 4; ++rg) { const float e = __expf(sc[kt][rg] - m); sc[kt][rg] = e; ls += e; } \
        ls += __shfl_xor(ls, 16); ls += __shfl_xor(ls, 32); \
        l_run = l_run * alpha + ls; m_run = m; \
        _Pragma("unroll") for (int rg = 0; rg < 4; ++rg) { const float ah = __shfl(alpha, 4 * g + rg); _Pragma("unroll") for (int dt = 0; dt < 8; ++dt) O[dt][rg] *= ah; } \
        _Pragma("unroll") for (int c = 0; c < 2; ++c) { v4u o_; o_.x = pk2(sc[2 * c][0], sc[2 * c][1]); o_.y = pk2(sc[2 * c][2], sc[2 * c][3]); o_.z = pk2(sc[2 * c + 1][0], sc[2 * c + 1][1]); o_.w = pk2(sc[2 * c + 1][2], sc[2 * c + 1][3]); \
            const bf16x8 pa = __builtin_bit_cast(bf16x8, o_); \
            _Pragma("unroll") for (int dt = 0; dt < 8; ++dt) { \
                const v4s b0 = __builtin_amdgcn_ds_read_tr16_b64_v4i16((LAS v4s*)(tb + (32 * c) * AQ_STRIDE + 32 * dt)); \
                const v4s b1 = __builtin_amdgcn_ds_read_tr16_b64_v4i16((LAS v4s*)(tb + (32 * c + 16) * AQ_STRIDE + 32 * dt)); \
                const bf16x8 bfr = __builtin_shufflevector(b0, b1, 0, 1, 2, 3, 4, 5, 6, 7); \
                O[dt] = __builtin_amdgcn_mfma_f32_16x16x32_bf16(pa, bfr, O[dt], 0, 0, 0); } } \
        __builtin_amdgcn_sched_barrier(0); } while (0)
    const LAS unsigned char* tb = KT + (4 * g + (r >> 2)) * AQ_STRIDE + 8 * (r & 3);
    AQ_LOAD(0, ka);
    AQ_LOAD(1, kb);
    AQ_PASS(0, ka);
    AQ_LOAD(2, ka);
    if (nq > 1) AQ_PASS(1, kb);
    AQ_LOAD(3, kb);
    if (nq > 2) AQ_PASS(2, ka);
    if (nq > 3) AQ_PASS(3, kb);
#undef AQ_LOAD
#undef AQ_PASS
    const float il = 1.f / l_run;
    if (true) {
        float ih[4];
#pragma unroll
        for (int rg = 0; rg < 4; ++rg) ih[rg] = __shfl(il, 4 * g + rg);
        if (g < 2) {
#pragma unroll
            for (int rg = 0; rg < 4; ++rg)
#pragma unroll
                for (int dt = 0; dt < 8; ++dt) yab[(size_t)t * YW + (4 * g + rg) * 128 + 16 * dt + r] = (bf16)f2bf(O[dt][rg] * ih[rg]);
        }
    }
    LDS_WAIT();
}

__device__ __forceinline__ void phase4(const Args& a, LAS unsigned char* lds) {
    const int bid = blockIdx.x, G = gridDim.x, tid = threadIdx.x, lane = tid & 63, wave = tid >> 6;
    const int nscan = (G >= 64) ? 32 : 0;
#ifndef P4_REP
#define P4_REP 0
#endif
    if (nscan && bid < 32) { gdn_scan(a, lds, bid); if (P4_REP & 1) { __syncthreads(); gdn_scan(a, lds, bid); } return; }
    if (!nscan) { for (int bh = bid; bh < 32; bh += G) gdn_scan(a, lds, bh); __syncthreads(); }
    LAS float* qg4 = (LAS float*)(lds + 8 * AQ_WAVE_LDS);
    if (tid < 128) qg4[tid] = a.in[5][tid];
    __syncthreads();
    LAS unsigned char* wl4 = lds + wave * AQ_WAVE_LDS;
    if (nscan == 32 && (G & 7) == 0) {
        const int bb = bid & 7, wl_i = ((bid - 32) >> 3) * 8 + wave, nwl = ((G - 32) >> 3) * 8;
        for (int p = wl_i; p < SEQ; p += nwl) attn_query_q4(a, wl4, qg4, bb * SEQ + p, lane);
        if (P4_REP & 2) for (int p = wl_i; p < SEQ; p += nwl) attn_query_q4(a, wl4, qg4, bb * SEQ + p, lane);
    } else {
        const int gw = (bid - nscan) * 8 + wave, NGW = (G - nscan) * 8;
        for (int t = gw; t < T_TOK; t += NGW) attn_query_q4(a, wl4, qg4, t, lane);
    }
}

#define INS16P(L, v_) do { float _x = (v_); \
    _Pragma("unroll") for (int _k = 0; _k < 16; ++_k) { const float _h = __builtin_fmaxf(L[_k], _x); _x = __builtin_fminf(L[_k], _x); L[_k] = _h; } } while (0)
#define CE_D(a_, b_) do { const float _h = __builtin_fmaxf(a_, b_), _l = __builtin_fminf(a_, b_); a_ = _h; b_ = _l; } while (0)
#define SORT16_DESC(A) do { \
    _Pragma("unroll") for (int k_ = 2; k_ <= 16; k_ <<= 1) \
    _Pragma("unroll") for (int j_ = k_ >> 1; j_ > 0; j_ >>= 1) \
    _Pragma("unroll") for (int i_ = 0; i_ < 16; ++i_) { const int l_ = i_ ^ j_; if (l_ > i_) { if ((i_ & k_) == 0) CE_D(A[i_], A[l_]); else CE_D(A[l_], A[i_]); } } } while (0)
#define MERGE16_TOP(L, B) do { \
    _Pragma("unroll") for (int i_ = 0; i_ < 16; ++i_) L[i_] = __builtin_fmaxf(L[i_], B[15 - i_]); \
    _Pragma("unroll") for (int j_ = 8; j_ > 0; j_ >>= 1) \
    _Pragma("unroll") for (int i_ = 0; i_ < 16; ++i_) { const int l_ = i_ ^ j_; if (l_ > i_) CE_D(L[i_], L[l_]); } } while (0)
__device__ __forceinline__ float packf(float v, unsigned id, unsigned mask) { return __uint_as_float((__float_as_uint(v) & ~mask) | id); }

__device__ __forceinline__ void peer_route_unit(const Args& a, LAS float* SC, int tt, int p, int lane) {
    const bf16* query = (const bf16*)(a.ws + WS_QUERY); const bf16* subk = (const bf16*)(a.ws + WS_SUBK);
    int* expid = (int*)(a.ws + WS_EXPID); float* gate = (float*)(a.ws + WS_GATE);
    const int r = lane & 15, g = lane >> 4;
    const int tok = lane & 31, ch = lane >> 5;
    float L1[16], L2[16];
#pragma unroll
    for (int k = 0; k < 16; ++k) { L1[k] = 0.f; L2[k] = 0.f; }
#pragma unroll 1
    for (int half = 0; half < 2; ++half) {
        bf16x8 bk[8][4];
        {
            const bf16* kp = subk + (size_t)((p * 2 + half) * 128 + r) * 128 + 8 * g;
#pragma unroll
            for (int nt = 0; nt < 8; ++nt)
#pragma unroll
                for (int ks = 0; ks < 4; ++ks) bk[nt][ks] = *(const bf16x8*)(kp + (size_t)nt * 16 * 128 + 32 * ks);
        }
        bf16x8 af[2][4];
#pragma unroll
        for (int mt = 0; mt < 2; ++mt) {
            const bf16* qp = query + (size_t)(tt * 32 + mt * 16 + r) * 2048 + p * 256 + half * 128 + 8 * g;
#pragma unroll
            for (int ks = 0; ks < 4; ++ks) af[mt][ks] = *(const bf16x8*)(qp + 32 * ks);
        }
#pragma unroll
        for (int mt = 0; mt < 2; ++mt) {
#pragma unroll
            for (int nt = 0; nt < 8; ++nt) {
                f32x4 acc = (f32x4){0.f, 0.f, 0.f, 0.f};
#pragma unroll
                for (int ks = 0; ks < 4; ++ks) acc = __builtin_amdgcn_mfma_f32_16x16x32_bf16(af[mt][ks], bk[nt][ks], acc, 0, 0, 0);
#pragma unroll
                for (int rg = 0; rg < 4; ++rg) SC[(mt * 16 + 4 * g + rg) * 132 + nt * 16 + r] = acc[rg];
            }
        }
        LDS_WAIT();
        float L[16];
#pragma unroll
        for (int c16 = 0; c16 < 4; ++c16) {
            float B[16];
#pragma unroll
            for (int c4 = 0; c4 < 4; ++c4) {
                const f32x4 v = *(const LAS f32x4*)(SC + tok * 132 + 64 * ch + 16 * c16 + 4 * c4);
                const unsigned n0 = 64 * ch + 16 * c16 + 4 * c4;
                B[4 * c4] = packf(v.x, n0, 127u); B[4 * c4 + 1] = packf(v.y, n0 + 1, 127u); B[4 * c4 + 2] = packf(v.z, n0 + 2, 127u); B[4 * c4 + 3] = packf(v.w, n0 + 3, 127u);
            }
            SORT16_DESC(B);
            if (c16 == 0) {
#pragma unroll
                for (int k = 0; k < 16; ++k) L[k] = B[k];
            } else MERGE16_TOP(L, B);
        }
        {
            float B[16];
#pragma unroll
            for (int k = 0; k < 16; ++k) B[k] = __shfl(L[k], tok + 32);
            MERGE16_TOP(L, B);
        }
#pragma unroll
        for (int k = 0; k < 16; ++k) { L1[k] = (half == 0) ? L[k] : L1[k]; L2[k] = (half == 0) ? L2[k] : L[k]; }
        LDS_WAIT();
    }
    float V1[16], V2[16];
#pragma unroll
    for (int k = 0; k < 16; ++k) { V1[k] = __uint_as_float(__float_as_uint(L1[k]) & ~127u); V2[k] = __uint_as_float(__float_as_uint(L2[k]) & ~127u); }
    float C[16];
#pragma unroll
    for (int k = 0; k < 16; ++k) C[k] = -INFINITY;
#pragma unroll
    for (int i = 0; i < 16; ++i)
#pragma unroll
        for (int j = 0; j < 16; ++j)
            if ((i + 1) * (j + 1) <= 16) INS16P(C, packf(V1[i] + V2[j], (unsigned)(i * 16 + j), 255u));
    if (ch == 0) {
        float e[16], sum = 0.f; int ex[16];
        const float c0 = __uint_as_float(__float_as_uint(C[0]) & ~255u);
#pragma unroll
        for (int k = 0; k < 16; ++k) {
            const unsigned cb = __float_as_uint(C[k]); const int ci = (cb >> 4) & 15, cj = cb & 15;
            int i1 = 0, i2 = 0;
#pragma unroll
            for (int m = 0; m < 16; ++m) { i1 = (ci == m) ? (int)(__float_as_uint(L1[m]) & 127u) : i1; i2 = (cj == m) ? (int)(__float_as_uint(L2[m]) & 127u) : i2; }
            ex[k] = i1 * 128 + i2;
            e[k] = __expf(__uint_as_float(cb & ~255u) - c0); sum += e[k];
        }
        const float inv = 1.f / sum;
        const size_t base = ((size_t)(tt * 32 + tok) * 8 + p) * 16;
#pragma unroll
        for (int q = 0; q < 4; ++q) {
            *(v4u*)(expid + base + 4 * q) = (v4u){(unsigned)ex[4 * q], (unsigned)ex[4 * q + 1], (unsigned)ex[4 * q + 2], (unsigned)ex[4 * q + 3]};
            *(f32x4*)(gate + base + 4 * q) = (f32x4){e[4 * q] * inv, e[4 * q + 1] * inv, e[4 * q + 2] * inv, e[4 * q + 3] * inv};
        }
    }
}
__device__ __forceinline__ void phase8(const Args& a, LAS unsigned char* lds) {
    const int tid = threadIdx.x, lane = tid & 63, wave = tid >> 6;
    LAS float* SC = (LAS float*)(lds + wave * 16896);
    const int gw = blockIdx.x * 8 + wave, NGW = gridDim.x * 8;
#ifndef P8_REP
#define P8_REP 1
#endif
    for (int rep_ = 0; rep_ < P8_REP; ++rep_)
    for (int u = gw; u < 1024 * 8; u += NGW) peer_route_unit(a, SC, u >> 3, u & 7, lane);
}

typedef float f32x2 __attribute__((ext_vector_type(2)));
__device__ __forceinline__ void cvt8(const v4u u, float* f) { f[0] = bflo(u.x); f[1] = bfhi(u.x); f[2] = bflo(u.y); f[3] = bfhi(u.y); f[4] = bflo(u.z); f[5] = bfhi(u.z); f[6] = bflo(u.w); f[7] = bfhi(u.w); }
__device__ __forceinline__ void cvt16_fp8(const v4u u, float* f) {
#pragma unroll
    for (int q = 0; q < 4; ++q) { const f32x2 lo = __builtin_amdgcn_cvt_pk_f32_fp8((int)u[q], false), hi = __builtin_amdgcn_cvt_pk_f32_fp8((int)u[q], true);
        f[4 * q] = lo.x; f[4 * q + 1] = lo.y; f[4 * q + 2] = hi.x; f[4 * q + 3] = hi.y; }
}
#define DPPF(x_, ctrl_) __builtin_bit_cast(float, __builtin_amdgcn_update_dpp(0, __builtin_bit_cast(int, (x_)), (ctrl_), 0xF, 0xF, false))
__device__ __forceinline__ float reduce8(const float* d, int lane) {
    const bool b0 = lane & 1, b1 = lane & 2, b2 = lane & 4;
    float s1[4], s2[2];
#pragma unroll
    for (int i = 0; i < 4; ++i) { const float a = b0 ? d[2 * i + 1] : d[2 * i], b = b0 ? d[2 * i] : d[2 * i + 1]; s1[i] = a + DPPF(b, 0xB1); }
#pragma unroll
    for (int i = 0; i < 2; ++i) { const float a = b1 ? s1[2 * i + 1] : s1[2 * i], b = b1 ? s1[2 * i] : s1[2 * i + 1]; s2[i] = a + DPPF(b, 0x4E); }
    const float a3 = b2 ? s2[1] : s2[0], b3 = b2 ? s2[0] : s2[1];
    float s = a3 + DPPF(b3, 0x124);
    s += DPPF(s, 0x128);
    s += __shfl_xor(s, 16); s += __shfl_xor(s, 32);
    return s;
}
#ifndef P9L_G
#define P9L_G 8
#endif
constexpr int P9LG = P9L_G, P9LP = 128 + P9LG;
constexpr int P9L_WAVE = 4 * (P9LP * 4 * 3);
#ifndef P9L_SH
#define P9L_SH 12
#endif
constexpr int P9L_NS = 16384 >> P9L_SH;
__device__ __forceinline__ void phase9l(const Args& a, LAS unsigned char* lds) {
    const int tid = threadIdx.x, lane = tid & 63, wave = tid >> 6, G = gridDim.x;
    const unsigned char* UT = a.ws + WS_UT; const unsigned char* VT = a.ws + WS_VT;
    const float* SU = (const float*)(a.ws + WS_SU); const float* SV = (const float*)(a.ws + WS_SV);
    const int* expid = (const int*)(a.ws + WS_EXPID); const float* gate = (const float*)(a.ws + WS_GATE);
    const float* mod = (const float*)(a.ws + WS_MOD);
    LAS int* LE = (LAS int*)(lds + wave * P9L_WAVE);
    LAS float* LG = (LAS float*)(LE + 4 * P9LP);
    LAS float* LA = LG + 4 * P9LP;
    const bool isdiag = (lane >> 4) == ((lane & 15) >> 2);
    for (int rd = 0; ; ++rd) {
        const int tb = ((rd * G + (int)blockIdx.x) * 8 + wave) * 4;
        if (tb >= T_TOK) break;
        v4u h8[4]; float hsc[4]; int off[4][P9L_NS + 1];
#pragma unroll
        for (int i = 0; i < 4; ++i) {
            const size_t t = (size_t)(tb + i);
            h8[i] = *(const v4u*)(a.ws + WS_H8 + t * DM + 16 * lane); hsc[i] = ((const float*)(a.ws + WS_HS))[t];
            int e[2]; float gq[2];
#pragma unroll
            for (int q = 0; q < 2; ++q) { e[q] = expid[t * 128 + lane + 64 * q]; gq[q] = gate[t * 128 + lane + 64 * q]; }
            int base = 0;
#pragma unroll
            for (int s = 0; s < P9L_NS; ++s) {
                off[i][s] = base;
#pragma unroll
                for (int q = 0; q < 2; ++q) {
                    const bool in = (e[q] >> P9L_SH) == s;
                    const unsigned long long mk = __builtin_amdgcn_ballot_w64(in);
                    const int pos = base + __builtin_amdgcn_mbcnt_hi((unsigned)(mk >> 32), __builtin_amdgcn_mbcnt_lo((unsigned)mk, 0));
                    if (in) { LE[i * P9LP + pos] = e[q]; LG[i * P9LP + pos] = gq[q]; }
                    base += __builtin_popcountll(mk);
                }
            }
            off[i][P9L_NS] = 128;
            if (lane < P9LG) LE[i * P9LP + 128 + lane] = e[0];
        }
        LDS_WAIT();
#pragma unroll 1
        for (int s = 0; s < P9L_NS; ++s) {
#pragma unroll
            for (int i = 0; i < 4; ++i) {
                for (int g0 = off[i][s]; g0 < off[i][s + 1]; g0 += P9LG) {
                    const int n = off[i][s + 1] - g0;
                    const int ev = LE[i * P9LP + g0 + (lane & (P9LG - 1))];
                    v4u ua[P9LG];
#pragma unroll
                    for (int k = 0; k < P9LG; ++k) { const int e = __builtin_amdgcn_readlane(ev, k); ua[k] = *(const v4u*)(UT + (size_t)e * 1024 + 16 * lane); }
                    const long hlo = (long)(((unsigned long long)h8[i].y << 32) | h8[i].x), hhi = (long)(((unsigned long long)h8[i].w << 32) | h8[i].z);
#pragma unroll
                    for (int k8 = 0; k8 < P9LG; k8 += 8) {
                        float dd[8];
#pragma unroll
                        for (int k = 0; k < 8; ++k) {
                            f32x4 cacc = (f32x4){0.f, 0.f, 0.f, 0.f};
                            cacc = __builtin_amdgcn_mfma_f32_16x16x32_fp8_fp8((long)(((unsigned long long)ua[k8 + k].y << 32) | ua[k8 + k].x), hlo, cacc, 0, 0, 0);
                            cacc = __builtin_amdgcn_mfma_f32_16x16x32_fp8_fp8((long)(((unsigned long long)ua[k8 + k].w << 32) | ua[k8 + k].z), hhi, cacc, 0, 0, 0);
                            const float c01 = (lane & 1) ? cacc[1] : cacc[0], c23 = (lane & 1) ? cacc[3] : cacc[2];
                            dd[k] = isdiag ? ((lane & 2) ? c23 : c01) : 0.f;
                        }
                        const float tot = reduce8(dd, lane);
                        if (lane < 8 && k8 + lane < n) LA[i * P9LP + g0 + k8 + lane] = tot;
                        __builtin_amdgcn_sched_barrier(0);
                    }
                }
            }
        }
        LDS_WAIT();
#pragma unroll
        for (int i = 0; i < 4; ++i)
#pragma unroll
            for (int q = 0; q < 2; ++q) { const int ix = i * P9LP + lane + 64 * q; const int e = LE[ix];
                const float dq = LA[ix] * SU[e] * hsc[i];
                LA[ix] = 0.5f * dq * (1.f + erff(dq * 0.70710678118654752f)) * LG[ix] * SV[e]; }
        LDS_WAIT();
        float y[4][16];
#pragma unroll
        for (int i = 0; i < 4; ++i)
#pragma unroll
            for (int c = 0; c < 16; ++c) y[i][c] = 0.f;
#pragma unroll 1
        for (int s = 0; s < P9L_NS; ++s) {
#pragma unroll
            for (int i = 0; i < 4; ++i) {
                for (int g0 = off[i][s]; g0 < off[i][s + 1]; g0 += P9LG) {
                    const int n = off[i][s + 1] - g0;
                    const int ev = LE[i * P9LP + g0 + (lane & (P9LG - 1))];
                    const float av = ((lane & (P9LG - 1)) < n) ? LA[i * P9LP + g0 + (lane & (P9LG - 1))] : 0.f;
                    v4u va[P9LG];
#pragma unroll
                    for (int k = 0; k < P9LG; ++k) { const int e = __builtin_amdgcn_readlane(ev, k); va[k] = *(const v4u*)(VT + (size_t)e * 1024 + 16 * lane); }
#pragma unroll
                    for (int k = 0; k < P9LG; ++k) { const float aj = __builtin_bit_cast(float, __builtin_amdgcn_readlane(__builtin_bit_cast(int, av), k));
                        float f[16]; cvt16_fp8(va[k], f);
#pragma unroll
                        for (int c = 0; c < 16; ++c) y[i][c] = __builtin_fmaf(aj, f[c], y[i][c]);
                        if ((k & 3) == 3) __builtin_amdgcn_sched_barrier(0); }
                }
            }
        }
#pragma unroll
        for (int i = 0; i < 4; ++i) {
            const int t = tb + i, b = t >> 12;
            float* orow = a.out + (size_t)t * DM + 16 * lane; const float* g2 = mod + b * 6144 + 5120 + 16 * lane;
#pragma unroll
            for (int q4 = 0; q4 < 4; ++q4) {
                const f32x4 xv = *(const f32x4*)(orow + 4 * q4), gv = *(const f32x4*)(g2 + 4 * q4);
                const f32x4 yv = (f32x4){y[i][4 * q4], y[i][4 * q4 + 1], y[i][4 * q4 + 2], y[i][4 * q4 + 3]};
                *(f32x4*)(orow + 4 * q4) = xv + gv * yv;
            }
        }
        LDS_WAIT();
    }
}

#define XB_TMO      128
#define XB_XCNT(j)  (256  + 64 * (j))
#define XB_XSUB(j)  (1280 + 64 * (j))
#define XB_XGEN(j)  (2304 + 64 * (j))
#define XB_TOP      3328
#define XB_TOPGEN   3392
#define XCD_BAR_WORDS 3456
#define XB_SPIN_CAP (1u << 18)

__device__ __forceinline__ unsigned xb_ld(unsigned* p)              { return __hip_atomic_load(p, __ATOMIC_RELAXED, __HIP_MEMORY_SCOPE_AGENT); }
__device__ __forceinline__ unsigned xb_add(unsigned* p, unsigned v) { return __hip_atomic_fetch_add(p, v, __ATOMIC_RELAXED, __HIP_MEMORY_SCOPE_AGENT); }
__device__ __forceinline__ unsigned xb_xcc_id() { return (unsigned)__builtin_amdgcn_s_getreg((3 << 11) | 20) & 0xFu; }
#define XB_SPIN(cond, bar) do { unsigned _sp = 0; while (cond) { __builtin_amdgcn_s_sleep(1); \
    if ((++_sp & 255u) == 0u) { if (xb_ld(&(bar)[XB_TMO])) break; if (_sp > XB_SPIN_CAP) { atomicAdd(&(bar)[XB_TMO], 1u); break; } } } } while (0)

struct XcdBarrier {
    unsigned* bar; unsigned x;
    volatile LAS unsigned* st;
};

__device__ __forceinline__ XcdBarrier xcd_barrier_post(unsigned* bar, volatile LAS unsigned* st) {
    XcdBarrier b; b.bar = bar; b.x = xb_xcc_id(); b.st = st;
    if (threadIdx.x == 0) (void)xb_add(&bar[XB_XCNT(b.x)], 1u);
    return b;
}
__device__ __forceinline__ void xcd_barrier_complete(unsigned* bar, unsigned x, unsigned& nloc, unsigned& nx) {
    const unsigned G = gridDim.x * gridDim.y * gridDim.z;
    unsigned sum, cnt, mine, sp = 0u;
    for (;;) {
        sum = 0u; cnt = 0u; mine = 0u;
#pragma unroll
        for (unsigned j = 0; j < 16; ++j) { const unsigned c = xb_ld(&bar[XB_XCNT(j)]); sum += c; cnt += (c > 0u) ? 1u : 0u; mine = (j == x) ? c : mine; }
        if (sum == G) break;
        __builtin_amdgcn_s_sleep(1);
        if ((++sp & 255u) == 0u) { if (xb_ld(&bar[XB_TMO])) break; if (sp > XB_SPIN_CAP) { atomicAdd(&bar[XB_TMO], 1u); break; } }
    }
    nloc = mine > 0u ? mine : 1u; nx = cnt > 0u ? cnt : 1u;
}

__device__ __forceinline__ void xcd_barrier(const XcdBarrier& b) {
    asm volatile("s_waitcnt vmcnt(0)" ::: "memory");
    __syncthreads();
    if (threadIdx.x == 0) {
        unsigned* bar = b.bar;
        __builtin_amdgcn_s_waitcnt(0);
        unsigned nloc = b.st[0], nx = b.st[1];
        if (nloc == 0u) { xcd_barrier_complete(bar, b.x, nloc, nx); b.st[0] = nloc; b.st[1] = nx; }
        const unsigned old = xb_add(&bar[XB_XSUB(b.x)], 1u);
        const unsigned gen = old / nloc;
        if (old + 1u == (gen + 1u) * nloc) {
            __builtin_amdgcn_fence(__ATOMIC_RELEASE, "agent");
            asm volatile("s_waitcnt vmcnt(0)" ::: "memory");
            const unsigned og = xb_add(&bar[XB_TOP], 1u);
            const unsigned tg = og / nx;
            if (og + 1u == (tg + 1u) * nx) xb_add(&bar[XB_TOPGEN], 1u);
            else XB_SPIN(xb_ld(&bar[XB_TOPGEN]) == tg, bar);
            __builtin_amdgcn_fence(__ATOMIC_ACQUIRE, "agent");
            xb_add(&bar[XB_XGEN(b.x)], 1u);
            asm volatile("s_waitcnt vmcnt(0)" ::: "memory");
        } else {
            XB_SPIN(xb_ld(&bar[XB_XGEN(b.x)]) == gen, bar);
            __builtin_amdgcn_fence(__ATOMIC_ACQUIRE, "agent");
            asm volatile("s_waitcnt vmcnt(0)" ::: "memory");
        }
    }
    __syncthreads();
}

__global__ void __launch_bounds__(512, 2) mega_fwd(Args a) {
    extern __shared__ __attribute__((aligned(16))) unsigned char lds_raw[];
    LAS unsigned char* lds = (LAS unsigned char*)lds_raw;
    asm volatile("" : "+v"(lds));
    cg::grid_group grid = cg::this_grid();
#define MISC_PTR ((volatile LAS unsigned*)((LAS unsigned char*)lds_raw + (LDS_BYTES - 64)))
    if (threadIdx.x < 16) MISC_PTR[threadIdx.x] = 0u;
    __syncthreads();
    const unsigned xcc_id = xcd_barrier_post((unsigned*)(a.ws + WS_CTL) + 4096, MISC_PTR).x;
    grid.sync();
    unsigned char* ws = a.ws;
    const int lo = a.ph_lo, hi = a.ph_hi;
#ifndef PH_MASK
#define PH_MASK 0x3ff
#endif
#define IN(k) (((PH_MASK >> (k)) & 1) && lo <= (k) && (k) < hi)
#define SEAM(k) do { if (IN(k) && IN((k) + 1)) { if ((k) == 99) grid.sync(); else { XcdBarrier xb_; xb_.bar = (unsigned*)(a.ws + WS_CTL) + 4096; xb_.x = xcc_id; xb_.st = MISC_PTR; xcd_barrier(xb_); } } } while (0)
#ifndef REP_MASK
#define REP_MASK 0
#endif
#define RUNP(k, body) do { if (IN(k)) { body; if ((REP_MASK >> (k)) & 1) { grid.sync(); body; } } } while (0)
    RUNP(0, phase0(a, lds)); SEAM(0);
    RUNP(1, phase_norm(a.in[0], (const float*)(ws + WS_MOD), 0, 1024, (bf16*)(ws + WS_H))); SEAM(1);
    RUNP(2, ({
        pg8::Gemm g{(const pg8::bf16_t*)(ws + WS_H), (const pg8::bf16_t*)(ws + WS_WIN), T_TOK, PW, DM}; pg8::StaticOrder S; S.init(T_TOK, PW, gridDim.x, blockIdx.x);
        EpiBf E{(bf16*)(ws + WS_PROJ), PW};
        pg8::gemm_phase<EpiBf, pg8::StaticOrder, true, true>(lds, g, S, E); })); SEAM(2);
#ifdef IDX_FP32
    if (IN(3)) { phase_idx32(a, lds); grid.sync(); }
#endif
    RUNP(3, phase3(a, lds)); SEAM(3);
    RUNP(4, phase4(a, lds)); SEAM(4);
    RUNP(5, ({
        pg8::Gemm g{(const pg8::bf16_t*)(ws + WS_YAB), (const pg8::bf16_t*)(ws + WS_BT2), T_TOK, DM, YW}; pg8::StaticOrder S; S.init(T_TOK, DM, gridDim.x, blockIdx.x);
        EpiX1 E{a.in[0], a.out, (const float*)(ws + WS_MOD)};
        pg8::gemm_phase<EpiX1, pg8::StaticOrder, true, true>(lds, g, S, E); })); SEAM(5);
    RUNP(6, phase_norm(a.out, (const float*)(ws + WS_MOD), 3072, 4096, (bf16*)(ws + WS_H), ws + WS_H8, (float*)(ws + WS_HS))); SEAM(6);
    RUNP(7, ({
        pg8::Gemm g{(const pg8::bf16_t*)(ws + WS_H), (const pg8::bf16_t*)(ws + WS_WQ), T_TOK, 2048, DM}; pg8::StaticOrder S; S.init(T_TOK, 2048, gridDim.x, blockIdx.x);
        EpiBf E{(bf16*)(ws + WS_QUERY), 2048};
        pg8::gemm_phase<EpiBf, pg8::StaticOrder, true, true>(lds, g, S, E); })); SEAM(7);
    RUNP(8, phase8(a, lds)); SEAM(8);
    if (IN(9)) { phase9l(a, lds); }
#undef IN
#undef SEAM
}

#ifndef MK_N_LAUNCHES
#define MK_N_LAUNCHES 1
#endif
extern "C" void kernel_launch(void* const* d_in, const int* in_sizes, int n_in, void* d_out, int out_size, void* d_ws, size_t ws_size, hipStream_t stream) {
    static int grid = 0;
    if (grid == 0) {
        int dev = 0, cus = 0, per_cu = 0;
        hipGetDevice(&dev);
        hipDeviceGetAttribute(&cus, hipDeviceAttributeMultiprocessorCount, dev);
        hipFuncSetAttribute((const void*)mega_fwd, hipFuncAttributeMaxDynamicSharedMemorySize, LDS_BYTES);
        hipOccupancyMaxActiveBlocksPerMultiprocessor(&per_cu, (const void*)mega_fwd, 512, LDS_BYTES);
        if (per_cu < 1) { fprintf(stderr, "kernel_launch: occupancy query says %d blocks per CU\n", per_cu); per_cu = 1; }
        grid = cus * 1;
        if (n_in != 17 || ws_size < WS_END) fprintf(stderr, "kernel_launch: unexpected n_in %d / ws_size %zu\n", n_in, ws_size);
    }
    (void)hipMemsetAsync((char*)d_ws + WS_CTL, 0, 65536, stream);
    Args a{};
    for (int i = 0; i < 17; ++i) a.in[i] = (const float*)d_in[i];
    a.out = (float*)d_out; a.ws = (unsigned char*)d_ws;
#if MK_N_LAUNCHES == 1
    a.ph_lo = 0; a.ph_hi = 10;
    void* args[] = {&a};
    hipError_t e = hipLaunchCooperativeKernel((const void*)mega_fwd, dim3(grid), dim3(512), args, LDS_BYTES, stream);
    if (e != hipSuccess) fprintf(stderr, "cooperative launch failed: %s (grid %d)\n", hipGetErrorString(e), grid);
#else
    for (int p = 0; p < 10; ++p) { a.ph_lo = p; a.ph_hi = p + 1; hipLaunchKernelGGL(mega_fwd, dim3(grid), dim3(512), LDS_BYTES, stream, a); }
#endif
}
```

```cpp
#include <hip/hip_runtime.h>
#include <hip/hip_cooperative_groups.h>
#include <cstdio>
#include <cstdint>
namespace cg = cooperative_groups;
namespace pg8 {
#define PG8_LAS __attribute__((address_space(3)))
typedef unsigned short bf16_t;
typedef short bf16x8 __attribute__((ext_vector_type(8)));
typedef float f32x4 __attribute__((ext_vector_type(4)));
typedef unsigned u32x4 __attribute__((ext_vector_type(4)));
constexpr int BM = 256, BK = 64, HALF = 128, HTB = HALF * BK * 2  , STAGE_BYTES = 8 * HTB, NXCD = 8, WGM = 8;

__host__ __device__ __forceinline__ int lds_byte(int r, int c) { const int st = (r >> 4) * 2 + (c >> 5), rr = r & 15, cc = c & 31, ob = rr * 64 + cc * 2; return st * 1024 + (ob ^ (((ob >> 9) & 1) << 5)); }
__host__ __device__ __forceinline__ void stage_rc(int b, int& R, int& C) { const int st = b / 1024, sb = b % 1024, swz = sb ^ (((sb >> 9) & 1) << 5); R = (st >> 1) * 16 + swz / 64; C = (st & 1) * 32 + (swz % 64) / 2; }
__host__ __device__ __forceinline__ int perm32(int rho) { const int n = rho >> 4, i = rho & 15; return 8 * (i >> 2) + 4 * n + (i & 3); }

struct Unit { int pm, pn; };
struct Gemm { const bf16_t* A; const bf16_t* Bt; int M, N, K; };

struct StaticOrder {
    int nM, nN, nwg, G, c;
    __host__ __device__ void init(int M, int N, int G_, int c_) { nM = M / BM; nN = N / BM; nwg = nM * nN; G = G_; c = c_; }
    __host__ __device__ bool next(int i, Unit& u) const {
        const long L = (long)i * G + c; if (L >= nwg) return false;
        int wgid = (int)L; { const int q = nwg / NXCD, r = nwg % NXCD, xcd = wgid % NXCD, off = wgid / NXCD; wgid = (xcd < r ? xcd * (q + 1) : r * (q + 1) + (xcd - r) * q) + off; }
        const int nig = WGM * nN, gid = wgid / nig, fm = gid * WGM, gsz = (nM - fm) < WGM ? (nM - fm) : WGM;
        u.pm = fm + ((wgid % nig) % gsz); u.pn = (wgid % nig) / gsz; return true;
    }
    __device__ __forceinline__ void a_ready(const Unit&) const {}
    __device__ __forceinline__ void done(const Unit&) const {}
};
__device__ __forceinline__ unsigned cvt_pk_bf16(float lo, float hi) { unsigned r; asm volatile("v_cvt_pk_bf16_f32 %0, %1, %2" : "=v"(r) : "v"(lo), "v"(hi)); return r; }
template <class Epi, class Sched, bool ALIGN_EPI = false, bool SP2 = false>
__device__ __forceinline__ void gemm_phase(PG8_LAS unsigned char* lds, const Gemm g, const Sched& S, const Epi& E) {
    const int tid = threadIdx.x, wid = __builtin_amdgcn_readfirstlane(tid >> 6), lane = tid & 63, wr = wid >> 2, wc = wid & 3, fr = lane & 15, fq = lane >> 4;
    const int K = g.K, nt = K / BK;
    unsigned voffA[2], voffB[2];
#pragma unroll
    for (int i = 0; i < 2; ++i) { int R, C; stage_rc(tid * 16 + i * 8192, R, C); const int Rb = Epi::PERM ? ((R & ~31) + perm32(R & 31)) : R;
        voffA[i] = (unsigned)(R * K + C) * 2u; voffB[i] = (unsigned)(Rb * K + C) * 2u; }
    const size_t kstep = (size_t)(BK * 2);
    const size_t hstep = (size_t)HALF * K * 2;
    const size_t tstep = 2 * hstep;
    const unsigned ldsw = (unsigned)wid * 1024u;
    const int aoff = lds_byte(wr * 64 + fr, fq * 8), boff = lds_byte(wc * 32 + fr, fq * 8);
#define PG8_SA(b, h) (((b) * 2 + (h)) * HTB)
#define PG8_SB(b, h) ((4 + (b) * 2 + (h)) * HTB)
#define PG8_STAGE(bufoff, gbase, voff) do { _Pragma("unroll") for (int _i = 0; _i < 2; ++_i) \
        __builtin_amdgcn_global_load_lds((const unsigned*)((const char*)(gbase) + (voff)[_i]), (PG8_LAS unsigned*)(lds + (bufoff) + ldsw + _i * 8192), 16, 0, 0); } while (0)
#define PG8_LDA(dst, b, h) do { _Pragma("unroll") for (int m = 0; m < 4; ++m) _Pragma("unroll") for (int k = 0; k < 2; ++k) dst[m][k] = *(const PG8_LAS bf16x8*)(lds + PG8_SA(b, h) + aoff + m * 2048 + k * 1024); } while (0)
#define PG8_LDB(dst, b, h) do { _Pragma("unroll") for (int n = 0; n < 2; ++n) _Pragma("unroll") for (int k = 0; k < 2; ++k) dst[n][k] = *(const PG8_LAS bf16x8*)(lds + PG8_SB(b, h) + boff + n * 2048 + k * 1024); } while (0)
#define PG8_MMA(ai, bj, At, Bt) do { __builtin_amdgcn_s_setprio(1); _Pragma("unroll") for (int m = 0; m < 4; ++m) _Pragma("unroll") for (int n = 0; n < 2; ++n) _Pragma("unroll") for (int k = 0; k < 2; ++k) \
        acc[ai][bj][m][n] = __builtin_amdgcn_mfma_f32_16x16x32_bf16(Bt[n][k], At[m][k], acc[ai][bj][m][n], 0, 0, 0); __builtin_amdgcn_s_setprio(0); } while (0)
#define PG8_WAIT_V(n) asm volatile("s_waitcnt vmcnt(" #n ")" ::: "memory")
#define PG8_WAIT_L(n) asm volatile("s_waitcnt lgkmcnt(" #n ")" ::: "memory")
#define PG8_BAR __builtin_amdgcn_s_barrier()
#define PG8_SCHED __builtin_amdgcn_sched_barrier(0)
    Unit cur, nxt; int ui = 0;
    if (!S.next(0, cur)) return;
    f32x4 acc[2][2][4][2];
#pragma unroll
    for (int a = 0; a < 2; ++a)
#pragma unroll
        for (int b = 0; b < 2; ++b)
#pragma unroll
            for (int m = 0; m < 4; ++m)
#pragma unroll
                for (int n = 0; n < 2; ++n) acc[a][b][m][n] = (f32x4){0.f, 0.f, 0.f, 0.f};
    bf16x8 At[4][2], B0[2][2], B1[2][2];
    const char* cA = (const char*)g.A + (size_t)cur.pm * tstep; const char* cB = (const char*)g.Bt + (size_t)cur.pn * tstep;
    S.a_ready(cur);
    if constexpr (SP2) {
        PG8_STAGE(PG8_SB(0, 0), cB, voffB); PG8_STAGE(PG8_SB(0, 1), cB + hstep, voffB); PG8_STAGE(PG8_SA(0, 0), cA, voffA); PG8_STAGE(PG8_SA(0, 1), cA + hstep, voffA);
        if (wr == 1) PG8_BAR;
        PG8_WAIT_V(2); PG8_BAR;
        PG8_STAGE(PG8_SB(1, 0), cB + kstep, voffB); PG8_STAGE(PG8_SA(1, 0), cA + kstep, voffA); PG8_STAGE(PG8_SB(1, 1), cB + hstep + kstep, voffB);
        PG8_WAIT_V(6); PG8_BAR;
    } else {
        PG8_STAGE(PG8_SB(0, 0), cB, voffB); PG8_STAGE(PG8_SA(0, 0), cA, voffA); PG8_STAGE(PG8_SB(0, 1), cB + hstep, voffB); PG8_STAGE(PG8_SA(0, 1), cA + hstep, voffA);
        if (wr == 1) PG8_BAR;
        PG8_WAIT_V(4); PG8_BAR;
        PG8_STAGE(PG8_SB(1, 0), cB + kstep, voffB); PG8_STAGE(PG8_SA(1, 0), cA + kstep, voffA); PG8_STAGE(PG8_SB(1, 1), cB + hstep + kstep, voffB);
        PG8_WAIT_V(6); PG8_BAR;
    }
    for (;;) {
        const bool has_next = S.next(ui + 1, nxt);
        const char* nA = has_next ? (const char*)g.A + (size_t)nxt.pm * tstep : cA; const char* nB = has_next ? (const char*)g.Bt + (size_t)nxt.pn * tstep : cB;
        for (int t = 0; t < nt; t += 2) {
            const bool last = (t == nt - 2);
            const char* a1 = cA + (size_t)(t + 1) * kstep;
            const char* a2 = last ? nA : cA + (size_t)(t + 2) * kstep; const char* b2 = last ? nB : cB + (size_t)(t + 2) * kstep;
            const char* a3 = a2 + kstep; const char* b3 = b2 + kstep;
            if (last && has_next) S.a_ready(nxt);
            if constexpr (SP2) {
            PG8_LDB(B0, 0, 0); PG8_LDB(B1, 0, 1); PG8_SCHED; PG8_LDA(At, 0, 0); PG8_STAGE(PG8_SA(1, 1), a1 + hstep, voffA);
            PG8_WAIT_V(8); PG8_WAIT_L(0); PG8_BAR; PG8_MMA(0, 0, At, B0); PG8_MMA(0, 1, At, B1); PG8_BAR; PG8_SCHED;
            PG8_LDA(At, 0, 1); PG8_STAGE(PG8_SB(0, 0), b2, voffB); PG8_STAGE(PG8_SB(0, 1), b2 + hstep, voffB); PG8_STAGE(PG8_SA(0, 0), a2, voffA);
            PG8_WAIT_V(8); PG8_WAIT_L(0); PG8_BAR; PG8_MMA(1, 0, At, B0); PG8_MMA(1, 1, At, B1); PG8_BAR; PG8_SCHED;
            PG8_LDB(B0, 1, 0); PG8_LDB(B1, 1, 1); PG8_SCHED; PG8_LDA(At, 1, 0); PG8_STAGE(PG8_SA(0, 1), a2 + hstep, voffA);
            PG8_WAIT_V(8); PG8_WAIT_L(0); PG8_BAR; PG8_MMA(0, 0, At, B0); PG8_MMA(0, 1, At, B1); PG8_BAR; PG8_SCHED;
            PG8_LDA(At, 1, 1); PG8_STAGE(PG8_SB(1, 0), b3, voffB); PG8_STAGE(PG8_SB(1, 1), b3 + hstep, voffB); PG8_STAGE(PG8_SA(1, 0), a3, voffA);
            PG8_WAIT_V(8); PG8_WAIT_L(0); PG8_BAR; PG8_MMA(1, 0, At, B0); PG8_MMA(1, 1, At, B1); PG8_BAR; PG8_SCHED;
            } else {
            PG8_LDB(B0, 0, 0); PG8_SCHED; PG8_LDA(At, 0, 0); PG8_STAGE(PG8_SA(1, 1), a1 + hstep, voffA);
            PG8_WAIT_L(8); PG8_BAR; PG8_WAIT_L(0); PG8_MMA(0, 0, At, B0); PG8_BAR; PG8_SCHED;
            PG8_LDB(B1, 0, 1); PG8_STAGE(PG8_SB(0, 0), b2, voffB);
            PG8_BAR; PG8_WAIT_L(0); PG8_MMA(0, 1, At, B1); PG8_BAR;
            PG8_LDA(At, 0, 1); PG8_STAGE(PG8_SA(0, 0), a2, voffA);
            PG8_BAR; PG8_WAIT_L(0); PG8_MMA(1, 0, At, B0); PG8_BAR; PG8_SCHED;
            PG8_STAGE(PG8_SB(0, 1), b2 + hstep, voffB);
            PG8_WAIT_V(6); PG8_BAR; PG8_MMA(1, 1, At, B1); PG8_BAR;
            PG8_LDB(B0, 1, 0); PG8_SCHED; PG8_LDA(At, 1, 0); PG8_STAGE(PG8_SA(0, 1), a2 + hstep, voffA);
            PG8_WAIT_L(8); PG8_BAR; PG8_WAIT_L(0); PG8_MMA(0, 0, At, B0); PG8_BAR; PG8_SCHED;
            PG8_LDB(B1, 1, 1); PG8_STAGE(PG8_SB(1, 0), b3, voffB);
            PG8_BAR; PG8_WAIT_L(0); PG8_MMA(0, 1, At, B1); PG8_BAR;
            PG8_LDA(At, 1, 1); PG8_STAGE(PG8_SA(1, 0), a3, voffA);
            PG8_BAR; PG8_WAIT_L(0); PG8_MMA(1, 0, At, B0); PG8_BAR; PG8_SCHED;
            PG8_STAGE(PG8_SB(1, 1), b3 + hstep, voffB);
            PG8_WAIT_V(6); PG8_BAR; PG8_MMA(1, 1, At, B1); PG8_BAR;
            }
        }
        if constexpr (ALIGN_EPI) { if (wr == 0) PG8_BAR; }
        if constexpr (!Epi::AFTER_DRAIN) { E(acc, cur, wr, wc, fr, fq); S.done(cur); }
        if (!has_next) break;
#pragma unroll
        for (int a = 0; a < 2; ++a)
#pragma unroll
            for (int b = 0; b < 2; ++b)
#pragma unroll
                for (int m = 0; m < 4; ++m)
#pragma unroll
                    for (int n = 0; n < 2; ++n) acc[a][b][m][n] = (f32x4){0.f, 0.f, 0.f, 0.f};
        cur = nxt; cA = nA; cB = nB; ++ui;
        if constexpr (ALIGN_EPI) { if (wr == 1) PG8_BAR; }
    }
    PG8_WAIT_V(0);
    if constexpr (!ALIGN_EPI) { if (wr == 0) PG8_BAR; }
    PG8_BAR;
    if constexpr (Epi::AFTER_DRAIN) { E.fused(acc, cur, wr, wc, fr, fq, lds, wid, lane); S.done(cur); }
#undef PG8_SA
#undef PG8_SB
#undef PG8_STAGE
#undef PG8_LDA
#undef PG8_LDB
#undef PG8_MMA
#undef PG8_WAIT_V
#undef PG8_WAIT_L
#undef PG8_BAR
#undef PG8_SCHED
}
}


#define LAS __attribute__((address_space(3)))
typedef unsigned short bf16;
typedef unsigned v4u __attribute__((ext_vector_type(4)));
typedef unsigned v2u __attribute__((ext_vector_type(2)));
typedef float f32x4 __attribute__((ext_vector_type(4)));
typedef float f32x16 __attribute__((ext_vector_type(16)));
typedef short bf16x8 __attribute__((ext_vector_type(8)));

constexpr int T_TOK = 32768, DM = 1024, SEQ = 4096, NBATCH = 8;
constexpr int PW = 3584;
constexpr int IN_W = 3532;
constexpr int C_AQ = 0, C_AKV = 1024, C_IQ = 1152, C_IK = 1408, C_IW = 1472, C_BA = 1476, C_BB = 1480, C_BQ = 1536, C_BK = 2048, C_BV = 2560, C_BZ = 3072;
constexpr int YW = 1536;
constexpr int NCHUNK = 2048;
constexpr float EPS = 1e-6f;

constexpr size_t MiB = 1u << 20;
constexpr size_t WS_CTL = 0;
constexpr size_t WS_MOD = 1 * MiB;
constexpr size_t WS_GL = WS_MOD + 256 * 1024;
constexpr size_t WS_SU = WS_MOD + 512 * 1024;
constexpr size_t WS_SV = WS_MOD + 640 * 1024;
constexpr size_t WS_WIN = 2 * MiB;
constexpr size_t WS_BT2 = 9 * MiB;
constexpr size_t WS_WQ = 12 * MiB;
constexpr size_t WS_SUBK = 16 * MiB;
constexpr size_t WS_H = 18 * MiB;
constexpr size_t WS_KN = WS_H;
constexpr size_t WS_SEL = WS_H + 8 * MiB;
constexpr size_t WS_PROJ = 82 * MiB;
constexpr size_t WS_QUERY = WS_PROJ;
constexpr size_t WS_YAB = 306 * MiB;
constexpr size_t WS_EXPID = WS_YAB;
constexpr size_t WS_GATE = WS_YAB + 16 * MiB;
constexpr size_t WS_H8 = WS_YAB + 32 * MiB;
constexpr size_t WS_HS = WS_YAB + 64 * MiB;
constexpr size_t WS_GA = 402 * MiB;
constexpr size_t WS_UT = 418 * MiB;
constexpr size_t WS_VT = 450 * MiB;
constexpr size_t WS_END = 482 * MiB;
constexpr size_t DO_W = 0, DO_QD = 32 * MiB, DO_KDT = 64 * MiB, DO_UT = 96 * MiB;

constexpr int LDS_BYTES = 147456;

struct Args { const float* in[17]; float* out; unsigned char* ws; int ph_lo, ph_hi; };

__device__ __forceinline__ unsigned pk2(float lo, float hi) { unsigned r; asm("v_cvt_pk_bf16_f32 %0, %1, %2" : "=v"(r) : "v"(lo), "v"(hi)); return r; }
__device__ __forceinline__ unsigned f2bf(float f) { return pk2(f, f) & 0xffffu; }
__device__ __forceinline__ float bflo(unsigned u) { return __uint_as_float(u << 16); }
__device__ __forceinline__ float bfhi(unsigned u) { return __uint_as_float(u & 0xffff0000u); }
__device__ __forceinline__ float bf1(bf16 b) { return __uint_as_float(((unsigned)b) << 16); }
__device__ __forceinline__ float wave_sum(float v) {
#pragma unroll
    for (int o = 1; o < 64; o <<= 1) v += __shfl_xor(v, o);
    return v;
}
__device__ __forceinline__ float wave_max(float v) {
#pragma unroll
    for (int o = 1; o < 64; o <<= 1) v = fmaxf(v, __shfl_xor(v, o));
    return v;
}
__device__ __forceinline__ float silu_f(float v) { return v / (1.f + expf(-v)); }
__device__ __forceinline__ float silu_fast(float v) { return v * __builtin_amdgcn_rcpf(1.f + __expf(-v)); }
__device__ __forceinline__ float sigmoid_f(float v) { return 1.f / (1.f + expf(-v)); }
__device__ __forceinline__ float softplus_f(float v) { return fmaxf(v, 0.f) + log1pf(expf(-fabsf(v))); }
#define LDS_WAIT() asm volatile("s_waitcnt lgkmcnt(0)" ::: "memory")

__device__ __forceinline__ int win_srccol(int n) {
    if (n < 1476) return n;
    if (n < 1480) return 3524 + (n - 1476);
    if (n < 1484) return 3528 + (n - 1480);
    if (n < 1536) return -1;
    return 1476 + (n - 1536);
}
__device__ __forceinline__ void transpose_item(const float* W, int spitch, int k0, int sc, bf16* WT, int dpitch, int drow0, int dcol0, LAS float* scr, int lane) {
    float tv[32];
#pragma unroll
    for (int i = 0; i < 32; ++i) { const int kk = 2 * i + (lane >> 5); tv[i] = W[(size_t)(k0 + kk) * spitch + ((sc >= 0) ? sc : 0)]; }
#pragma unroll
    for (int i = 0; i < 32; ++i) { const int kk = 2 * i + (lane >> 5); scr[kk * 33 + (lane & 31)] = (sc >= 0) ? tv[i] : 0.f; }
    LDS_WAIT();
    const int c = lane & 7;
#pragma unroll
    for (int j = 0; j < 4; ++j) { const int n = (lane >> 3) + 8 * j; const LAS float* s = scr + (8 * c) * 33 + n;
        v4u o; o.x = pk2(s[0 * 33], s[1 * 33]); o.y = pk2(s[2 * 33], s[3 * 33]); o.z = pk2(s[4 * 33], s[5 * 33]); o.w = pk2(s[6 * 33], s[7 * 33]);
        *(v4u*)(WT + (size_t)(drow0 + n) * dpitch + dcol0 + 8 * c) = o; }
    LDS_WAIT();
}

__device__ __forceinline__ void phase0(const Args& a, LAS unsigned char* lds) {
    const int tid = threadIdx.x, lane = tid & 63, wave = tid >> 6, bid = blockIdx.x, G = gridDim.x;
    unsigned char* ws = a.ws;
#ifndef P0_REP
#define P0_REP 0
#endif
    for (int rep0_ = 0; rep0_ < 1 + (P0_REP ? 1 : 0); ++rep0_) {
    if (rep0_ == 0 || (P0_REP & 1))
    for (int item = bid; item < 192; item += G) {
        LAS float* sc = (LAS float*)lds;
        LAS float* red = sc + 8192;
        const float* c = a.in[1];
        for (int i = tid; i < 8192; i += 512) sc[i] = silu_f(c[i]);
        __syncthreads();
        const int cc = tid & 31, kg = tid >> 5;
        const float* w = a.in[2] + item * 32 + cc;
        float acc[8];
#pragma unroll
        for (int b = 0; b < 8; ++b) acc[b] = 0.f;
#pragma unroll 16
        for (int k = kg; k < 1024; k += 16) { const float wv = w[(size_t)k * 6144];
#pragma unroll
            for (int b = 0; b < 8; ++b) acc[b] += sc[b * 1024 + k] * wv; }
#pragma unroll
        for (int b = 0; b < 8; ++b) red[(kg * 8 + b) * 32 + cc] = acc[b];
        __syncthreads();
        if (tid < 256) { const int b = tid >> 5; float s = 0.f;
            for (int k2 = 0; k2 < 16; ++k2) s += red[(k2 * 8 + b) * 32 + cc];
            ((float*)(ws + WS_MOD))[b * 6144 + item * 32 + cc] = s + a.in[3][item * 32 + cc]; }
        __syncthreads();
    }
    if (rep0_ == 0 || (P0_REP & 2)) {
        LAS float* scr = (LAS float*)(lds + 65536 + wave * 8704);
        const int gw = bid * 8 + wave, NGW = G * 8;
        constexpr int I_WIN = 16 * 112, I_WQ = 16 * 64, I_WO = 8 * 32;
        for (int it = gw; it < I_WIN + I_WQ + I_WO; it += NGW) {
            int r = it;
            if (r < I_WIN) { const int kb = r / 112, nb = r % 112; transpose_item(a.in[4], IN_W, 64 * kb, win_srccol(32 * nb + (lane & 31)), (bf16*)(ws + WS_WIN), 1024, 32 * nb, 64 * kb, scr, lane); continue; }
            r -= I_WIN;
            if (r < I_WQ) { const int kb = r / 64, nb = r % 64; transpose_item(a.in[13], 2048, 64 * kb, 32 * nb + (lane & 31), (bf16*)(ws + WS_WQ), 1024, 32 * nb, 64 * kb, scr, lane); continue; }
            r -= I_WQ;
            { const int kb = r / 32, nb = r % 32; transpose_item(a.in[12] + (size_t)512 * 1024, 1024, 64 * kb, 32 * nb + (lane & 31), (bf16*)(ws + WS_BT2), YW, 32 * nb, 1024 + 64 * kb, scr, lane); }
        }
    }
    if (rep0_ == 0 || (P0_REP & 4)) {
        const float* wuv = a.in[7]; const float* wout = a.in[12]; bf16* bt2 = (bf16*)(ws + WS_BT2);
        for (int it = bid * 512 + tid; it < 1024 * 128; it += G * 512) {
            const int n = it & 1023, kb = __builtin_amdgcn_readfirstlane(it >> 10);
            const int h = kb >> 4, r0 = (kb & 15) * 8;
            float acc[8];
#pragma unroll
            for (int j = 0; j < 8; ++j) acc[j] = 0.f;
#pragma unroll 16
            for (int v = 0; v < 64; ++v) { const float wo = wout[(size_t)(h * 64 + v) * 1024 + n];
#pragma unroll
                for (int j = 0; j < 8; ++j) acc[j] += wuv[(size_t)(h * 128 + r0 + j) * 64 + v] * wo; }
            v4u o; o.x = pk2(acc[0], acc[1]); o.y = pk2(acc[2], acc[3]); o.z = pk2(acc[4], acc[5]); o.w = pk2(acc[6], acc[7]);
            *(v4u*)(bt2 + (size_t)n * YW + h * 128 + r0) = o;
        }
    }
    if (rep0_ == 0 || (P0_REP & 8)) {
        const size_t gt = (size_t)bid * 512 + tid, GT = (size_t)G * 512;
        for (size_t i = gt; i < 262144 / 8; i += GT) {
            const f32x4 v0 = *(const f32x4*)(a.in[14] + i * 8), v1 = *(const f32x4*)(a.in[14] + i * 8 + 4);
            v4u o; o.x = pk2(v0.x, v0.y); o.y = pk2(v0.z, v0.w); o.z = pk2(v1.x, v1.y); o.w = pk2(v1.z, v1.w);
            *(v4u*)((bf16*)(ws + WS_SUBK) + i * 8) = o;
        }
        const int gw = bid * 8 + wave, NGW = G * 8;
        f32x4 v[4], vn[4];
        if (gw < 2 * 16384) { const float* s0 = ((gw >> 14) ? a.in[16] : a.in[15]) + (size_t)(gw & 16383) * 1024 + 16 * lane;
#pragma unroll
            for (int q = 0; q < 4; ++q) v[q] = *(const f32x4*)(s0 + 4 * q); }
        for (int row = gw; row < 2 * 16384; row += NGW) {
            const int tb = row >> 14, e = row & 16383;
            { const int rn = (row + NGW < 2 * 16384) ? row + NGW : row;
              const float* sn = ((rn >> 14) ? a.in[16] : a.in[15]) + (size_t)(rn & 16383) * 1024 + 16 * lane;
#pragma unroll
              for (int q = 0; q < 4; ++q) vn[q] = *(const f32x4*)(sn + 4 * q); }
            float mx = 0.f;
#pragma unroll
            for (int q = 0; q < 4; ++q) mx = fmaxf(fmaxf(mx, fmaxf(fabsf(v[q].x), fabsf(v[q].y))), fmaxf(fabsf(v[q].z), fabsf(v[q].w)));
            mx = wave_max(mx);
            const float scale = (mx > 0.f) ? mx * (1.f / 240.f) : 1.f, inv = 1.f / scale;
            v4u o;
#pragma unroll
            for (int q = 0; q < 4; ++q) { int p = __builtin_amdgcn_cvt_pk_fp8_f32(v[q].x * inv, v[q].y * inv, 0, false); p = __builtin_amdgcn_cvt_pk_fp8_f32(v[q].z * inv, v[q].w * inv, p, true); o[q] = (unsigned)p; }
            *(v4u*)(ws + (tb ? WS_VT : WS_UT) + (size_t)e * 1024 + 16 * lane) = o;
            if (lane == 0) ((float*)(ws + (tb ? WS_SV : WS_SU)))[e] = scale;
#pragma unroll
            for (int q = 0; q < 4; ++q) v[q] = vn[q];
        }
    }
    }
}

__device__ __forceinline__ void phase_norm(const float* x, const float* mod, int shift_off, int scale_off, bf16* hout, unsigned char* h8 = nullptr, float* hs = nullptr) {
    const int tid = threadIdx.x, lane = tid & 63, wave = tid >> 6;
    const int gw = blockIdx.x * 8 + wave, NGW = gridDim.x * 8;
    f32x4 v[4], vn[4];
    if (gw < T_TOK) {
#pragma unroll
        for (int j = 0; j < 4; ++j) v[j] = ((const f32x4*)(x + (size_t)gw * DM) + lane)[64 * j];
    }
    for (int m = gw; m < T_TOK; m += NGW) {
        const int b = m >> 12;
        { const int mn = (m + NGW < T_TOK) ? m + NGW : m;
#pragma unroll
          for (int j = 0; j < 4; ++j) vn[j] = ((const f32x4*)(x + (size_t)mn * DM) + lane)[64 * j]; }
        float s = 0.f;
#pragma unroll
        for (int j = 0; j < 4; ++j) s += (v[j].x * v[j].x + v[j].y * v[j].y) + (v[j].z * v[j].z + v[j].w * v[j].w);
        const float inv = rsqrtf(wave_sum(s) * (1.f / DM) + EPS);
        const f32x4* sh = (const f32x4*)(mod + b * 6144 + shift_off) + lane;
        const f32x4* sc = (const f32x4*)(mod + b * 6144 + scale_off) + lane;
        v2u* o8 = (v2u*)(hout + (size_t)m * DM) + lane;
        float amax = 0.f;
#pragma unroll
        for (int j = 0; j < 4; ++j) { const f32x4 a = sh[64 * j], c = sc[64 * j];
            v[j].x = v[j].x * inv * (1.f + c.x) + a.x; v[j].y = v[j].y * inv * (1.f + c.y) + a.y; v[j].z = v[j].z * inv * (1.f + c.z) + a.z; v[j].w = v[j].w * inv * (1.f + c.w) + a.w;
            v2u o; o.x = pk2(v[j].x, v[j].y); o.y = pk2(v[j].z, v[j].w);
            o8[64 * j] = o;
            amax = fmaxf(fmaxf(amax, fmaxf(fabsf(v[j].x), fabsf(v[j].y))), fmaxf(fabsf(v[j].z), fabsf(v[j].w))); }
        if (h8) {
            amax = wave_max(amax);
            const float scale = (amax > 0.f) ? amax * (1.f / 240.f) : 1.f, qi = 1.f / scale;
#pragma unroll
            for (int j = 0; j < 4; ++j) { int p = __builtin_amdgcn_cvt_pk_fp8_f32(v[j].x * qi, v[j].y * qi, 0, false); p = __builtin_amdgcn_cvt_pk_fp8_f32(v[j].z * qi, v[j].w * qi, p, true);
                *(unsigned*)(h8 + (size_t)m * DM + 4 * (lane + 64 * j)) = (unsigned)p; }
            if (lane == 0) hs[m] = scale;
        }
#pragma unroll
        for (int j = 0; j < 4; ++j) v[j] = vn[j];
    }
}

struct EpiX1 {
    static constexpr bool PERM = false, AFTER_DRAIN = false;
    const float* x; float* out; const float* mod;
    __device__ __forceinline__ void operator()(const pg8::f32x4 (&acc)[2][2][4][2], const pg8::Unit& u, int wr, int wc, int fr, int fq) const {
        const int row0 = u.pm * 256 + wr * 64 + fr, col0 = u.pn * 256 + wc * 32 + 4 * fq;
        const int b = (u.pm * 256) >> 12;
        f32x4 gv[2][2];
#pragma unroll
        for (int bj = 0; bj < 2; ++bj)
#pragma unroll
            for (int n = 0; n < 2; ++n) gv[bj][n] = *(const f32x4*)(mod + b * 6144 + 2048 + col0 + bj * 128 + n * 16);
#pragma unroll
        for (int ai = 0; ai < 2; ++ai)
#pragma unroll
            for (int m = 0; m < 4; ++m) { const size_t ro = (size_t)(row0 + ai * 128 + m * 16) * DM + col0;
#pragma unroll
                for (int bj = 0; bj < 2; ++bj)
#pragma unroll
                    for (int n = 0; n < 2; ++n) { const f32x4 xv = *(const f32x4*)(x + ro + bj * 128 + n * 16);
                        *(f32x4*)(out + ro + bj * 128 + n * 16) = xv + gv[bj][n] * acc[ai][bj][m][n]; } }
    }
};
struct EpiBf {
    static constexpr bool PERM = true, AFTER_DRAIN = false;
    bf16* O; int ldc;
    __device__ __forceinline__ void operator()(const pg8::f32x4 (&acc)[2][2][4][2], const pg8::Unit& u, int wr, int wc, int fr, int fq) const {
        const int row0 = u.pm * 256 + wr * 64 + fr, col0 = u.pn * 256 + wc * 32 + 8 * fq;
#pragma unroll
        for (int ai = 0; ai < 2; ++ai)
#pragma unroll
            for (int m = 0; m < 4; ++m) { bf16* rowp = O + (size_t)(row0 + ai * 128 + m * 16) * ldc + col0;
#pragma unroll
                for (int bj = 0; bj < 2; ++bj) { const pg8::f32x4 zz = (pg8::f32x4){0.f, 0.f, 0.f, 0.f}; const pg8::f32x4 v0 = acc[ai][bj][m][0] + zz, v1 = acc[ai][bj][m][1] + zz;
                    v4u w; w.x = pg8::cvt_pk_bf16(v0[0], v0[1]); w.y = pg8::cvt_pk_bf16(v0[2], v0[3]); w.z = pg8::cvt_pk_bf16(v1[0], v1[1]); w.w = pg8::cvt_pk_bf16(v1[2], v1[3]);
                    *(v4u*)(rowp + bj * 128) = w; } }
    }
};

constexpr int GP_QS = 0, GP_KS = 33792, GP_VS = 67584, GP_LS = 101376, GP_GV = 118784;
__device__ __forceinline__ void gdn_prep_item(const Args& a, LAS unsigned char* lds, int chunk) {
    int tid = threadIdx.x; asm volatile("" : "+v"(tid));
    const int lane = tid & 63, wave = __builtin_amdgcn_readfirstlane(tid >> 6);
    unsigned char* ws = a.ws;
    const bf16* proj = (const bf16*)(ws + WS_PROJ);
    const int bh = chunk >> 6, n = chunk & 63, b = bh >> 2, h = bh & 3;
    const int t0 = b * SEQ + n * 64;
    LAS float* QS = (LAS float*)(lds + GP_QS); LAS float* KS = (LAS float*)(lds + GP_KS); LAS float* VS = (LAS float*)(lds + GP_VS);
    LAS float* LS = (LAS float*)(lds + GP_LS); LAS float* GV = (LAS float*)(lds + GP_GV);
#ifndef GP_MASK
#define GP_MASK 31
#endif
#ifndef GP_REP
#define GP_REP 0
#endif
    for (int rep_ = 0; rep_ < 1 + (GP_REP & 1); ++rep_)
    if ((GP_MASK & 1) && tid < 384) {
        const int cg = tid % 48, rs = tid / 48;
        const int sec = cg >> 4, c8 = (cg & 15) * 8;
        const int pcol = C_BQ + sec * 512 + h * 128 + c8;
        const float* cw = a.in[8] + sec * 512 + h * 128 + c8;
        float wt[4][8];
#pragma unroll
        for (int i = 0; i < 4; ++i) { const f32x4 w0 = *(const f32x4*)(cw + i * 1536), w1 = *(const f32x4*)(cw + i * 1536 + 4);
            wt[i][0] = w0.x; wt[i][1] = w0.y; wt[i][2] = w0.z; wt[i][3] = w0.w; wt[i][4] = w1.x; wt[i][5] = w1.y; wt[i][6] = w1.z; wt[i][7] = w1.w; }
        LAS float* XS = (sec == 0) ? QS : (sec == 1 ? KS : VS);
        v4u raw[11];
#pragma unroll
        for (int j = 0; j < 11; ++j) { const int rr = 8 * rs - 3 + j;
            raw[j] = (rr >= 0 || n > 0) ? *(const v4u*)(proj + (size_t)(t0 + rr) * PW + pcol) : (v4u){0u, 0u, 0u, 0u}; }
#pragma unroll
        for (int j = 0; j < 8; ++j) {
            float y[8];
#pragma unroll
            for (int c = 0; c < 8; ++c) y[c] = 0.f;
#pragma unroll
            for (int i = 0; i < 4; ++i) { float xv[8]; const v4u u = raw[j + i];
                xv[0] = bflo(u.x); xv[1] = bfhi(u.x); xv[2] = bflo(u.y); xv[3] = bfhi(u.y); xv[4] = bflo(u.z); xv[5] = bfhi(u.z); xv[6] = bflo(u.w); xv[7] = bfhi(u.w);
#pragma unroll
                for (int c = 0; c < 8; ++c) y[c] += wt[i][c] * xv[c]; }
            f32x4 o0, o1;
            o0.x = silu_fast(y[0]); o0.y = silu_fast(y[1]); o0.z = silu_fast(y[2]); o0.w = silu_fast(y[3]); o1.x = silu_fast(y[4]); o1.y = silu_fast(y[5]); o1.z = silu_fast(y[6]); o1.w = silu_fast(y[7]);
            *(LAS f32x4*)(XS + (8 * rs + j) * 132 + c8) = o0; *(LAS f32x4*)(XS + (8 * rs + j) * 132 + c8 + 4) = o1;
        }
    }
    if (wave == 7) {
        const int i = lane;
        const float av = bf1(proj[(size_t)(t0 + i) * PW + C_BA + h]), bv = bf1(proj[(size_t)(t0 + i) * PW + C_BB + h]);
        const float beta = sigmoid_f(bv);
        const float g = -expf(a.in[9][h]) * softplus_f(av + a.in[10][h]);
        float G = g;
#pragma unroll
        for (int o = 1; o < 64; o <<= 1) { const float t = __shfl_up(G, o); if (lane >= o) G += t; }
        const float Glast = __shfl(G, 63);
        GV[i] = G; GV[64 + i] = expf(G); GV[128 + i] = beta; GV[192 + i] = expf(Glast - G); GV[256 + i] = beta * expf(G);
        if (lane == 0) ((float*)(ws + WS_GL))[chunk] = expf(Glast);
    }
    __syncthreads();
    if (GP_MASK & 2) {
#pragma unroll
        for (int rr = 0; rr < 16; ++rr) {
            const int row = wave * 16 + rr;
            LAS float* X = (row < 64) ? (QS + row * 132) : (KS + (row - 64) * 132);
            const float v0 = X[lane], v1 = X[lane + 64];
            const float ss = wave_sum(v0 * v0 + v1 * v1);
            const float sc = rsqrtf(ss + EPS) * ((row < 64) ? 0.08838834764831845f : 1.f);
            X[lane] = v0 * sc; X[lane + 64] = v1 * sc;
        }
    }
    __syncthreads();
    for (int rep_ = 0; rep_ < 1 + ((GP_REP >> 2) & 1); ++rep_)
    if (GP_MASK & 4) {
        const int gram = wave >> 2, ti = wave & 3, r = lane & 15, g = lane >> 4;
        const LAS float* X = gram ? QS : KS;
        f32x4 acc[4];
#pragma unroll
        for (int tj = 0; tj < 4; ++tj) acc[tj] = (f32x4){0.f, 0.f, 0.f, 0.f};
#pragma unroll 2
        for (int kk = 0; kk < 8; ++kk) {
            const f32x4 xa = *(const LAS f32x4*)(X + (16 * ti + r) * 132 + 16 * kk + 4 * g);
#pragma unroll
            for (int tj = 0; tj < 4; ++tj) {
                if (tj <= ti) {
                    const f32x4 kb = *(const LAS f32x4*)(KS + (16 * tj + r) * 132 + 16 * kk + 4 * g);
                    acc[tj] = __builtin_amdgcn_mfma_f32_16x16x4f32(xa.x, kb.x, acc[tj], 0, 0, 0);
                    acc[tj] = __builtin_amdgcn_mfma_f32_16x16x4f32(xa.y, kb.y, acc[tj], 0, 0, 0);
                    acc[tj] = __builtin_amdgcn_mfma_f32_16x16x4f32(xa.z, kb.z, acc[tj], 0, 0, 0);
                    acc[tj] = __builtin_amdgcn_mfma_f32_16x16x4f32(xa.w, kb.w, acc[tj], 0, 0, 0);
                }
            }
        }
        bf16* Aout = (bf16*)(ws + WS_GA) + (size_t)chunk * 4096;
#pragma unroll
        for (int tj = 0; tj < 4; ++tj)
#pragma unroll
            for (int rg = 0; rg < 4; ++rg) {
                const int i = 16 * ti + 4 * g + rg, j = 16 * tj + r;
                const float dec = (j <= i) ? __expf(GV[i] - GV[j]) : 0.f;
                if (gram == 0) { if (tj <= ti) LS[i * 68 + j] = (j < i) ? GV[128 + i] * acc[tj][rg] * dec : 0.f; }
                else Aout[((((i >> 4) * 2 + (j >> 5)) * 64 + (i & 15) + 16 * ((j >> 3) & 3)) << 3) + (j & 7)] = (bf16)f2bf((tj <= ti) ? acc[tj][rg] * dec : 0.f);
            }
    }
    __syncthreads();
    {
        bf16* QD = (bf16*)((unsigned char*)a.out + DO_QD) + (size_t)chunk * 8192;
        bf16* KDT = (bf16*)((unsigned char*)a.out + DO_KDT) + (size_t)chunk * 8192;
#pragma unroll
        for (int m = 0; m < 2; ++m) {
            const int p = tid + 512 * m;
            { const int i = p >> 4, k8 = (p & 15) * 8; const float e = GV[64 + i]; const LAS float* sq = QS + i * 132 + k8;
              v4u o; o.x = pk2(sq[0] * e, sq[1] * e); o.y = pk2(sq[2] * e, sq[3] * e); o.z = pk2(sq[4] * e, sq[5] * e); o.w = pk2(sq[6] * e, sq[7] * e);
              *(v4u*)(QD + ((((i >> 4) * 4 + ((p & 15) >> 2)) * 64 + (i & 15) + 16 * (p & 3)) << 3)) = o; }
            { const int k = p >> 3, i8 = (p & 7) * 8; float v[8];
#pragma unroll
              for (int j = 0; j < 8; ++j) v[j] = KS[(i8 + j) * 132 + k] * GV[192 + i8 + j];
              v4u o; o.x = pk2(v[0], v[1]); o.y = pk2(v[2], v[3]); o.z = pk2(v[4], v[5]); o.w = pk2(v[6], v[7]);
              *(v4u*)(KDT + ((((k >> 4) * 2 + ((p & 7) >> 2)) * 64 + (k & 15) + 16 * (p & 3)) << 3)) = o; }
        }
    }
    __syncthreads();
    {
#pragma unroll
        for (int m = 0; m < 4; ++m) {
            const int p = tid + 512 * m, i = p >> 5, c4 = (p & 31) * 4;
            const float mu = GV[128 + i], mw = GV[256 + i];
            f32x4 v = *(LAS f32x4*)(VS + i * 132 + c4); v.x *= mu; v.y *= mu; v.z *= mu; v.w *= mu; *(LAS f32x4*)(VS + i * 132 + c4) = v;
            f32x4 k = *(LAS f32x4*)(KS + i * 132 + c4); k.x *= mw; k.y *= mw; k.z *= mw; k.w *= mw; *(LAS f32x4*)(KS + i * 132 + c4) = k;
        }
    }
    __syncthreads();
    {
        const int r = lane & 15, g = lane >> 4;
#pragma unroll 1
        for (int I = 0; I < 4; ++I) {
            if (I > 0) {
#pragma unroll
                for (int tt = 0; tt < 2; ++tt) {
                    const int ct = 2 * wave + tt;
                    LAS float* XB = ((ct < 8) ? VS : KS) + (ct & 7) * 16 + r;
                    f32x4 acc;
#pragma unroll
                    for (int rg = 0; rg < 4; ++rg) acc[rg] = XB[(16 * I + 4 * g + rg) * 132];
                    for (int J = 0; J < I; ++J) {
#pragma unroll
                        for (int ks = 0; ks < 4; ++ks) {
                            const float la = -LS[(16 * I + r) * 68 + 16 * J + 4 * ks + g];
                            const float xb = XB[(16 * J + 4 * ks + g) * 132];
                            acc = __builtin_amdgcn_mfma_f32_16x16x4f32(la, xb, acc, 0, 0, 0);
                        }
                    }
#pragma unroll
                    for (int rg = 0; rg < 4; ++rg) XB[(16 * I + 4 * g + rg) * 132] = acc[rg];
                }
                __syncthreads();
            }
            if (tid < 256) {
                LAS float* XC = ((tid < 128) ? VS : KS) + (tid & 127);
                float x[16];
#pragma unroll
                for (int rr = 0; rr < 16; ++rr) {
                    float a0 = XC[(16 * I + rr) * 132], a1 = 0.f, a2 = 0.f, a3 = 0.f;
#pragma unroll
                    for (int j4 = 0; j4 < (rr + 3) / 4; ++j4) {
                        const f32x4 l = *(const LAS f32x4*)(LS + (16 * I + rr) * 68 + 16 * I + 4 * j4);
                        if (4 * j4 + 0 < rr) a0 -= l.x * x[4 * j4 + 0];
                        if (4 * j4 + 1 < rr) a1 -= l.y * x[4 * j4 + 1];
                        if (4 * j4 + 2 < rr) a2 -= l.z * x[4 * j4 + 2];
                        if (4 * j4 + 3 < rr) a3 -= l.w * x[4 * j4 + 3];
                    }
                    x[rr] = (a0 + a1) + (a2 + a3);
                }
#pragma unroll
                for (int rr = 0; rr < 16; ++rr) XC[(16 * I + rr) * 132] = x[rr];
            }
            __syncthreads();
        }
    }
    {
        bf16* W = (bf16*)((unsigned char*)a.out + DO_W) + (size_t)chunk * 8192;
        bf16* UT = (bf16*)((unsigned char*)a.out + DO_UT) + (size_t)chunk * 8192;
#pragma unroll
        for (int m = 0; m < 2; ++m) {
            const int p = tid + 512 * m, i = p >> 4, k8 = p & 15;
            const f32x4 x0 = *(const LAS f32x4*)(KS + i * 132 + 8 * k8), x1 = *(const LAS f32x4*)(KS + i * 132 + 8 * k8 + 4);
            v4u o; o.x = pk2(x0.x, x0.y); o.y = pk2(x0.z, x0.w); o.z = pk2(x1.x, x1.y); o.w = pk2(x1.z, x1.w);
            *(v4u*)(W + ((((i >> 4) * 4 + (k8 >> 2)) * 64 + (i & 15) + 16 * (k8 & 3)) << 3)) = o;
        }
#pragma unroll
        for (int m = 0; m < 4; ++m) {
            const int p = tid + 512 * m, v = p & 127, q = p >> 7;
            v2u o; o.x = pk2(VS[(4 * q) * 132 + v], VS[(4 * q + 1) * 132 + v]); o.y = pk2(VS[(4 * q + 2) * 132 + v], VS[(4 * q + 3) * 132 + v]);
            *(v2u*)(UT + ((((q >> 2) * 8 + (v >> 4)) * 64 + (v & 15) + 16 * (q & 3)) << 2)) = o;
        }
    }
    __syncthreads();
}

__device__ __forceinline__ void kn_item(const Args& a, int item) {
    const int tid = threadIdx.x, lane = tid & 63, wave = tid >> 6;
    const bf16* proj = (const bf16*)(a.ws + WS_PROJ); bf16* KN = (bf16*)(a.ws + WS_KN);
    const float g0 = a.in[6][2 * lane], g1 = a.in[6][2 * lane + 1];
    unsigned u[16];
#pragma unroll
    for (int rr = 0; rr < 16; ++rr) u[rr] = *(const unsigned*)(proj + (size_t)(item * 128 + wave * 16 + rr) * PW + C_AKV + 2 * lane);
#pragma unroll
    for (int rr = 0; rr < 16; ++rr) {
        const int t = item * 128 + wave * 16 + rr;
        const float v0 = bflo(u[rr]), v1 = bfhi(u[rr]);
        const float inv = rsqrtf(wave_sum(v0 * v0 + v1 * v1) * (1.f / 128.f) + EPS);
        *(unsigned*)(KN + (size_t)t * 128 + 2 * lane) = pk2(v0 * inv * g0, v1 * inv * g1);
    }
}


#ifdef IDX_FP32
__device__ __forceinline__ void phase_idx32(const Args& a, LAS unsigned char* lds) {
    const int tid = threadIdx.x, lane = tid & 63, wave = tid >> 6;
    LAS float* HS = (LAS float*)lds;
    float* IDX32 = (float*)(a.ws + WS_YAB);
    const float* mod = (const float*)(a.ws + WS_MOD);
    for (int tile = blockIdx.x; tile < 1024; tile += gridDim.x) {
        const int t0 = tile * 32, b = t0 >> 12;
        for (int rr = 0; rr < 4; ++rr) {
            const int m = t0 + wave * 4 + rr;
            const f32x4* xr = (const f32x4*)(a.in[0] + (size_t)m * DM) + lane;
            f32x4 v[4]; float s = 0.f;
#pragma unroll
            for (int j = 0; j < 4; ++j) { v[j] = xr[64 * j]; s += (v[j].x * v[j].x + v[j].y * v[j].y) + (v[j].z * v[j].z + v[j].w * v[j].w); }
            const float inv = rsqrtf(wave_sum(s) * (1.f / DM) + EPS);
            const f32x4* sh = (const f32x4*)(mod + b * 6144) + lane; const f32x4* sc = (const f32x4*)(mod + b * 6144 + 1024) + lane;
#pragma unroll
            for (int j = 0; j < 4; ++j) { const f32x4 aa = sh[64 * j], c = sc[64 * j];
                f32x4 o; o.x = v[j].x * inv * (1.f + c.x) + aa.x; o.y = v[j].y * inv * (1.f + c.y) + aa.y; o.z = v[j].z * inv * (1.f + c.z) + aa.z; o.w = v[j].w * inv * (1.f + c.w) + aa.w;
                *(LAS f32x4*)(HS + (wave * 4 + rr) * 1028 + 4 * (lane + 64 * j)) = o; }
        }
        __syncthreads();
        if (tid < 324) {
            const float* w = a.in[4] + 1152 + tid;
            float acc[32];
#pragma unroll
            for (int t = 0; t < 32; ++t) acc[t] = 0.f;
            for (int k4 = 0; k4 < 256; ++k4) {
                const float w0 = w[(size_t)(4 * k4) * IN_W], w1 = w[(size_t)(4 * k4 + 1) * IN_W], w2 = w[(size_t)(4 * k4 + 2) * IN_W], w3 = w[(size_t)(4 * k4 + 3) * IN_W];
#pragma unroll
                for (int t = 0; t < 32; ++t) { const f32x4 hv = *(const LAS f32x4*)(HS + t * 1028 + 4 * k4); acc[t] += hv.x * w0 + hv.y * w1 + hv.z * w2 + hv.w * w3; }
            }
#pragma unroll
            for (int t = 0; t < 32; ++t) IDX32[(size_t)(t0 + t) * 384 + tid] = acc[t];
        }
        __syncthreads();
    }
}
#endif
__device__ __forceinline__ unsigned sortable(float f) { const unsigned u = __float_as_uint(f + 0.f); return (u & 0x80000000u) ? ~u : (u | 0x80000000u); }
__device__ __forceinline__ int wave_sum_dpp(int x) {
    x += __builtin_amdgcn_update_dpp(0, x, 0xB1, 0xF, 0xF, false);
    x += __builtin_amdgcn_update_dpp(0, x, 0x4E, 0xF, 0xF, false);
    x += __builtin_amdgcn_update_dpp(0, x, 0x141, 0xF, 0xF, false);
    x += __builtin_amdgcn_update_dpp(0, x, 0x140, 0xF, 0xF, false);
    return __builtin_amdgcn_readlane(x, 0) + __builtin_amdgcn_readlane(x, 16) + __builtin_amdgcn_readlane(x, 32) + __builtin_amdgcn_readlane(x, 48);
}
#define CNT8(OP, acc_, k_, s_, c_) asm("v_cmp_" OP "_u32 s[36:37], %1, %9\n\tv_cmp_" OP "_u32 s[38:39], %2, %9\n\tv_cmp_" OP "_u32 s[40:41], %3, %9\n\tv_cmp_" OP "_u32 s[42:43], %4, %9\n\t" \
        "v_cmp_" OP "_u32 s[44:45], %5, %9\n\tv_cmp_" OP "_u32 s[46:47], %6, %9\n\tv_cmp_" OP "_u32 s[48:49], %7, %9\n\tv_cmp_" OP "_u32 s[50:51], %8, %9\n\t" \
        "v_addc_co_u32 %0, s[36:37], 0, %0, s[36:37]\n\tv_addc_co_u32 %0, s[38:39], 0, %0, s[38:39]\n\tv_addc_co_u32 %0, s[40:41], 0, %0, s[40:41]\n\tv_addc_co_u32 %0, s[42:43], 0, %0, s[42:43]\n\t" \
        "v_addc_co_u32 %0, s[44:45], 0, %0, s[44:45]\n\tv_addc_co_u32 %0, s[46:47], 0, %0, s[46:47]\n\tv_addc_co_u32 %0, s[48:49], 0, %0, s[48:49]\n\tv_addc_co_u32 %0, s[50:51], 0, %0, s[50:51]" \
        : "+v"(acc_) : "v"(k_[(s_)]), "v"(k_[(s_) + 1]), "v"(k_[(s_) + 2]), "v"(k_[(s_) + 3]), "v"(k_[(s_) + 4]), "v"(k_[(s_) + 5]), "v"(k_[(s_) + 6]), "v"(k_[(s_) + 7]), "v"(c_) \
        : "s36", "s37", "s38", "s39", "s40", "s41", "s42", "s43", "s44", "s45", "s46", "s47", "s48", "s49", "s50", "s51")
__device__ __forceinline__ unsigned wave_umin_dpp(unsigned x) {
    x = min(x, (unsigned)__builtin_amdgcn_update_dpp((int)x, (int)x, 0xB1, 0xF, 0xF, false));
    x = min(x, (unsigned)__builtin_amdgcn_update_dpp((int)x, (int)x, 0x4E, 0xF, 0xF, false));
    x = min(x, (unsigned)__builtin_amdgcn_update_dpp((int)x, (int)x, 0x141, 0xF, 0xF, false));
    x = min(x, (unsigned)__builtin_amdgcn_update_dpp((int)x, (int)x, 0x140, 0xF, 0xF, false));
    return min(min((unsigned)__builtin_amdgcn_readlane((int)x, 0), (unsigned)__builtin_amdgcn_readlane((int)x, 16)), min((unsigned)__builtin_amdgcn_readlane((int)x, 32), (unsigned)__builtin_amdgcn_readlane((int)x, 48)));
}
__device__ __forceinline__ unsigned wave_umax_dpp(unsigned x) {
    x = max(x, (unsigned)__builtin_amdgcn_update_dpp((int)x, (int)x, 0xB1, 0xF, 0xF, false));
    x = max(x, (unsigned)__builtin_amdgcn_update_dpp((int)x, (int)x, 0x4E, 0xF, 0xF, false));
    x = max(x, (unsigned)__builtin_amdgcn_update_dpp((int)x, (int)x, 0x141, 0xF, 0xF, false));
    x = max(x, (unsigned)__builtin_amdgcn_update_dpp((int)x, (int)x, 0x140, 0xF, 0xF, false));
    return max(max((unsigned)__builtin_amdgcn_readlane((int)x, 0), (unsigned)__builtin_amdgcn_readlane((int)x, 16)), max((unsigned)__builtin_amdgcn_readlane((int)x, 32), (unsigned)__builtin_amdgcn_readlane((int)x, 48)));
}
template <int NS> __device__ __forceinline__ void topk_select(LAS float* row, int n, int lane, unsigned short* out) {
    asm volatile("" : "+v"(lane));
    unsigned key[NS];
#pragma unroll
    for (int s = 0; s < NS; ++s) key[s] = __float_as_uint(row[s * 64 + lane]);
#pragma unroll
    for (int s = 0; s < NS; ++s) { const int idx = s * 64 + lane; const unsigned k = sortable(__uint_as_float(key[s])); key[s] = (idx < n) ? k : 0u; }
    LAS unsigned short* sel_l = (LAS unsigned short*)row;
    LAS unsigned* cq = (LAS unsigned*)row + 256;
    unsigned thr; int bit;
    {
        unsigned m0 = key[0], m1 = key[1], m2 = key[2], m3 = key[3];
#pragma unroll
        for (int s = 4; s < NS; s += 4) { m0 = max(m0, key[s]); m1 = max(m1, key[s + 1]); m2 = max(m2, key[s + 2]); m3 = max(m3, key[s + 3]); }
        const unsigned lo = wave_umin_dpp(min(min(m0, m1), min(m2, m3))), hi = wave_umax_dpp(max(max(m0, m1), max(m2, m3)));
        const unsigned x = lo ^ hi;
        bit = 31 - __builtin_clz(x | 1u); if (x == 0u) bit = -1;
        thr = (bit >= 31) ? 0u : (hi & ~((2u << bit) - 1u));
    }
    int cthr = NS * 64, cU = 0;
    bool exact = false;
    for (; bit >= 0; --bit) {
        if (cthr - cU <= 256) break;
        const unsigned cand = thr | (1u << bit);
        int c0 = 0, c1 = 0;
#pragma unroll
        for (int s = 0; s < NS; s += 16) { CNT8("ge", c0, key, s, cand); CNT8("ge", c1, key, s + 8, cand); }
        const int cnt = wave_sum_dpp(c0 + c1);
        if (cnt >= 256) { thr = cand; cthr = cnt; } else cU = cnt;
        if (cnt == 256) { exact = true; break; }
    }
    int cgt = 0, ceq = 0;
    if (!exact) {
        if (bit >= 0) {
            const int sh = bit + 1;
            int pos = 0;
#pragma unroll
            for (int s = 0; s < NS; ++s) {
                const bool act = ((key[s] ^ thr) >> sh) == 0u;
                const unsigned long long mt = __builtin_amdgcn_ballot_w64(act);
                const int at = __builtin_amdgcn_mbcnt_hi((unsigned)(mt >> 32), __builtin_amdgcn_mbcnt_lo((unsigned)mt, pos));
                cq[act ? at : 256] = key[s];
                pos += __builtin_popcountll(mt);
            }
            LDS_WAIT();
            unsigned ck[4];
#pragma unroll
            for (int j = 0; j < 4; ++j) ck[j] = cq[64 * j + lane];
#pragma unroll
            for (int j = 0; j < 4; ++j) ck[j] = (64 * j + lane < pos) ? ck[j] : 0u;
            for (; bit >= 0; --bit) {
                const unsigned cand = thr | (1u << bit);
                int cnt = cU;
#pragma unroll
                for (int j = 0; j < 4; ++j) cnt += __builtin_popcountll(__builtin_amdgcn_ballot_w64(ck[j] >= cand));
                if (cnt >= 256) thr = cand;
                if (cnt == 256) { exact = true; break; }
            }
            if (!exact) {
                cgt = cU;
#pragma unroll
                for (int j = 0; j < 4; ++j) { cgt += __builtin_popcountll(__builtin_amdgcn_ballot_w64(ck[j] > thr)); ceq += __builtin_popcountll(__builtin_amdgcn_ballot_w64(ck[j] == thr)); }
            }
        } else {
            int g0 = 0, e0 = 0;
#pragma unroll
            for (int s = 0; s < NS; s += 8) { CNT8("gt", g0, key, s, thr); CNT8("eq", e0, key, s, thr); }
            cgt = wave_sum_dpp(g0); ceq = wave_sum_dpp(e0);
        }
    }
    const int need_eq = 256 - cgt;
    asm volatile("" : "+v"(thr));
    asm volatile("" : "+v"(lane));
    int pos_out = 0;
    if (exact || ceq == need_eq) {
#pragma unroll
        for (int s = 0; s < NS; ++s) {
            const bool take = key[s] >= thr;
            const unsigned long long mt = __builtin_amdgcn_ballot_w64(take);
            const int pre = __builtin_amdgcn_mbcnt_hi((unsigned)(mt >> 32), __builtin_amdgcn_mbcnt_lo((unsigned)mt, 0));
            sel_l[take ? pos_out + pre : 256] = (unsigned short)(s * 64 + lane);
            pos_out += __builtin_popcountll(mt);
        }
    } else {
        const unsigned long long ltmask = (1ull << lane) - 1ull;
        int eq_seen = 0;
#pragma unroll
        for (int s = 0; s < NS; ++s) {
            const bool gt = key[s] > thr, eq = key[s] == thr;
            const unsigned long long meq = __builtin_amdgcn_ballot_w64(eq);
            const bool take = gt || (eq && (eq_seen + __builtin_popcountll(meq & ltmask) < need_eq));
            const unsigned long long mt = __builtin_amdgcn_ballot_w64(take);
            if (take) sel_l[pos_out + __builtin_popcountll(mt & ltmask)] = (unsigned short)(s * 64 + lane);
            pos_out += __builtin_popcountll(mt); eq_seen += __builtin_popcountll(meq);
            if ((s & 3) == 3) __builtin_amdgcn_sched_barrier(0);
        }
    }
    LDS_WAIT();
    *(v2u*)(out + 4 * lane) = *(const LAS v2u*)(sel_l + 4 * lane);
}
struct IdxPre { bf16x8 af[4]; v2u wqr[4]; bf16x8 bfr[4][4]; };
__device__ __forceinline__ void idx_issue(const Args& a, int b, int qblk, int wave, int lane, IdxPre& P) {
    const bf16* proj = (const bf16*)(a.ws + WS_PROJ);
    const int p0 = qblk * 8, r = lane & 31, hh = lane >> 5;
    const size_t rowb = (size_t)b * SEQ;
    if (p0 + 7 < 256) return;
    { const bf16* qp = proj + (rowb + p0 + (r & 7)) * PW + C_IQ + (r >> 3) * 64 + 32 * hh;
#pragma unroll
      for (int s = 0; s < 4; ++s) P.af[s] = *(const bf16x8*)(qp + 8 * s); }
#pragma unroll
    for (int i = 0; i < 4; ++i) P.wqr[i] = *(const v2u*)(proj + (rowb + p0 + 4 * hh + i) * PW + C_IW);
    const int ntiles = (p0 + 7) / 32 + 1;
#pragma unroll
    for (int u = 0; u < 4; ++u) {
        const int kt = (wave + 8 * u < ntiles) ? wave + 8 * u : 0;
        const bf16* kp = proj + (rowb + (size_t)kt * 32 + r) * PW + C_IK + 32 * hh;
#pragma unroll
        for (int s = 0; s < 4; ++s) P.bfr[u][s] = *(const bf16x8*)(kp + 8 * s);
    }
}
__device__ __forceinline__ void indexer_item(const Args& a, LAS unsigned char* lds, int b, int qblk, IdxPre& P, bool has_next, int b_next, int qblk_next) {
    int tid = threadIdx.x; asm volatile("" : "+v"(tid));
    const int lane = tid & 63, wave = __builtin_amdgcn_readfirstlane(tid >> 6);
    const bf16* proj = (const bf16*)(a.ws + WS_PROJ);
    unsigned short* SEL = (unsigned short*)(a.ws + WS_SEL);
    LAS float* SC = (LAS float*)lds;
    const int p0 = qblk * 8;
    const int r = lane & 31, hh = lane >> 5;
    const size_t rowb = (size_t)b * SEQ;
#ifdef IDX_FP32
    if (p0 + 7 >= 256) {
        const float* IDX32 = (const float*)(a.ws + WS_YAB);
        LAS float* IQS = (LAS float*)(lds + 131072);
        for (int i = tid; i < 2048; i += 512) IQS[i] = IDX32[(rowb + p0 + (i >> 8)) * 384 + (i & 255)];
        float wq8[8][4];
#pragma unroll
        for (int q = 0; q < 8; ++q)
#pragma unroll
            for (int hd = 0; hd < 4; ++hd) wq8[q][hd] = IDX32[(rowb + p0 + q) * 384 + 320 + hd];
        __syncthreads();
        for (int s = tid; s <= p0 + 7; s += 512) {
            float kf[64];
#pragma unroll
            for (int d4 = 0; d4 < 16; ++d4) { const f32x4 v = *(const f32x4*)(IDX32 + (rowb + s) * 384 + 256 + 4 * d4); kf[4 * d4] = v.x; kf[4 * d4 + 1] = v.y; kf[4 * d4 + 2] = v.z; kf[4 * d4 + 3] = v.w; }
#pragma unroll 1
            for (int q = 0; q < 8; ++q) {
                float sc = 0.f;
#pragma unroll
                for (int hd = 0; hd < 4; ++hd) {
                    float lg = 0.f;
#pragma unroll
                    for (int d4 = 0; d4 < 16; ++d4) { const f32x4 qv = *(const LAS f32x4*)(IQS + q * 256 + hd * 64 + 4 * d4); lg += kf[4 * d4] * qv.x + kf[4 * d4 + 1] * qv.y + kf[4 * d4 + 2] * qv.z + kf[4 * d4 + 3] * qv.w; }
                    sc += fmaxf(lg, 0.f) * wq8[q][hd];
                }
                SC[q * 4096 + s] = sc * 0.0625f;
            }
        }
    }
#else
    if (p0 + 7 >= 256) {
        float wq[4][4];
#pragma unroll
        for (int i = 0; i < 4; ++i) { wq[i][0] = bflo(P.wqr[i].x) * 0.0625f; wq[i][1] = bfhi(P.wqr[i].x) * 0.0625f; wq[i][2] = bflo(P.wqr[i].y) * 0.0625f; wq[i][3] = bfhi(P.wqr[i].y) * 0.0625f; }
        const int ntiles = (p0 + 7) / 32 + 1;
        for (int kt0 = wave; kt0 < ntiles; kt0 += 32) {
            bf16x8 nxt[4][4];
            const bool more = kt0 + 32 < ntiles;
            if (more) {
#pragma unroll
                for (int u = 0; u < 4; ++u) {
                    const int kt = (kt0 + 32 + 8 * u < ntiles) ? kt0 + 32 + 8 * u : kt0;
                    const bf16* kp = proj + (rowb + (size_t)kt * 32 + r) * PW + C_IK + 32 * hh;
#pragma unroll
                    for (int s = 0; s < 4; ++s) nxt[u][s] = *(const bf16x8*)(kp + 8 * s);
                }
            }
#pragma unroll
            for (int u = 0; u < 4; ++u) {
                const int kt = kt0 + 8 * u;
                if (kt < ntiles) {
                    f32x16 acc;
#pragma unroll
                    for (int i = 0; i < 16; ++i) acc[i] = 0.f;
#pragma unroll
                    for (int s = 0; s < 4; ++s) acc = __builtin_amdgcn_mfma_f32_32x32x16_bf16(P.af[s], P.bfr[u][s], acc, 0, 0, 0);
#pragma unroll
                    for (int i = 0; i < 4; ++i) {
                        float s = 0.f;
#pragma unroll
                        for (int hd = 0; hd < 4; ++hd) s += wq[i][hd] * fmaxf(acc[i + 4 * hd], 0.f);
                        SC[(4 * hh + i) * 4096 + kt * 32 + r] = s;
                    }
                }
            }
            if (more) {
#pragma unroll
                for (int u = 0; u < 4; ++u)
#pragma unroll
                    for (int s = 0; s < 4; ++s) P.bfr[u][s] = nxt[u][s];
            }
        }
    }
#endif
    __syncthreads();
#ifndef IDX_FP32
    if (has_next) idx_issue(a, b_next, qblk_next, wave, lane, P);
#endif
    {
        const int pos = p0 + wave, n = pos + 1;
        unsigned short* out = SEL + (rowb + pos) * 256;
        if (n <= 256) {
#pragma unroll
            for (int q = 0; q < 4; ++q) { const int j = lane + 64 * q; out[j] = (unsigned short)((j < n) ? j : 0xFFFF); }
        } else {
            LAS float* row = SC + wave * 4096;
            const int nslots = (n + 63) >> 6;
#ifndef IDX_REP_SELECT
#define IDX_REP_SELECT 1
#endif
            float* bk_ = (float*)(a.ws + WS_YAB) + ((size_t)blockIdx.x * 8 + wave) * 4096;
            if (IDX_REP_SELECT > 1) for (int i_ = lane; i_ < 4096; i_ += 64) bk_[i_] = row[i_];
            for (int rep_ = 0; rep_ < IDX_REP_SELECT; ++rep_) {
            if (rep_ > 0) { for (int i_ = lane; i_ < 4096; i_ += 64) row[i_] = bk_[i_]; LDS_WAIT(); }
            if (nslots <= 16) topk_select<16>(row, n, lane, out);
            else if (nslots <= 32) topk_select<32>(row, n, lane, out);
            else if (nslots <= 48) topk_select<48>(row, n, lane, out);
            else topk_select<64>(row, n, lane, out);
            }
        }
    }
    __syncthreads();
}

__device__ __forceinline__ void phase3(const Args& a, LAS unsigned char* lds) {
    const int bid = blockIdx.x, G = gridDim.x;
#ifndef P3_MASK
#define P3_MASK 7
#endif
#ifndef P3_REP
#define P3_REP 0
#endif
    if (P3_MASK & 1) for (int it = bid; it < 2048; it += G) { gdn_prep_item(a, lds, it); if (P3_REP & 1) gdn_prep_item(a, lds, it); }
    if (P3_MASK & 2) {
#define IDX_MAP(j_, bb_, qb_) do { if (G == 256) { const int i_ = (j_) / G, c_ = (j_) % G, q0_ = (c_ >> 3) + 32 * (i_ >> 1); bb_ = c_ & 7; qb_ = (i_ & 1) ? 511 - q0_ : q0_; } else { bb_ = (j_) >> 9; qb_ = (j_) & 511; } } while (0)
        IdxPre P;
        const int tid_ = threadIdx.x, lane_ = tid_ & 63, wave_ = __builtin_amdgcn_readfirstlane(tid_ >> 6);
        int bb, qb;
        if (bid < 4096) { IDX_MAP(bid, bb, qb); idx_issue(a, bb, qb, wave_, lane_, P); }
        for (int j = bid; j < 4096; j += G) {
            IDX_MAP(j, bb, qb);
            int bn = 0, qn = 0; const bool hn = (j + G < 4096);
            if (hn) IDX_MAP(j + G, bn, qn);
            indexer_item(a, lds, bb, qb, P, hn, bn, qn);
            if (P3_REP & 2) { idx_issue(a, bb, qb, wave_, lane_, P); indexer_item(a, lds, bb, qb, P, false, 0, 0); if (hn) idx_issue(a, bn, qn, wave_, lane_, P); }
        }
#undef IDX_MAP
    }
    if (P3_MASK & 4) for (int it = bid; it < 256; it += G) kn_item(a, it);
}

constexpr int SC_ST = 0, SC_VNT = 34816, SC_O = 53248;
__device__ __forceinline__ v2u pack4(float a, float b, float c, float d) { v2u o; o.x = pk2(a, b); o.y = pk2(c, d); return o; }
__device__ __forceinline__ void scan_epilogue(const LAS float* OS, const v4u z0, const v4u z1, const LAS float* gainl, bf16* ydst, int tid) {
    const int row = tid >> 3, seg = tid & 7;
    float o[16];
#pragma unroll
    for (int q = 0; q < 4; ++q) { const f32x4 v = *(const LAS f32x4*)(OS + row * 132 + 16 * seg + 4 * q); o[4 * q] = v.x; o[4 * q + 1] = v.y; o[4 * q + 2] = v.z; o[4 * q + 3] = v.w; }
    float ss = 0.f;
#pragma unroll
    for (int i = 0; i < 16; ++i) ss += o[i] * o[i];
    ss += __shfl_xor(ss, 1); ss += __shfl_xor(ss, 2); ss += __shfl_xor(ss, 4);
    const float inv = rsqrtf(ss * (1.f / 128.f) + EPS);
    float z[16];
    z[0] = bflo(z0.x); z[1] = bfhi(z0.x); z[2] = bflo(z0.y); z[3] = bfhi(z0.y); z[4] = bflo(z0.z); z[5] = bfhi(z0.z); z[6] = bflo(z0.w); z[7] = bfhi(z0.w);
    z[8] = bflo(z1.x); z[9] = bfhi(z1.x); z[10] = bflo(z1.y); z[11] = bfhi(z1.y); z[12] = bflo(z1.z); z[13] = bfhi(z1.z); z[14] = bflo(z1.w); z[15] = bfhi(z1.w);
    float y[16];
#pragma unroll
    for (int q = 0; q < 4; ++q) { const f32x4 gq = *(const LAS f32x4*)(gainl + 16 * seg + 4 * q);
        y[4 * q] = o[4 * q] * inv * gq.x * silu_fast(z[4 * q]); y[4 * q + 1] = o[4 * q + 1] * inv * gq.y * silu_fast(z[4 * q + 1]); y[4 * q + 2] = o[4 * q + 2] * inv * gq.z * silu_fast(z[4 * q + 2]); y[4 * q + 3] = o[4 * q + 3] * inv * gq.w * silu_fast(z[4 * q + 3]); }
    v4u w0, w1;
    w0.x = pk2(y[0], y[1]); w0.y = pk2(y[2], y[3]); w0.z = pk2(y[4], y[5]); w0.w = pk2(y[6], y[7]);
    w1.x = pk2(y[8], y[9]); w1.y = pk2(y[10], y[11]); w1.z = pk2(y[12], y[13]); w1.w = pk2(y[14], y[15]);
    *(v4u*)(ydst) = w0; *(v4u*)(ydst + 8) = w1;
}
__device__ __forceinline__ void gdn_scan(const Args& a, LAS unsigned char* lds, int bh) {
    const int tid = threadIdx.x, lane = tid & 63, w = __builtin_amdgcn_readfirstlane(tid >> 6), r = lane & 15, g = lane >> 4;
    const int b = bh >> 2, h = bh & 3;
    LAS bf16* ST = (LAS bf16*)(lds + SC_ST); LAS bf16* VNT = (LAS bf16*)(lds + SC_VNT); LAS float* OS = (LAS float*)(lds + SC_O);
    const bf16* proj = (const bf16*)(a.ws + WS_PROJ); bf16* yab = (bf16*)(a.ws + WS_YAB);
    const float* GL = (const float*)(a.ws + WS_GL);
    for (int i = tid; i < 34816 / 4; i += 512) ((LAS unsigned*)ST)[i] = 0u;
    f32x4 S[8];
#pragma unroll
    for (int vt = 0; vt < 8; ++vt) S[vt] = (f32x4){0.f, 0.f, 0.f, 0.f};
    const int erow = tid >> 3, eseg = tid & 7;
    LAS float* gainl = (LAS float*)(lds + 87040);
    if (tid < 128) gainl[tid] = a.in[11][tid];
    const int ct = w & 3;
    const size_t cb = (size_t)bh * 64;
    const bf16* Wb = (const bf16*)((const unsigned char*)a.out + DO_W) + cb * 8192;
    const bf16* QDb = (const bf16*)((const unsigned char*)a.out + DO_QD) + cb * 8192;
    const bf16* KDTb = (const bf16*)((const unsigned char*)a.out + DO_KDT) + cb * 8192;
    const bf16* UTb = (const bf16*)((const unsigned char*)a.out + DO_UT) + cb * 8192;
    const bf16* Ab = (const bf16*)(a.ws + WS_GA) + cb * 4096;
    const bf16* Xb = (w < 4) ? Wb : QDb;
    const size_t tz = ((size_t)b * SEQ + erow) * PW + C_BZ + h * 128 + 16 * eseg;
    const size_t ty = ((size_t)b * SEQ + erow) * YW + 1024 + h * 128 + 16 * eseg;
    bf16x8 af[4], kd[2]; v4u xr[4]; float gl; v4u zh0, zh1;
#define SCAN_LOAD(n_, af_, kd_, xr_, gl_) do { \
        const bf16* X_ = Xb + (size_t)(n_) * 8192 + (ct * 4 * 64 + lane) * 8; \
        _Pragma("unroll") for (int ks = 0; ks < 4; ++ks) af_[ks] = *(const bf16x8*)(X_ + ks * 512); \
        const bf16* K_ = KDTb + (size_t)(n_) * 8192 + (w * 2 * 64 + lane) * 8; \
        kd_[0] = *(const bf16x8*)(K_); kd_[1] = *(const bf16x8*)(K_ + 512); \
        if (w >= 4) { const bf16* A_ = Ab + (size_t)(n_) * 4096 + (ct * 2 * 64 + lane) * 8; xr_[0] = *(const v4u*)(A_); xr_[1] = *(const v4u*)(A_ + 512); } \
        else { const bf16* U_ = UTb + (size_t)(n_) * 8192 + (ct * 8 * 64 + lane) * 4; _Pragma("unroll") for (int q_ = 0; q_ < 4; ++q_) { const v2u u0_ = *(const v2u*)(U_ + (2 * q_) * 256), u1_ = *(const v2u*)(U_ + (2 * q_ + 1) * 256); xr_[q_] = (v4u){u0_.x, u0_.y, u1_.x, u1_.y}; } } \
        gl_ = GL[cb + (n_)]; } while (0)
    SCAN_LOAD(0, af, kd, xr, gl);
    zh0 = (v4u){0u, 0u, 0u, 0u}; zh1 = zh0;
    __syncthreads();
    for (int n = 0; n < 64; ++n) {
        bf16x8 afn[4], kdn[2]; v4u xrn[4]; float gln;
        const int nn = (n < 63) ? n + 1 : 63;
        SCAN_LOAD(nn, afn, kdn, xrn, gln);
        const v4u zn0 = *(const v4u*)(proj + tz + (size_t)n * 64 * PW), zn1 = *(const v4u*)(proj + tz + (size_t)n * 64 * PW + 8);
        if (n > 0) scan_epilogue(OS, zh0, zh1, gainl, yab + ty + (size_t)(n - 1) * 64 * YW, tid);
        zh0 = zn0; zh1 = zn1;
        f32x4 acc[8];
#pragma unroll
        for (int vt = 0; vt < 8; ++vt) acc[vt] = (f32x4){0.f, 0.f, 0.f, 0.f};
#pragma unroll
        for (int ks = 0; ks < 4; ++ks) {
#pragma unroll
            for (int vt = 0; vt < 8; ++vt) {
                const bf16x8 bfr = *(const LAS bf16x8*)(ST + (16 * vt + r) * 136 + 32 * ks + 8 * g);
                acc[vt] = __builtin_amdgcn_mfma_f32_16x16x32_bf16(af[ks], bfr, acc[vt], 0, 0, 0);
            }
        }
        if (w < 4) {
#pragma unroll
            for (int vt = 0; vt < 8; ++vt) {
                const unsigned ux = (vt & 1) ? xr[vt >> 1].z : xr[vt >> 1].x, uy = (vt & 1) ? xr[vt >> 1].w : xr[vt >> 1].y;
                const v2u o = pack4(bflo(ux) - acc[vt][0], bfhi(ux) - acc[vt][1], bflo(uy) - acc[vt][2], bfhi(uy) - acc[vt][3]);
                *(LAS v2u*)(VNT + (16 * vt + r) * 72 + 16 * ct + 4 * g) = o;
            }
        }
        __syncthreads();
        if (w >= 4) {
#pragma unroll
            for (int ks = 0; ks < 2; ++ks)
#pragma unroll
                for (int vt = 0; vt < 8; ++vt) {
                    const bf16x8 vb = *(const LAS bf16x8*)(VNT + (16 * vt + r) * 72 + 32 * ks + 8 * g);
                    acc[vt] = __builtin_amdgcn_mfma_f32_16x16x32_bf16(__builtin_bit_cast(bf16x8, xr[ks]), vb, acc[vt], 0, 0, 0);
                }
#pragma unroll
            for (int vt = 0; vt < 8; ++vt)
#pragma unroll
                for (int rg = 0; rg < 4; ++rg) OS[(16 * ct + 4 * g + rg) * 132 + 16 * vt + r] = acc[vt][rg];
        }
#pragma unroll
        for (int vt = 0; vt < 8; ++vt) S[vt] = S[vt] * gl;
#pragma unroll
        for (int ks = 0; ks < 2; ++ks)
#pragma unroll
            for (int vt = 0; vt < 8; ++vt) {
                const bf16x8 vb = *(const LAS bf16x8*)(VNT + (16 * vt + r) * 72 + 32 * ks + 8 * g);
                S[vt] = __builtin_amdgcn_mfma_f32_16x16x32_bf16(kd[ks], vb, S[vt], 0, 0, 0);
            }
#pragma unroll
        for (int vt = 0; vt < 8; ++vt)
            *(LAS v2u*)(ST + (16 * vt + r) * 136 + 16 * w + 4 * g) = pack4(S[vt][0] + 0.f, S[vt][1] + 0.f, S[vt][2] + 0.f, S[vt][3] + 0.f);
#pragma unroll
        for (int ks = 0; ks < 4; ++ks) af[ks] = afn[ks];
        kd[0] = kdn[0]; kd[1] = kdn[1];
#pragma unroll
        for (int q = 0; q < 4; ++q) xr[q] = xrn[q];
        gl = gln;
        __syncthreads();
    }
    scan_epilogue(OS, zh0, zh1, gainl, yab + ty + (size_t)63 * 64 * YW, tid);
    __syncthreads();
#undef SCAN_LOAD
}

typedef short v4s __attribute__((ext_vector_type(4)));
constexpr int AQ_STRIDE = 272, AQ_WAVE_LDS = 64 * AQ_STRIDE + 512;
__device__ __forceinline__ void attn_query_q4(const Args& a, LAS unsigned char* wl, const LAS float* qgl, int t, int lane) {
    const bf16* proj = (const bf16*)(a.ws + WS_PROJ); const bf16* KN = (const bf16*)(a.ws + WS_KN);
    const unsigned short* SEL = (const unsigned short*)(a.ws + WS_SEL); bf16* yab = (bf16*)(a.ws + WS_YAB);
    LAS unsigned char* KT = wl; LAS unsigned short* SL = (LAS unsigned short*)(wl + 64 * AQ_STRIDE);
    const int r = lane & 15, g = lane >> 4;
    const int b = t >> 12, pos = t & 4095;
    const bf16* knb = KN + (size_t)b * SEQ * 128;
    *(LAS v2u*)(SL + 4 * lane) = *(const v2u*)(SEL + (size_t)t * 256 + 4 * lane);
    bf16x8 qf[4];
    {
        const bf16* qp = proj + (size_t)t * PW + C_AQ + (r & 7) * 128 + 8 * g;
        float f[32]; float ss = 0.f;
#pragma unroll
        for (int ks = 0; ks < 4; ++ks) { const v4u raw = *(const v4u*)(qp + 32 * ks);
            f[8 * ks] = bflo(raw.x); f[8 * ks + 1] = bfhi(raw.x); f[8 * ks + 2] = bflo(raw.y); f[8 * ks + 3] = bfhi(raw.y); f[8 * ks + 4] = bflo(raw.z); f[8 * ks + 5] = bfhi(raw.z); f[8 * ks + 6] = bflo(raw.w); f[8 * ks + 7] = bfhi(raw.w); }
#pragma unroll
        for (int i = 0; i < 32; ++i) ss += f[i] * f[i];
        ss += __shfl_xor(ss, 16); ss += __shfl_xor(ss, 32);
        float inv = rsqrtf(ss * (1.f / 128.f) + EPS) * 0.08838834764831845f;
        if (r >= 8) inv = 0.f;
#pragma unroll
        for (int ks = 0; ks < 4; ++ks) { const f32x4 ga = *(const LAS f32x4*)(qgl + 32 * ks + 8 * g), gb = *(const LAS f32x4*)(qgl + 32 * ks + 8 * g + 4);
            v4u o; o.x = pk2(f[8 * ks] * inv * ga.x, f[8 * ks + 1] * inv * ga.y); o.y = pk2(f[8 * ks + 2] * inv * ga.z, f[8 * ks + 3] * inv * ga.w);
            o.z = pk2(f[8 * ks + 4] * inv * gb.x, f[8 * ks + 5] * inv * gb.y); o.w = pk2(f[8 * ks + 6] * inv * gb.z, f[8 * ks + 7] * inv * gb.w);
            qf[ks] = __builtin_bit_cast(bf16x8, o); }
    }
    LDS_WAIT();
    const int cnt = (pos + 1 < 256) ? pos + 1 : 256, nq = (cnt + 63) >> 6;
    const float slope = exp2f(-(float)((r & 7) + 1));
    float m_run = -INFINITY, l_run = 0.f;
    f32x4 O[8];
#pragma unroll
    for (int dt = 0; dt < 8; ++dt) O[dt] = (f32x4){0.f, 0.f, 0.f, 0.f};
    bf16x8 ka[4][4], kb[4][4];
#define AQ_LOAD(q_, k_) do { _Pragma("unroll") for (int kt = 0; kt < 4; ++kt) { int ix_ = SL[64 * (q_) + 16 * kt + r]; ix_ = (ix_ == 0xFFFF) ? 0 : ix_; \
        const bf16* kp_ = knb + (size_t)ix_ * 128 + 8 * g; _Pragma("unroll") for (int ks = 0; ks < 4; ++ks) k_[kt][ks] = *(const bf16x8*)(kp_ + 32 * ks); } } while (0)
#define AQ_PASS(q_, k_) do { \
        f32x4 sc[4]; \
        _Pragma("unroll") for (int kt = 0; kt < 4; ++kt) { f32x4 acc = (f32x4){0.f, 0.f, 0.f, 0.f}; \
            _Pragma("unroll") for (int ks = 0; ks < 4; ++ks) { acc = __builtin_amdgcn_mfma_f32_16x16x32_bf16(k_[kt][ks], qf[ks], acc, 0, 0, 0); \
                *(LAS bf16x8*)(KT + (16 * kt + r) * AQ_STRIDE + (32 * ks + 8 * g) * 2) = k_[kt][ks]; } \
            sc[kt] = acc; } \
        float m = m_run; \
        _Pragma("unroll") for (int kt = 0; kt < 4; ++kt) { const v2u s4 = *(const LAS v2u*)(SL + 64 * (q_) + 16 * kt + 4 * g); \
            const int i0 = s4.x & 0xFFFF, i1 = s4.x >> 16, i2 = s4.y & 0xFFFF, i3 = s4.y >> 16; \
            sc[kt][0] = (i0 != 0xFFFF) ? sc[kt][0] - slope * (float)(pos - i0) : -INFINITY; sc[kt][1] = (i1 != 0xFFFF) ? sc[kt][1] - slope * (float)(pos - i1) : -INFINITY; \
            sc[kt][2] = (i2 != 0xFFFF) ? sc[kt][2] - slope * (float)(pos - i2) : -INFINITY; sc[kt][3] = (i3 != 0xFFFF) ? sc[kt][3] - slope * (float)(pos - i3) : -INFINITY; \
            m = fmaxf(fmaxf(m, fmaxf(sc[kt][0], sc[kt][1])), fmaxf(sc[kt][2], sc[kt][3])); } \
        m = fmaxf(m, __shfl_xor(m, 16)); m = fmaxf(m, __shfl_xor(m, 32)); \
        const float alpha = __expf(m_run - m); \
        float ls = 0.f; \
        _Pragma("unroll") for (int kt = 0; kt < 4; ++kt) _Pragma("unroll") for (int rg = 0; rg < 4; ++rg) { const float e = __expf(sc[kt][rg] - m); sc[kt][rg] = e; ls += e; } \
        ls += __shfl_xor(ls, 16); ls += __shfl_xor(ls, 32); \
        l_run = l_run * alpha + ls; m_run = m; \
        _Pragma("unroll") for (int rg = 0; rg < 4; ++rg) { const float ah = __shfl(alpha, 4 * g + rg); _Pragma("unroll") for (int dt = 0; dt < 8; ++dt) O[dt][rg] *= ah; } \
        _Pragma("unroll") for (int c = 0; c < 2; ++c) { v4u o_; o_.x = pk2(sc[2 * c][0], sc[2 * c][1]); o_.y = pk2(sc[2 * c][2], sc[2 * c][3]); o_.z = pk2(sc[2 * c + 1][0], sc[2 * c + 1][1]); o_.w = pk2(sc[2 * c + 1][2], sc[2 * c + 1][3]); \
            const bf16x8 pa = __builtin_bit_cast(bf16x8, o_); \
            _Pragma("unroll") for (int dt = 0; dt < 8; ++dt) { \
                const v4s b0 = __builtin_amdgcn_ds_read_tr16_b64_v4i16((LAS v4s*)(tb + (32 * c) * AQ_STRIDE + 32 * dt)); \
                const v4s b1 = __builtin_amdgcn_ds_read_tr16_b64_v4i16((LAS v4s*)(tb + (32 * c + 16) * AQ_STRIDE + 32 * dt)); \
                const bf16x8 bfr = __builtin_shufflevector(b0, b1, 0, 1, 2, 3, 4, 5, 6, 7); \
                O[dt] = __builtin_amdgcn_mfma_f32_16x16x32_bf16(pa, bfr, O[dt], 0, 0, 0); } } \
        __builtin_amdgcn_sched_barrier(0); } while (0)
    const LAS unsigned char* tb = KT + (4 * g + (r >> 2)) * AQ_STRIDE + 8 * (r & 3);
    AQ_LOAD(0, ka);
    AQ_LOAD(1, kb);
    AQ_PASS(0, ka);
    AQ_LOAD(2, ka);
    if (nq > 1) AQ_PASS(1, kb);
    AQ_LOAD(3, kb);
    if (nq > 2) AQ_PASS(2, ka);
    if (nq > 3) AQ_PASS(3, kb);
#undef AQ_LOAD
#undef AQ_PASS
    const float il = 1.f / l_run;
    if (true) {
        float ih[4];
#pragma unroll
        for (int rg = 0; rg < 4; ++rg) ih[rg] = __shfl(il, 4 * g + rg);
        if (g < 2) {
#pragma unroll
            for (int rg = 0; rg < 4; ++rg)
#pragma unroll
                for (int dt = 0; dt < 8; ++dt) yab[(size_t)t * YW + (4 * g + rg) * 128 + 16 * dt + r] = (bf16)f2bf(O[dt][rg] * ih[rg]);
        }
    }
    LDS_WAIT();
}

__device__ __forceinline__ void phase4(const Args& a, LAS unsigned char* lds) {
    const int bid = blockIdx.x, G = gridDim.x, tid = threadIdx.x, lane = tid & 63, wave = tid >> 6;
    const int nscan = (G >= 64) ? 32 : 0;
#ifndef P4_REP
#define P4_REP 0
#endif
    if (nscan && bid < 32) { gdn_scan(a, lds, bid); if (P4_REP & 1) { __syncthreads(); gdn_scan(a, lds, bid); } return; }
    if (!nscan) { for (int bh = bid; bh < 32; bh += G) gdn_scan(a, lds, bh); __syncthreads(); }
    LAS float* qg4 = (LAS float*)(lds + 8 * AQ_WAVE_LDS);
    if (tid < 128) qg4[tid] = a.in[5][tid];
    __syncthreads();
    LAS unsigned char* wl4 = lds + wave * AQ_WAVE_LDS;
    if (nscan == 32 && (G & 7) == 0) {
        const int bb = bid & 7, wl_i = ((bid - 32) >> 3) * 8 + wave, nwl = ((G - 32) >> 3) * 8;
        for (int p = wl_i; p < SEQ; p += nwl) attn_query_q4(a, wl4, qg4, bb * SEQ + p, lane);
        if (P4_REP & 2) for (int p = wl_i; p < SEQ; p += nwl) attn_query_q4(a, wl4, qg4, bb * SEQ + p, lane);
    } else {
        const int gw = (bid - nscan) * 8 + wave, NGW = (G - nscan) * 8;
        for (int t = gw; t < T_TOK; t += NGW) attn_query_q4(a, wl4, qg4, t, lane);
    }
}

#define INS16P(L, v_) do { float _x = (v_); \
    _Pragma("unroll") for (int _k = 0; _k < 16; ++_k) { const float _h = __builtin_fmaxf(L[_k], _x); _x = __builtin_fminf(L[_k], _x); L[_k] = _h; } } while (0)
#define CE_D(a_, b_) do { const float _h = __builtin_fmaxf(a_, b_), _l = __builtin_fminf(a_, b_); a_ = _h; b_ = _l; } while (0)
#define SORT16_DESC(A) do { \
    _Pragma("unroll") for (int k_ = 2; k_ <= 16; k_ <<= 1) \
    _Pragma("unroll") for (int j_ = k_ >> 1; j_ > 0; j_ >>= 1) \
    _Pragma("unroll") for (int i_ = 0; i_ < 16; ++i_) { const int l_ = i_ ^ j_; if (l_ > i_) { if ((i_ & k_) == 0) CE_D(A[i_], A[l_]); else CE_D(A[l_], A[i_]); } } } while (0)
#define MERGE16_TOP(L, B) do { \
    _Pragma("unroll") for (int i_ = 0; i_ < 16; ++i_) L[i_] = __builtin_fmaxf(L[i_], B[15 - i_]); \
    _Pragma("unroll") for (int j_ = 8; j_ > 0; j_ >>= 1) \
    _Pragma("unroll") for (int i_ = 0; i_ < 16; ++i_) { const int l_ = i_ ^ j_; if (l_ > i_) CE_D(L[i_], L[l_]); } } while (0)
__device__ __forceinline__ float packf(float v, unsigned id, unsigned mask) { return __uint_as_float((__float_as_uint(v) & ~mask) | id); }

__device__ __forceinline__ void peer_route_unit(const Args& a, LAS float* SC, int tt, int p, int lane) {
    const bf16* query = (const bf16*)(a.ws + WS_QUERY); const bf16* subk = (const bf16*)(a.ws + WS_SUBK);
    int* expid = (int*)(a.ws + WS_EXPID); float* gate = (float*)(a.ws + WS_GATE);
    const int r = lane & 15, g = lane >> 4;
    const int tok = lane & 31, ch = lane >> 5;
    float L1[16], L2[16];
#pragma unroll
    for (int k = 0; k < 16; ++k) { L1[k] = 0.f; L2[k] = 0.f; }
#pragma unroll 1
    for (int half = 0; half < 2; ++half) {
        bf16x8 bk[8][4];
        {
            const bf16* kp = subk + (size_t)((p * 2 + half) * 128 + r) * 128 + 8 * g;
#pragma unroll
            for (int nt = 0; nt < 8; ++nt)
#pragma unroll
                for (int ks = 0; ks < 4; ++ks) bk[nt][ks] = *(const bf16x8*)(kp + (size_t)nt * 16 * 128 + 32 * ks);
        }
        bf16x8 af[2][4];
#pragma unroll
        for (int mt = 0; mt < 2; ++mt) {
            const bf16* qp = query + (size_t)(tt * 32 + mt * 16 + r) * 2048 + p * 256 + half * 128 + 8 * g;
#pragma unroll
            for (int ks = 0; ks < 4; ++ks) af[mt][ks] = *(const bf16x8*)(qp + 32 * ks);
        }
#pragma unroll
        for (int mt = 0; mt < 2; ++mt) {
#pragma unroll
            for (int nt = 0; nt < 8; ++nt) {
                f32x4 acc = (f32x4){0.f, 0.f, 0.f, 0.f};
#pragma unroll
                for (int ks = 0; ks < 4; ++ks) acc = __builtin_amdgcn_mfma_f32_16x16x32_bf16(af[mt][ks], bk[nt][ks], acc, 0, 0, 0);
#pragma unroll
                for (int rg = 0; rg < 4; ++rg) SC[(mt * 16 + 4 * g + rg) * 132 + nt * 16 + r] = acc[rg];
            }
        }
        LDS_WAIT();
        float L[16];
#pragma unroll
        for (int c16 = 0; c16 < 4; ++c16) {
            float B[16];
#pragma unroll
            for (int c4 = 0; c4 < 4; ++c4) {
                const f32x4 v = *(const LAS f32x4*)(SC + tok * 132 + 64 * ch + 16 * c16 + 4 * c4);
                const unsigned n0 = 64 * ch + 16 * c16 + 4 * c4;
                B[4 * c4] = packf(v.x, n0, 127u); B[4 * c4 + 1] = packf(v.y, n0 + 1, 127u); B[4 * c4 + 2] = packf(v.z, n0 + 2, 127u); B[4 * c4 + 3] = packf(v.w, n0 + 3, 127u);
            }
            SORT16_DESC(B);
            if (c16 == 0) {
#pragma unroll
                for (int k = 0; k < 16; ++k) L[k] = B[k];
            } else MERGE16_TOP(L, B);
        }
        {
            float B[16];
#pragma unroll
            for (int k = 0; k < 16; ++k) B[k] = __shfl(L[k], tok + 32);
            MERGE16_TOP(L, B);
        }
#pragma unroll
        for (int k = 0; k < 16; ++k) { L1[k] = (half == 0) ? L[k] : L1[k]; L2[k] = (half == 0) ? L2[k] : L[k]; }
        LDS_WAIT();
    }
    float V1[16], V2[16];
#pragma unroll
    for (int k = 0; k < 16; ++k) { V1[k] = __uint_as_float(__float_as_uint(L1[k]) & ~127u); V2[k] = __uint_as_float(__float_as_uint(L2[k]) & ~127u); }
    float C[16];
#pragma unroll
    for (int k = 0; k < 16; ++k) C[k] = -INFINITY;
#pragma unroll
    for (int i = 0; i < 16; ++i)
#pragma unroll
        for (int j = 0; j < 16; ++j)
            if ((i + 1) * (j + 1) <= 16) INS16P(C, packf(V1[i] + V2[j], (unsigned)(i * 16 + j), 255u));
    if (ch == 0) {
        float e[16], sum = 0.f; int ex[16];
        const float c0 = __uint_as_float(__float_as_uint(C[0]) & ~255u);
#pragma unroll
        for (int k = 0; k < 16; ++k) {
            const unsigned cb = __float_as_uint(C[k]); const int ci = (cb >> 4) & 15, cj = cb & 15;
            int i1 = 0, i2 = 0;
#pragma unroll
            for (int m = 0; m < 16; ++m) { i1 = (ci == m) ? (int)(__float_as_uint(L1[m]) & 127u) : i1; i2 = (cj == m) ? (int)(__float_as_uint(L2[m]) & 127u) : i2; }
            ex[k] = i1 * 128 + i2;
            e[k] = __expf(__uint_as_float(cb & ~255u) - c0); sum += e[k];
        }
        const float inv = 1.f / sum;
        const size_t base = ((size_t)(tt * 32 + tok) * 8 + p) * 16;
#pragma unroll
        for (int q = 0; q < 4; ++q) {
            *(v4u*)(expid + base + 4 * q) = (v4u){(unsigned)ex[4 * q], (unsigned)ex[4 * q + 1], (unsigned)ex[4 * q + 2], (unsigned)ex[4 * q + 3]};
            *(f32x4*)(gate + base + 4 * q) = (f32x4){e[4 * q] * inv, e[4 * q + 1] * inv, e[4 * q + 2] * inv, e[4 * q + 3] * inv};
        }
    }
}
__device__ __forceinline__ void phase8(const Args& a, LAS unsigned char* lds) {
    const int tid = threadIdx.x, lane = tid & 63, wave = tid >> 6;
    LAS float* SC = (LAS float*)(lds + wave * 16896);
    const int gw = blockIdx.x * 8 + wave, NGW = gridDim.x * 8;
#ifndef P8_REP
#define P8_REP 1
#endif
    for (int rep_ = 0; rep_ < P8_REP; ++rep_)
    for (int u = gw; u < 1024 * 8; u += NGW) peer_route_unit(a, SC, u >> 3, u & 7, lane);
}

typedef float f32x2 __attribute__((ext_vector_type(2)));
__device__ __forceinline__ void cvt8(const v4u u, float* f) { f[0] = bflo(u.x); f[1] = bfhi(u.x); f[2] = bflo(u.y); f[3] = bfhi(u.y); f[4] = bflo(u.z); f[5] = bfhi(u.z); f[6] = bflo(u.w); f[7] = bfhi(u.w); }
__device__ __forceinline__ void cvt16_fp8(const v4u u, float* f) {
#pragma unroll
    for (int q = 0; q < 4; ++q) { const f32x2 lo = __builtin_amdgcn_cvt_pk_f32_fp8((int)u[q], false), hi = __builtin_amdgcn_cvt_pk_f32_fp8((int)u[q], true);
        f[4 * q] = lo.x; f[4 * q + 1] = lo.y; f[4 * q + 2] = hi.x; f[4 * q + 3] = hi.y; }
}
#define DPPF(x_, ctrl_) __builtin_bit_cast(float, __builtin_amdgcn_update_dpp(0, __builtin_bit_cast(int, (x_)), (ctrl_), 0xF, 0xF, false))
__device__ __forceinline__ float reduce8(const float* d, int lane) {
    const bool b0 = lane & 1, b1 = lane & 2, b2 = lane & 4;
    float s1[4], s2[2];
#pragma unroll
    for (int i = 0; i < 4; ++i) { const float a = b0 ? d[2 * i + 1] : d[2 * i], b = b0 ? d[2 * i] : d[2 * i + 1]; s1[i] = a + DPPF(b, 0xB1); }
#pragma unroll
    for (int i = 0; i < 2; ++i) { const float a = b1 ? s1[2 * i + 1] : s1[2 * i], b = b1 ? s1[2 * i] : s1[2 * i + 1]; s2[i] = a + DPPF(b, 0x4E); }
    const float a3 = b2 ? s2[1] : s2[0], b3 = b2 ? s2[0] : s2[1];
    float s = a3 + DPPF(b3, 0x124);
    s += DPPF(s, 0x128);
    s += __shfl_xor(s, 16); s += __shfl_xor(s, 32);
    return s;
}
#ifndef P9L_G
#define P9L_G 8
#endif
constexpr int P9LG = P9L_G, P9LP = 128 + P9LG;
constexpr int P9L_WAVE = 4 * (P9LP * 4 * 3);
#ifndef P9L_SH
#define P9L_SH 12
#endif
constexpr int P9L_NS = 16384 >> P9L_SH;
__device__ __forceinline__ void phase9l(const Args& a, LAS unsigned char* lds) {
    const int tid = threadIdx.x, lane = tid & 63, wave = tid >> 6, G = gridDim.x;
    const unsigned char* UT = a.ws + WS_UT; const unsigned char* VT = a.ws + WS_VT;
    const float* SU = (const float*)(a.ws + WS_SU); const float* SV = (const float*)(a.ws + WS_SV);
    const int* expid = (const int*)(a.ws + WS_EXPID); const float* gate = (const float*)(a.ws + WS_GATE);
    const float* mod = (const float*)(a.ws + WS_MOD);
    LAS int* LE = (LAS int*)(lds + wave * P9L_WAVE);
    LAS float* LG = (LAS float*)(LE + 4 * P9LP);
    LAS float* LA = LG + 4 * P9LP;
    const bool isdiag = (lane >> 4) == ((lane & 15) >> 2);
    for (int rd = 0; ; ++rd) {
        const int tb = ((rd * G + (int)blockIdx.x) * 8 + wave) * 4;
        if (tb >= T_TOK) break;
        v4u h8[4]; float hsc[4]; int off[4][P9L_NS + 1];
#pragma unroll
        for (int i = 0; i < 4; ++i) {
            const size_t t = (size_t)(tb + i);
            h8[i] = *(const v4u*)(a.ws + WS_H8 + t * DM + 16 * lane); hsc[i] = ((const float*)(a.ws + WS_HS))[t];
            int e[2]; float gq[2];
#pragma unroll
            for (int q = 0; q < 2; ++q) { e[q] = expid[t * 128 + lane + 64 * q]; gq[q] = gate[t * 128 + lane + 64 * q]; }
            int base = 0;
#pragma unroll
            for (int s = 0; s < P9L_NS; ++s) {
                off[i][s] = base;
#pragma unroll
                for (int q = 0; q < 2; ++q) {
                    const bool in = (e[q] >> P9L_SH) == s;
                    const unsigned long long mk = __builtin_amdgcn_ballot_w64(in);
                    const int pos = base + __builtin_amdgcn_mbcnt_hi((unsigned)(mk >> 32), __builtin_amdgcn_mbcnt_lo((unsigned)mk, 0));
                    if (in) { LE[i * P9LP + pos] = e[q]; LG[i * P9LP + pos] = gq[q]; }
                    base += __builtin_popcountll(mk);
                }
            }
            off[i][P9L_NS] = 128;
            if (lane < P9LG) LE[i * P9LP + 128 + lane] = e[0];
        }
        LDS_WAIT();
#pragma unroll 1
        for (int s = 0; s < P9L_NS; ++s) {
#pragma unroll
            for (int i = 0; i < 4; ++i) {
                for (int g0 = off[i][s]; g0 < off[i][s + 1]; g0 += P9LG) {
                    const int n = off[i][s + 1] - g0;
                    const int ev = LE[i * P9LP + g0 + (lane & (P9LG - 1))];
                    v4u ua[P9LG];
#pragma unroll
                    for (int k = 0; k < P9LG; ++k) { const int e = __builtin_amdgcn_readlane(ev, k); ua[k] = *(const v4u*)(UT + (size_t)e * 1024 + 16 * lane); }
                    const long hlo = (long)(((unsigned long long)h8[i].y << 32) | h8[i].x), hhi = (long)(((unsigned long long)h8[i].w << 32) | h8[i].z);
#pragma unroll
                    for (int k8 = 0; k8 < P9LG; k8 += 8) {
                        float dd[8];
#pragma unroll
                        for (int k = 0; k < 8; ++k) {
                            f32x4 cacc = (f32x4){0.f, 0.f, 0.f, 0.f};
                            cacc = __builtin_amdgcn_mfma_f32_16x16x32_fp8_fp8((long)(((unsigned long long)ua[k8 + k].y << 32) | ua[k8 + k].x), hlo, cacc, 0, 0, 0);
                            cacc = __builtin_amdgcn_mfma_f32_16x16x32_fp8_fp8((long)(((unsigned long long)ua[k8 + k].w << 32) | ua[k8 + k].z), hhi, cacc, 0, 0, 0);
                            const float c01 = (lane & 1) ? cacc[1] : cacc[0], c23 = (lane & 1) ? cacc[3] : cacc[2];
                            dd[k] = isdiag ? ((lane & 2) ? c23 : c01) : 0.f;
                        }
                        const float tot = reduce8(dd, lane);
                        if (lane < 8 && k8 + lane < n) LA[i * P9LP + g0 + k8 + lane] = tot;
                        __builtin_amdgcn_sched_barrier(0);
                    }
                }
            }
        }
        LDS_WAIT();
#pragma unroll
        for (int i = 0; i < 4; ++i)
#pragma unroll
            for (int q = 0; q < 2; ++q) { const int ix = i * P9LP + lane + 64 * q; const int e = LE[ix];
                const float dq = LA[ix] * SU[e] * hsc[i];
                LA[ix] = 0.5f * dq * (1.f + erff(dq * 0.70710678118654752f)) * LG[ix] * SV[e]; }
        LDS_WAIT();
        float y[4][16];
#pragma unroll
        for (int i = 0; i < 4; ++i)
#pragma unroll
            for (int c = 0; c < 16; ++c) y[i][c] = 0.f;
#pragma unroll 1
        for (int s = 0; s < P9L_NS; ++s) {
#pragma unroll
            for (int i = 0; i < 4; ++i) {
                for (int g0 = off[i][s]; g0 < off[i][s + 1]; g0 += P9LG) {
                    const int n = off[i][s + 1] - g0;
                    const int ev = LE[i * P9LP + g0 + (lane & (P9LG - 1))];
                    const float av = ((lane & (P9LG - 1)) < n) ? LA[i * P9LP + g0 + (lane & (P9LG - 1))] : 0.f;
                    v4u va[P9LG];
#pragma unroll
                    for (int k = 0; k < P9LG; ++k) { const int e = __builtin_amdgcn_readlane(ev, k); va[k] = *(const v4u*)(VT + (size_t)e * 1024 + 16 * lane); }
#pragma unroll
                    for (int k = 0; k < P9LG; ++k) { const float aj = __builtin_bit_cast(float, __builtin_amdgcn_readlane(__builtin_bit_cast(int, av), k));
                        float f[16]; cvt16_fp8(va[k], f);
#pragma unroll
                        for (int c = 0; c < 16; ++c) y[i][c] = __builtin_fmaf(aj, f[c], y[i][c]);
                        if ((k & 3) == 3) __builtin_amdgcn_sched_barrier(0); }
                }
            }
        }
#pragma unroll
        for (int i = 0; i < 4; ++i) {
            const int t = tb + i, b = t >> 12;
            float* orow = a.out + (size_t)t * DM + 16 * lane; const float* g2 = mod + b * 6144 + 5120 + 16 * lane;
#pragma unroll
            for (int q4 = 0; q4 < 4; ++q4) {
                const f32x4 xv = *(const f32x4*)(orow + 4 * q4), gv = *(const f32x4*)(g2 + 4 * q4);
                const f32x4 yv = (f32x4){y[i][4 * q4], y[i][4 * q4 + 1], y[i][4 * q4 + 2], y[i][4 * q4 + 3]};
                *(f32x4*)(orow + 4 * q4) = xv + gv * yv;
            }
        }
        LDS_WAIT();
    }
}

#define XB_TMO      128
#define XB_XCNT(j)  (256  + 64 * (j))
#define XB_XSUB(j)  (1280 + 64 * (j))
#define XB_XGEN(j)  (2304 + 64 * (j))
#define XB_TOP      3328
#define XB_TOPGEN   3392
#define XCD_BAR_WORDS 3456
#define XB_SPIN_CAP (1u << 18)

__device__ __forceinline__ unsigned xb_ld(unsigned* p)              { return __hip_atomic_load(p, __ATOMIC_RELAXED, __HIP_MEMORY_SCOPE_AGENT); }
__device__ __forceinline__ unsigned xb_add(unsigned* p, unsigned v) { return __hip_atomic_fetch_add(p, v, __ATOMIC_RELAXED, __HIP_MEMORY_SCOPE_AGENT); }
__device__ __forceinline__ unsigned xb_xcc_id() { return (unsigned)__builtin_amdgcn_s_getreg((3 << 11) | 20) & 0xFu; }
#define XB_SPIN(cond, bar) do { unsigned _sp = 0; while (cond) { __builtin_amdgcn_s_sleep(1); \
    if ((++_sp & 255u) == 0u) { if (xb_ld(&(bar)[XB_TMO])) break; if (_sp > XB_SPIN_CAP) { atomicAdd(&(bar)[XB_TMO], 1u); break; } } } } while (0)

struct XcdBarrier {
    unsigned* bar; unsigned x;
    volatile LAS unsigned* st;
};

__device__ __forceinline__ XcdBarrier xcd_barrier_post(unsigned* bar, volatile LAS unsigned* st) {
    XcdBarrier b; b.bar = bar; b.x = xb_xcc_id(); b.st = st;
    if (threadIdx.x == 0) (void)xb_add(&bar[XB_XCNT(b.x)], 1u);
    return b;
}
__device__ __forceinline__ void xcd_barrier_complete(unsigned* bar, unsigned x, unsigned& nloc, unsigned& nx) {
    const unsigned G = gridDim.x * gridDim.y * gridDim.z;
    unsigned sum, cnt, mine, sp = 0u;
    for (;;) {
        sum = 0u; cnt = 0u; mine = 0u;
#pragma unroll
        for (unsigned j = 0; j < 16; ++j) { const unsigned c = xb_ld(&bar[XB_XCNT(j)]); sum += c; cnt += (c > 0u) ? 1u : 0u; mine = (j == x) ? c : mine; }
        if (sum == G) break;
        __builtin_amdgcn_s_sleep(1);
        if ((++sp & 255u) == 0u) { if (xb_ld(&bar[XB_TMO])) break; if (sp > XB_SPIN_CAP) { atomicAdd(&bar[XB_TMO], 1u); break; } }
    }
    nloc = mine > 0u ? mine : 1u; nx = cnt > 0u ? cnt : 1u;
}

__device__ __forceinline__ void xcd_barrier(const XcdBarrier& b) {
    asm volatile("s_waitcnt vmcnt(0)" ::: "memory");
    __syncthreads();
    if (threadIdx.x == 0) {
        unsigned* bar = b.bar;
        __builtin_amdgcn_s_waitcnt(0);
        unsigned nloc = b.st[0], nx = b.st[1];
        if (nloc == 0u) { xcd_barrier_complete(bar, b.x, nloc, nx); b.st[0] = nloc; b.st[1] = nx; }
        const unsigned old = xb_add(&bar[XB_XSUB(b.x)], 1u);
        const unsigned gen = old / nloc;
        if (old + 1u == (gen + 1u) * nloc) {
            __builtin_amdgcn_fence(__ATOMIC_RELEASE, "agent");
            asm volatile("s_waitcnt vmcnt(0)" ::: "memory");
            const unsigned og = xb_add(&bar[XB_TOP], 1u);
            const unsigned tg = og / nx;
            if (og + 1u == (tg + 1u) * nx) xb_add(&bar[XB_TOPGEN], 1u);
            else XB_SPIN(xb_ld(&bar[XB_TOPGEN]) == tg, bar);
            __builtin_amdgcn_fence(__ATOMIC_ACQUIRE, "agent");
            xb_add(&bar[XB_XGEN(b.x)], 1u);
            asm volatile("s_waitcnt vmcnt(0)" ::: "memory");
        } else {
            XB_SPIN(xb_ld(&bar[XB_XGEN(b.x)]) == gen, bar);
            __builtin_amdgcn_fence(__ATOMIC_ACQUIRE, "agent");
            asm volatile("s_waitcnt vmcnt(0)" ::: "memory");
        }
    }
    __syncthreads();
}

__global__ void __launch_bounds__(512, 2) mega_fwd(Args a) {
    extern __shared__ __attribute__((aligned(16))) unsigned char lds_raw[];
    LAS unsigned char* lds = (LAS unsigned char*)lds_raw;
    asm volatile("" : "+v"(lds));
    cg::grid_group grid = cg::this_grid();
#define MISC_PTR ((volatile LAS unsigned*)((LAS unsigned char*)lds_raw + (LDS_BYTES - 64)))
    if (threadIdx.x < 16) MISC_PTR[threadIdx.x] = 0u;
    __syncthreads();
    const unsigned xcc_id = xcd_barrier_post((unsigned*)(a.ws + WS_CTL) + 4096, MISC_PTR).x;
    grid.sync();
    unsigned char* ws = a.ws;
    const int lo = a.ph_lo, hi = a.ph_hi;
#ifndef PH_MASK
#define PH_MASK 0x3ff
#endif
#define IN(k) (((PH_MASK >> (k)) & 1) && lo <= (k) && (k) < hi)
#define SEAM(k) do { if (IN(k) && IN((k) + 1)) { if ((k) == 99) grid.sync(); else { XcdBarrier xb_; xb_.bar = (unsigned*)(a.ws + WS_CTL) + 4096; xb_.x = xcc_id; xb_.st = MISC_PTR; xcd_barrier(xb_); } } } while (0)
#ifndef REP_MASK
#define REP_MASK 0
#endif
#define RUNP(k, body) do { if (IN(k)) { body; if ((REP_MASK >> (k)) & 1) { grid.sync(); body; } } } while (0)
    RUNP(0, phase0(a, lds)); SEAM(0);
    RUNP(1, phase_norm(a.in[0], (const float*)(ws + WS_MOD), 0, 1024, (bf16*)(ws + WS_H))); SEAM(1);
    RUNP(2, ({
        pg8::Gemm g{(const pg8::bf16_t*)(ws + WS_H), (const pg8::bf16_t*)(ws + WS_WIN), T_TOK, PW, DM}; pg8::StaticOrder S; S.init(T_TOK, PW, gridDim.x, blockIdx.x);
        EpiBf E{(bf16*)(ws + WS_PROJ), PW};
        pg8::gemm_phase<EpiBf, pg8::StaticOrder, true, true>(lds, g, S, E); })); SEAM(2);
#ifdef IDX_FP32
    if (IN(3)) { phase_idx32(a, lds); grid.sync(); }
#endif
    RUNP(3, phase3(a, lds)); SEAM(3);
    RUNP(4, phase4(a, lds)); SEAM(4);
    RUNP(5, ({
        pg8::Gemm g{(const pg8::bf16_t*)(ws + WS_YAB), (const pg8::bf16_t*)(ws + WS_BT2), T_TOK, DM, YW}; pg8::StaticOrder S; S.init(T_TOK, DM, gridDim.x, blockIdx.x);
        EpiX1 E{a.in[0], a.out, (const float*)(ws + WS_MOD)};
        pg8::gemm_phase<EpiX1, pg8::StaticOrder, true, true>(lds, g, S, E); })); SEAM(5);
    RUNP(6, phase_norm(a.out, (const float*)(ws + WS_MOD), 3072, 4096, (bf16*)(ws + WS_H), ws + WS_H8, (float*)(ws + WS_HS))); SEAM(6);
    RUNP(7, ({
        pg8::Gemm g{(const pg8::bf16_t*)(ws + WS_H), (const pg8::bf16_t*)(ws + WS_WQ), T_TOK, 2048, DM}; pg8::StaticOrder S; S.init(T_TOK, 2048, gridDim.x, blockIdx.x);
        EpiBf E{(bf16*)(ws + WS_QUERY), 2048};
        pg8::gemm_phase<EpiBf, pg8::StaticOrder, true, true>(lds, g, S, E); })); SEAM(7);
    RUNP(8, phase8(a, lds)); SEAM(8);
    if (IN(9)) { phase9l(a, lds); }
#undef IN
#undef SEAM
}

#ifndef MK_N_LAUNCHES
#define MK_N_LAUNCHES 1
#endif
extern "C" void kernel_launch(void* const* d_in, const int* in_sizes, int n_in, void* d_out, int out_size, void* d_ws, size_t ws_size, hipStream_t stream) {
    static int grid = 0;
    if (grid == 0) {
        int dev = 0, cus = 0, per_cu = 0;
        hipGetDevice(&dev);
        hipDeviceGetAttribute(&cus, hipDeviceAttributeMultiprocessorCount, dev);
        hipFuncSetAttribute((const void*)mega_fwd, hipFuncAttributeMaxDynamicSharedMemorySize, LDS_BYTES);
        hipOccupancyMaxActiveBlocksPerMultiprocessor(&per_cu, (const void*)mega_fwd, 512, LDS_BYTES);
        if (per_cu < 1) { fprintf(stderr, "kernel_launch: occupancy query says %d blocks per CU\n", per_cu); per_cu = 1; }
        grid = cus * 1;
        if (n_in != 17 || ws_size < WS_END) fprintf(stderr, "kernel_launch: unexpected n_in %d / ws_size %zu\n", n_in, ws_size);
    }
    (void)hipMemsetAsync((char*)d_ws + WS_CTL, 0, 65536, stream);
    Args a{};
    for (int i = 0; i < 17; ++i) a.in[i] = (const float*)d_in[i];
    a.out = (float*)d_out; a.ws = (unsigned char*)d_ws;
#if MK_N_LAUNCHES == 1
    a.ph_lo = 0; a.ph_hi = 10;
    void* args[] = {&a};
    hipError_t e = hipLaunchCooperativeKernel((const void*)mega_fwd, dim3(grid), dim3(512), args, LDS_BYTES, stream);
    if (e != hipSuccess) fprintf(stderr, "cooperative launch failed: %s (grid %d)\n", hipGetErrorString(e), grid);
#else
    for (int p = 0; p < 10; ++p) { a.ph_lo = p; a.ph_hi = p + 1; hipLaunchKernelGGL(mega_fwd, dim3(grid), dim3(512), LDS_BYTES, stream, a); }
#endif
}
```

```cpp
#include <hip/hip_runtime.h>
#include <hip/hip_cooperative_groups.h>
#include <cstdio>
#include <cstdint>
namespace cg = cooperative_groups;
namespace pg8 {
#define PG8_LAS __attribute__((address_space(3)))
typedef unsigned short bf16_t;
typedef short bf16x8 __attribute__((ext_vector_type(8)));
typedef float f32x4 __attribute__((ext_vector_type(4)));
typedef unsigned u32x4 __attribute__((ext_vector_type(4)));
constexpr int BM = 256, BK = 64, HALF = 128, HTB = HALF * BK * 2  , STAGE_BYTES = 8 * HTB, NXCD = 8, WGM = 8;

__host__ __device__ __forceinline__ int lds_byte(int r, int c) { const int st = (r >> 4) * 2 + (c >> 5), rr = r & 15, cc = c & 31, ob = rr * 64 + cc * 2; return st * 1024 + (ob ^ (((ob >> 9) & 1) << 5)); }
__host__ __device__ __forceinline__ void stage_rc(int b, int& R, int& C) { const int st = b / 1024, sb = b % 1024, swz = sb ^ (((sb >> 9) & 1) << 5); R = (st >> 1) * 16 + swz / 64; C = (st & 1) * 32 + (swz % 64) / 2; }
__host__ __device__ __forceinline__ int perm32(int rho) { const int n = rho >> 4, i = rho & 15; return 8 * (i >> 2) + 4 * n + (i & 3); }

struct Unit { int pm, pn; };
struct Gemm { const bf16_t* A; const bf16_t* Bt; int M, N, K; };

struct StaticOrder {
    int nM, nN, nwg, G, c;
    __host__ __device__ void init(int M, int N, int G_, int c_) { nM = M / BM; nN = N / BM; nwg = nM * nN; G = G_; c = c_; }
    __host__ __device__ bool next(int i, Unit& u) const {
        const long L = (long)i * G + c; if (L >= nwg) return false;
        int wgid = (int)L; { const int q = nwg / NXCD, r = nwg % NXCD, xcd = wgid % NXCD, off = wgid / NXCD; wgid = (xcd < r ? xcd * (q + 1) : r * (q + 1) + (xcd - r) * q) + off; }
        const int nig = WGM * nN, gid = wgid / nig, fm = gid * WGM, gsz = (nM - fm) < WGM ? (nM - fm) : WGM;
        u.pm = fm + ((wgid % nig) % gsz); u.pn = (wgid % nig) / gsz; return true;
    }
    __device__ __forceinline__ void a_ready(const Unit&) const {}
    __device__ __forceinline__ void done(const Unit&) const {}
};
__device__ __forceinline__ unsigned cvt_pk_bf16(float lo, float hi) { unsigned r; asm volatile("v_cvt_pk_bf16_f32 %0, %1, %2" : "=v"(r) : "v"(lo), "v"(hi)); return r; }
template <class Epi, class Sched, bool ALIGN_EPI = false, bool SP2 = false>
__device__ __forceinline__ void gemm_phase(PG8_LAS unsigned char* lds, const Gemm g, const Sched& S, const Epi& E) {
    const int tid = threadIdx.x, wid = __builtin_amdgcn_readfirstlane(tid >> 6), lane = tid & 63, wr = wid >> 2, wc = wid & 3, fr = lane & 15, fq = lane >> 4;
    const int K = g.K, nt = K / BK;
    unsigned voffA[2], voffB[2];
#pragma unroll
    for (int i = 0; i < 2; ++i) { int R, C; stage_rc(tid * 16 + i * 8192, R, C); const int Rb = Epi::PERM ? ((R & ~31) + perm32(R & 31)) : R;
        voffA[i] = (unsigned)(R * K + C) * 2u; voffB[i] = (unsigned)(Rb * K + C) * 2u; }
    const size_t kstep = (size_t)(BK * 2);
    const size_t hstep = (size_t)HALF * K * 2;
    const size_t tstep = 2 * hstep;
    const unsigned ldsw = (unsigned)wid * 1024u;
    const int aoff = lds_byte(wr * 64 + fr, fq * 8), boff = lds_byte(wc * 32 + fr, fq * 8);
#define PG8_SA(b, h) (((b) * 2 + (h)) * HTB)
#define PG8_SB(b, h) ((4 + (b) * 2 + (h)) * HTB)
#define PG8_STAGE(bufoff, gbase, voff) do { _Pragma("unroll") for (int _i = 0; _i < 2; ++_i) \
        __builtin_amdgcn_global_load_lds((const unsigned*)((const char*)(gbase) + (voff)[_i]), (PG8_LAS unsigned*)(lds + (bufoff) + ldsw + _i * 8192), 16, 0, 0); } while (0)
#define PG8_LDA(dst, b, h) do { _Pragma("unroll") for (int m = 0; m < 4; ++m) _Pragma("unroll") for (int k = 0; k < 2; ++k) dst[m][k] = *(const PG8_LAS bf16x8*)(lds + PG8_SA(b, h) + aoff + m * 2048 + k * 1024); } while (0)
#define PG8_LDB(dst, b, h) do { _Pragma("unroll") for (int n = 0; n < 2; ++n) _Pragma("unroll") for (int k = 0; k < 2; ++k) dst[n][k] = *(const PG8_LAS bf16x8*)(lds + PG8_SB(b, h) + boff + n * 2048 + k * 1024); } while (0)
#define PG8_MMA(ai, bj, At, Bt) do { __builtin_amdgcn_s_setprio(1); _Pragma("unroll") for (int m = 0; m < 4; ++m) _Pragma("unroll") for (int n = 0; n < 2; ++n) _Pragma("unroll") for (int k = 0; k < 2; ++k) \
        acc[ai][bj][m][n] = __builtin_amdgcn_mfma_f32_16x16x32_bf16(Bt[n][k], At[m][k], acc[ai][bj][m][n], 0, 0, 0); __builtin_amdgcn_s_setprio(0); } while (0)
#define PG8_WAIT_V(n) asm volatile("s_waitcnt vmcnt(" #n ")" ::: "memory")
#define PG8_WAIT_L(n) asm volatile("s_waitcnt lgkmcnt(" #n ")" ::: "memory")
#define PG8_BAR __builtin_amdgcn_s_barrier()
#define PG8_SCHED __builtin_amdgcn_sched_barrier(0)
    Unit cur, nxt; int ui = 0;
    if (!S.next(0, cur)) return;
    f32x4 acc[2][2][4][2];
#pragma unroll
    for (int a = 0; a < 2; ++a)
#pragma unroll
        for (int b = 0; b < 2; ++b)
#pragma unroll
            for (int m = 0; m < 4; ++m)
#pragma unroll
                for (int n = 0; n < 2; ++n) acc[a][b][m][n] = (f32x4){0.f, 0.f, 0.f, 0.f};
    bf16x8 At[4][2], B0[2][2], B1[2][2];
    const char* cA = (const char*)g.A + (size_t)cur.pm * tstep; const char* cB = (const char*)g.Bt + (size_t)cur.pn * tstep;
    S.a_ready(cur);
    if constexpr (SP2) {
        PG8_STAGE(PG8_SB(0, 0), cB, voffB); PG8_STAGE(PG8_SB(0, 1), cB + hstep, voffB); PG8_STAGE(PG8_SA(0, 0), cA, voffA); PG8_STAGE(PG8_SA(0, 1), cA + hstep, voffA);
        if (wr == 1) PG8_BAR;
        PG8_WAIT_V(2); PG8_BAR;
        PG8_STAGE(PG8_SB(1, 0), cB + kstep, voffB); PG8_STAGE(PG8_SA(1, 0), cA + kstep, voffA); PG8_STAGE(PG8_SB(1, 1), cB + hstep + kstep, voffB);
        PG8_WAIT_V(6); PG8_BAR;
    } else {
        PG8_STAGE(PG8_SB(0, 0), cB, voffB); PG8_STAGE(PG8_SA(0, 0), cA, voffA); PG8_STAGE(PG8_SB(0, 1), cB + hstep, voffB); PG8_STAGE(PG8_SA(0, 1), cA + hstep, voffA);
        if (wr == 1) PG8_BAR;
        PG8_WAIT_V(4); PG8_BAR;
        PG8_STAGE(PG8_SB(1, 0), cB + kstep, voffB); PG8_STAGE(PG8_SA(1, 0), cA + kstep, voffA); PG8_STAGE(PG8_SB(1, 1), cB + hstep + kstep, voffB);
        PG8_WAIT_V(6); PG8_BAR;
    }
    for (;;) {
        const bool has_next = S.next(ui + 1, nxt);
        const char* nA = has_next ? (const char*)g.A + (size_t)nxt.pm * tstep : cA; const char* nB = has_next ? (const char*)g.Bt + (size_t)nxt.pn * tstep : cB;
        for (int t = 0; t < nt; t += 2) {
            const bool last = (t == nt - 2);
            const char* a1 = cA + (size_t)(t + 1) * kstep;
            const char* a2 = last ? nA : cA + (size_t)(t + 2) * kstep; const char* b2 = last ? nB : cB + (size_t)(t + 2) * kstep;
            const char* a3 = a2 + kstep; const char* b3 = b2 + kstep;
            if (last && has_next) S.a_ready(nxt);
            if constexpr (SP2) {
            PG8_LDB(B0, 0, 0); PG8_LDB(B1, 0, 1); PG8_SCHED; PG8_LDA(At, 0, 0); PG8_STAGE(PG8_SA(1, 1), a1 + hstep, voffA);
            PG8_WAIT_V(8); PG8_WAIT_L(0); PG8_BAR; PG8_MMA(0, 0, At, B0); PG8_MMA(0, 1, At, B1); PG8_BAR; PG8_SCHED;
            PG8_LDA(At, 0, 1); PG8_STAGE(PG8_SB(0, 0), b2, voffB); PG8_STAGE(PG8_SB(0, 1), b2 + hstep, voffB); PG8_STAGE(PG8_SA(0, 0), a2, voffA);
            PG8_WAIT_V(8); PG8_WAIT_L(0); PG8_BAR; PG8_MMA(1, 0, At, B0); PG8_MMA(1, 1, At, B1); PG8_BAR; PG8_SCHED;
            PG8_LDB(B0, 1, 0); PG8_LDB(B1, 1, 1); PG8_SCHED; PG8_LDA(At, 1, 0); PG8_STAGE(PG8_SA(0, 1), a2 + hstep, voffA);
            PG8_WAIT_V(8); PG8_WAIT_L(0); PG8_BAR; PG8_MMA(0, 0, At, B0); PG8_MMA(0, 1, At, B1); PG8_BAR; PG8_SCHED;
            PG8_LDA(At, 1, 1); PG8_STAGE(PG8_SB(1, 0), b3, voffB); PG8_STAGE(PG8_SB(1, 1), b3 + hstep, voffB); PG8_STAGE(PG8_SA(1, 0), a3, voffA);
            PG8_WAIT_V(8); PG8_WAIT_L(0); PG8_BAR; PG8_MMA(1, 0, At, B0); PG8_MMA(1, 1, At, B1); PG8_BAR; PG8_SCHED;
            } else {
            PG8_LDB(B0, 0, 0); PG8_SCHED; PG8_LDA(At, 0, 0); PG8_STAGE(PG8_SA(1, 1), a1 + hstep, voffA);
            PG8_WAIT_L(8); PG8_BAR; PG8_WAIT_L(0); PG8_MMA(0, 0, At, B0); PG8_BAR; PG8_SCHED;
            PG8_LDB(B1, 0, 1); PG8_STAGE(PG8_SB(0, 0), b2, voffB);
            PG8_BAR; PG8_WAIT_L(0); PG8_MMA(0, 1, At, B1); PG8_BAR;
            PG8_LDA(At, 0, 1); PG8_STAGE(PG8_SA(0, 0), a2, voffA);
            PG8_BAR; PG8_WAIT_L(0); PG8_MMA(1, 0, At, B0); PG8_BAR; PG8_SCHED;
            PG8_STAGE(PG8_SB(0, 1), b2 + hstep, voffB);
            PG8_WAIT_V(6); PG8_BAR; PG8_MMA(1, 1, At, B1); PG8_BAR;
            PG8_LDB(B0, 1, 0); PG8_SCHED; PG8_LDA(At, 1, 0); PG8_STAGE(PG8_SA(0, 1), a2 + hstep, voffA);
            PG8_WAIT_L(8); PG8_BAR; PG8_WAIT_L(0); PG8_MMA(0, 0, At, B0); PG8_BAR; PG8_SCHED;
            PG8_LDB(B1, 1, 1); PG8_STAGE(PG8_SB(1, 0), b3, voffB);
            PG8_BAR; PG8_WAIT_L(0); PG8_MMA(0, 1, At, B1); PG8_BAR;
            PG8_LDA(At, 1, 1); PG8_STAGE(PG8_SA(1, 0), a3, voffA);
            PG8_BAR; PG8_WAIT_L(0); PG8_MMA(1, 0, At, B0); PG8_BAR; PG8_SCHED;
            PG8_STAGE(PG8_SB(1, 1), b3 + hstep, voffB);
            PG8_WAIT_V(6); PG8_BAR; PG8_MMA(1, 1, At, B1); PG8_BAR;
            }
        }
        if constexpr (ALIGN_EPI) { if (wr == 0) PG8_BAR; }
        if constexpr (!Epi::AFTER_DRAIN) { E(acc, cur, wr, wc, fr, fq); S.done(cur); }
        if (!has_next) break;
#pragma unroll
        for (int a = 0; a < 2; ++a)
#pragma unroll
            for (int b = 0; b < 2; ++b)
#pragma unroll
                for (int m = 0; m < 4; ++m)
#pragma unroll
                    for (int n = 0; n < 2; ++n) acc[a][b][m][n] = (f32x4){0.f, 0.f, 0.f, 0.f};
        cur = nxt; cA = nA; cB = nB; ++ui;
        if constexpr (ALIGN_EPI) { if (wr == 1) PG8_BAR; }
    }
    PG8_WAIT_V(0);
    if constexpr (!ALIGN_EPI) { if (wr == 0) PG8_BAR; }
    PG8_BAR;
    if constexpr (Epi::AFTER_DRAIN) { E.fused(acc, cur, wr, wc, fr, fq, lds, wid, lane); S.done(cur); }
#undef PG8_SA
#undef PG8_SB
#undef PG8_STAGE
#undef PG8_LDA
#undef PG8_LDB
#undef PG8_MMA
#undef PG8_WAIT_V
#undef PG8_WAIT_L
#undef PG8_BAR
#undef PG8_SCHED
}
}


#define LAS __attribute__((address_space(3)))
typedef unsigned short bf16;
typedef unsigned v4u __attribute__((ext_vector_type(4)));
typedef unsigned v2u __attribute__((ext_vector_type(2)));
typedef float f32x4 __attribute__((ext_vector_type(4)));
typedef float f32x16 __attribute__((ext_vector_type(16)));
typedef short bf16x8 __attribute__((ext_vector_type(8)));

constexpr int T_TOK = 32768, DM = 1024, SEQ = 4096, NBATCH = 8;
constexpr int PW = 3584;
constexpr int IN_W = 3532;
constexpr int C_AQ = 0, C_AKV = 1024, C_IQ = 1152, C_IK = 1408, C_IW = 1472, C_BA = 1476, C_BB = 1480, C_BQ = 1536, C_BK = 2048, C_BV = 2560, C_BZ = 3072;
constexpr int YW = 1536;
constexpr int NCHUNK = 2048;
constexpr float EPS = 1e-6f;

constexpr size_t MiB = 1u << 20;
constexpr size_t WS_CTL = 0;
constexpr size_t WS_MOD = 1 * MiB;
constexpr size_t WS_GL = WS_MOD + 256 * 1024;
constexpr size_t WS_SU = WS_MOD + 512 * 1024;
constexpr size_t WS_SV = WS_MOD + 640 * 1024;
constexpr size_t WS_WIN = 2 * MiB;
constexpr size_t WS_BT2 = 9 * MiB;
constexpr size_t WS_WQ = 12 * MiB;
constexpr size_t WS_SUBK = 16 * MiB;
constexpr size_t WS_H = 18 * MiB;
constexpr size_t WS_KN = WS_H;
constexpr size_t WS_SEL = WS_H + 8 * MiB;
constexpr size_t WS_PROJ = 82 * MiB;
constexpr size_t WS_QUERY = WS_PROJ;
constexpr size_t WS_YAB = 306 * MiB;
constexpr size_t WS_EXPID = WS_YAB;
constexpr size_t WS_GATE = WS_YAB + 16 * MiB;
constexpr size_t WS_H8 = WS_YAB + 32 * MiB;
constexpr size_t WS_HS = WS_YAB + 64 * MiB;
constexpr size_t WS_GA = 402 * MiB;
constexpr size_t WS_UT = 418 * MiB;
constexpr size_t WS_VT = 450 * MiB;
constexpr size_t WS_END = 482 * MiB;
constexpr size_t DO_W = 0, DO_QD = 32 * MiB, DO_KDT = 64 * MiB, DO_UT = 96 * MiB;

constexpr int LDS_BYTES = 147456;

struct Args { const float* in[17]; float* out; unsigned char* ws; int ph_lo, ph_hi; };

__device__ __forceinline__ unsigned pk2(float lo, float hi) { unsigned r; asm("v_cvt_pk_bf16_f32 %0, %1, %2" : "=v"(r) : "v"(lo), "v"(hi)); return r; }
__device__ __forceinline__ unsigned f2bf(float f) { return pk2(f, f) & 0xffffu; }
__device__ __forceinline__ float bflo(unsigned u) { return __uint_as_float(u << 16); }
__device__ __forceinline__ float bfhi(unsigned u) { return __uint_as_float(u & 0xffff0000u); }
__device__ __forceinline__ float bf1(bf16 b) { return __uint_as_float(((unsigned)b) << 16); }
__device__ __forceinline__ float wave_sum(float v) {
#pragma unroll
    for (int o = 1; o < 64; o <<= 1) v += __shfl_xor(v, o);
    return v;
}
__device__ __forceinline__ float wave_max(float v) {
#pragma unroll
    for (int o = 1; o < 64; o <<= 1) v = fmaxf(v, __shfl_xor(v, o));
    return v;
}
__device__ __forceinline__ float silu_f(float v) { return v / (1.f + expf(-v)); }
__device__ __forceinline__ float silu_fast(float v) { return v * __builtin_amdgcn_rcpf(1.f + __expf(-v)); }
__device__ __forceinline__ float sigmoid_f(float v) { return 1.f / (1.f + expf(-v)); }
__device__ __forceinline__ float softplus_f(float v) { return fmaxf(v, 0.f) + log1pf(expf(-fabsf(v))); }
#define LDS_WAIT() asm volatile("s_waitcnt lgkmcnt(0)" ::: "memory")

__device__ __forceinline__ int win_srccol(int n) {
    if (n < 1476) return n;
    if (n < 1480) return 3524 + (n - 1476);
    if (n < 1484) return 3528 + (n - 1480);
    if (n < 1536) return -1;
    return 1476 + (n - 1536);
}
__device__ __forceinline__ void transpose_item(const float* W, int spitch, int k0, int sc, bf16* WT, int dpitch, int drow0, int dcol0, LAS float* scr, int lane) {
    float tv[32];
#pragma unroll
    for (int i = 0; i < 32; ++i) { const int kk = 2 * i + (lane >> 5); tv[i] = W[(size_t)(k0 + kk) * spitch + ((sc >= 0) ? sc : 0)]; }
#pragma unroll
    for (int i = 0; i < 32; ++i) { const int kk = 2 * i + (lane >> 5); scr[kk * 33 + (lane & 31)] = (sc >= 0) ? tv[i] : 0.f; }
    LDS_WAIT();
    const int c = lane & 7;
#pragma unroll
    for (int j = 0; j < 4; ++j) { const int n = (lane >> 3) + 8 * j; const LAS float* s = scr + (8 * c) * 33 + n;
        v4u o; o.x = pk2(s[0 * 33], s[1 * 33]); o.y = pk2(s[2 * 33], s[3 * 33]); o.z = pk2(s[4 * 33], s[5 * 33]); o.w = pk2(s[6 * 33], s[7 * 33]);
        *(v4u*)(WT + (size_t)(drow0 + n) * dpitch + dcol0 + 8 * c) = o; }
    LDS_WAIT();
}

__device__ __forceinline__ void phase0(const Args& a, LAS unsigned char* lds) {
    const int tid = threadIdx.x, lane = tid & 63, wave = tid >> 6, bid = blockIdx.x, G = gridDim.x;
    unsigned char* ws = a.ws;
#ifndef P0_REP
#define P0_REP 0
#endif
    for (int rep0_ = 0; rep0_ < 1 + (P0_REP ? 1 : 0); ++rep0_) {
    if (rep0_ == 0 || (P0_REP & 1))
    for (int item = bid; item < 192; item += G) {
        LAS float* sc = (LAS float*)lds;
        LAS float* red = sc + 8192;
        const float* c = a.in[1];
        for (int i = tid; i < 8192; i += 512) sc[i] = silu_f(c[i]);
        __syncthreads();
        const int cc = tid & 31, kg = tid >> 5;
        const float* w = a.in[2] + item * 32 + cc;
        float acc[8];
#pragma unroll
        for (int b = 0; b < 8; ++b) acc[b] = 0.f;
#pragma unroll 16
        for (int k = kg; k < 1024; k += 16) { const float wv = w[(size_t)k * 6144];
#pragma unroll
            for (int b = 0; b < 8; ++b) acc[b] += sc[b * 1024 + k] * wv; }
#pragma unroll
        for (int b = 0; b < 8; ++b) red[(kg * 8 + b) * 32 + cc] = acc[b];
        __syncthreads();
        if (tid < 256) { const int b = tid >> 5; float s = 0.f;
            for (int k2 = 0; k2 < 16; ++k2) s += red[(k2 * 8 + b) * 32 + cc];
            ((float*)(ws + WS_MOD))[b * 6144 + item * 32 + cc] = s + a.in[3][item * 32 + cc]; }
        __syncthreads();
    }
    if (rep0_ == 0 || (P0_REP & 2)) {
        LAS float* scr = (LAS float*)(lds + 65536 + wave * 8704);
        const int gw = bid * 8 + wave, NGW = G * 8;
        constexpr int I_WIN = 16 * 112, I_WQ = 16 * 64, I_WO = 8 * 32;
        for (int it = gw; it < I_WIN + I_WQ + I_WO; it += NGW) {
            int r = it;
            if (r < I_WIN) { const int kb = r / 112, nb = r % 112; transpose_item(a.in[4], IN_W, 64 * kb, win_srccol(32 * nb + (lane & 31)), (bf16*)(ws + WS_WIN), 1024, 32 * nb, 64 * kb, scr, lane); continue; }
            r -= I_WIN;
            if (r < I_WQ) { const int kb = r / 64, nb = r % 64; transpose_item(a.in[13], 2048, 64 * kb, 32 * nb + (lane & 31), (bf16*)(ws + WS_WQ), 1024, 32 * nb, 64 * kb, scr, lane); continue; }
            r -= I_WQ;
            { const int kb = r / 32, nb = r % 32; transpose_item(a.in[12] + (size_t)512 * 1024, 1024, 64 * kb, 32 * nb + (lane & 31), (bf16*)(ws + WS_BT2), YW, 32 * nb, 1024 + 64 * kb, scr, lane); }
        }
    }
    if (rep0_ == 0 || (P0_REP & 4)) {
        const float* wuv = a.in[7]; const float* wout = a.in[12]; bf16* bt2 = (bf16*)(ws + WS_BT2);
        for (int it = bid * 512 + tid; it < 1024 * 128; it += G * 512) {
            const int n = it & 1023, kb = __builtin_amdgcn_readfirstlane(it >> 10);
            const int h = kb >> 4, r0 = (kb & 15) * 8;
            float acc[8];
#pragma unroll
            for (int j = 0; j < 8; ++j) acc[j] = 0.f;
#pragma unroll 16
            for (int v = 0; v < 64; ++v) { const float wo = wout[(size_t)(h * 64 + v) * 1024 + n];
#pragma unroll
                for (int j = 0; j < 8; ++j) acc[j] += wuv[(size_t)(h * 128 + r0 + j) * 64 + v] * wo; }
            v4u o; o.x = pk2(acc[0], acc[1]); o.y = pk2(acc[2], acc[3]); o.z = pk2(acc[4], acc[5]); o.w = pk2(acc[6], acc[7]);
            *(v4u*)(bt2 + (size_t)n * YW + h * 128 + r0) = o;
        }
    }
    if (rep0_ == 0 || (P0_REP & 8)) {
        const size_t gt = (size_t)bid * 512 + tid, GT = (size_t)G * 512;
        for (size_t i = gt; i < 262144 / 8; i += GT) {
            const f32x4 v0 = *(const f32x4*)(a.in[14] + i * 8), v1 = *(const f32x4*)(a.in[14] + i * 8 + 4);
            v4u o; o.x = pk2(v0.x, v0.y); o.y = pk2(v0.z, v0.w); o.z = pk2(v1.x, v1.y); o.w = pk2(v1.z, v1.w);
            *(v4u*)((bf16*)(ws + WS_SUBK) + i * 8) = o;
        }
        const int gw = bid * 8 + wave, NGW = G * 8;
        f32x4 v[4], vn[4];
        if (gw < 2 * 16384) { const float* s0 = ((gw >> 14) ? a.in[16] : a.in[15]) + (size_t)(gw & 16383) * 1024 + 16 * lane;
#pragma unroll
            for (int q = 0; q < 4; ++q) v[q] = *(const f32x4*)(s0 + 4 * q); }
        for (int row = gw; row < 2 * 16384; row += NGW) {
            const int tb = row >> 14, e = row & 16383;
            { const int rn = (row + NGW < 2 * 16384) ? row + NGW : row;
              const float* sn = ((rn >> 14) ? a.in[16] : a.in[15]) + (size_t)(rn & 16383) * 1024 + 16 * lane;
#pragma unroll
              for (int q = 0; q < 4; ++q) vn[q] = *(const f32x4*)(sn + 4 * q); }
            float mx = 0.f;
#pragma unroll
            for (int q = 0; q < 4; ++q) mx = fmaxf(fmaxf(mx, fmaxf(fabsf(v[q].x), fabsf(v[q].y))), fmaxf(fabsf(v[q].z), fabsf(v[q].w)));
            mx = wave_max(mx);
            const float scale = (mx > 0.f) ? mx * (1.f / 240.f) : 1.f, inv = 1.f / scale;
            v4u o;
#pragma unroll
            for (int q = 0; q < 4; ++q) { int p = __builtin_amdgcn_cvt_pk_fp8_f32(v[q].x * inv, v[q].y * inv, 0, false); p = __builtin_amdgcn_cvt_pk_fp8_f32(v[q].z * inv, v[q].w * inv, p, true); o[q] = (unsigned)p; }
            *(v4u*)(ws + (tb ? WS_VT : WS_UT) + (size_t)e * 1024 + 16 * lane) = o;
            if (lane == 0) ((float*)(ws + (tb ? WS_SV : WS_SU)))[e] = scale;
#pragma unroll
            for (int q = 0; q < 4; ++q) v[q] = vn[q];
        }
    }
    }
}

__device__ __forceinline__ void phase_norm(const float* x, const float* mod, int shift_off, int scale_off, bf16* hout, unsigned char* h8 = nullptr, float* hs = nullptr) {
    const int tid = threadIdx.x, lane = tid & 63, wave = tid >> 6;
    const int gw = blockIdx.x * 8 + wave, NGW = gridDim.x * 8;
    f32x4 v[4], vn[4];
    if (gw < T_TOK) {
#pragma unroll
        for (int j = 0; j < 4; ++j) v[j] = ((const f32x4*)(x + (size_t)gw * DM) + lane)[64 * j];
    }
    for (int m = gw; m < T_TOK; m += NGW) {
        const int b = m >> 12;
        { const int mn = (m + NGW < T_TOK) ? m + NGW : m;
#pragma unroll
          for (int j = 0; j < 4; ++j) vn[j] = ((const f32x4*)(x + (size_t)mn * DM) + lane)[64 * j]; }
        float s = 0.f;
#pragma unroll
        for (int j = 0; j < 4; ++j) s += (v[j].x * v[j].x + v[j].y * v[j].y) + (v[j].z * v[j].z + v[j].w * v[j].w);
        const float inv = rsqrtf(wave_sum(s) * (1.f / DM) + EPS);
        const f32x4* sh = (const f32x4*)(mod + b * 6144 + shift_off) + lane;
        const f32x4* sc = (const f32x4*)(mod + b * 6144 + scale_off) + lane;
        v2u* o8 = (v2u*)(hout + (size_t)m * DM) + lane;
        float amax = 0.f;
#pragma unroll
        for (int j = 0; j < 4; ++j) { const f32x4 a = sh[64 * j], c = sc[64 * j];
            v[j].x = v[j].x * inv * (1.f + c.x) + a.x; v[j].y = v[j].y * inv * (1.f + c.y) + a.y; v[j].z = v[j].z * inv * (1.f + c.z) + a.z; v[j].w = v[j].w * inv * (1.f + c.w) + a.w;
            v2u o; o.x = pk2(v[j].x, v[j].y); o.y = pk2(v[j].z, v[j].w);
            o8[64 * j] = o;
            amax = fmaxf(fmaxf(amax, fmaxf(fabsf(v[j].x), fabsf(v[j].y))), fmaxf(fabsf(v[j].z), fabsf(v[j].w))); }
        if (h8) {
            amax = wave_max(amax);
            const float scale = (amax > 0.f) ? amax * (1.f / 240.f) : 1.f, qi = 1.f / scale;
#pragma unroll
            for (int j = 0; j < 4; ++j) { int p = __builtin_amdgcn_cvt_pk_fp8_f32(v[j].x * qi, v[j].y * qi, 0, false); p = __builtin_amdgcn_cvt_pk_fp8_f32(v[j].z * qi, v[j].w * qi, p, true);
                *(unsigned*)(h8 + (size_t)m * DM + 4 * (lane + 64 * j)) = (unsigned)p; }
            if (lane == 0) hs[m] = scale;
        }
#pragma unroll
        for (int j = 0; j < 4; ++j) v[j] = vn[j];
    }
}

struct EpiX1 {
    static constexpr bool PERM = false, AFTER_DRAIN = false;
    const float* x; float* out; const float* mod;
    __device__ __forceinline__ void operator()(const pg8::f32x4 (&acc)[2][2][4][2], const pg8::Unit& u, int wr, int wc, int fr, int fq) const {
        const int row0 = u.pm * 256 + wr * 64 + fr, col0 = u.pn * 256 + wc * 32 + 4 * fq;
        const int b = (u.pm * 256) >> 12;
        f32x4 gv[2][2];
#pragma unroll
        for (int bj = 0; bj < 2; ++bj)
#pragma unroll
            for (int n = 0; n < 2; ++n) gv[bj][n] = *(const f32x4*)(mod + b * 6144 + 2048 + col0 + bj * 128 + n * 16);
#pragma unroll
        for (int ai = 0; ai < 2; ++ai)
#pragma unroll
            for (int m = 0; m < 4; ++m) { const size_t ro = (size_t)(row0 + ai * 128 + m * 16) * DM + col0;
#pragma unroll
                for (int bj = 0; bj < 2; ++bj)
#pragma unroll
                    for (int n = 0; n < 2; ++n) { const f32x4 xv = *(const f32x4*)(x + ro + bj * 128 + n * 16);
                        *(f32x4*)(out + ro + bj * 128 + n * 16) = xv + gv[bj][n] * acc[ai][bj][m][n]; } }
    }
};
struct EpiBf {
    static constexpr bool PERM = true, AFTER_DRAIN = false;
    bf16* O; int ldc;
    __device__ __forceinline__ void operator()(const pg8::f32x4 (&acc)[2][2][4][2], const pg8::Unit& u, int wr, int wc, int fr, int fq) const {
        const int row0 = u.pm * 256 + wr * 64 + fr, col0 = u.pn * 256 + wc * 32 + 8 * fq;
#pragma unroll
        for (int ai = 0; ai < 2; ++ai)
#pragma unroll
            for (int m = 0; m < 4; ++m) { bf16* rowp = O + (size_t)(row0 + ai * 128 + m * 16) * ldc + col0;
#pragma unroll
                for (int bj = 0; bj < 2; ++bj) { const pg8::f32x4 zz = (pg8::f32x4){0.f, 0.f, 0.f, 0.f}; const pg8::f32x4 v0 = acc[ai][bj][m][0] + zz, v1 = acc[ai][bj][m][1] + zz;
                    v4u w; w.x = pg8::cvt_pk_bf16(v0[0], v0[1]); w.y = pg8::cvt_pk_bf16(v0[2], v0[3]); w.z = pg8::cvt_pk_bf16(v1[0], v1[1]); w.w = pg8::cvt_pk_bf16(v1[2], v1[3]);
                    *(v4u*)(rowp + bj * 128) = w; } }
    }
};

constexpr int GP_QS = 0, GP_KS = 33792, GP_VS = 67584, GP_LS = 101376, GP_GV = 118784;
__device__ __forceinline__ void gdn_prep_item(const Args& a, LAS unsigned char* lds, int chunk) {
    int tid = threadIdx.x; asm volatile("" : "+v"(tid));
    const int lane = tid & 63, wave = __builtin_amdgcn_readfirstlane(tid >> 6);
    unsigned char* ws = a.ws;
    const bf16* proj = (const bf16*)(ws + WS_PROJ);
    const int bh = chunk >> 6, n = chunk & 63, b = bh >> 2, h = bh & 3;
    const int t0 = b * SEQ + n * 64;
    LAS float* QS = (LAS float*)(lds + GP_QS); LAS float* KS = (LAS float*)(lds + GP_KS); LAS float* VS = (LAS float*)(lds + GP_VS);
    LAS float* LS = (LAS float*)(lds + GP_LS); LAS float* GV = (LAS float*)(lds + GP_GV);
#ifndef GP_MASK
#define GP_MASK 31
#endif
#ifndef GP_REP
#define GP_REP 0
#endif
    for (int rep_ = 0; rep_ < 1 + (GP_REP & 1); ++rep_)
    if ((GP_MASK & 1) && tid < 384) {
        const int cg = tid % 48, rs = tid / 48;
        const int sec = cg >> 4, c8 = (cg & 15) * 8;
        const int pcol = C_BQ + sec * 512 + h * 128 + c8;
        const float* cw = a.in[8] + sec * 512 + h * 128 + c8;
        float wt[4][8];
#pragma unroll
        for (int i = 0; i < 4; ++i) { const f32x4 w0 = *(const f32x4*)(cw + i * 1536), w1 = *(const f32x4*)(cw + i * 1536 + 4);
            wt[i][0] = w0.x; wt[i][1] = w0.y; wt[i][2] = w0.z; wt[i][3] = w0.w; wt[i][4] = w1.x; wt[i][5] = w1.y; wt[i][6] = w1.z; wt[i][7] = w1.w; }
        LAS float* XS = (sec == 0) ? QS : (sec == 1 ? KS : VS);
        v4u raw[11];
#pragma unroll
        for (int j = 0; j < 11; ++j) { const int rr = 8 * rs - 3 + j;
            raw[j] = (rr >= 0 || n > 0) ? *(const v4u*)(proj + (size_t)(t0 + rr) * PW + pcol) : (v4u){0u, 0u, 0u, 0u}; }
#pragma unroll
        for (int j = 0; j < 8; ++j) {
            float y[8];
#pragma unroll
            for (int c = 0; c < 8; ++c) y[c] = 0.f;
#pragma unroll
            for (int i = 0; i < 4; ++i) { float xv[8]; const v4u u = raw[j + i];
                xv[0] = bflo(u.x); xv[1] = bfhi(u.x); xv[2] = bflo(u.y); xv[3] = bfhi(u.y); xv[4] = bflo(u.z); xv[5] = bfhi(u.z); xv[6] = bflo(u.w); xv[7] = bfhi(u.w);
#pragma unroll
                for (int c = 0; c < 8; ++c) y[c] += wt[i][c] * xv[c]; }
            f32x4 o0, o1;
            o0.x = silu_fast(y[0]); o0.y = silu_fast(y[1]); o0.z = silu_fast(y[2]); o0.w = silu_fast(y[3]); o1.x = silu_fast(y[4]); o1.y = silu_fast(y[5]); o1.z = silu_fast(y[6]); o1.w = silu_fast(y[7]);
            *(LAS f32x4*)(XS + (8 * rs + j) * 132 + c8) = o0; *(LAS f32x4*)(XS + (8 * rs + j) * 132 + c8 + 4) = o1;
        }
    }
    if (wave == 7) {
        const int i = lane;
        const float av = bf1(proj[(size_t)(t0 + i) * PW + C_BA + h]), bv = bf1(proj[(size_t)(t0 + i) * PW + C_BB + h]);
        const float beta = sigmoid_f(bv);
        const float g = -expf(a.in[9][h]) * softplus_f(av + a.in[10][h]);
        float G = g;
#pragma unroll
        for (int o = 1; o < 64; o <<= 1) { const float t = __shfl_up(G, o); if (lane >= o) G += t; }
        const float Glast = __shfl(G, 63);
        GV[i] = G; GV[64 + i] = expf(G); GV[128 + i] = beta; GV[192 + i] = expf(Glast - G); GV[256 + i] = beta * expf(G);
        if (lane == 0) ((float*)(ws + WS_GL))[chunk] = expf(Glast);
    }
    __syncthreads();
    if (GP_MASK & 2) {
#pragma unroll
        for (int rr = 0; rr < 16; ++rr) {
            const int row = wave * 16 + rr;
            LAS float* X = (row < 64) ? (QS + row * 132) : (KS + (row - 64) * 132);
            const float v0 = X[lane], v1 = X[lane + 64];
            const float ss = wave_sum(v0 * v0 + v1 * v1);
            const float sc = rsqrtf(ss + EPS) * ((row < 64) ? 0.08838834764831845f : 1.f);
            X[lane] = v0 * sc; X[lane + 64] = v1 * sc;
        }
    }
    __syncthreads();
    for (int rep_ = 0; rep_ < 1 + ((GP_REP >> 2) & 1); ++rep_)
    if (GP_MASK & 4) {
        const int gram = wave >> 2, ti = wave & 3, r = lane & 15, g = lane >> 4;
        const LAS float* X = gram ? QS : KS;
        f32x4 acc[4];
#pragma unroll
        for (int tj = 0; tj < 4; ++tj) acc[tj] = (f32x4){0.f, 0.f, 0.f, 0.f};
#pragma unroll 2
        for (int kk = 0; kk < 8; ++kk) {
            const f32x4 xa = *(const LAS f32x4*)(X + (16 * ti + r) * 132 + 16 * kk + 4 * g);
#pragma unroll
            for (int tj = 0; tj < 4; ++tj) {
                if (tj <= ti) {
                    const f32x4 kb = *(const LAS f32x4*)(KS + (16 * tj + r) * 132 + 16 * kk + 4 * g);
                    acc[tj] = __builtin_amdgcn_mfma_f32_16x16x4f32(xa.x, kb.x, acc[tj], 0, 0, 0);
                    acc[tj] = __builtin_amdgcn_mfma_f32_16x16x4f32(xa.y, kb.y, acc[tj], 0, 0, 0);
                    acc[tj] = __builtin_amdgcn_mfma_f32_16x16x4f32(xa.z, kb.z, acc[tj], 0, 0, 0);
                    acc[tj] = __builtin_amdgcn_mfma_f32_16x16x4f32(xa.w, kb.w, acc[tj], 0, 0, 0);
                }
            }
        }
        bf16* Aout = (bf16*)(ws + WS_GA) + (size_t)chunk * 4096;
#pragma unroll
        for (int tj = 0; tj < 4; ++tj)
#pragma unroll
            for (int rg = 0; rg < 4; ++rg) {
                const int i = 16 * ti + 4 * g + rg, j = 16 * tj + r;
                const float dec = (j <= i) ? __expf(GV[i] - GV[j]) : 0.f;
                if (gram == 0) { if (tj <= ti) LS[i * 68 + j] = (j < i) ? GV[128 + i] * acc[tj][rg] * dec : 0.f; }
                else Aout[((((i >> 4) * 2 + (j >> 5)) * 64 + (i & 15) + 16 * ((j >> 3) & 3)) << 3) + (j & 7)] = (bf16)f2bf((tj <= ti) ? acc[tj][rg] * dec : 0.f);
            }
    }
    __syncthreads();
    {
        bf16* QD = (bf16*)((unsigned char*)a.out + DO_QD) + (size_t)chunk * 8192;
        bf16* KDT = (bf16*)((unsigned char*)a.out + DO_KDT) + (size_t)chunk * 8192;
#pragma unroll
        for (int m = 0; m < 2; ++m) {
            const int p = tid + 512 * m;
            { const int i = p >> 4, k8 = (p & 15) * 8; const float e = GV[64 + i]; const LAS float* sq = QS + i * 132 + k8;
              v4u o; o.x = pk2(sq[0] * e, sq[1] * e); o.y = pk2(sq[2] * e, sq[3] * e); o.z = pk2(sq[4] * e, sq[5] * e); o.w = pk2(sq[6] * e, sq[7] * e);
              *(v4u*)(QD + ((((i >> 4) * 4 + ((p & 15) >> 2)) * 64 + (i & 15) + 16 * (p & 3)) << 3)) = o; }
            { const int k = p >> 3, i8 = (p & 7) * 8; float v[8];
#pragma unroll
              for (int j = 0; j < 8; ++j) v[j] = KS[(i8 + j) * 132 + k] * GV[192 + i8 + j];
              v4u o; o.x = pk2(v[0], v[1]); o.y = pk2(v[2], v[3]); o.z = pk2(v[4], v[5]); o.w = pk2(v[6], v[7]);
              *(v4u*)(KDT + ((((k >> 4) * 2 + ((p & 7) >> 2)) * 64 + (k & 15) + 16 * (p & 3)) << 3)) = o; }
        }
    }
    __syncthreads();
    {
#pragma unroll
        for (int m = 0; m < 4; ++m) {
            const int p = tid + 512 * m, i = p >> 5, c4 = (p & 31) * 4;
            const float mu = GV[128 + i], mw = GV[256 + i];
            f32x4 v = *(LAS f32x4*)(VS + i * 132 + c4); v.x *= mu; v.y *= mu; v.z *= mu; v.w *= mu; *(LAS f32x4*)(VS + i * 132 + c4) = v;
            f32x4 k = *(LAS f32x4*)(KS + i * 132 + c4); k.x *= mw; k.y *= mw; k.z *= mw; k.w *= mw; *(LAS f32x4*)(KS + i * 132 + c4) = k;
        }
    }
    __syncthreads();
    {
        const int r = lane & 15, g = lane >> 4;
#pragma unroll 1
        for (int I = 0; I < 4; ++I) {
            if (I > 0) {
#pragma unroll
                for (int tt = 0; tt < 2; ++tt) {
                    const int ct = 2 * wave + tt;
                    LAS float* XB = ((ct < 8) ? VS : KS) + (ct & 7) * 16 + r;
                    f32x4 acc;
#pragma unroll
                    for (int rg = 0; rg < 4; ++rg) acc[rg] = XB[(16 * I + 4 * g + rg) * 132];
                    for (int J = 0; J < I; ++J) {
#pragma unroll
                        for (int ks = 0; ks < 4; ++ks) {
                            const float la = -LS[(16 * I + r) * 68 + 16 * J + 4 * ks + g];
                            const float xb = XB[(16 * J + 4 * ks + g) * 132];
                            acc = __builtin_amdgcn_mfma_f32_16x16x4f32(la, xb, acc, 0, 0, 0);
                        }
                    }
#pragma unroll
                    for (int rg = 0; rg < 4; ++rg) XB[(16 * I + 4 * g + rg) * 132] = acc[rg];
                }
                __syncthreads();
            }
            if (tid < 256) {
                LAS float* XC = ((tid < 128) ? VS : KS) + (tid & 127);
                float x[16];
#pragma unroll
                for (int rr = 0; rr < 16; ++rr) {
                    float a0 = XC[(16 * I + rr) * 132], a1 = 0.f, a2 = 0.f, a3 = 0.f;
#pragma unroll
                    for (int j4 = 0; j4 < (rr + 3) / 4; ++j4) {
                        const f32x4 l = *(const LAS f32x4*)(LS + (16 * I + rr) * 68 + 16 * I + 4 * j4);
                        if (4 * j4 + 0 < rr) a0 -= l.x * x[4 * j4 + 0];
                        if (4 * j4 + 1 < rr) a1 -= l.y * x[4 * j4 + 1];
                        if (4 * j4 + 2 < rr) a2 -= l.z * x[4 * j4 + 2];
                        if (4 * j4 + 3 < rr) a3 -= l.w * x[4 * j4 + 3];
                    }
                    x[rr] = (a0 + a1) + (a2 + a3);
                }
#pragma unroll
                for (int rr = 0; rr < 16; ++rr) XC[(16 * I + rr) * 132] = x[rr];
            }
            __syncthreads();
        }
    }
    {
        bf16* W = (bf16*)((unsigned char*)a.out + DO_W) + (size_t)chunk * 8192;
        bf16* UT = (bf16*)((unsigned char*)a.out + DO_UT) + (size_t)chunk * 8192;
#pragma unroll
        for (int m = 0; m < 2; ++m) {
            const int p = tid + 512 * m, i = p >> 4, k8 = p & 15;
            const f32x4 x0 = *(const LAS f32x4*)(KS + i * 132 + 8 * k8), x1 = *(const LAS f32x4*)(KS + i * 132 + 8 * k8 + 4);
            v4u o; o.x = pk2(x0.x, x0.y); o.y = pk2(x0.z, x0.w); o.z = pk2(x1.x, x1.y); o.w = pk2(x1.z, x1.w);
            *(v4u*)(W + ((((i >> 4) * 4 + (k8 >> 2)) * 64 + (i & 15) + 16 * (k8 & 3)) << 3)) = o;
        }
#pragma unroll
        for (int m = 0; m < 4; ++m) {
            const int p = tid + 512 * m, v = p & 127, q = p >> 7;
            v2u o; o.x = pk2(VS[(4 * q) * 132 + v], VS[(4 * q + 1) * 132 + v]); o.y = pk2(VS[(4 * q + 2) * 132 + v], VS[(4 * q + 3) * 132 + v]);
            *(v2u*)(UT + ((((q >> 2) * 8 + (v >> 4)) * 64 + (v & 15) + 16 * (q & 3)) << 2)) = o;
        }
    }
    __syncthreads();
}

__device__ __forceinline__ void kn_item(const Args& a, int item) {
    const int tid = threadIdx.x, lane = tid & 63, wave = tid >> 6;
    const bf16* proj = (const bf16*)(a.ws + WS_PROJ); bf16* KN = (bf16*)(a.ws + WS_KN);
    const float g0 = a.in[6][2 * lane], g1 = a.in[6][2 * lane + 1];
    unsigned u[16];
#pragma unroll
    for (int rr = 0; rr < 16; ++rr) u[rr] = *(const unsigned*)(proj + (size_t)(item * 128 + wave * 16 + rr) * PW + C_AKV + 2 * lane);
#pragma unroll
    for (int rr = 0; rr < 16; ++rr) {
        const int t = item * 128 + wave * 16 + rr;
        const float v0 = bflo(u[rr]), v1 = bfhi(u[rr]);
        const float inv = rsqrtf(wave_sum(v0 * v0 + v1 * v1) * (1.f / 128.f) + EPS);
        *(unsigned*)(KN + (size_t)t * 128 + 2 * lane) = pk2(v0 * inv * g0, v1 * inv * g1);
    }
}


#ifdef IDX_FP32
__device__ __forceinline__ void phase_idx32(const Args& a, LAS unsigned char* lds) {
    const int tid = threadIdx.x, lane = tid & 63, wave = tid >> 6;
    LAS float* HS = (LAS float*)lds;
    float* IDX32 = (float*)(a.ws + WS_YAB);
    const float* mod = (const float*)(a.ws + WS_MOD);
    for (int tile = blockIdx.x; tile < 1024; tile += gridDim.x) {
        const int t0 = tile * 32, b = t0 >> 12;
        for (int rr = 0; rr < 4; ++rr) {
            const int m = t0 + wave * 4 + rr;
            const f32x4* xr = (const f32x4*)(a.in[0] + (size_t)m * DM) + lane;
            f32x4 v[4]; float s = 0.f;
#pragma unroll
            for (int j = 0; j < 4; ++j) { v[j] = xr[64 * j]; s += (v[j].x * v[j].x + v[j].y * v[j].y) + (v[j].z * v[j].z + v[j].w * v[j].w); }
            const float inv = rsqrtf(wave_sum(s) * (1.f / DM) + EPS);
            const f32x4* sh = (const f32x4*)(mod + b * 6144) + lane; const f32x4* sc = (const f32x4*)(mod + b * 6144 + 1024) + lane;
#pragma unroll
            for (int j = 0; j < 4; ++j) { const f32x4 aa = sh[64 * j], c = sc[64 * j];
                f32x4 o; o.x = v[j].x * inv * (1.f + c.x) + aa.x; o.y = v[j].y * inv * (1.f + c.y) + aa.y; o.z = v[j].z * inv * (1.f + c.z) + aa.z; o.w = v[j].w * inv * (1.f + c.w) + aa.w;
                *(LAS f32x4*)(HS + (wave * 4 + rr) * 1028 + 4 * (lane + 64 * j)) = o; }
        }
        __syncthreads();
        if (tid < 324) {
            const float* w = a.in[4] + 1152 + tid;
            float acc[32];
#pragma unroll
            for (int t = 0; t < 32; ++t) acc[t] = 0.f;
            for (int k4 = 0; k4 < 256; ++k4) {
                const float w0 = w[(size_t)(4 * k4) * IN_W], w1 = w[(size_t)(4 * k4 + 1) * IN_W], w2 = w[(size_t)(4 * k4 + 2) * IN_W], w3 = w[(size_t)(4 * k4 + 3) * IN_W];
#pragma unroll
                for (int t = 0; t < 32; ++t) { const f32x4 hv = *(const LAS f32x4*)(HS + t * 1028 + 4 * k4); acc[t] += hv.x * w0 + hv.y * w1 + hv.z * w2 + hv.w * w3; }
            }
#pragma unroll
            for (int t = 0; t < 32; ++t) IDX32[(size_t)(t0 + t) * 384 + tid] = acc[t];
        }
        __syncthreads();
    }
}
#endif
__device__ __forceinline__ unsigned sortable(float f) { const unsigned u = __float_as_uint(f + 0.f); return (u & 0x80000000u) ? ~u : (u | 0x80000000u); }
__device__ __forceinline__ int wave_sum_dpp(int x) {
    x += __builtin_amdgcn_update_dpp(0, x, 0xB1, 0xF, 0xF, false);
    x += __builtin_amdgcn_update_dpp(0, x, 0x4E, 0xF, 0xF, false);
    x += __builtin_amdgcn_update_dpp(0, x, 0x141, 0xF, 0xF, false);
    x += __builtin_amdgcn_update_dpp(0, x, 0x140, 0xF, 0xF, false);
    return __builtin_amdgcn_readlane(x, 0) + __builtin_amdgcn_readlane(x, 16) + __builtin_amdgcn_readlane(x, 32) + __builtin_amdgcn_readlane(x, 48);
}
#define CNT8(OP, acc_, k_, s_, c_) asm("v_cmp_" OP "_u32 s[36:37], %1, %9\n\tv_cmp_" OP "_u32 s[38:39], %2, %9\n\tv_cmp_" OP "_u32 s[40:41], %3, %9\n\tv_cmp_" OP "_u32 s[42:43], %4, %9\n\t" \
        "v_cmp_" OP "_u32 s[44:45], %5, %9\n\tv_cmp_" OP "_u32 s[46:47], %6, %9\n\tv_cmp_" OP "_u32 s[48:49], %7, %9\n\tv_cmp_" OP "_u32 s[50:51], %8, %9\n\t" \
        "v_addc_co_u32 %0, s[36:37], 0, %0, s[36:37]\n\tv_addc_co_u32 %0, s[38:39], 0, %0, s[38:39]\n\tv_addc_co_u32 %0, s[40:41], 0, %0, s[40:41]\n\tv_addc_co_u32 %0, s[42:43], 0, %0, s[42:43]\n\t" \
        "v_addc_co_u32 %0, s[44:45], 0, %0, s[44:45]\n\tv_addc_co_u32 %0, s[46:47], 0, %0, s[46:47]\n\tv_addc_co_u32 %0, s[48:49], 0, %0, s[48:49]\n\tv_addc_co_u32 %0, s[50:51], 0, %0, s[50:51]" \
        : "+v"(acc_) : "v"(k_[(s_)]), "v"(k_[(s_) + 1]), "v"(k_[(s_) + 2]), "v"(k_[(s_) + 3]), "v"(k_[(s_) + 4]), "v"(k_[(s_) + 5]), "v"(k_[(s_) + 6]), "v"(k_[(s_) + 7]), "v"(c_) \
        : "s36", "s37", "s38", "s39", "s40", "s41", "s42", "s43", "s44", "s45", "s46", "s47", "s48", "s49", "s50", "s51")
__device__ __forceinline__ unsigned wave_umin_dpp(unsigned x) {
    x = min(x, (unsigned)__builtin_amdgcn_update_dpp((int)x, (int)x, 0xB1, 0xF, 0xF, false));
    x = min(x, (unsigned)__builtin_amdgcn_update_dpp((int)x, (int)x, 0x4E, 0xF, 0xF, false));
    x = min(x, (unsigned)__builtin_amdgcn_update_dpp((int)x, (int)x, 0x141, 0xF, 0xF, false));
    x = min(x, (unsigned)__builtin_amdgcn_update_dpp((int)x, (int)x, 0x140, 0xF, 0xF, false));
    return min(min((unsigned)__builtin_amdgcn_readlane((int)x, 0), (unsigned)__builtin_amdgcn_readlane((int)x, 16)), min((unsigned)__builtin_amdgcn_readlane((int)x, 32), (unsigned)__builtin_amdgcn_readlane((int)x, 48)));
}
__device__ __forceinline__ unsigned wave_umax_dpp(unsigned x) {
    x = max(x, (unsigned)__builtin_amdgcn_update_dpp((int)x, (int)x, 0xB1, 0xF, 0xF, false));
    x = max(x, (unsigned)__builtin_amdgcn_update_dpp((int)x, (int)x, 0x4E, 0xF, 0xF, false));
    x = max(x, (unsigned)__builtin_amdgcn_update_dpp((int)x, (int)x, 0x141, 0xF, 0xF, false));
    x = max(x, (unsigned)__builtin_amdgcn_update_dpp((int)x, (int)x, 0x140, 0xF, 0xF, false));
    return max(max((unsigned)__builtin_amdgcn_readlane((int)x, 0), (unsigned)__builtin_amdgcn_readlane((int)x, 16)), max((unsigned)__builtin_amdgcn_readlane((int)x, 32), (unsigned)__builtin_amdgcn_readlane((int)x, 48)));
}
template <int NS> __device__ __forceinline__ void topk_select(const LAS float* row, LAS unsigned char* stage, int n, int lane, unsigned short* out) {
    asm volatile("" : "+v"(lane));
    unsigned key[NS];
#pragma unroll
    for (int s = 0; s < NS; ++s) key[s] = __float_as_uint(row[s * 64 + lane]);
#pragma unroll
    for (int s = 0; s < NS; ++s) { const int idx = s * 64 + lane; const unsigned k = sortable(__uint_as_float(key[s])); key[s] = (s < NS - 16 || idx < n) ? k : 0u; }
    LAS unsigned short* sel_l = (LAS unsigned short*)stage;
    LAS unsigned* cq = (LAS unsigned*)(stage + 640);
    const int dmy = 256 + lane;
    unsigned thr; int bit;
    {
        unsigned m0 = key[0], m1 = key[1], m2 = key[2], m3 = key[3];
#pragma unroll
        for (int s = 4; s < NS; s += 4) { m0 = max(m0, key[s]); m1 = max(m1, key[s + 1]); m2 = max(m2, key[s + 2]); m3 = max(m3, key[s + 3]); }
        const unsigned lo = (unsigned)__builtin_amdgcn_readfirstlane((int)wave_umin_dpp(min(min(m0, m1), min(m2, m3)))), hi = (unsigned)__builtin_amdgcn_readfirstlane((int)wave_umax_dpp(max(max(m0, m1), max(m2, m3))));
        const unsigned x = lo ^ hi;
        bit = 31 - __builtin_clz(x | 1u); if (x == 0u) bit = -1;
        thr = (bit >= 31) ? 0u : (hi & ~((2u << bit) - 1u));
    }
    int cthr = NS * 64, cU = 0;
    bool exact = false;
    if (bit >= 20) {
        unsigned pk[NS / 2];
#pragma unroll
        for (int i = 0; i < NS / 2; ++i) pk[i] = ((key[2 * i + 1] >> 4) & 0x0FFF0000u) | (key[2 * i] >> 20);
        for (; bit >= 20; --bit) {
            if (cthr - cU <= 256) break;
            const unsigned cand = thr | (1u << bit), c12 = cand >> 20;
            const unsigned cc = (c12 | (c12 << 16)) - 0x10001000u;
            unsigned a0 = 0u, a1 = 0u;
#pragma unroll
            for (int i = 0; i < NS / 2; i += 2) { a0 = __builtin_amdgcn_udot8(pk[i] - cc, 0x10001000u, a0, false); a1 = __builtin_amdgcn_udot8(pk[i + 1] - cc, 0x10001000u, a1, false); }
            const int cnt = wave_sum_dpp((int)(a0 + a1));
            if (cnt >= 256) { thr = cand; cthr = cnt; } else cU = cnt;
            if (cnt == 256) { exact = true; break; }
        }
    }
    if (!exact) for (; bit >= 0; --bit) {
        if (cthr - cU <= 256) break;
        const unsigned cand = thr | (1u << bit);
        int c0 = 0, c1 = 0;
#pragma unroll
        for (int s = 0; s < NS; s += 16) { CNT8("ge", c0, key, s, cand); CNT8("ge", c1, key, s + 8, cand); }
        const int cnt = wave_sum_dpp(c0 + c1);
        if (cnt >= 256) { thr = cand; cthr = cnt; } else cU = cnt;
        if (cnt == 256) { exact = true; break; }
    }
    int cgt = 0, ceq = 0;
    if (!exact) {
        if (bit >= 0) {
            const int sh = bit + 1;
            int pos = 0;
#pragma unroll
            for (int s = 0; s < NS; ++s) {
                const bool act = ((key[s] ^ thr) >> sh) == 0u;
                const unsigned long long mt = __builtin_amdgcn_ballot_w64(act);
                const int at = __builtin_amdgcn_mbcnt_hi((unsigned)(mt >> 32), __builtin_amdgcn_mbcnt_lo((unsigned)mt, pos));
                cq[act ? at : dmy] = key[s];
                pos += __builtin_popcountll(mt);
            }
            LDS_WAIT();
            unsigned ck[4];
#pragma unroll
            for (int j = 0; j < 4; ++j) ck[j] = cq[64 * j + lane];
#pragma unroll
            for (int j = 0; j < 4; ++j) ck[j] = (64 * j + lane < pos) ? ck[j] : 0u;
            for (; bit >= 0; --bit) {
                const unsigned cand = thr | (1u << bit);
                int cnt = cU;
#pragma unroll
                for (int j = 0; j < 4; ++j) cnt += __builtin_popcountll(__builtin_amdgcn_ballot_w64(ck[j] >= cand));
                if (cnt >= 256) thr = cand;
                if (cnt == 256) { exact = true; break; }
            }
            if (!exact) {
                cgt = cU;
#pragma unroll
                for (int j = 0; j < 4; ++j) { cgt += __builtin_popcountll(__builtin_amdgcn_ballot_w64(ck[j] > thr)); ceq += __builtin_popcountll(__builtin_amdgcn_ballot_w64(ck[j] == thr)); }
            }
        } else {
            int g0 = 0, e0 = 0;
#pragma unroll
            for (int s = 0; s < NS; s += 8) { CNT8("gt", g0, key, s, thr); CNT8("eq", e0, key, s, thr); }
            cgt = wave_sum_dpp(g0); ceq = wave_sum_dpp(e0);
        }
    }
    const int need_eq = 256 - cgt;
    asm volatile("" : "+v"(thr));
    asm volatile("" : "+v"(lane));
    int pos_out = 0;
    if (exact || ceq == need_eq) {
#pragma unroll
        for (int s = 0; s < NS; ++s) {
            const bool take = key[s] >= thr;
            const unsigned long long mt = __builtin_amdgcn_ballot_w64(take);
            const int pre = __builtin_amdgcn_mbcnt_hi((unsigned)(mt >> 32), __builtin_amdgcn_mbcnt_lo((unsigned)mt, 0));
            sel_l[take ? pos_out + pre : dmy] = (unsigned short)(s * 64 + lane);
            pos_out += __builtin_popcountll(mt);
        }
    } else {
        const unsigned long long ltmask = (1ull << lane) - 1ull;
        int eq_seen = 0;
#pragma unroll
        for (int s = 0; s < NS; ++s) {
            const bool gt = key[s] > thr, eq = key[s] == thr;
            const unsigned long long meq = __builtin_amdgcn_ballot_w64(eq);
            const bool take = gt || (eq && (eq_seen + __builtin_popcountll(meq & ltmask) < need_eq));
            const unsigned long long mt = __builtin_amdgcn_ballot_w64(take);
            if (take) sel_l[pos_out + __builtin_popcountll(mt & ltmask)] = (unsigned short)(s * 64 + lane);
            pos_out += __builtin_popcountll(mt); eq_seen += __builtin_popcountll(meq);
            if ((s & 3) == 3) __builtin_amdgcn_sched_barrier(0);
        }
    }
    LDS_WAIT();
    *(v2u*)(out + 4 * lane) = *(const LAS v2u*)(sel_l + 4 * lane);
}
struct IdxPre { bf16x8 af[4]; v2u wqr[4]; bf16x8 bfr[4][4]; };
__device__ __forceinline__ void idx_issue(const Args& a, int b, int qblk, int wave, int lane, IdxPre& P) {
    const bf16* proj = (const bf16*)(a.ws + WS_PROJ);
    const int p0 = qblk * 8, r = lane & 31, hh = lane >> 5;
    const size_t rowb = (size_t)b * SEQ;
    if (p0 + 7 < 256) return;
    { const bf16* qp = proj + (rowb + p0 + (r & 7)) * PW + C_IQ + (r >> 3) * 64 + 32 * hh;
#pragma unroll
      for (int s = 0; s < 4; ++s) P.af[s] = *(const bf16x8*)(qp + 8 * s); }
#pragma unroll
    for (int i = 0; i < 4; ++i) P.wqr[i] = *(const v2u*)(proj + (rowb + p0 + 4 * hh + i) * PW + C_IW);
    const int ntiles = (p0 + 7) / 32 + 1;
#pragma unroll
    for (int u = 0; u < 4; ++u) {
        const int kt = (wave + 8 * u < ntiles) ? wave + 8 * u : 0;
        const bf16* kp = proj + (rowb + (size_t)kt * 32 + r) * PW + C_IK + 32 * hh;
#pragma unroll
        for (int s = 0; s < 4; ++s) P.bfr[u][s] = *(const bf16x8*)(kp + 8 * s);
    }
}
__device__ __forceinline__ void indexer_item(const Args& a, LAS unsigned char* lds, int b, int qblk, IdxPre& P, bool has_next, int b_next, int qblk_next) {
    int tid = threadIdx.x; asm volatile("" : "+v"(tid));
    const int lane = tid & 63, wave = __builtin_amdgcn_readfirstlane(tid >> 6);
    const bf16* proj = (const bf16*)(a.ws + WS_PROJ);
    unsigned short* SEL = (unsigned short*)(a.ws + WS_SEL);
    LAS float* SC = (LAS float*)lds;
    const int p0 = qblk * 8;
    const int r = lane & 31, hh = lane >> 5;
    const size_t rowb = (size_t)b * SEQ;
#ifdef IDX_FP32
    if (p0 + 7 >= 256) {
        const float* IDX32 = (const float*)(a.ws + WS_YAB);
        LAS float* IQS = (LAS float*)(lds + 131072);
        for (int i = tid; i < 2048; i += 512) IQS[i] = IDX32[(rowb + p0 + (i >> 8)) * 384 + (i & 255)];
        float wq8[8][4];
#pragma unroll
        for (int q = 0; q < 8; ++q)
#pragma unroll
            for (int hd = 0; hd < 4; ++hd) wq8[q][hd] = IDX32[(rowb + p0 + q) * 384 + 320 + hd];
        __syncthreads();
        for (int s = tid; s <= p0 + 7; s += 512) {
            float kf[64];
#pragma unroll
            for (int d4 = 0; d4 < 16; ++d4) { const f32x4 v = *(const f32x4*)(IDX32 + (rowb + s) * 384 + 256 + 4 * d4); kf[4 * d4] = v.x; kf[4 * d4 + 1] = v.y; kf[4 * d4 + 2] = v.z; kf[4 * d4 + 3] = v.w; }
#pragma unroll 1
            for (int q = 0; q < 8; ++q) {
                float sc = 0.f;
#pragma unroll
                for (int hd = 0; hd < 4; ++hd) {
                    float lg = 0.f;
#pragma unroll
                    for (int d4 = 0; d4 < 16; ++d4) { const f32x4 qv = *(const LAS f32x4*)(IQS + q * 256 + hd * 64 + 4 * d4); lg += kf[4 * d4] * qv.x + kf[4 * d4 + 1] * qv.y + kf[4 * d4 + 2] * qv.z + kf[4 * d4 + 3] * qv.w; }
                    sc += fmaxf(lg, 0.f) * wq8[q][hd];
                }
                SC[q * 4096 + s] = sc * 0.0625f;
            }
        }
    }
#else
    if (p0 + 7 >= 256) {
        float wq[4][4];
#pragma unroll
        for (int i = 0; i < 4; ++i) { wq[i][0] = bflo(P.wqr[i].x) * 0.0625f; wq[i][1] = bfhi(P.wqr[i].x) * 0.0625f; wq[i][2] = bflo(P.wqr[i].y) * 0.0625f; wq[i][3] = bfhi(P.wqr[i].y) * 0.0625f; }
        const int ntiles = (p0 + 7) / 32 + 1;
        for (int kt0 = wave; kt0 < ntiles; kt0 += 32) {
            bf16x8 nxt[4][4];
            const bool more = kt0 + 32 < ntiles;
            if (more) {
#pragma unroll
                for (int u = 0; u < 4; ++u) {
                    const int kt = (kt0 + 32 + 8 * u < ntiles) ? kt0 + 32 + 8 * u : kt0;
                    const bf16* kp = proj + (rowb + (size_t)kt * 32 + r) * PW + C_IK + 32 * hh;
#pragma unroll
                    for (int s = 0; s < 4; ++s) nxt[u][s] = *(const bf16x8*)(kp + 8 * s);
                }
            }
#pragma unroll
            for (int u = 0; u < 4; ++u) {
                const int kt = kt0 + 8 * u;
                if (kt < ntiles) {
                    f32x16 acc;
#pragma unroll
                    for (int i = 0; i < 16; ++i) acc[i] = 0.f;
#pragma unroll
                    for (int s = 0; s < 4; ++s) acc = __builtin_amdgcn_mfma_f32_32x32x16_bf16(P.af[s], P.bfr[u][s], acc, 0, 0, 0);
#pragma unroll
                    for (int i = 0; i < 4; ++i) {
                        float s = 0.f;
#pragma unroll
                        for (int hd = 0; hd < 4; ++hd) s += wq[i][hd] * fmaxf(acc[i + 4 * hd], 0.f);
                        SC[(4 * hh + i) * 4096 + kt * 32 + r] = s;
                    }
                }
            }
            if (more) {
#pragma unroll
                for (int u = 0; u < 4; ++u)
#pragma unroll
                    for (int s = 0; s < 4; ++s) P.bfr[u][s] = nxt[u][s];
            }
        }
    }
#endif
    __syncthreads();
#ifndef IDX_FP32
    if (has_next) idx_issue(a, b_next, qblk_next, wave, lane, P);
#endif
    {
        const int pos = p0 + wave, n = pos + 1;
        unsigned short* out = SEL + (rowb + pos) * 256;
        if (n <= 256) {
#pragma unroll
            for (int q = 0; q < 4; ++q) { const int j = lane + 64 * q; out[j] = (unsigned short)((j < n) ? j : 0xFFFF); }
        } else {
            LAS float* row = SC + wave * 4096;
            const int nslots = (n + 63) >> 6;
#ifndef IDX_REP_SELECT
#define IDX_REP_SELECT 1
#endif
            LAS unsigned char* stage = lds + 131072 + wave * 2040;
            for (int rep_ = 0; rep_ < IDX_REP_SELECT; ++rep_) {
            if (nslots <= 16) topk_select<16>(row, stage, n, lane, out);
            else if (nslots <= 32) topk_select<32>(row, stage, n, lane, out);
            else if (nslots <= 48) topk_select<48>(row, stage, n, lane, out);
            else topk_select<64>(row, stage, n, lane, out);
            }
        }
    }
    __syncthreads();
}

__device__ __forceinline__ void phase3(const Args& a, LAS unsigned char* lds) {
    const int bid = blockIdx.x, G = gridDim.x;
#ifndef P3_MASK
#define P3_MASK 7
#endif
#ifndef P3_REP
#define P3_REP 0
#endif
    if (P3_MASK & 1) for (int it = bid; it < 2048; it += G) { gdn_prep_item(a, lds, it); if (P3_REP & 1) gdn_prep_item(a, lds, it); }
    if (P3_MASK & 2) {
#define IDX_MAP(j_, bb_, qb_) do { if (G == 256) { const int i_ = (j_) / G, c_ = (j_) % G, q0_ = (c_ >> 3) + 32 * (i_ >> 1); bb_ = c_ & 7; qb_ = (i_ & 1) ? 511 - q0_ : q0_; } else { bb_ = (j_) >> 9; qb_ = (j_) & 511; } } while (0)
        IdxPre P;
        const int tid_ = threadIdx.x, lane_ = tid_ & 63, wave_ = __builtin_amdgcn_readfirstlane(tid_ >> 6);
        int bb, qb;
        if (bid < 4096) { IDX_MAP(bid, bb, qb); idx_issue(a, bb, qb, wave_, lane_, P); }
        for (int j = bid; j < 4096; j += G) {
            IDX_MAP(j, bb, qb);
            int bn = 0, qn = 0; const bool hn = (j + G < 4096);
            if (hn) IDX_MAP(j + G, bn, qn);
            indexer_item(a, lds, bb, qb, P, hn, bn, qn);
            if (P3_REP & 2) { idx_issue(a, bb, qb, wave_, lane_, P); indexer_item(a, lds, bb, qb, P, false, 0, 0); if (hn) idx_issue(a, bn, qn, wave_, lane_, P); }
        }
#undef IDX_MAP
    }
    if (P3_MASK & 4) for (int it = bid; it < 256; it += G) kn_item(a, it);
}

constexpr int SC_ST = 0, SC_VNT = 34816, SC_O = 53248;
__device__ __forceinline__ v2u pack4(float a, float b, float c, float d) { v2u o; o.x = pk2(a, b); o.y = pk2(c, d); return o; }
__device__ __forceinline__ void scan_epilogue(const LAS float* OS, const v4u z0, const v4u z1, const LAS float* gainl, bf16* ydst, int tid) {
    const int row = tid >> 3, seg = tid & 7;
    float o[16];
#pragma unroll
    for (int q = 0; q < 4; ++q) { const f32x4 v = *(const LAS f32x4*)(OS + row * 132 + 16 * seg + 4 * q); o[4 * q] = v.x; o[4 * q + 1] = v.y; o[4 * q + 2] = v.z; o[4 * q + 3] = v.w; }
    float ss = 0.f;
#pragma unroll
    for (int i = 0; i < 16; ++i) ss += o[i] * o[i];
    ss += __shfl_xor(ss, 1); ss += __shfl_xor(ss, 2); ss += __shfl_xor(ss, 4);
    const float inv = rsqrtf(ss * (1.f / 128.f) + EPS);
    float z[16];
    z[0] = bflo(z0.x); z[1] = bfhi(z0.x); z[2] = bflo(z0.y); z[3] = bfhi(z0.y); z[4] = bflo(z0.z); z[5] = bfhi(z0.z); z[6] = bflo(z0.w); z[7] = bfhi(z0.w);
    z[8] = bflo(z1.x); z[9] = bfhi(z1.x); z[10] = bflo(z1.y); z[11] = bfhi(z1.y); z[12] = bflo(z1.z); z[13] = bfhi(z1.z); z[14] = bflo(z1.w); z[15] = bfhi(z1.w);
    float y[16];
#pragma unroll
    for (int q = 0; q < 4; ++q) { const f32x4 gq = *(const LAS f32x4*)(gainl + 16 * seg + 4 * q);
        y[4 * q] = o[4 * q] * inv * gq.x * silu_fast(z[4 * q]); y[4 * q + 1] = o[4 * q + 1] * inv * gq.y * silu_fast(z[4 * q + 1]); y[4 * q + 2] = o[4 * q + 2] * inv * gq.z * silu_fast(z[4 * q + 2]); y[4 * q + 3] = o[4 * q + 3] * inv * gq.w * silu_fast(z[4 * q + 3]); }
    v4u w0, w1;
    w0.x = pk2(y[0], y[1]); w0.y = pk2(y[2], y[3]); w0.z = pk2(y[4], y[5]); w0.w = pk2(y[6], y[7]);
    w1.x = pk2(y[8], y[9]); w1.y = pk2(y[10], y[11]); w1.z = pk2(y[12], y[13]); w1.w = pk2(y[14], y[15]);
    *(v4u*)(ydst) = w0; *(v4u*)(ydst + 8) = w1;
}
__device__ __forceinline__ void gdn_scan(const Args& a, LAS unsigned char* lds, int bh) {
    const int tid = threadIdx.x, lane = tid & 63, w = __builtin_amdgcn_readfirstlane(tid >> 6), r = lane & 15, g = lane >> 4;
    const int b = bh >> 2, h = bh & 3;
    LAS bf16* ST = (LAS bf16*)(lds + SC_ST); LAS bf16* VNT = (LAS bf16*)(lds + SC_VNT); LAS float* OS = (LAS float*)(lds + SC_O);
    const bf16* proj = (const bf16*)(a.ws + WS_PROJ); bf16* yab = (bf16*)(a.ws + WS_YAB);
    const float* GL = (const float*)(a.ws + WS_GL);
    for (int i = tid; i < 34816 / 4; i += 512) ((LAS unsigned*)ST)[i] = 0u;
    f32x4 S[8];
#pragma unroll
    for (int vt = 0; vt < 8; ++vt) S[vt] = (f32x4){0.f, 0.f, 0.f, 0.f};
    const int erow = tid >> 3, eseg = tid & 7;
    LAS float* gainl = (LAS float*)(lds + 87040);
    if (tid < 128) gainl[tid] = a.in[11][tid];
    const int ct = w & 3;
    const size_t cb = (size_t)bh * 64;
    const bf16* Wb = (const bf16*)((const unsigned char*)a.out + DO_W) + cb * 8192;
    const bf16* QDb = (const bf16*)((const unsigned char*)a.out + DO_QD) + cb * 8192;
    const bf16* KDTb = (const bf16*)((const unsigned char*)a.out + DO_KDT) + cb * 8192;
    const bf16* UTb = (const bf16*)((const unsigned char*)a.out + DO_UT) + cb * 8192;
    const bf16* Ab = (const bf16*)(a.ws + WS_GA) + cb * 4096;
    const bf16* Xb = (w < 4) ? Wb : QDb;
    const size_t tz = ((size_t)b * SEQ + erow) * PW + C_BZ + h * 128 + 16 * eseg;
    const size_t ty = ((size_t)b * SEQ + erow) * YW + 1024 + h * 128 + 16 * eseg;
    bf16x8 af[4], kd[2]; v4u xr[4]; float gl; v4u zh0, zh1;
#define SCAN_LOAD(n_, af_, kd_, xr_, gl_) do { \
        const bf16* X_ = Xb + (size_t)(n_) * 8192 + (ct * 4 * 64 + lane) * 8; \
        _Pragma("unroll") for (int ks = 0; ks < 4; ++ks) af_[ks] = *(const bf16x8*)(X_ + ks * 512); \
        const bf16* K_ = KDTb + (size_t)(n_) * 8192 + (w * 2 * 64 + lane) * 8; \
        kd_[0] = *(const bf16x8*)(K_); kd_[1] = *(const bf16x8*)(K_ + 512); \
        if (w >= 4) { const bf16* A_ = Ab + (size_t)(n_) * 4096 + (ct * 2 * 64 + lane) * 8; xr_[0] = *(const v4u*)(A_); xr_[1] = *(const v4u*)(A_ + 512); } \
        else { const bf16* U_ = UTb + (size_t)(n_) * 8192 + (ct * 8 * 64 + lane) * 4; _Pragma("unroll") for (int q_ = 0; q_ < 4; ++q_) { const v2u u0_ = *(const v2u*)(U_ + (2 * q_) * 256), u1_ = *(const v2u*)(U_ + (2 * q_ + 1) * 256); xr_[q_] = (v4u){u0_.x, u0_.y, u1_.x, u1_.y}; } } \
        gl_ = GL[cb + (n_)]; } while (0)
    SCAN_LOAD(0, af, kd, xr, gl);
    zh0 = (v4u){0u, 0u, 0u, 0u}; zh1 = zh0;
    __syncthreads();
    for (int n = 0; n < 64; ++n) {
        bf16x8 afn[4], kdn[2]; v4u xrn[4]; float gln;
        const int nn = (n < 63) ? n + 1 : 63;
        SCAN_LOAD(nn, afn, kdn, xrn, gln);
        const v4u zn0 = *(const v4u*)(proj + tz + (size_t)n * 64 * PW), zn1 = *(const v4u*)(proj + tz + (size_t)n * 64 * PW + 8);
        if (n > 0) scan_epilogue(OS, zh0, zh1, gainl, yab + ty + (size_t)(n - 1) * 64 * YW, tid);
        zh0 = zn0; zh1 = zn1;
        f32x4 acc[8];
#pragma unroll
        for (int vt = 0; vt < 8; ++vt) acc[vt] = (f32x4){0.f, 0.f, 0.f, 0.f};
#pragma unroll
        for (int ks = 0; ks < 4; ++ks) {
#pragma unroll
            for (int vt = 0; vt < 8; ++vt) {
                const bf16x8 bfr = *(const LAS bf16x8*)(ST + (16 * vt + r) * 136 + 32 * ks + 8 * g);
                acc[vt] = __builtin_amdgcn_mfma_f32_16x16x32_bf16(af[ks], bfr, acc[vt], 0, 0, 0);
            }
        }
        if (w < 4) {
#pragma unroll
            for (int vt = 0; vt < 8; ++vt) {
                const unsigned ux = (vt & 1) ? xr[vt >> 1].z : xr[vt >> 1].x, uy = (vt & 1) ? xr[vt >> 1].w : xr[vt >> 1].y;
                const v2u o = pack4(bflo(ux) - acc[vt][0], bfhi(ux) - acc[vt][1], bflo(uy) - acc[vt][2], bfhi(uy) - acc[vt][3]);
                *(LAS v2u*)(VNT + (16 * vt + r) * 72 + 16 * ct + 4 * g) = o;
            }
        }
        __syncthreads();
        if (w >= 4) {
#pragma unroll
            for (int ks = 0; ks < 2; ++ks)
#pragma unroll
                for (int vt = 0; vt < 8; ++vt) {
                    const bf16x8 vb = *(const LAS bf16x8*)(VNT + (16 * vt + r) * 72 + 32 * ks + 8 * g);
                    acc[vt] = __builtin_amdgcn_mfma_f32_16x16x32_bf16(__builtin_bit_cast(bf16x8, xr[ks]), vb, acc[vt], 0, 0, 0);
                }
#pragma unroll
            for (int vt = 0; vt < 8; ++vt)
#pragma unroll
                for (int rg = 0; rg < 4; ++rg) OS[(16 * ct + 4 * g + rg) * 132 + 16 * vt + r] = acc[vt][rg];
        }
#pragma unroll
        for (int vt = 0; vt < 8; ++vt) S[vt] = S[vt] * gl;
#pragma unroll
        for (int ks = 0; ks < 2; ++ks)
#pragma unroll
            for (int vt = 0; vt < 8; ++vt) {
                const bf16x8 vb = *(const LAS bf16x8*)(VNT + (16 * vt + r) * 72 + 32 * ks + 8 * g);
                S[vt] = __builtin_amdgcn_mfma_f32_16x16x32_bf16(kd[ks], vb, S[vt], 0, 0, 0);
            }
#pragma unroll
        for (int vt = 0; vt < 8; ++vt)
            *(LAS v2u*)(ST + (16 * vt + r) * 136 + 16 * w + 4 * g) = pack4(S[vt][0] + 0.f, S[vt][1] + 0.f, S[vt][2] + 0.f, S[vt][3] + 0.f);
#pragma unroll
        for (int ks = 0; ks < 4; ++ks) af[ks] = afn[ks];
        kd[0] = kdn[0]; kd[1] = kdn[1];
#pragma unroll
        for (int q = 0; q < 4; ++q) xr[q] = xrn[q];
        gl = gln;
        __syncthreads();
    }
    scan_epilogue(OS, zh0, zh1, gainl, yab + ty + (size_t)63 * 64 * YW, tid);
    __syncthreads();
#undef SCAN_LOAD
}

typedef short v4s __attribute__((ext_vector_type(4)));
constexpr int AQ_STRIDE = 272, AQ_WAVE_LDS = 64 * AQ_STRIDE + 512;
__device__ __forceinline__ void attn_query_q4(const Args& a, LAS unsigned char* wl, const LAS float* qgl, int t, int lane) {
    const bf16* proj = (const bf16*)(a.ws + WS_PROJ); const bf16* KN = (const bf16*)(a.ws + WS_KN);
    const unsigned short* SEL = (const unsigned short*)(a.ws + WS_SEL); bf16* yab = (bf16*)(a.ws + WS_YAB);
    LAS unsigned char* KT = wl; LAS unsigned short* SL = (LAS unsigned short*)(wl + 64 * AQ_STRIDE);
    const int r = lane & 15, g = lane >> 4;
    const int b = t >> 12, pos = t & 4095;
    const bf16* knb = KN + (size_t)b * SEQ * 128;
    *(LAS v2u*)(SL + 4 * lane) = *(const v2u*)(SEL + (size_t)t * 256 + 4 * lane);
    bf16x8 qf[4];
    {
        const bf16* qp = proj + (size_t)t * PW + C_AQ + (r & 7) * 128 + 8 * g;
        float f[32]; float ss = 0.f;
#pragma unroll
        for (int ks = 0; ks < 4; ++ks) { const v4u raw = *(const v4u*)(qp + 32 * ks);
            f[8 * ks] = bflo(raw.x); f[8 * ks + 1] = bfhi(raw.x); f[8 * ks + 2] = bflo(raw.y); f[8 * ks + 3] = bfhi(raw.y); f[8 * ks + 4] = bflo(raw.z); f[8 * ks + 5] = bfhi(raw.z); f[8 * ks + 6] = bflo(raw.w); f[8 * ks + 7] = bfhi(raw.w); }
#pragma unroll
        for (int i = 0; i < 32; ++i) ss += f[i] * f[i];
        ss += __shfl_xor(ss, 16); ss += __shfl_xor(ss, 32);
        float inv = rsqrtf(ss * (1.f / 128.f) + EPS) * 0.08838834764831845f;
        if (r >= 8) inv = 0.f;
#pragma unroll
        for (int ks = 0; ks < 4; ++ks) { const f32x4 ga = *(const LAS f32x4*)(qgl + 32 * ks + 8 * g), gb = *(const LAS f32x4*)(qgl + 32 * ks + 8 * g + 4);
            v4u o; o.x = pk2(f[8 * ks] * inv * ga.x, f[8 * ks + 1] * inv * ga.y); o.y = pk2(f[8 * ks + 2] * inv * ga.z, f[8 * ks + 3] * inv * ga.w);
            o.z = pk2(f[8 * ks + 4] * inv * gb.x, f[8 * ks + 5] * inv * gb.y); o.w = pk2(f[8 * ks + 6] * inv * gb.z, f[8 * ks + 7] * inv * gb.w);
            qf[ks] = __builtin_bit_cast(bf16x8, o); }
    }
    LDS_WAIT();
    const int cnt = (pos + 1 < 256) ? pos + 1 : 256, nq = (cnt + 63) >> 6;
    const float slope = exp2f(-(float)((r & 7) + 1));
    float m_run = -INFINITY, l_run = 0.f;
    f32x4 O[8];
#pragma unroll
    for (int dt = 0; dt < 8; ++dt) O[dt] = (f32x4){0.f, 0.f, 0.f, 0.f};
    bf16x8 ka[4][4], kb[4][4];
#define AQ_LOAD(q_, k_) do { _Pragma("unroll") for (int kt = 0; kt < 4; ++kt) { int ix_ = SL[64 * (q_) + 16 * kt + r]; ix_ = (ix_ == 0xFFFF) ? 0 : ix_; \
        const bf16* kp_ = knb + (size_t)ix_ * 128 + 8 * g; _Pragma("unroll") for (int ks = 0; ks < 4; ++ks) k_[kt][ks] = *(const bf16x8*)(kp_ + 32 * ks); } } while (0)
#define AQ_PASS(q_, k_) do { \
        f32x4 sc[4]; \
        _Pragma("unroll") for (int kt = 0; kt < 4; ++kt) { f32x4 acc = (f32x4){0.f, 0.f, 0.f, 0.f}; \
            _Pragma("unroll") for (int ks = 0; ks < 4; ++ks) { acc = __builtin_amdgcn_mfma_f32_16x16x32_bf16(k_[kt][ks], qf[ks], acc, 0, 0, 0); \
                *(LAS bf16x8*)(KT + (16 * kt + r) * AQ_STRIDE + (32 * ks + 8 * g) * 2) = k_[kt][ks]; } \
            sc[kt] = acc; } \
        float m = m_run; \
        _Pragma("unroll") for (int kt = 0; kt < 4; ++kt) { const v2u s4 = *(const LAS v2u*)(SL + 64 * (q_) + 16 * kt + 4 * g); \
            const int i0 = s4.x & 0xFFFF, i1 = s4.x >> 16, i2 = s4.y & 0xFFFF, i3 = s4.y >> 16; \
            sc[kt][0] = (i0 != 0xFFFF) ? sc[kt][0] - slope * (float)(pos - i0) : -INFINITY; sc[kt][1] = (i1 != 0xFFFF) ? sc[kt][1] - slope * (float)(pos - i1) : -INFINITY; \
            sc[kt][2] = (i2 != 0xFFFF) ? sc[kt][2] - slope * (float)(pos - i2) : -INFINITY; sc[kt][3] = (i3 != 0xFFFF) ? sc[kt][3] - slope * (float)(pos - i3) : -INFINITY; \
            m = fmaxf(fmaxf(m, fmaxf(sc[kt][0], sc[kt][1])), fmaxf(sc[kt][2], sc[kt][3])); } \
        m = fmaxf(m, __shfl_xor(m, 16)); m = fmaxf(m, __shfl_xor(m, 32)); \
        const float alpha = __expf(m_run - m); \
        float ls = 0.f; \
        _Pragma("unroll") for (int kt = 0; kt < 4; ++kt) _Pragma("unroll") for (int rg = 0; rg < 4; ++rg) { const float e = __expf(sc[kt][rg] - m); sc[kt][rg] = e; ls += e; } \
        ls += __shfl_xor(ls, 16); ls += __shfl_xor(ls, 32); \
        l_run = l_run * alpha + ls; m_run = m; \
        _Pragma("unroll") for (int rg = 0; rg < 4; ++rg) { const float ah = __shfl(alpha, 4 * g + rg); _Pragma("unroll") for (int dt = 0; dt < 8; ++dt) O[dt][rg] *= ah; } \
        _Pragma("unroll") for (int c = 0; c < 2; ++c) { v4u o_; o_.x = pk2(sc[2 * c][0], sc[2 * c][1]); o_.y = pk2(sc[2 * c][2], sc[2 * c][3]); o_.z = pk2(sc[2 * c + 1][0], sc[2 * c + 1][1]); o_.w = pk2(sc[2 * c + 1][2], sc[2 * c + 1][3]); \
            const bf16x8 pa = __builtin_bit_cast(bf16x8, o_); \
            _Pragma("unroll") for (int dt = 0; dt < 8; ++dt) { \
                const v4s b0 = __builtin_amdgcn_ds_read_tr16_b64_v4i16((LAS v4s*)(tb + (32 * c) * AQ_STRIDE + 32 * dt)); \
                const v4s b1 = __builtin_amdgcn_ds_read_tr16_b64_v4i16((LAS v4s*)(tb + (32 * c + 16) * AQ_STRIDE + 32 * dt)); \
                const bf16x8 bfr = __builtin_shufflevector(b0, b1, 0, 1, 2, 3, 4, 5, 6, 7); \
                O[dt] = __builtin_amdgcn_mfma_f32_16x16x32_bf16(pa, bfr, O[dt], 0, 0, 0); } } \
        __builtin_amdgcn_sched_barrier(0); } while (0)
    const LAS unsigned char* tb = KT + (4 * g + (r >> 2)) * AQ_STRIDE + 8 * (r & 3);
    AQ_LOAD(0, ka);
    AQ_LOAD(1, kb);
    AQ_PASS(0, ka);
    AQ_LOAD(2, ka);
    if (nq > 1) AQ_PASS(1, kb);
    AQ_LOAD(3, kb);
    if (nq > 2) AQ_PASS(2, ka);
    if (nq > 3) AQ_PASS(3, kb);
#undef AQ_LOAD
#undef AQ_PASS
    const float il = 1.f / l_run;
    if (true) {
        float ih[4];
#pragma unroll
        for (int rg = 0; rg < 4; ++rg) ih[rg] = __shfl(il, 4 * g + rg);
        if (g < 2) {
#pragma unroll
            for (int rg = 0; rg < 4; ++rg)
#pragma unroll
                for (int dt = 0; dt < 8; ++dt) yab[(size_t)t * YW + (4 * g + rg) * 128 + 16 * dt + r] = (bf16)f2bf(O[dt][rg] * ih[rg]);
        }
    }
    LDS_WAIT();
}

__device__ __forceinline__ void phase4(const Args& a, LAS unsigned char* lds) {
    const int bid = blockIdx.x, G = gridDim.x, tid = threadIdx.x, lane = tid & 63, wave = tid >> 6;
    const int nscan = (G >= 64) ? 32 : 0;
#ifndef P4_REP
#define P4_REP 0
#endif
    if (nscan && bid < 32) { gdn_scan(a, lds, bid); if (P4_REP & 1) { __syncthreads(); gdn_scan(a, lds, bid); } return; }
    if (!nscan) { for (int bh = bid; bh < 32; bh += G) gdn_scan(a, lds, bh); __syncthreads(); }
    LAS float* qg4 = (LAS float*)(lds + 8 * AQ_WAVE_LDS);
    if (tid < 128) qg4[tid] = a.in[5][tid];
    __syncthreads();
    LAS unsigned char* wl4 = lds + wave * AQ_WAVE_LDS;
    if (nscan == 32 && (G & 7) == 0) {
        const int bb = bid & 7, wl_i = ((bid - 32) >> 3) * 8 + wave, nwl = ((G - 32) >> 3) * 8;
        for (int p = wl_i; p < SEQ; p += nwl) attn_query_q4(a, wl4, qg4, bb * SEQ + p, lane);
        if (P4_REP & 2) for (int p = wl_i; p < SEQ; p += nwl) attn_query_q4(a, wl4, qg4, bb * SEQ + p, lane);
    } else {
        const int gw = (bid - nscan) * 8 + wave, NGW = (G - nscan) * 8;
        for (int t = gw; t < T_TOK; t += NGW) attn_query_q4(a, wl4, qg4, t, lane);
    }
}

#define INS16P(L, v_) do { float _x = (v_); \
    _Pragma("unroll") for (int _k = 0; _k < 16; ++_k) { const float _h = __builtin_fmaxf(L[_k], _x); _x = __builtin_fminf(L[_k], _x); L[_k] = _h; } } while (0)
#define CE_D(a_, b_) do { const float _h = __builtin_fmaxf(a_, b_), _l = __builtin_fminf(a_, b_); a_ = _h; b_ = _l; } while (0)
#define SORT16_DESC(A) do { \
    _Pragma("unroll") for (int k_ = 2; k_ <= 16; k_ <<= 1) \
    _Pragma("unroll") for (int j_ = k_ >> 1; j_ > 0; j_ >>= 1) \
    _Pragma("unroll") for (int i_ = 0; i_ < 16; ++i_) { const int l_ = i_ ^ j_; if (l_ > i_) { if ((i_ & k_) == 0) CE_D(A[i_], A[l_]); else CE_D(A[l_], A[i_]); } } } while (0)
#define MERGE16_TOP(L, B) do { \
    _Pragma("unroll") for (int i_ = 0; i_ < 16; ++i_) L[i_] = __builtin_fmaxf(L[i_], B[15 - i_]); \
    _Pragma("unroll") for (int j_ = 8; j_ > 0; j_ >>= 1) \
    _Pragma("unroll") for (int i_ = 0; i_ < 16; ++i_) { const int l_ = i_ ^ j_; if (l_ > i_) CE_D(L[i_], L[l_]); } } while (0)
__device__ __forceinline__ float packf(float v, unsigned id, unsigned mask) { return __uint_as_float((__float_as_uint(v) & ~mask) | id); }

__device__ __forceinline__ void peer_route_unit(const Args& a, LAS float* SC, int tt, int p, int lane) {
    const bf16* query = (const bf16*)(a.ws + WS_QUERY); const bf16* subk = (const bf16*)(a.ws + WS_SUBK);
    int* expid = (int*)(a.ws + WS_EXPID); float* gate = (float*)(a.ws + WS_GATE);
    const int r = lane & 15, g = lane >> 4;
    const int tok = lane & 31, ch = lane >> 5;
    float L1[16], L2[16];
#pragma unroll
    for (int k = 0; k < 16; ++k) { L1[k] = 0.f; L2[k] = 0.f; }
#pragma unroll 1
    for (int half = 0; half < 2; ++half) {
        bf16x8 bk[8][4];
        {
            const bf16* kp = subk + (size_t)((p * 2 + half) * 128 + r) * 128 + 8 * g;
#pragma unroll
            for (int nt = 0; nt < 8; ++nt)
#pragma unroll
                for (int ks = 0; ks < 4; ++ks) bk[nt][ks] = *(const bf16x8*)(kp + (size_t)nt * 16 * 128 + 32 * ks);
        }
        bf16x8 af[2][4];
#pragma unroll
        for (int mt = 0; mt < 2; ++mt) {
            const bf16* qp = query + (size_t)(tt * 32 + mt * 16 + r) * 2048 + p * 256 + half * 128 + 8 * g;
#pragma unroll
            for (int ks = 0; ks < 4; ++ks) af[mt][ks] = *(const bf16x8*)(qp + 32 * ks);
        }
#pragma unroll
        for (int mt = 0; mt < 2; ++mt) {
#pragma unroll
            for (int nt = 0; nt < 8; ++nt) {
                f32x4 acc = (f32x4){0.f, 0.f, 0.f, 0.f};
#pragma unroll
                for (int ks = 0; ks < 4; ++ks) acc = __builtin_amdgcn_mfma_f32_16x16x32_bf16(af[mt][ks], bk[nt][ks], acc, 0, 0, 0);
#pragma unroll
                for (int rg = 0; rg < 4; ++rg) SC[(mt * 16 + 4 * g + rg) * 132 + nt * 16 + r] = acc[rg];
            }
        }
        LDS_WAIT();
        float L[16];
#pragma unroll
        for (int c16 = 0; c16 < 4; ++c16) {
            float B[16];
#pragma unroll
            for (int c4 = 0; c4 < 4; ++c4) {
                const f32x4 v = *(const LAS f32x4*)(SC + tok * 132 + 64 * ch + 16 * c16 + 4 * c4);
                const unsigned n0 = 64 * ch + 16 * c16 + 4 * c4;
                B[4 * c4] = packf(v.x, n0, 127u); B[4 * c4 + 1] = packf(v.y, n0 + 1, 127u); B[4 * c4 + 2] = packf(v.z, n0 + 2, 127u); B[4 * c4 + 3] = packf(v.w, n0 + 3, 127u);
            }
            SORT16_DESC(B);
            if (c16 == 0) {
#pragma unroll
                for (int k = 0; k < 16; ++k) L[k] = B[k];
            } else MERGE16_TOP(L, B);
        }
        {
            float B[16];
#pragma unroll
            for (int k = 0; k < 16; ++k) B[k] = __shfl(L[k], tok + 32);
            MERGE16_TOP(L, B);
        }
#pragma unroll
        for (int k = 0; k < 16; ++k) { L1[k] = (half == 0) ? L[k] : L1[k]; L2[k] = (half == 0) ? L2[k] : L[k]; }
        LDS_WAIT();
    }
    float V1[16], V2[16];
#pragma unroll
    for (int k = 0; k < 16; ++k) { V1[k] = __uint_as_float(__float_as_uint(L1[k]) & ~127u); V2[k] = __uint_as_float(__float_as_uint(L2[k]) & ~127u); }
    float C[16];
#pragma unroll
    for (int k = 0; k < 16; ++k) C[k] = -INFINITY;
#pragma unroll
    for (int i = 0; i < 16; ++i)
#pragma unroll
        for (int j = 0; j < 16; ++j)
            if ((i + 1) * (j + 1) <= 16) INS16P(C, packf(V1[i] + V2[j], (unsigned)(i * 16 + j), 255u));
    if (ch == 0) {
        float e[16], sum = 0.f; int ex[16];
        const float c0 = __uint_as_float(__float_as_uint(C[0]) & ~255u);
#pragma unroll
        for (int k = 0; k < 16; ++k) {
            const unsigned cb = __float_as_uint(C[k]); const int ci = (cb >> 4) & 15, cj = cb & 15;
            int i1 = 0, i2 = 0;
#pragma unroll
            for (int m = 0; m < 16; ++m) { i1 = (ci == m) ? (int)(__float_as_uint(L1[m]) & 127u) : i1; i2 = (cj == m) ? (int)(__float_as_uint(L2[m]) & 127u) : i2; }
            ex[k] = i1 * 128 + i2;
            e[k] = __expf(__uint_as_float(cb & ~255u) - c0); sum += e[k];
        }
        const float inv = 1.f / sum;
        const size_t base = ((size_t)(tt * 32 + tok) * 8 + p) * 16;
#pragma unroll
        for (int q = 0; q < 4; ++q) {
            *(v4u*)(expid + base + 4 * q) = (v4u){(unsigned)ex[4 * q], (unsigned)ex[4 * q + 1], (unsigned)ex[4 * q + 2], (unsigned)ex[4 * q + 3]};
            *(f32x4*)(gate + base + 4 * q) = (f32x4){e[4 * q] * inv, e[4 * q + 1] * inv, e[4 * q + 2] * inv, e[4 * q + 3] * inv};
        }
    }
}
__device__ __forceinline__ void phase8(const Args& a, LAS unsigned char* lds) {
    const int tid = threadIdx.x, lane = tid & 63, wave = tid >> 6;
    LAS float* SC = (LAS float*)(lds + wave * 16896);
    const int gw = blockIdx.x * 8 + wave, NGW = gridDim.x * 8;
#ifndef P8_REP
#define P8_REP 1
#endif
    for (int rep_ = 0; rep_ < P8_REP; ++rep_)
    for (int u = gw; u < 1024 * 8; u += NGW) peer_route_unit(a, SC, u >> 3, u & 7, lane);
}

typedef float f32x2 __attribute__((ext_vector_type(2)));
__device__ __forceinline__ void cvt8(const v4u u, float* f) { f[0] = bflo(u.x); f[1] = bfhi(u.x); f[2] = bflo(u.y); f[3] = bfhi(u.y); f[4] = bflo(u.z); f[5] = bfhi(u.z); f[6] = bflo(u.w); f[7] = bfhi(u.w); }
__device__ __forceinline__ void cvt16_fp8(const v4u u, float* f) {
#pragma unroll
    for (int q = 0; q < 4; ++q) { const f32x2 lo = __builtin_amdgcn_cvt_pk_f32_fp8((int)u[q], false), hi = __builtin_amdgcn_cvt_pk_f32_fp8((int)u[q], true);
        f[4 * q] = lo.x; f[4 * q + 1] = lo.y; f[4 * q + 2] = hi.x; f[4 * q + 3] = hi.y; }
}
#define DPPF(x_, ctrl_) __builtin_bit_cast(float, __builtin_amdgcn_update_dpp(0, __builtin_bit_cast(int, (x_)), (ctrl_), 0xF, 0xF, false))
__device__ __forceinline__ float reduce8(const float* d, int lane) {
    const bool b0 = lane & 1, b1 = lane & 2, b2 = lane & 4;
    float s1[4], s2[2];
#pragma unroll
    for (int i = 0; i < 4; ++i) { const float a = b0 ? d[2 * i + 1] : d[2 * i], b = b0 ? d[2 * i] : d[2 * i + 1]; s1[i] = a + DPPF(b, 0xB1); }
#pragma unroll
    for (int i = 0; i < 2; ++i) { const float a = b1 ? s1[2 * i + 1] : s1[2 * i], b = b1 ? s1[2 * i] : s1[2 * i + 1]; s2[i] = a + DPPF(b, 0x4E); }
    const float a3 = b2 ? s2[1] : s2[0], b3 = b2 ? s2[0] : s2[1];
    float s = a3 + DPPF(b3, 0x124);
    s += DPPF(s, 0x128);
    s += __shfl_xor(s, 16); s += __shfl_xor(s, 32);
    return s;
}
#ifndef P9L_G
#define P9L_G 8
#endif
constexpr int P9LG = P9L_G, P9LP = 128 + P9LG;
constexpr int P9L_WAVE = 4 * (P9LP * 4 * 3);
#ifndef P9L_SH
#define P9L_SH 12
#endif
constexpr int P9L_NS = 16384 >> P9L_SH;
__device__ __forceinline__ void phase9l(const Args& a, LAS unsigned char* lds) {
    const int tid = threadIdx.x, lane = tid & 63, wave = tid >> 6, G = gridDim.x;
    const unsigned char* UT = a.ws + WS_UT; const unsigned char* VT = a.ws + WS_VT;
    const float* SU = (const float*)(a.ws + WS_SU); const float* SV = (const float*)(a.ws + WS_SV);
    const int* expid = (const int*)(a.ws + WS_EXPID); const float* gate = (const float*)(a.ws + WS_GATE);
    const float* mod = (const float*)(a.ws + WS_MOD);
    LAS int* LE = (LAS int*)(lds + wave * P9L_WAVE);
    LAS float* LG = (LAS float*)(LE + 4 * P9LP);
    LAS float* LA = LG + 4 * P9LP;
    const bool isdiag = (lane >> 4) == ((lane & 15) >> 2);
    for (int rd = 0; ; ++rd) {
        const int tb = ((rd * G + (int)blockIdx.x) * 8 + wave) * 4;
        if (tb >= T_TOK) break;
        v4u h8[4]; float hsc[4]; int off[4][P9L_NS + 1];
#pragma unroll
        for (int i = 0; i < 4; ++i) {
            const size_t t = (size_t)(tb + i);
            h8[i] = *(const v4u*)(a.ws + WS_H8 + t * DM + 16 * lane); hsc[i] = ((const float*)(a.ws + WS_HS))[t];
            int e[2]; float gq[2];
#pragma unroll
            for (int q = 0; q < 2; ++q) { e[q] = expid[t * 128 + lane + 64 * q]; gq[q] = gate[t * 128 + lane + 64 * q]; }
            int base = 0;
#pragma unroll
            for (int s = 0; s < P9L_NS; ++s) {
                off[i][s] = base;
#pragma unroll
                for (int q = 0; q < 2; ++q) {
                    const bool in = (e[q] >> P9L_SH) == s;
                    const unsigned long long mk = __builtin_amdgcn_ballot_w64(in);
                    const int pos = base + __builtin_amdgcn_mbcnt_hi((unsigned)(mk >> 32), __builtin_amdgcn_mbcnt_lo((unsigned)mk, 0));
                    if (in) { LE[i * P9LP + pos] = e[q]; LG[i * P9LP + pos] = gq[q]; }
                    base += __builtin_popcountll(mk);
                }
            }
            off[i][P9L_NS] = 128;
            if (lane < P9LG) LE[i * P9LP + 128 + lane] = e[0];
        }
        LDS_WAIT();
#pragma unroll 1
        for (int s = 0; s < P9L_NS; ++s) {
#pragma unroll
            for (int i = 0; i < 4; ++i) {
                for (int g0 = off[i][s]; g0 < off[i][s + 1]; g0 += P9LG) {
                    const int n = off[i][s + 1] - g0;
                    const int ev = LE[i * P9LP + g0 + (lane & (P9LG - 1))];
                    v4u ua[P9LG];
#pragma unroll
                    for (int k = 0; k < P9LG; ++k) { const int e = __builtin_amdgcn_readlane(ev, k); ua[k] = *(const v4u*)(UT + (size_t)e * 1024 + 16 * lane); }
                    const long hlo = (long)(((unsigned long long)h8[i].y << 32) | h8[i].x), hhi = (long)(((unsigned long long)h8[i].w << 32) | h8[i].z);
#pragma unroll
                    for (int k8 = 0; k8 < P9LG; k8 += 8) {
                        float dd[8];
#pragma unroll
                        for (int k = 0; k < 8; ++k) {
                            f32x4 cacc = (f32x4){0.f, 0.f, 0.f, 0.f};
                            cacc = __builtin_amdgcn_mfma_f32_16x16x32_fp8_fp8((long)(((unsigned long long)ua[k8 + k].y << 32) | ua[k8 + k].x), hlo, cacc, 0, 0, 0);
                            cacc = __builtin_amdgcn_mfma_f32_16x16x32_fp8_fp8((long)(((unsigned long long)ua[k8 + k].w << 32) | ua[k8 + k].z), hhi, cacc, 0, 0, 0);
                            const float c01 = (lane & 1) ? cacc[1] : cacc[0], c23 = (lane & 1) ? cacc[3] : cacc[2];
                            dd[k] = isdiag ? ((lane & 2) ? c23 : c01) : 0.f;
                        }
                        const float tot = reduce8(dd, lane);
                        if (lane < 8 && k8 + lane < n) LA[i * P9LP + g0 + k8 + lane] = tot;
                        __builtin_amdgcn_sched_barrier(0);
                    }
                }
            }
        }
        LDS_WAIT();
#pragma unroll
        for (int i = 0; i < 4; ++i)
#pragma unroll
            for (int q = 0; q < 2; ++q) { const int ix = i * P9LP + lane + 64 * q; const int e = LE[ix];
                const float dq = LA[ix] * SU[e] * hsc[i];
                LA[ix] = 0.5f * dq * (1.f + erff(dq * 0.70710678118654752f)) * LG[ix] * SV[e]; }
        LDS_WAIT();
        float y[4][16];
#pragma unroll
        for (int i = 0; i < 4; ++i)
#pragma unroll
            for (int c = 0; c < 16; ++c) y[i][c] = 0.f;
#pragma unroll 1
        for (int s = 0; s < P9L_NS; ++s) {
#pragma unroll
            for (int i = 0; i < 4; ++i) {
                for (int g0 = off[i][s]; g0 < off[i][s + 1]; g0 += P9LG) {
                    const int n = off[i][s + 1] - g0;
                    const int ev = LE[i * P9LP + g0 + (lane & (P9LG - 1))];
                    const float av = ((lane & (P9LG - 1)) < n) ? LA[i * P9LP + g0 + (lane & (P9LG - 1))] : 0.f;
                    v4u va[P9LG];
#pragma unroll
                    for (int k = 0; k < P9LG; ++k) { const int e = __builtin_amdgcn_readlane(ev, k); va[k] = *(const v4u*)(VT + (size_t)e * 1024 + 16 * lane); }
#pragma unroll
                    for (int k = 0; k < P9LG; ++k) { const float aj = __builtin_bit_cast(float, __builtin_amdgcn_readlane(__builtin_bit_cast(int, av), k));
                        float f[16]; cvt16_fp8(va[k], f);
#pragma unroll
                        for (int c = 0; c < 16; ++c) y[i][c] = __builtin_fmaf(aj, f[c], y[i][c]);
                        if ((k & 3) == 3) __builtin_amdgcn_sched_barrier(0); }
                }
            }
        }
#pragma unroll
        for (int i = 0; i < 4; ++i) {
            const int t = tb + i, b = t >> 12;
            float* orow = a.out + (size_t)t * DM + 16 * lane; const float* g2 = mod + b * 6144 + 5120 + 16 * lane;
#pragma unroll
            for (int q4 = 0; q4 < 4; ++q4) {
                const f32x4 xv = *(const f32x4*)(orow + 4 * q4), gv = *(const f32x4*)(g2 + 4 * q4);
                const f32x4 yv = (f32x4){y[i][4 * q4], y[i][4 * q4 + 1], y[i][4 * q4 + 2], y[i][4 * q4 + 3]};
                *(f32x4*)(orow + 4 * q4) = xv + gv * yv;
            }
        }
        LDS_WAIT();
    }
}

#define XB_TMO      128
#define XB_XCNT(j)  (256  + 64 * (j))
#define XB_XSUB(j)  (1280 + 64 * (j))
#define XB_XGEN(j)  (2304 + 64 * (j))
#define XB_TOP      3328
#define XB_TOPGEN   3392
#define XCD_BAR_WORDS 3456
#define XB_SPIN_CAP (1u << 18)

__device__ __forceinline__ unsigned xb_ld(unsigned* p)              { return __hip_atomic_load(p, __ATOMIC_RELAXED, __HIP_MEMORY_SCOPE_AGENT); }
__device__ __forceinline__ unsigned xb_add(unsigned* p, unsigned v) { return __hip_atomic_fetch_add(p, v, __ATOMIC_RELAXED, __HIP_MEMORY_SCOPE_AGENT); }
__device__ __forceinline__ unsigned xb_xcc_id() { return (unsigned)__builtin_amdgcn_s_getreg((3 << 11) | 20) & 0xFu; }
#define XB_SPIN(cond, bar) do { unsigned _sp = 0; while (cond) { __builtin_amdgcn_s_sleep(1); \
    if ((++_sp & 255u) == 0u) { if (xb_ld(&(bar)[XB_TMO])) break; if (_sp > XB_SPIN_CAP) { atomicAdd(&(bar)[XB_TMO], 1u); break; } } } } while (0)

struct XcdBarrier {
    unsigned* bar; unsigned x;
    volatile LAS unsigned* st;
};

__device__ __forceinline__ XcdBarrier xcd_barrier_post(unsigned* bar, volatile LAS unsigned* st) {
    XcdBarrier b; b.bar = bar; b.x = xb_xcc_id(); b.st = st;
    if (threadIdx.x == 0) (void)xb_add(&bar[XB_XCNT(b.x)], 1u);
    return b;
}
__device__ __forceinline__ void xcd_barrier_complete(unsigned* bar, unsigned x, unsigned& nloc, unsigned& nx) {
    const unsigned G = gridDim.x * gridDim.y * gridDim.z;
    unsigned sum, cnt, mine, sp = 0u;
    for (;;) {
        sum = 0u; cnt = 0u; mine = 0u;
#pragma unroll
        for (unsigned j = 0; j < 16; ++j) { const unsigned c = xb_ld(&bar[XB_XCNT(j)]); sum += c; cnt += (c > 0u) ? 1u : 0u; mine = (j == x) ? c : mine; }
        if (sum == G) break;
        __builtin_amdgcn_s_sleep(1);
        if ((++sp & 255u) == 0u) { if (xb_ld(&bar[XB_TMO])) break; if (sp > XB_SPIN_CAP) { atomicAdd(&bar[XB_TMO], 1u); break; } }
    }
    nloc = mine > 0u ? mine : 1u; nx = cnt > 0u ? cnt : 1u;
}

__device__ __forceinline__ void xcd_barrier(const XcdBarrier& b) {
    asm volatile("s_waitcnt vmcnt(0)" ::: "memory");
    __syncthreads();
    if (threadIdx.x == 0) {
        unsigned* bar = b.bar;
        __builtin_amdgcn_s_waitcnt(0);
        unsigned nloc = b.st[0], nx = b.st[1];
        if (nloc == 0u) { xcd_barrier_complete(bar, b.x, nloc, nx); b.st[0] = nloc; b.st[1] = nx; }
        const unsigned old = xb_add(&bar[XB_XSUB(b.x)], 1u);
        const unsigned gen = old / nloc;
        if (old + 1u == (gen + 1u) * nloc) {
            __builtin_amdgcn_fence(__ATOMIC_RELEASE, "agent");
            asm volatile("s_waitcnt vmcnt(0)" ::: "memory");
            const unsigned og = xb_add(&bar[XB_TOP], 1u);
            const unsigned tg = og / nx;
            if (og + 1u == (tg + 1u) * nx) xb_add(&bar[XB_TOPGEN], 1u);
            else XB_SPIN(xb_ld(&bar[XB_TOPGEN]) == tg, bar);
            __builtin_amdgcn_fence(__ATOMIC_ACQUIRE, "agent");
            xb_add(&bar[XB_XGEN(b.x)], 1u);
            asm volatile("s_waitcnt vmcnt(0)" ::: "memory");
        } else {
            XB_SPIN(xb_ld(&bar[XB_XGEN(b.x)]) == gen, bar);
            __builtin_amdgcn_fence(__ATOMIC_ACQUIRE, "agent");
            asm volatile("s_waitcnt vmcnt(0)" ::: "memory");
        }
    }
    __syncthreads();
}

__global__ void __launch_bounds__(512, 2) mega_fwd(Args a) {
    extern __shared__ __attribute__((aligned(16))) unsigned char lds_raw[];
    LAS unsigned char* lds = (LAS unsigned char*)lds_raw;
    asm volatile("" : "+v"(lds));
    cg::grid_group grid = cg::this_grid();
#define MISC_PTR ((volatile LAS unsigned*)((LAS unsigned char*)lds_raw + (LDS_BYTES - 64)))
    if (threadIdx.x < 16) MISC_PTR[threadIdx.x] = 0u;
    __syncthreads();
    const unsigned xcc_id = xcd_barrier_post((unsigned*)(a.ws + WS_CTL) + 4096, MISC_PTR).x;
    grid.sync();
    unsigned char* ws = a.ws;
    const int lo = a.ph_lo, hi = a.ph_hi;
#ifndef PH_MASK
#define PH_MASK 0x3ff
#endif
#define IN(k) (((PH_MASK >> (k)) & 1) && lo <= (k) && (k) < hi)
#define SEAM(k) do { if (IN(k) && IN((k) + 1)) { if ((k) == 99) grid.sync(); else { XcdBarrier xb_; xb_.bar = (unsigned*)(a.ws + WS_CTL) + 4096; xb_.x = xcc_id; xb_.st = MISC_PTR; xcd_barrier(xb_); } } } while (0)
#ifndef REP_MASK
#define REP_MASK 0
#endif
#define RUNP(k, body) do { if (IN(k)) { body; if ((REP_MASK >> (k)) & 1) { grid.sync(); body; } } } while (0)
    RUNP(0, phase0(a, lds)); SEAM(0);
    RUNP(1, phase_norm(a.in[0], (const float*)(ws + WS_MOD), 0, 1024, (bf16*)(ws + WS_H))); SEAM(1);
    RUNP(2, ({
        pg8::Gemm g{(const pg8::bf16_t*)(ws + WS_H), (const pg8::bf16_t*)(ws + WS_WIN), T_TOK, PW, DM}; pg8::StaticOrder S; S.init(T_TOK, PW, gridDim.x, blockIdx.x);
        EpiBf E{(bf16*)(ws + WS_PROJ), PW};
        pg8::gemm_phase<EpiBf, pg8::StaticOrder, true, true>(lds, g, S, E); })); SEAM(2);
#ifdef IDX_FP32
    if (IN(3)) { phase_idx32(a, lds); grid.sync(); }
#endif
    RUNP(3, phase3(a, lds)); SEAM(3);
    RUNP(4, phase4(a, lds)); SEAM(4);
    RUNP(5, ({
        pg8::Gemm g{(const pg8::bf16_t*)(ws + WS_YAB), (const pg8::bf16_t*)(ws + WS_BT2), T_TOK, DM, YW}; pg8::StaticOrder S; S.init(T_TOK, DM, gridDim.x, blockIdx.x);
        EpiX1 E{a.in[0], a.out, (const float*)(ws + WS_MOD)};
        pg8::gemm_phase<EpiX1, pg8::StaticOrder, true, true>(lds, g, S, E); })); SEAM(5);
    RUNP(6, phase_norm(a.out, (const float*)(ws + WS_MOD), 3072, 4096, (bf16*)(ws + WS_H), ws + WS_H8, (float*)(ws + WS_HS))); SEAM(6);
    RUNP(7, ({
        pg8::Gemm g{(const pg8::bf16_t*)(ws + WS_H), (const pg8::bf16_t*)(ws + WS_WQ), T_TOK, 2048, DM}; pg8::StaticOrder S; S.init(T_TOK, 2048, gridDim.x, blockIdx.x);
        EpiBf E{(bf16*)(ws + WS_QUERY), 2048};
        pg8::gemm_phase<EpiBf, pg8::StaticOrder, true, true>(lds, g, S, E); })); SEAM(7);
    RUNP(8, phase8(a, lds)); SEAM(8);
    if (IN(9)) { phase9l(a, lds); }
#undef IN
#undef SEAM
}

#ifndef MK_N_LAUNCHES
#define MK_N_LAUNCHES 1
#endif
extern "C" void kernel_launch(void* const* d_in, const int* in_sizes, int n_in, void* d_out, int out_size, void* d_ws, size_t ws_size, hipStream_t stream) {
    static int grid = 0;
    if (grid == 0) {
        int dev = 0, cus = 0, per_cu = 0;
        hipGetDevice(&dev);
        hipDeviceGetAttribute(&cus, hipDeviceAttributeMultiprocessorCount, dev);
        hipFuncSetAttribute((const void*)mega_fwd, hipFuncAttributeMaxDynamicSharedMemorySize, LDS_BYTES);
        hipOccupancyMaxActiveBlocksPerMultiprocessor(&per_cu, (const void*)mega_fwd, 512, LDS_BYTES);
        if (per_cu < 1) { fprintf(stderr, "kernel_launch: occupancy query says %d blocks per CU\n", per_cu); per_cu = 1; }
        grid = cus * 1;
        if (n_in != 17 || ws_size < WS_END) fprintf(stderr, "kernel_launch: unexpected n_in %d / ws_size %zu\n", n_in, ws_size);
    }
    (void)hipMemsetAsync((char*)d_ws + WS_CTL, 0, 65536, stream);
    Args a{};
    for (int i = 0; i < 17; ++i) a.in[i] = (const float*)d_in[i];
    a.out = (float*)d_out; a.ws = (unsigned char*)d_ws;
#if MK_N_LAUNCHES == 1
    a.ph_lo = 0; a.ph_hi = 10;
    void* args[] = {&a};
    hipError_t e = hipLaunchCooperativeKernel((const void*)mega_fwd, dim3(grid), dim3(512), args, LDS_BYTES, stream);
    if (e != hipSuccess) fprintf(stderr, "cooperative launch failed: %s (grid %d)\n", hipGetErrorString(e), grid);
#else
    for (int p = 0; p < 10; ++p) { a.ph_lo = p; a.ph_hi = p + 1; hipLaunchKernelGGL(mega_fwd, dim3(grid), dim3(512), LDS_BYTES, stream, a); }
#endif
}
```

```cpp
#include <hip/hip_runtime.h>
#include <hip/hip_cooperative_groups.h>
#include <cstdio>
#include <cstdint>
namespace cg = cooperative_groups;
namespace pg8 {
#define PG8_LAS __attribute__((address_space(3)))
typedef unsigned short bf16_t;
typedef short bf16x8 __attribute__((ext_vector_type(8)));
typedef float f32x4 __attribute__((ext_vector_type(4)));
typedef unsigned u32x4 __attribute__((ext_vector_type(4)));
constexpr int BM = 256, BK = 64, HALF = 128, HTB = HALF * BK * 2  , STAGE_BYTES = 8 * HTB, NXCD = 8, WGM = 8;

__host__ __device__ __forceinline__ int lds_byte(int r, int c) { const int st = (r >> 4) * 2 + (c >> 5), rr = r & 15, cc = c & 31, ob = rr * 64 + cc * 2; return st * 1024 + (ob ^ (((ob >> 9) & 1) << 5)); }
__host__ __device__ __forceinline__ void stage_rc(int b, int& R, int& C) { const int st = b / 1024, sb = b % 1024, swz = sb ^ (((sb >> 9) & 1) << 5); R = (st >> 1) * 16 + swz / 64; C = (st & 1) * 32 + (swz % 64) / 2; }
__host__ __device__ __forceinline__ int perm32(int rho) { const int n = rho >> 4, i = rho & 15; return 8 * (i >> 2) + 4 * n + (i & 3); }

struct Unit { int pm, pn; };
struct Gemm { const bf16_t* A; const bf16_t* Bt; int M, N, K; };

struct StaticOrder {
    int nM, nN, nwg, G, c;
    __host__ __device__ void init(int M, int N, int G_, int c_) { nM = M / BM; nN = N / BM; nwg = nM * nN; G = G_; c = c_; }
    __host__ __device__ bool next(int i, Unit& u) const {
        const long L = (long)i * G + c; if (L >= nwg) return false;
        int wgid = (int)L; { const int q = nwg / NXCD, r = nwg % NXCD, xcd = wgid % NXCD, off = wgid / NXCD; wgid = (xcd < r ? xcd * (q + 1) : r * (q + 1) + (xcd - r) * q) + off; }
        const int nig = WGM * nN, gid = wgid / nig, fm = gid * WGM, gsz = (nM - fm) < WGM ? (nM - fm) : WGM;
        u.pm = fm + ((wgid % nig) % gsz); u.pn = (wgid % nig) / gsz; return true;
    }
    __device__ __forceinline__ void a_ready(const Unit&) const {}
    __device__ __forceinline__ void done(const Unit&) const {}
};
__device__ __forceinline__ unsigned cvt_pk_bf16(float lo, float hi) { unsigned r; asm volatile("v_cvt_pk_bf16_f32 %0, %1, %2" : "=v"(r) : "v"(lo), "v"(hi)); return r; }
template <class Epi, class Sched, bool ALIGN_EPI = false, bool SP2 = false>
__device__ __forceinline__ void gemm_phase(PG8_LAS unsigned char* lds, const Gemm g, const Sched& S, const Epi& E) {
    const int tid = threadIdx.x, wid = __builtin_amdgcn_readfirstlane(tid >> 6), lane = tid & 63, wr = wid >> 2, wc = wid & 3, fr = lane & 15, fq = lane >> 4;
    const int K = g.K, nt = K / BK;
    unsigned voffA[2], voffB[2];
#pragma unroll
    for (int i = 0; i < 2; ++i) { int R, C; stage_rc(tid * 16 + i * 8192, R, C); const int Rb = Epi::PERM ? ((R & ~31) + perm32(R & 31)) : R;
        voffA[i] = (unsigned)(R * K + C) * 2u; voffB[i] = (unsigned)(Rb * K + C) * 2u; }
    const size_t kstep = (size_t)(BK * 2);
    const size_t hstep = (size_t)HALF * K * 2;
    const size_t tstep = 2 * hstep;
    const unsigned ldsw = (unsigned)wid * 1024u;
    const int aoff = lds_byte(wr * 64 + fr, fq * 8), boff = lds_byte(wc * 32 + fr, fq * 8);
#define PG8_SA(b, h) (((b) * 2 + (h)) * HTB)
#define PG8_SB(b, h) ((4 + (b) * 2 + (h)) * HTB)
#define PG8_STAGE(bufoff, gbase, voff) do { _Pragma("unroll") for (int _i = 0; _i < 2; ++_i) \
        __builtin_amdgcn_global_load_lds((const unsigned*)((const char*)(gbase) + (voff)[_i]), (PG8_LAS unsigned*)(lds + (bufoff) + ldsw + _i * 8192), 16, 0, 0); } while (0)
#define PG8_LDA(dst, b, h) do { _Pragma("unroll") for (int m = 0; m < 4; ++m) _Pragma("unroll") for (int k = 0; k < 2; ++k) dst[m][k] = *(const PG8_LAS bf16x8*)(lds + PG8_SA(b, h) + aoff + m * 2048 + k * 1024); } while (0)
#define PG8_LDB(dst, b, h) do { _Pragma("unroll") for (int n = 0; n < 2; ++n) _Pragma("unroll") for (int k = 0; k < 2; ++k) dst[n][k] = *(const PG8_LAS bf16x8*)(lds + PG8_SB(b, h) + boff + n * 2048 + k * 1024); } while (0)
#define PG8_MMA(ai, bj, At, Bt) do { __builtin_amdgcn_s_setprio(1); _Pragma("unroll") for (int m = 0; m < 4; ++m) _Pragma("unroll") for (int n = 0; n < 2; ++n) _Pragma("unroll") for (int k = 0; k < 2; ++k) \
        acc[ai][bj][m][n] = __builtin_amdgcn_mfma_f32_16x16x32_bf16(Bt[n][k], At[m][k], acc[ai][bj][m][n], 0, 0, 0); __builtin_amdgcn_s_setprio(0); } while (0)
#define PG8_WAIT_V(n) asm volatile("s_waitcnt vmcnt(" #n ")" ::: "memory")
#define PG8_WAIT_L(n) asm volatile("s_waitcnt lgkmcnt(" #n ")" ::: "memory")
#define PG8_BAR __builtin_amdgcn_s_barrier()
#define PG8_SCHED __builtin_amdgcn_sched_barrier(0)
    Unit cur, nxt; int ui = 0;
    if (!S.next(0, cur)) return;
    f32x4 acc[2][2][4][2];
#pragma unroll
    for (int a = 0; a < 2; ++a)
#pragma unroll
        for (int b = 0; b < 2; ++b)
#pragma unroll
            for (int m = 0; m < 4; ++m)
#pragma unroll
                for (int n = 0; n < 2; ++n) acc[a][b][m][n] = (f32x4){0.f, 0.f, 0.f, 0.f};
    bf16x8 At[4][2], B0[2][2], B1[2][2];
    const char* cA = (const char*)g.A + (size_t)cur.pm * tstep; const char* cB = (const char*)g.Bt + (size_t)cur.pn * tstep;
    S.a_ready(cur);
    if constexpr (SP2) {
        PG8_STAGE(PG8_SB(0, 0), cB, voffB); PG8_STAGE(PG8_SB(0, 1), cB + hstep, voffB); PG8_STAGE(PG8_SA(0, 0), cA, voffA); PG8_STAGE(PG8_SA(0, 1), cA + hstep, voffA);
        if (wr == 1) PG8_BAR;
        PG8_WAIT_V(2); PG8_BAR;
        PG8_STAGE(PG8_SB(1, 0), cB + kstep, voffB); PG8_STAGE(PG8_SA(1, 0), cA + kstep, voffA); PG8_STAGE(PG8_SB(1, 1), cB + hstep + kstep, voffB);
        PG8_WAIT_V(6); PG8_BAR;
    } else {
        PG8_STAGE(PG8_SB(0, 0), cB, voffB); PG8_STAGE(PG8_SA(0, 0), cA, voffA); PG8_STAGE(PG8_SB(0, 1), cB + hstep, voffB); PG8_STAGE(PG8_SA(0, 1), cA + hstep, voffA);
        if (wr == 1) PG8_BAR;
        PG8_WAIT_V(4); PG8_BAR;
        PG8_STAGE(PG8_SB(1, 0), cB + kstep, voffB); PG8_STAGE(PG8_SA(1, 0), cA + kstep, voffA); PG8_STAGE(PG8_SB(1, 1), cB + hstep + kstep, voffB);
        PG8_WAIT_V(6); PG8_BAR;
    }
    for (;;) {
        const bool has_next = S.next(ui + 1, nxt);
        const char* nA = has_next ? (const char*)g.A + (size_t)nxt.pm * tstep : cA; const char* nB = has_next ? (const char*)g.Bt + (size_t)nxt.pn * tstep : cB;
        for (int t = 0; t < nt; t += 2) {
            const bool last = (t == nt - 2);
            const char* a1 = cA + (size_t)(t + 1) * kstep;
            const char* a2 = last ? nA : cA + (size_t)(t + 2) * kstep; const char* b2 = last ? nB : cB + (size_t)(t + 2) * kstep;
            const char* a3 = a2 + kstep; const char* b3 = b2 + kstep;
            if (last && has_next) S.a_ready(nxt);
            if constexpr (SP2) {
            PG8_LDB(B0, 0, 0); PG8_LDB(B1, 0, 1); PG8_SCHED; PG8_LDA(At, 0, 0); PG8_STAGE(PG8_SA(1, 1), a1 + hstep, voffA);
            PG8_WAIT_V(8); PG8_WAIT_L(0); PG8_BAR; PG8_MMA(0, 0, At, B0); PG8_MMA(0, 1, At, B1); PG8_BAR; PG8_SCHED;
            PG8_LDA(At, 0, 1); PG8_STAGE(PG8_SB(0, 0), b2, voffB); PG8_STAGE(PG8_SB(0, 1), b2 + hstep, voffB); PG8_STAGE(PG8_SA(0, 0), a2, voffA);
            PG8_WAIT_V(8); PG8_WAIT_L(0); PG8_BAR; PG8_MMA(1, 0, At, B0); PG8_MMA(1, 1, At, B1); PG8_BAR; PG8_SCHED;
            PG8_LDB(B0, 1, 0); PG8_LDB(B1, 1, 1); PG8_SCHED; PG8_LDA(At, 1, 0); PG8_STAGE(PG8_SA(0, 1), a2 + hstep, voffA);
            PG8_WAIT_V(8); PG8_WAIT_L(0); PG8_BAR; PG8_MMA(0, 0, At, B0); PG8_MMA(0, 1, At, B1); PG8_BAR; PG8_SCHED;
            PG8_LDA(At, 1, 1); PG8_STAGE(PG8_SB(1, 0), b3, voffB); PG8_STAGE(PG8_SB(1, 1), b3 + hstep, voffB); PG8_STAGE(PG8_SA(1, 0), a3, voffA);
            PG8_WAIT_V(8); PG8_WAIT_L(0); PG8_BAR; PG8_MMA(1, 0, At, B0); PG8_MMA(1, 1, At, B1); PG8_BAR; PG8_SCHED;
            } else {
            PG8_LDB(B0, 0, 0); PG8_SCHED; PG8_LDA(At, 0, 0); PG8_STAGE(PG8_SA(1, 1), a1 + hstep, voffA);
            PG8_WAIT_L(8); PG8_BAR; PG8_WAIT_L(0); PG8_MMA(0, 0, At, B0); PG8_BAR; PG8_SCHED;
            PG8_LDB(B1, 0, 1); PG8_STAGE(PG8_SB(0, 0), b2, voffB);
            PG8_BAR; PG8_WAIT_L(0); PG8_MMA(0, 1, At, B1); PG8_BAR;
            PG8_LDA(At, 0, 1); PG8_STAGE(PG8_SA(0, 0), a2, voffA);
            PG8_BAR; PG8_WAIT_L(0); PG8_MMA(1, 0, At, B0); PG8_BAR; PG8_SCHED;
            PG8_STAGE(PG8_SB(0, 1), b2 + hstep, voffB);
            PG8_WAIT_V(6); PG8_BAR; PG8_MMA(1, 1, At, B1); PG8_BAR;
            PG8_LDB(B0, 1, 0); PG8_SCHED; PG8_LDA(At, 1, 0); PG8_STAGE(PG8_SA(0, 1), a2 + hstep, voffA);
            PG8_WAIT_L(8); PG8_BAR; PG8_WAIT_L(0); PG8_MMA(0, 0, At, B0); PG8_BAR; PG8_SCHED;
            PG8_LDB(B1, 1, 1); PG8_STAGE(PG8_SB(1, 0), b3, voffB);
            PG8_BAR; PG8_WAIT_L(0); PG8_MMA(0, 1, At, B1); PG8_BAR;
            PG8_LDA(At, 1, 1); PG8_STAGE(PG8_SA(1, 0), a3, voffA);
            PG8_BAR; PG8_WAIT_L(0); PG8_MMA(1, 0, At, B0); PG8_BAR; PG8_SCHED;
            PG8_STAGE(PG8_SB(1, 1), b3 + hstep, voffB);
            PG8_WAIT_V(6); PG8_BAR; PG8_MMA(1, 1, At, B1); PG8_BAR;
            }
        }
        if constexpr (ALIGN_EPI) { if (wr == 0) PG8_BAR; }
        if constexpr (!Epi::AFTER_DRAIN) { E(acc, cur, wr, wc, fr, fq); S.done(cur); }
        if (!has_next) break;
#pragma unroll
        for (int a = 0; a < 2; ++a)
#pragma unroll
            for (int b = 0; b < 2; ++b)
#pragma unroll
                for (int m = 0; m < 4; ++m)
#pragma unroll
                    for (int n = 0; n < 2; ++n) acc[a][b][m][n] = (f32x4){0.f, 0.f, 0.f, 0.f};
        cur = nxt; cA = nA; cB = nB; ++ui;
        if constexpr (ALIGN_EPI) { if (wr == 1) PG8_BAR; }
    }
    PG8_WAIT_V(0);
    if constexpr (!ALIGN_EPI) { if (wr == 0) PG8_BAR; }
    PG8_BAR;
    if constexpr (Epi::AFTER_DRAIN) { E.fused(acc, cur, wr, wc, fr, fq, lds, wid, lane); S.done(cur); }
#undef PG8_SA
#undef PG8_SB
#undef PG8_STAGE
#undef PG8_LDA
#undef PG8_LDB
#undef PG8_MMA
#undef PG8_WAIT_V
#undef PG8_WAIT_L
#undef PG8_BAR
#undef PG8_SCHED
}
}


#define LAS __attribute__((address_space(3)))
typedef unsigned short bf16;
typedef unsigned v4u __attribute__((ext_vector_type(4)));
typedef unsigned v2u __attribute__((ext_vector_type(2)));
typedef float f32x4 __attribute__((ext_vector_type(4)));
typedef float f32x16 __attribute__((ext_vector_type(16)));
typedef short bf16x8 __attribute__((ext_vector_type(8)));

constexpr int T_TOK = 32768, DM = 1024, SEQ = 4096, NBATCH = 8;
constexpr int PW = 3584;
constexpr int IN_W = 3532;
constexpr int C_AQ = 0, C_AKV = 1024, C_IQ = 1152, C_IK = 1408, C_IW = 1472, C_BA = 1476, C_BB = 1480, C_BQ = 1536, C_BK = 2048, C_BV = 2560, C_BZ = 3072;
constexpr int YW = 1536;
constexpr int NCHUNK = 2048;
constexpr float EPS = 1e-6f;

constexpr size_t MiB = 1u << 20;
constexpr size_t WS_CTL = 0;
constexpr size_t WS_MOD = 1 * MiB;
constexpr size_t WS_GL = WS_MOD + 256 * 1024;
constexpr size_t WS_SU = WS_MOD + 512 * 1024;
constexpr size_t WS_SV = WS_MOD + 640 * 1024;
constexpr size_t WS_WIN = 2 * MiB;
constexpr size_t WS_BT2 = 9 * MiB;
constexpr size_t WS_WQ = 12 * MiB;
constexpr size_t WS_SUBK = 16 * MiB;
constexpr size_t WS_H = 18 * MiB;
constexpr size_t WS_KN = WS_H;
constexpr size_t WS_SEL = WS_H + 8 * MiB;
constexpr size_t WS_PROJ = 82 * MiB;
constexpr size_t WS_QUERY = WS_PROJ;
constexpr size_t WS_YAB = 306 * MiB;
constexpr size_t WS_EXPID = WS_YAB;
constexpr size_t WS_GATE = WS_YAB + 16 * MiB;
constexpr size_t WS_H8 = WS_YAB + 32 * MiB;
constexpr size_t WS_HS = WS_YAB + 64 * MiB;
constexpr size_t WS_GA = 402 * MiB;
constexpr size_t WS_UT = 418 * MiB;
constexpr size_t WS_VT = 450 * MiB;
constexpr size_t WS_END = 482 * MiB;
constexpr size_t DO_W = 0, DO_QD = 32 * MiB, DO_KDT = 64 * MiB, DO_UT = 96 * MiB;

constexpr int LDS_BYTES = 147456;

struct Args { const float* in[17]; float* out; unsigned char* ws; int ph_lo, ph_hi; };

__device__ __forceinline__ unsigned pk2(float lo, float hi) { unsigned r; asm("v_cvt_pk_bf16_f32 %0, %1, %2" : "=v"(r) : "v"(lo), "v"(hi)); return r; }
__device__ __forceinline__ unsigned f2bf(float f) { return pk2(f, f) & 0xffffu; }
__device__ __forceinline__ float bflo(unsigned u) { return __uint_as_float(u << 16); }
__device__ __forceinline__ float bfhi(unsigned u) { return __uint_as_float(u & 0xffff0000u); }
__device__ __forceinline__ float bf1(bf16 b) { return __uint_as_float(((unsigned)b) << 16); }
__device__ __forceinline__ float wave_sum(float v) {
#pragma unroll
    for (int o = 1; o < 64; o <<= 1) v += __shfl_xor(v, o);
    return v;
}
__device__ __forceinline__ float wave_max(float v) {
#pragma unroll
    for (int o = 1; o < 64; o <<= 1) v = fmaxf(v, __shfl_xor(v, o));
    return v;
}
__device__ __forceinline__ float silu_f(float v) { return v / (1.f + expf(-v)); }
__device__ __forceinline__ float silu_fast(float v) { return v * __builtin_amdgcn_rcpf(1.f + __expf(-v)); }
__device__ __forceinline__ float sigmoid_f(float v) { return 1.f / (1.f + expf(-v)); }
__device__ __forceinline__ float softplus_f(float v) { return fmaxf(v, 0.f) + log1pf(expf(-fabsf(v))); }
#define LDS_WAIT() asm volatile("s_waitcnt lgkmcnt(0)" ::: "memory")

__device__ __forceinline__ int win_srccol(int n) {
    if (n < 1476) return n;
    if (n < 1480) return 3524 + (n - 1476);
    if (n < 1484) return 3528 + (n - 1480);
    if (n < 1536) return -1;
    return 1476 + (n - 1536);
}
__device__ __forceinline__ void transpose_item(const float* W, int spitch, int k0, int sc, bf16* WT, int dpitch, int drow0, int dcol0, LAS float* scr, int lane) {
    float tv[32];
#pragma unroll
    for (int i = 0; i < 32; ++i) { const int kk = 2 * i + (lane >> 5); tv[i] = W[(size_t)(k0 + kk) * spitch + ((sc >= 0) ? sc : 0)]; }
#pragma unroll
    for (int i = 0; i < 32; ++i) { const int kk = 2 * i + (lane >> 5); scr[kk * 33 + (lane & 31)] = (sc >= 0) ? tv[i] : 0.f; }
    LDS_WAIT();
    const int c = lane & 7;
#pragma unroll
    for (int j = 0; j < 4; ++j) { const int n = (lane >> 3) + 8 * j; const LAS float* s = scr + (8 * c) * 33 + n;
        v4u o; o.x = pk2(s[0 * 33], s[1 * 33]); o.y = pk2(s[2 * 33], s[3 * 33]); o.z = pk2(s[4 * 33], s[5 * 33]); o.w = pk2(s[6 * 33], s[7 * 33]);
        *(v4u*)(WT + (size_t)(drow0 + n) * dpitch + dcol0 + 8 * c) = o; }
    LDS_WAIT();
}

__device__ __forceinline__ void phase0(const Args& a, LAS unsigned char* lds) {
    const int tid = threadIdx.x, lane = tid & 63, wave = tid >> 6, bid = blockIdx.x, G = gridDim.x;
    unsigned char* ws = a.ws;
#ifndef P0_REP
#define P0_REP 0
#endif
    for (int rep0_ = 0; rep0_ < 1 + (P0_REP ? 1 : 0); ++rep0_) {
    if (rep0_ == 0 || (P0_REP & 1))
    for (int item = bid; item < 192; item += G) {
        LAS float* sc = (LAS float*)lds;
        LAS float* red = sc + 8192;
        const float* c = a.in[1];
        for (int i = tid; i < 8192; i += 512) sc[i] = silu_f(c[i]);
        __syncthreads();
        const int cc = tid & 31, kg = tid >> 5;
        const float* w = a.in[2] + item * 32 + cc;
        float acc[8];
#pragma unroll
        for (int b = 0; b < 8; ++b) acc[b] = 0.f;
#pragma unroll 16
        for (int k = kg; k < 1024; k += 16) { const float wv = w[(size_t)k * 6144];
#pragma unroll
            for (int b = 0; b < 8; ++b) acc[b] += sc[b * 1024 + k] * wv; }
#pragma unroll
        for (int b = 0; b < 8; ++b) red[(kg * 8 + b) * 32 + cc] = acc[b];
        __syncthreads();
        if (tid < 256) { const int b = tid >> 5; float s = 0.f;
            for (int k2 = 0; k2 < 16; ++k2) s += red[(k2 * 8 + b) * 32 + cc];
            ((float*)(ws + WS_MOD))[b * 6144 + item * 32 + cc] = s + a.in[3][item * 32 + cc]; }
        __syncthreads();
    }
    if (rep0_ == 0 || (P0_REP & 2)) {
        LAS float* scr = (LAS float*)(lds + 65536 + wave * 8704);
        const int gw = bid * 8 + wave, NGW = G * 8;
        constexpr int I_WIN = 16 * 112, I_WQ = 16 * 64, I_WO = 8 * 32;
        for (int it = gw; it < I_WIN + I_WQ + I_WO; it += NGW) {
            int r = it;
            if (r < I_WIN) { const int kb = r / 112, nb = r % 112; transpose_item(a.in[4], IN_W, 64 * kb, win_srccol(32 * nb + (lane & 31)), (bf16*)(ws + WS_WIN), 1024, 32 * nb, 64 * kb, scr, lane); continue; }
            r -= I_WIN;
            if (r < I_WQ) { const int kb = r / 64, nb = r % 64; transpose_item(a.in[13], 2048, 64 * kb, 32 * nb + (lane & 31), (bf16*)(ws + WS_WQ), 1024, 32 * nb, 64 * kb, scr, lane); continue; }
            r -= I_WQ;
            { const int kb = r / 32, nb = r % 32; transpose_item(a.in[12] + (size_t)512 * 1024, 1024, 64 * kb, 32 * nb + (lane & 31), (bf16*)(ws + WS_BT2), YW, 32 * nb, 1024 + 64 * kb, scr, lane); }
        }
    }
    if (rep0_ == 0 || (P0_REP & 4)) {
        const float* wuv = a.in[7]; const float* wout = a.in[12]; bf16* bt2 = (bf16*)(ws + WS_BT2);
        for (int it = bid * 512 + tid; it < 1024 * 128; it += G * 512) {
            const int n = it & 1023, kb = __builtin_amdgcn_readfirstlane(it >> 10);
            const int h = kb >> 4, r0 = (kb & 15) * 8;
            float acc[8];
#pragma unroll
            for (int j = 0; j < 8; ++j) acc[j] = 0.f;
#pragma unroll 16
            for (int v = 0; v < 64; ++v) { const float wo = wout[(size_t)(h * 64 + v) * 1024 + n];
#pragma unroll
                for (int j = 0; j < 8; ++j) acc[j] += wuv[(size_t)(h * 128 + r0 + j) * 64 + v] * wo; }
            v4u o; o.x = pk2(acc[0], acc[1]); o.y = pk2(acc[2], acc[3]); o.z = pk2(acc[4], acc[5]); o.w = pk2(acc[6], acc[7]);
            *(v4u*)(bt2 + (size_t)n * YW + h * 128 + r0) = o;
        }
    }
    if (rep0_ == 0 || (P0_REP & 8)) {
        const size_t gt = (size_t)bid * 512 + tid, GT = (size_t)G * 512;
        for (size_t i = gt; i < 262144 / 8; i += GT) {
            const f32x4 v0 = *(const f32x4*)(a.in[14] + i * 8), v1 = *(const f32x4*)(a.in[14] + i * 8 + 4);
            v4u o; o.x = pk2(v0.x, v0.y); o.y = pk2(v0.z, v0.w); o.z = pk2(v1.x, v1.y); o.w = pk2(v1.z, v1.w);
            *(v4u*)((bf16*)(ws + WS_SUBK) + i * 8) = o;
        }
        const int gw = bid * 8 + wave, NGW = G * 8;
        f32x4 v[4], vn[4];
        if (gw < 2 * 16384) { const float* s0 = ((gw >> 14) ? a.in[16] : a.in[15]) + (size_t)(gw & 16383) * 1024 + 16 * lane;
#pragma unroll
            for (int q = 0; q < 4; ++q) v[q] = *(const f32x4*)(s0 + 4 * q); }
        for (int row = gw; row < 2 * 16384; row += NGW) {
            const int tb = row >> 14, e = row & 16383;
            { const int rn = (row + NGW < 2 * 16384) ? row + NGW : row;
              const float* sn = ((rn >> 14) ? a.in[16] : a.in[15]) + (size_t)(rn & 16383) * 1024 + 16 * lane;
#pragma unroll
              for (int q = 0; q < 4; ++q) vn[q] = *(const f32x4*)(sn + 4 * q); }
            float mx = 0.f;
#pragma unroll
            for (int q = 0; q < 4; ++q) mx = fmaxf(fmaxf(mx, fmaxf(fabsf(v[q].x), fabsf(v[q].y))), fmaxf(fabsf(v[q].z), fabsf(v[q].w)));
            mx = wave_max(mx);
            const float scale = (mx > 0.f) ? mx * (1.f / 240.f) : 1.f, inv = 1.f / scale;
            v4u o;
#pragma unroll
            for (int q = 0; q < 4; ++q) { int p = __builtin_amdgcn_cvt_pk_fp8_f32(v[q].x * inv, v[q].y * inv, 0, false); p = __builtin_amdgcn_cvt_pk_fp8_f32(v[q].z * inv, v[q].w * inv, p, true); o[q] = (unsigned)p; }
            *(v4u*)(ws + (tb ? WS_VT : WS_UT) + (size_t)e * 1024 + 16 * lane) = o;
            if (lane == 0) ((float*)(ws + (tb ? WS_SV : WS_SU)))[e] = scale;
#pragma unroll
            for (int q = 0; q < 4; ++q) v[q] = vn[q];
        }
    }
    }
}

__device__ __forceinline__ void phase_norm(const float* x, const float* mod, int shift_off, int scale_off, bf16* hout, unsigned char* h8 = nullptr, float* hs = nullptr) {
    const int tid = threadIdx.x, lane = tid & 63, wave = tid >> 6;
    const int gw = blockIdx.x * 8 + wave, NGW = gridDim.x * 8;
    f32x4 v[4], vn[4];
    if (gw < T_TOK) {
#pragma unroll
        for (int j = 0; j < 4; ++j) v[j] = ((const f32x4*)(x + (size_t)gw * DM) + lane)[64 * j];
    }
    for (int m = gw; m < T_TOK; m += NGW) {
        const int b = m >> 12;
        { const int mn = (m + NGW < T_TOK) ? m + NGW : m;
#pragma unroll
          for (int j = 0; j < 4; ++j) vn[j] = ((const f32x4*)(x + (size_t)mn * DM) + lane)[64 * j]; }
        float s = 0.f;
#pragma unroll
        for (int j = 0; j < 4; ++j) s += (v[j].x * v[j].x + v[j].y * v[j].y) + (v[j].z * v[j].z + v[j].w * v[j].w);
        const float inv = rsqrtf(wave_sum(s) * (1.f / DM) + EPS);
        const f32x4* sh = (const f32x4*)(mod + b * 6144 + shift_off) + lane;
        const f32x4* sc = (const f32x4*)(mod + b * 6144 + scale_off) + lane;
        v2u* o8 = (v2u*)(hout + (size_t)m * DM) + lane;
        float amax = 0.f;
#pragma unroll
        for (int j = 0; j < 4; ++j) { const f32x4 a = sh[64 * j], c = sc[64 * j];
            v[j].x = v[j].x * inv * (1.f + c.x) + a.x; v[j].y = v[j].y * inv * (1.f + c.y) + a.y; v[j].z = v[j].z * inv * (1.f + c.z) + a.z; v[j].w = v[j].w * inv * (1.f + c.w) + a.w;
            v2u o; o.x = pk2(v[j].x, v[j].y); o.y = pk2(v[j].z, v[j].w);
            o8[64 * j] = o;
            amax = fmaxf(fmaxf(amax, fmaxf(fabsf(v[j].x), fabsf(v[j].y))), fmaxf(fabsf(v[j].z), fabsf(v[j].w))); }
        if (h8) {
            amax = wave_max(amax);
            const float scale = (amax > 0.f) ? amax * (1.f / 240.f) : 1.f, qi = 1.f / scale;
#pragma unroll
            for (int j = 0; j < 4; ++j) { int p = __builtin_amdgcn_cvt_pk_fp8_f32(v[j].x * qi, v[j].y * qi, 0, false); p = __builtin_amdgcn_cvt_pk_fp8_f32(v[j].z * qi, v[j].w * qi, p, true);
                *(unsigned*)(h8 + (size_t)m * DM + 4 * (lane + 64 * j)) = (unsigned)p; }
            if (lane == 0) hs[m] = scale;
        }
#pragma unroll
        for (int j = 0; j < 4; ++j) v[j] = vn[j];
    }
}

struct EpiX1 {
    static constexpr bool PERM = false, AFTER_DRAIN = false;
    const float* x; float* out; const float* mod;
    __device__ __forceinline__ void operator()(const pg8::f32x4 (&acc)[2][2][4][2], const pg8::Unit& u, int wr, int wc, int fr, int fq) const {
        const int row0 = u.pm * 256 + wr * 64 + fr, col0 = u.pn * 256 + wc * 32 + 4 * fq;
        const int b = (u.pm * 256) >> 12;
        f32x4 gv[2][2];
#pragma unroll
        for (int bj = 0; bj < 2; ++bj)
#pragma unroll
            for (int n = 0; n < 2; ++n) gv[bj][n] = *(const f32x4*)(mod + b * 6144 + 2048 + col0 + bj * 128 + n * 16);
#define EX_LOAD(dst_, b_) do { _Pragma("unroll") for (int mm = 0; mm < 2; ++mm) { const size_t ro_ = (size_t)(row0 + ((b_) >> 1) * 128 + (2 * ((b_) & 1) + mm) * 16) * DM + col0; \
            _Pragma("unroll") for (int bj = 0; bj < 2; ++bj) _Pragma("unroll") for (int n = 0; n < 2; ++n) dst_[mm][bj][n] = *(const f32x4*)(x + ro_ + bj * 128 + n * 16); } } while (0)
#define EX_STORE(src_, b_) do { _Pragma("unroll") for (int mm = 0; mm < 2; ++mm) { const size_t ro_ = (size_t)(row0 + ((b_) >> 1) * 128 + (2 * ((b_) & 1) + mm) * 16) * DM + col0; \
            _Pragma("unroll") for (int bj = 0; bj < 2; ++bj) _Pragma("unroll") for (int n = 0; n < 2; ++n) \
                *(f32x4*)(out + ro_ + bj * 128 + n * 16) = src_[mm][bj][n] + gv[bj][n] * acc[(b_) >> 1][bj][2 * ((b_) & 1) + mm][n]; } } while (0)
        f32x4 xa[2][2][2], xb[2][2][2];
        EX_LOAD(xa, 0); EX_LOAD(xb, 1);
        __builtin_amdgcn_sched_barrier(0);
        EX_STORE(xa, 0);
        __builtin_amdgcn_sched_barrier(0);
        EX_LOAD(xa, 2);
        __builtin_amdgcn_sched_barrier(0);
        EX_STORE(xb, 1);
        __builtin_amdgcn_sched_barrier(0);
        EX_LOAD(xb, 3);
        __builtin_amdgcn_sched_barrier(0);
        EX_STORE(xa, 2);
        __builtin_amdgcn_sched_barrier(0);
        EX_STORE(xb, 3);
#undef EX_LOAD
#undef EX_STORE
    }
};
struct EpiBf {
    static constexpr bool PERM = true, AFTER_DRAIN = false;
    bf16* O; int ldc;
    __device__ __forceinline__ void operator()(const pg8::f32x4 (&acc)[2][2][4][2], const pg8::Unit& u, int wr, int wc, int fr, int fq) const {
        const int row0 = u.pm * 256 + wr * 64 + fr, col0 = u.pn * 256 + wc * 32 + 8 * fq;
#pragma unroll
        for (int ai = 0; ai < 2; ++ai)
#pragma unroll
            for (int m = 0; m < 4; ++m) { bf16* rowp = O + (size_t)(row0 + ai * 128 + m * 16) * ldc + col0;
#pragma unroll
                for (int bj = 0; bj < 2; ++bj) { const pg8::f32x4 zz = (pg8::f32x4){0.f, 0.f, 0.f, 0.f}; const pg8::f32x4 v0 = acc[ai][bj][m][0] + zz, v1 = acc[ai][bj][m][1] + zz;
                    v4u w; w.x = pg8::cvt_pk_bf16(v0[0], v0[1]); w.y = pg8::cvt_pk_bf16(v0[2], v0[3]); w.z = pg8::cvt_pk_bf16(v1[0], v1[1]); w.w = pg8::cvt_pk_bf16(v1[2], v1[3]);
#ifdef EPI_NT
                    __builtin_nontemporal_store(w, (v4u*)(rowp + bj * 128)); } }
#elif defined(EPI_DUP)
                    *(volatile v4u*)(rowp + bj * 128) = w; *(volatile v4u*)(rowp + bj * 128) = w; } }
#else
                    *(v4u*)(rowp + bj * 128) = w; } }
#endif
    }
};

constexpr int GP_QS = 0, GP_KS = 33792, GP_VS = 67584, GP_LS = 101376, GP_GV = 118784;
struct GpPre { v4u raw[11]; unsigned short ga, gb; };
__device__ __forceinline__ void gp_fetch(const Args& a, int chunk, int tid, GpPre& P) {
    const bf16* proj = (const bf16*)(a.ws + WS_PROJ);
    const int bh = chunk >> 6, n = chunk & 63, b = bh >> 2, h = bh & 3;
    const int t0 = b * SEQ + n * 64;
    if (tid < 384) {
        const int cg = tid % 48, rs = tid / 48, sec = cg >> 4, c8 = (cg & 15) * 8;
        const int pcol = C_BQ + sec * 512 + h * 128 + c8;
#pragma unroll
        for (int j = 0; j < 11; ++j) { const int rr = 8 * rs - 3 + j;
            P.raw[j] = (rr >= 0 || n > 0) ? *(const v4u*)(proj + (size_t)(t0 + rr) * PW + pcol) : (v4u){0u, 0u, 0u, 0u}; }
    } else if (tid >= 448) {
        const int i = tid & 63;
        P.ga = *(const unsigned short*)(proj + (size_t)(t0 + i) * PW + C_BA + h); P.gb = *(const unsigned short*)(proj + (size_t)(t0 + i) * PW + C_BB + h);
    }
}
__device__ __forceinline__ void gdn_prep_item(const Args& a, LAS unsigned char* lds, int chunk, GpPre& P, int next_chunk) {
    int tid = threadIdx.x; asm volatile("" : "+v"(tid));
    const int lane = tid & 63, wave = __builtin_amdgcn_readfirstlane(tid >> 6);
    unsigned char* ws = a.ws;
    const bf16* proj = (const bf16*)(ws + WS_PROJ);
    const int bh = chunk >> 6, n = chunk & 63, b = bh >> 2, h = bh & 3;
    const int t0 = b * SEQ + n * 64;
    LAS float* QS = (LAS float*)(lds + GP_QS); LAS float* KS = (LAS float*)(lds + GP_KS); LAS float* VS = (LAS float*)(lds + GP_VS);
    LAS float* LS = (LAS float*)(lds + GP_LS); LAS float* GV = (LAS float*)(lds + GP_GV);
#ifndef GP_MASK
#define GP_MASK 31
#endif
#ifndef GP_REP
#define GP_REP 0
#endif
    for (int rep_ = 0; rep_ < 1 + (GP_REP & 1); ++rep_)
    if ((GP_MASK & 1) && tid < 384) {
        const int cg = tid % 48, rs = tid / 48;
        const int sec = cg >> 4, c8 = (cg & 15) * 8;
        const int pcol = C_BQ + sec * 512 + h * 128 + c8;
        const float* cw = a.in[8] + sec * 512 + h * 128 + c8;
        float wt[4][8];
#pragma unroll
        for (int i = 0; i < 4; ++i) { const f32x4 w0 = *(const f32x4*)(cw + i * 1536), w1 = *(const f32x4*)(cw + i * 1536 + 4);
            wt[i][0] = w0.x; wt[i][1] = w0.y; wt[i][2] = w0.z; wt[i][3] = w0.w; wt[i][4] = w1.x; wt[i][5] = w1.y; wt[i][6] = w1.z; wt[i][7] = w1.w; }
        LAS float* XS = (sec == 0) ? QS : (sec == 1 ? KS : VS);
        v4u raw[11];
#pragma unroll
        for (int j = 0; j < 11; ++j) raw[j] = P.raw[j];
#pragma unroll
        for (int j = 0; j < 8; ++j) {
            float y[8];
#pragma unroll
            for (int c = 0; c < 8; ++c) y[c] = 0.f;
#pragma unroll
            for (int i = 0; i < 4; ++i) { float xv[8]; const v4u u = raw[j + i];
                xv[0] = bflo(u.x); xv[1] = bfhi(u.x); xv[2] = bflo(u.y); xv[3] = bfhi(u.y); xv[4] = bflo(u.z); xv[5] = bfhi(u.z); xv[6] = bflo(u.w); xv[7] = bfhi(u.w);
#pragma unroll
                for (int c = 0; c < 8; ++c) y[c] += wt[i][c] * xv[c]; }
            f32x4 o0, o1;
            o0.x = silu_fast(y[0]); o0.y = silu_fast(y[1]); o0.z = silu_fast(y[2]); o0.w = silu_fast(y[3]); o1.x = silu_fast(y[4]); o1.y = silu_fast(y[5]); o1.z = silu_fast(y[6]); o1.w = silu_fast(y[7]);
            *(LAS f32x4*)(XS + (8 * rs + j) * 132 + c8) = o0; *(LAS f32x4*)(XS + (8 * rs + j) * 132 + c8 + 4) = o1;
        }
    }
    if (wave == 7) {
        const int i = lane;
        const float av = __uint_as_float((unsigned)P.ga << 16), bv = __uint_as_float((unsigned)P.gb << 16);
        const float beta = sigmoid_f(bv);
        const float g = -expf(a.in[9][h]) * softplus_f(av + a.in[10][h]);
        float G = g;
#pragma unroll
        for (int o = 1; o < 64; o <<= 1) { const float t = __shfl_up(G, o); if (lane >= o) G += t; }
        const float Glast = __shfl(G, 63);
        GV[i] = G; GV[64 + i] = expf(G); GV[128 + i] = beta; GV[192 + i] = expf(Glast - G); GV[256 + i] = beta * expf(G);
        if (lane == 0) ((float*)(ws + WS_GL))[chunk] = expf(Glast);
    }
    if (next_chunk >= 0) gp_fetch(a, next_chunk, tid, P);
    __syncthreads();
    if (GP_MASK & 2) {
#pragma unroll
        for (int rr = 0; rr < 16; ++rr) {
            const int row = wave * 16 + rr;
            LAS float* X = (row < 64) ? (QS + row * 132) : (KS + (row - 64) * 132);
            const float v0 = X[lane], v1 = X[lane + 64];
            const float ss = wave_sum(v0 * v0 + v1 * v1);
            const float sc = rsqrtf(ss + EPS) * ((row < 64) ? 0.08838834764831845f : 1.f);
            X[lane] = v0 * sc; X[lane + 64] = v1 * sc;
        }
    }
    __syncthreads();
    for (int rep_ = 0; rep_ < 1 + ((GP_REP >> 2) & 1); ++rep_)
    if (GP_MASK & 4) {
        const int gram = wave >> 2, ti = wave & 3, r = lane & 15, g = lane >> 4;
        const LAS float* X = gram ? QS : KS;
        f32x4 acc[4];
#pragma unroll
        for (int tj = 0; tj < 4; ++tj) acc[tj] = (f32x4){0.f, 0.f, 0.f, 0.f};
#pragma unroll 2
        for (int kk = 0; kk < 8; ++kk) {
            const f32x4 xa = *(const LAS f32x4*)(X + (16 * ti + r) * 132 + 16 * kk + 4 * g);
#pragma unroll
            for (int tj = 0; tj < 4; ++tj) {
                if (tj <= ti) {
                    const f32x4 kb = *(const LAS f32x4*)(KS + (16 * tj + r) * 132 + 16 * kk + 4 * g);
                    acc[tj] = __builtin_amdgcn_mfma_f32_16x16x4f32(xa.x, kb.x, acc[tj], 0, 0, 0);
                    acc[tj] = __builtin_amdgcn_mfma_f32_16x16x4f32(xa.y, kb.y, acc[tj], 0, 0, 0);
                    acc[tj] = __builtin_amdgcn_mfma_f32_16x16x4f32(xa.z, kb.z, acc[tj], 0, 0, 0);
                    acc[tj] = __builtin_amdgcn_mfma_f32_16x16x4f32(xa.w, kb.w, acc[tj], 0, 0, 0);
                }
            }
        }
        bf16* Aout = (bf16*)(ws + WS_GA) + (size_t)chunk * 4096;
#pragma unroll
        for (int tj = 0; tj < 4; ++tj)
#pragma unroll
            for (int rg = 0; rg < 4; ++rg) {
                const int i = 16 * ti + 4 * g + rg, j = 16 * tj + r;
                const float dec = (j <= i) ? __expf(GV[i] - GV[j]) : 0.f;
                if (gram == 0) { if (tj <= ti) LS[i * 68 + j] = (j < i) ? GV[128 + i] * acc[tj][rg] * dec : 0.f; }
                else Aout[((((i >> 4) * 2 + (j >> 5)) * 64 + (i & 15) + 16 * ((j >> 3) & 3)) << 3) + (j & 7)] = (bf16)f2bf((tj <= ti) ? acc[tj][rg] * dec : 0.f);
            }
    }
    __syncthreads();
    {
        bf16* QD = (bf16*)((unsigned char*)a.out + DO_QD) + (size_t)chunk * 8192;
        bf16* KDT = (bf16*)((unsigned char*)a.out + DO_KDT) + (size_t)chunk * 8192;
#pragma unroll
        for (int m = 0; m < 2; ++m) {
            const int p = tid + 512 * m;
            { const int i = p >> 4, k8 = (p & 15) * 8; const float e = GV[64 + i]; const LAS float* sq = QS + i * 132 + k8;
              v4u o; o.x = pk2(sq[0] * e, sq[1] * e); o.y = pk2(sq[2] * e, sq[3] * e); o.z = pk2(sq[4] * e, sq[5] * e); o.w = pk2(sq[6] * e, sq[7] * e);
              *(v4u*)(QD + ((((i >> 4) * 4 + ((p & 15) >> 2)) * 64 + (i & 15) + 16 * (p & 3)) << 3)) = o; }
            { const int k = p >> 3, i8 = (p & 7) * 8; float v[8];
#pragma unroll
              for (int j = 0; j < 8; ++j) v[j] = KS[(i8 + j) * 132 + k] * GV[192 + i8 + j];
              v4u o; o.x = pk2(v[0], v[1]); o.y = pk2(v[2], v[3]); o.z = pk2(v[4], v[5]); o.w = pk2(v[6], v[7]);
              *(v4u*)(KDT + ((((k >> 4) * 2 + ((p & 7) >> 2)) * 64 + (k & 15) + 16 * (p & 3)) << 3)) = o; }
        }
    }
    __syncthreads();
    {
#pragma unroll
        for (int m = 0; m < 4; ++m) {
            const int p = tid + 512 * m, i = p >> 5, c4 = (p & 31) * 4;
            const float mu = GV[128 + i], mw = GV[256 + i];
            f32x4 v = *(LAS f32x4*)(VS + i * 132 + c4); v.x *= mu; v.y *= mu; v.z *= mu; v.w *= mu; *(LAS f32x4*)(VS + i * 132 + c4) = v;
            f32x4 k = *(LAS f32x4*)(KS + i * 132 + c4); k.x *= mw; k.y *= mw; k.z *= mw; k.w *= mw; *(LAS f32x4*)(KS + i * 132 + c4) = k;
        }
    }
    __syncthreads();
    {
        const int r = lane & 15, g = lane >> 4;
#pragma unroll 1
        for (int I = 0; I < 4; ++I) {
            if (I > 0) {
#pragma unroll
                for (int tt = 0; tt < 2; ++tt) {
                    const int ct = 2 * wave + tt;
                    LAS float* XB = ((ct < 8) ? VS : KS) + (ct & 7) * 16 + r;
                    f32x4 acc;
#pragma unroll
                    for (int rg = 0; rg < 4; ++rg) acc[rg] = XB[(16 * I + 4 * g + rg) * 132];
                    for (int J = 0; J < I; ++J) {
#pragma unroll
                        for (int ks = 0; ks < 4; ++ks) {
                            const float la = -LS[(16 * I + r) * 68 + 16 * J + 4 * ks + g];
                            const float xb = XB[(16 * J + 4 * ks + g) * 132];
                            acc = __builtin_amdgcn_mfma_f32_16x16x4f32(la, xb, acc, 0, 0, 0);
                        }
                    }
#pragma unroll
                    for (int rg = 0; rg < 4; ++rg) XB[(16 * I + 4 * g + rg) * 132] = acc[rg];
                }
                __syncthreads();
            }
            if (tid < 256) {
                LAS float* XC = ((tid < 128) ? VS : KS) + (tid & 127);
                float x[16];
#pragma unroll
                for (int rr = 0; rr < 16; ++rr) {
                    float a0 = XC[(16 * I + rr) * 132], a1 = 0.f, a2 = 0.f, a3 = 0.f;
#pragma unroll
                    for (int j4 = 0; j4 < (rr + 3) / 4; ++j4) {
                        const f32x4 l = *(const LAS f32x4*)(LS + (16 * I + rr) * 68 + 16 * I + 4 * j4);
                        if (4 * j4 + 0 < rr) a0 -= l.x * x[4 * j4 + 0];
                        if (4 * j4 + 1 < rr) a1 -= l.y * x[4 * j4 + 1];
                        if (4 * j4 + 2 < rr) a2 -= l.z * x[4 * j4 + 2];
                        if (4 * j4 + 3 < rr) a3 -= l.w * x[4 * j4 + 3];
                    }
                    x[rr] = (a0 + a1) + (a2 + a3);
                }
#pragma unroll
                for (int rr = 0; rr < 16; ++rr) XC[(16 * I + rr) * 132] = x[rr];
            }
            __syncthreads();
        }
    }
    {
        bf16* W = (bf16*)((unsigned char*)a.out + DO_W) + (size_t)chunk * 8192;
        bf16* UT = (bf16*)((unsigned char*)a.out + DO_UT) + (size_t)chunk * 8192;
#pragma unroll
        for (int m = 0; m < 2; ++m) {
            const int p = tid + 512 * m, i = p >> 4, k8 = p & 15;
            const f32x4 x0 = *(const LAS f32x4*)(KS + i * 132 + 8 * k8), x1 = *(const LAS f32x4*)(KS + i * 132 + 8 * k8 + 4);
            v4u o; o.x = pk2(x0.x, x0.y); o.y = pk2(x0.z, x0.w); o.z = pk2(x1.x, x1.y); o.w = pk2(x1.z, x1.w);
            *(v4u*)(W + ((((i >> 4) * 4 + (k8 >> 2)) * 64 + (i & 15) + 16 * (k8 & 3)) << 3)) = o;
        }
#pragma unroll
        for (int m = 0; m < 4; ++m) {
            const int p = tid + 512 * m, v = p & 127, q = p >> 7;
            v2u o; o.x = pk2(VS[(4 * q) * 132 + v], VS[(4 * q + 1) * 132 + v]); o.y = pk2(VS[(4 * q + 2) * 132 + v], VS[(4 * q + 3) * 132 + v]);
            *(v2u*)(UT + ((((q >> 2) * 8 + (v >> 4)) * 64 + (v & 15) + 16 * (q & 3)) << 2)) = o;
        }
    }
    __syncthreads();
}

__device__ __forceinline__ void kn_item(const Args& a, int item) {
    const int tid = threadIdx.x, lane = tid & 63, wave = tid >> 6;
    const bf16* proj = (const bf16*)(a.ws + WS_PROJ); bf16* KN = (bf16*)(a.ws + WS_KN);
    const float g0 = a.in[6][2 * lane], g1 = a.in[6][2 * lane + 1];
    unsigned u[16];
#pragma unroll
    for (int rr = 0; rr < 16; ++rr) u[rr] = *(const unsigned*)(proj + (size_t)(item * 128 + wave * 16 + rr) * PW + C_AKV + 2 * lane);
#pragma unroll
    for (int rr = 0; rr < 16; ++rr) {
        const int t = item * 128 + wave * 16 + rr;
        const float v0 = bflo(u[rr]), v1 = bfhi(u[rr]);
        const float inv = rsqrtf(wave_sum(v0 * v0 + v1 * v1) * (1.f / 128.f) + EPS);
        *(unsigned*)(KN + (size_t)t * 128 + 2 * lane) = pk2(v0 * inv * g0, v1 * inv * g1);
    }
}


#ifdef IDX_FP32
__device__ __forceinline__ void phase_idx32(const Args& a, LAS unsigned char* lds) {
    const int tid = threadIdx.x, lane = tid & 63, wave = tid >> 6;
    LAS float* HS = (LAS float*)lds;
    float* IDX32 = (float*)(a.ws + WS_YAB);
    const float* mod = (const float*)(a.ws + WS_MOD);
    for (int tile = blockIdx.x; tile < 1024; tile += gridDim.x) {
        const int t0 = tile * 32, b = t0 >> 12;
        for (int rr = 0; rr < 4; ++rr) {
            const int m = t0 + wave * 4 + rr;
            const f32x4* xr = (const f32x4*)(a.in[0] + (size_t)m * DM) + lane;
            f32x4 v[4]; float s = 0.f;
#pragma unroll
            for (int j = 0; j < 4; ++j) { v[j] = xr[64 * j]; s += (v[j].x * v[j].x + v[j].y * v[j].y) + (v[j].z * v[j].z + v[j].w * v[j].w); }
            const float inv = rsqrtf(wave_sum(s) * (1.f / DM) + EPS);
            const f32x4* sh = (const f32x4*)(mod + b * 6144) + lane; const f32x4* sc = (const f32x4*)(mod + b * 6144 + 1024) + lane;
#pragma unroll
            for (int j = 0; j < 4; ++j) { const f32x4 aa = sh[64 * j], c = sc[64 * j];
                f32x4 o; o.x = v[j].x * inv * (1.f + c.x) + aa.x; o.y = v[j].y * inv * (1.f + c.y) + aa.y; o.z = v[j].z * inv * (1.f + c.z) + aa.z; o.w = v[j].w * inv * (1.f + c.w) + aa.w;
                *(LAS f32x4*)(HS + (wave * 4 + rr) * 1028 + 4 * (lane + 64 * j)) = o; }
        }
        __syncthreads();
        if (tid < 324) {
            const float* w = a.in[4] + 1152 + tid;
            float acc[32];
#pragma unroll
            for (int t = 0; t < 32; ++t) acc[t] = 0.f;
            for (int k4 = 0; k4 < 256; ++k4) {
                const float w0 = w[(size_t)(4 * k4) * IN_W], w1 = w[(size_t)(4 * k4 + 1) * IN_W], w2 = w[(size_t)(4 * k4 + 2) * IN_W], w3 = w[(size_t)(4 * k4 + 3) * IN_W];
#pragma unroll
                for (int t = 0; t < 32; ++t) { const f32x4 hv = *(const LAS f32x4*)(HS + t * 1028 + 4 * k4); acc[t] += hv.x * w0 + hv.y * w1 + hv.z * w2 + hv.w * w3; }
            }
#pragma unroll
            for (int t = 0; t < 32; ++t) IDX32[(size_t)(t0 + t) * 384 + tid] = acc[t];
        }
        __syncthreads();
    }
}
#endif
__device__ __forceinline__ unsigned sortable(float f) { const unsigned u = __float_as_uint(f + 0.f); return (u & 0x80000000u) ? ~u : (u | 0x80000000u); }
__device__ __forceinline__ int wave_sum_dpp(int x) {
    x += __builtin_amdgcn_update_dpp(0, x, 0xB1, 0xF, 0xF, false);
    x += __builtin_amdgcn_update_dpp(0, x, 0x4E, 0xF, 0xF, false);
    x += __builtin_amdgcn_update_dpp(0, x, 0x141, 0xF, 0xF, false);
    x += __builtin_amdgcn_update_dpp(0, x, 0x140, 0xF, 0xF, false);
    return __builtin_amdgcn_readlane(x, 0) + __builtin_amdgcn_readlane(x, 16) + __builtin_amdgcn_readlane(x, 32) + __builtin_amdgcn_readlane(x, 48);
}
#define CNT8(OP, acc_, k_, s_, c_) asm("v_cmp_" OP "_u32 s[36:37], %1, %9\n\tv_cmp_" OP "_u32 s[38:39], %2, %9\n\tv_cmp_" OP "_u32 s[40:41], %3, %9\n\tv_cmp_" OP "_u32 s[42:43], %4, %9\n\t" \
        "v_cmp_" OP "_u32 s[44:45], %5, %9\n\tv_cmp_" OP "_u32 s[46:47], %6, %9\n\tv_cmp_" OP "_u32 s[48:49], %7, %9\n\tv_cmp_" OP "_u32 s[50:51], %8, %9\n\t" \
        "v_addc_co_u32 %0, s[36:37], 0, %0, s[36:37]\n\tv_addc_co_u32 %0, s[38:39], 0, %0, s[38:39]\n\tv_addc_co_u32 %0, s[40:41], 0, %0, s[40:41]\n\tv_addc_co_u32 %0, s[42:43], 0, %0, s[42:43]\n\t" \
        "v_addc_co_u32 %0, s[44:45], 0, %0, s[44:45]\n\tv_addc_co_u32 %0, s[46:47], 0, %0, s[46:47]\n\tv_addc_co_u32 %0, s[48:49], 0, %0, s[48:49]\n\tv_addc_co_u32 %0, s[50:51], 0, %0, s[50:51]" \
        : "+v"(acc_) : "v"(k_[(s_)]), "v"(k_[(s_) + 1]), "v"(k_[(s_) + 2]), "v"(k_[(s_) + 3]), "v"(k_[(s_) + 4]), "v"(k_[(s_) + 5]), "v"(k_[(s_) + 6]), "v"(k_[(s_) + 7]), "v"(c_) \
        : "s36", "s37", "s38", "s39", "s40", "s41", "s42", "s43", "s44", "s45", "s46", "s47", "s48", "s49", "s50", "s51")
__device__ __forceinline__ unsigned wave_umin_dpp(unsigned x) {
    x = min(x, (unsigned)__builtin_amdgcn_update_dpp((int)x, (int)x, 0xB1, 0xF, 0xF, false));
    x = min(x, (unsigned)__builtin_amdgcn_update_dpp((int)x, (int)x, 0x4E, 0xF, 0xF, false));
    x = min(x, (unsigned)__builtin_amdgcn_update_dpp((int)x, (int)x, 0x141, 0xF, 0xF, false));
    x = min(x, (unsigned)__builtin_amdgcn_update_dpp((int)x, (int)x, 0x140, 0xF, 0xF, false));
    return min(min((unsigned)__builtin_amdgcn_readlane((int)x, 0), (unsigned)__builtin_amdgcn_readlane((int)x, 16)), min((unsigned)__builtin_amdgcn_readlane((int)x, 32), (unsigned)__builtin_amdgcn_readlane((int)x, 48)));
}
__device__ __forceinline__ unsigned wave_umax_dpp(unsigned x) {
    x = max(x, (unsigned)__builtin_amdgcn_update_dpp((int)x, (int)x, 0xB1, 0xF, 0xF, false));
    x = max(x, (unsigned)__builtin_amdgcn_update_dpp((int)x, (int)x, 0x4E, 0xF, 0xF, false));
    x = max(x, (unsigned)__builtin_amdgcn_update_dpp((int)x, (int)x, 0x141, 0xF, 0xF, false));
    x = max(x, (unsigned)__builtin_amdgcn_update_dpp((int)x, (int)x, 0x140, 0xF, 0xF, false));
    return max(max((unsigned)__builtin_amdgcn_readlane((int)x, 0), (unsigned)__builtin_amdgcn_readlane((int)x, 16)), max((unsigned)__builtin_amdgcn_readlane((int)x, 32), (unsigned)__builtin_amdgcn_readlane((int)x, 48)));
}
template <int NS> __device__ __forceinline__ void topk_select(LAS float* row, int n, int lane, unsigned short* out) {
    asm volatile("" : "+v"(lane));
    unsigned key[NS];
#pragma unroll
    for (int s = 0; s < NS; ++s) key[s] = __float_as_uint(row[s * 64 + lane]);
#pragma unroll
    for (int s = 0; s < NS; ++s) { const int idx = s * 64 + lane; const unsigned k = sortable(__uint_as_float(key[s])); key[s] = (s < NS - 16 || idx < n) ? k : 0u; }
    LAS unsigned* cq = (LAS unsigned*)row;
    LAS unsigned* ci = cq + 576;
    LAS unsigned* sel_l = cq + 1152;
    const int dmy = 256 + lane, dmy2 = 512 + lane;
    unsigned thr; int bit;
    {
        unsigned m0 = key[0], m1 = key[1], m2 = key[2], m3 = key[3];
#pragma unroll
        for (int s = 4; s < NS; s += 4) { m0 = max(m0, key[s]); m1 = max(m1, key[s + 1]); m2 = max(m2, key[s + 2]); m3 = max(m3, key[s + 3]); }
        const unsigned lo = (unsigned)__builtin_amdgcn_readfirstlane((int)wave_umin_dpp(min(min(m0, m1), min(m2, m3)))), hi = (unsigned)__builtin_amdgcn_readfirstlane((int)wave_umax_dpp(max(max(m0, m1), max(m2, m3))));
        const unsigned x = lo ^ hi;
        bit = 31 - __builtin_clz(x | 1u); if (x == 0u) bit = -1;
        thr = (bit >= 31) ? 0u : (hi & ~((2u << bit) - 1u));
    }
    int cthr = NS * 64;
    bool exact = false;
    if (bit >= 20) {
        unsigned pk[NS / 2];
#pragma unroll
        for (int i = 0; i < NS / 2; ++i) pk[i] = ((key[2 * i + 1] >> 4) & 0x0FFF0000u) | (key[2 * i] >> 20);
        for (; bit >= 20; --bit) {
            if (cthr <= 512) break;
            const unsigned cand = thr | (1u << bit), c12 = cand >> 20;
            const unsigned cc = (c12 | (c12 << 16)) - 0x10001000u;
            unsigned a0 = 0u, a1 = 0u;
#pragma unroll
            for (int i = 0; i < NS / 2; i += 2) { a0 = __builtin_amdgcn_udot8(pk[i] - cc, 0x10001000u, a0, false); a1 = __builtin_amdgcn_udot8(pk[i + 1] - cc, 0x10001000u, a1, false); }
            const int cnt = wave_sum_dpp((int)(a0 + a1));
            if (cnt >= 256) { thr = cand; cthr = cnt; }
            if (cnt == 256) { exact = true; break; }
        }
    }
    if (!exact) for (; bit >= 0; --bit) {
        if (cthr <= 512) break;
        const unsigned cand = thr | (1u << bit);
        int c0 = 0, c1 = 0;
#pragma unroll
        for (int s = 0; s < NS; s += 16) { CNT8("ge", c0, key, s, cand); CNT8("ge", c1, key, s + 8, cand); }
        const int cnt = wave_sum_dpp(c0 + c1);
        if (cnt >= 256) { thr = cand; cthr = cnt; }
        if (cnt == 256) { exact = true; break; }
    }
    asm volatile("" : "+v"(lane));
    int pos_out = 0;
    if (!exact && bit >= 0) {
        int pos = 0;
#pragma unroll
        for (int s = 0; s < NS; ++s) {
            const bool c = key[s] >= thr;
            const unsigned long long mt = __builtin_amdgcn_ballot_w64(c);
            const int at = __builtin_amdgcn_mbcnt_hi((unsigned)(mt >> 32), __builtin_amdgcn_mbcnt_lo((unsigned)mt, pos));
            const int w = c ? at : dmy2;
            cq[w] = key[s]; ci[w] = (unsigned)(s * 64 + lane);
            pos += __builtin_popcountll(mt);
        }
        LDS_WAIT();
        unsigned ck[8], cx[8];
#pragma unroll
        for (int j = 0; j < 8; ++j) { ck[j] = cq[64 * j + lane]; cx[j] = ci[64 * j + lane]; }
#pragma unroll
        for (int j = 0; j < 8; ++j) ck[j] = (64 * j + lane < pos) ? ck[j] : 0u;
        for (; bit >= 0; --bit) {
            const unsigned cand = thr | (1u << bit);
            int cnt = 0;
#pragma unroll
            for (int j = 0; j < 8; ++j) cnt += __builtin_popcountll(__builtin_amdgcn_ballot_w64(ck[j] >= cand));
            if (cnt >= 256) thr = cand;
            if (cnt == 256) { exact = true; break; }
        }
        int cgt = 0, ceq = 0;
        if (!exact) {
#pragma unroll
            for (int j = 0; j < 8; ++j) { cgt += __builtin_popcountll(__builtin_amdgcn_ballot_w64(ck[j] > thr)); ceq += __builtin_popcountll(__builtin_amdgcn_ballot_w64(ck[j] == thr)); }
        }
        const int need_eq = 256 - cgt;
        if (exact || ceq == need_eq) {
#pragma unroll
            for (int j = 0; j < 8; ++j) {
                const bool take = ck[j] >= thr;
                const unsigned long long mt = __builtin_amdgcn_ballot_w64(take);
                const int pre = __builtin_amdgcn_mbcnt_hi((unsigned)(mt >> 32), __builtin_amdgcn_mbcnt_lo((unsigned)mt, pos_out));
                sel_l[take ? pre : dmy] = cx[j];
                pos_out += __builtin_popcountll(mt);
            }
        } else {
            const unsigned long long ltmask = (1ull << lane) - 1ull;
            int eq_seen = 0;
#pragma unroll
            for (int j = 0; j < 8; ++j) {
                const bool gt = ck[j] > thr, eq = ck[j] == thr;
                const unsigned long long meq = __builtin_amdgcn_ballot_w64(eq);
                const bool take = gt || (eq && (eq_seen + __builtin_popcountll(meq & ltmask) < need_eq));
                const unsigned long long mt = __builtin_amdgcn_ballot_w64(take);
                if (take) sel_l[pos_out + __builtin_popcountll(mt & ltmask)] = cx[j];
                pos_out += __builtin_popcountll(mt); eq_seen += __builtin_popcountll(meq);
            }
        }
    } else {
        int cgt = 0, ceq = 0;
        if (!exact) {
            int g0 = 0, e0 = 0;
#pragma unroll
            for (int s = 0; s < NS; s += 8) { CNT8("gt", g0, key, s, thr); CNT8("eq", e0, key, s, thr); }
            cgt = wave_sum_dpp(g0); ceq = wave_sum_dpp(e0);
        }
        const int need_eq = 256 - cgt;
        asm volatile("" : "+v"(thr));
        if (exact || ceq == need_eq) {
#pragma unroll
            for (int s = 0; s < NS; ++s) {
                const bool take = key[s] >= thr;
                const unsigned long long mt = __builtin_amdgcn_ballot_w64(take);
                const int pre = __builtin_amdgcn_mbcnt_hi((unsigned)(mt >> 32), __builtin_amdgcn_mbcnt_lo((unsigned)mt, 0));
                sel_l[take ? pos_out + pre : dmy] = (unsigned)(s * 64 + lane);
                pos_out += __builtin_popcountll(mt);
            }
        } else {
            const unsigned long long ltmask = (1ull << lane) - 1ull;
            int eq_seen = 0;
#pragma unroll
            for (int s = 0; s < NS; ++s) {
                const bool gt = key[s] > thr, eq = key[s] == thr;
                const unsigned long long meq = __builtin_amdgcn_ballot_w64(eq);
                const bool take = gt || (eq && (eq_seen + __builtin_popcountll(meq & ltmask) < need_eq));
                const unsigned long long mt = __builtin_amdgcn_ballot_w64(take);
                if (take) sel_l[pos_out + __builtin_popcountll(mt & ltmask)] = (unsigned)(s * 64 + lane);
                pos_out += __builtin_popcountll(mt); eq_seen += __builtin_popcountll(meq);
                if ((s & 3) == 3) __builtin_amdgcn_sched_barrier(0);
            }
        }
    }
    LDS_WAIT();
    { const v4u q4 = *(const LAS v4u*)(sel_l + 4 * lane); v2u o; o.x = q4.x | (q4.y << 16); o.y = q4.z | (q4.w << 16); *(v2u*)(out + 4 * lane) = o; }
}
struct IdxPre { bf16x8 af[4]; v2u wqr[4]; bf16x8 bfr[4][4]; };
__device__ __forceinline__ void idx_issue(const Args& a, int b, int qblk, int wave, int lane, IdxPre& P) {
    const bf16* proj = (const bf16*)(a.ws + WS_PROJ);
    const int p0 = qblk * 8, r = lane & 31, hh = lane >> 5;
    const size_t rowb = (size_t)b * SEQ;
    if (p0 + 7 < 256) return;
    { const bf16* qp = proj + (rowb + p0 + (r & 7)) * PW + C_IQ + (r >> 3) * 64 + 32 * hh;
#pragma unroll
      for (int s = 0; s < 4; ++s) P.af[s] = *(const bf16x8*)(qp + 8 * s); }
#pragma unroll
    for (int i = 0; i < 4; ++i) P.wqr[i] = *(const v2u*)(proj + (rowb + p0 + 4 * hh + i) * PW + C_IW);
    const int ntiles = (p0 + 7) / 32 + 1;
#pragma unroll
    for (int u = 0; u < 4; ++u) {
        const int kt = (wave + 8 * u < ntiles) ? wave + 8 * u : 0;
        const bf16* kp = proj + (rowb + (size_t)kt * 32 + r) * PW + C_IK + 32 * hh;
#pragma unroll
        for (int s = 0; s < 4; ++s) P.bfr[u][s] = *(const bf16x8*)(kp + 8 * s);
    }
}
__device__ __forceinline__ void idx_score(const Args& a, LAS float* SC, int b, int qblk, IdxPre& P, int wave, int lane) {
    const bf16* proj = (const bf16*)(a.ws + WS_PROJ);
    const int p0 = qblk * 8, r = lane & 31, hh = lane >> 5;
    const size_t rowb = (size_t)b * SEQ;
    if (p0 + 7 >= 256) {
        float wq[4][4];
#pragma unroll
        for (int i = 0; i < 4; ++i) { wq[i][0] = bflo(P.wqr[i].x) * 0.0625f; wq[i][1] = bfhi(P.wqr[i].x) * 0.0625f; wq[i][2] = bflo(P.wqr[i].y) * 0.0625f; wq[i][3] = bfhi(P.wqr[i].y) * 0.0625f; }
        const int ntiles = (p0 + 7) / 32 + 1;
        for (int kt0 = wave; kt0 < ntiles; kt0 += 32) {
            bf16x8 nxt[4][4];
            const bool more = kt0 + 32 < ntiles;
            if (more) {
#pragma unroll
                for (int u = 0; u < 4; ++u) {
                    const int kt = (kt0 + 32 + 8 * u < ntiles) ? kt0 + 32 + 8 * u : kt0;
                    const bf16* kp = proj + (rowb + (size_t)kt * 32 + r) * PW + C_IK + 32 * hh;
#pragma unroll
                    for (int s = 0; s < 4; ++s) nxt[u][s] = *(const bf16x8*)(kp + 8 * s);
                }
            }
#pragma unroll
            for (int u = 0; u < 4; ++u) {
                const int kt = kt0 + 8 * u;
                if (kt < ntiles) {
                    f32x16 acc;
#pragma unroll
                    for (int i = 0; i < 16; ++i) acc[i] = 0.f;
#pragma unroll
                    for (int s = 0; s < 4; ++s) acc = __builtin_amdgcn_mfma_f32_32x32x16_bf16(P.af[s], P.bfr[u][s], acc, 0, 0, 0);
#pragma unroll
                    for (int i = 0; i < 4; ++i) {
                        float s = 0.f;
#pragma unroll
                        for (int hd = 0; hd < 4; ++hd) s += wq[i][hd] * fmaxf(acc[i + 4 * hd], 0.f);
                        SC[(4 * hh + i) * 4096 + kt * 32 + r] = s;
                    }
                }
            }
            if (more) {
#pragma unroll
                for (int u = 0; u < 4; ++u)
#pragma unroll
                    for (int s = 0; s < 4; ++s) P.bfr[u][s] = nxt[u][s];
            }
        }
    }
}
__device__ __forceinline__ void indexer_item(const Args& a, LAS unsigned char* lds, int b, int qblk, IdxPre& P, bool has_next, int b_next, int qblk_next) {
    int tid = threadIdx.x; asm volatile("" : "+v"(tid));
    const int lane = tid & 63, wave = __builtin_amdgcn_readfirstlane(tid >> 6);
    const bf16* proj = (const bf16*)(a.ws + WS_PROJ);
    unsigned short* SEL = (unsigned short*)(a.ws + WS_SEL);
    LAS float* SC = (LAS float*)lds;
    const int p0 = qblk * 8;
    const int r = lane & 31, hh = lane >> 5;
    const size_t rowb = (size_t)b * SEQ;
#ifdef IDX_FP32
    if (p0 + 7 >= 256) {
        const float* IDX32 = (const float*)(a.ws + WS_YAB);
        LAS float* IQS = (LAS float*)(lds + 131072);
        for (int i = tid; i < 2048; i += 512) IQS[i] = IDX32[(rowb + p0 + (i >> 8)) * 384 + (i & 255)];
        float wq8[8][4];
#pragma unroll
        for (int q = 0; q < 8; ++q)
#pragma unroll
            for (int hd = 0; hd < 4; ++hd) wq8[q][hd] = IDX32[(rowb + p0 + q) * 384 + 320 + hd];
        __syncthreads();
        for (int s = tid; s <= p0 + 7; s += 512) {
            float kf[64];
#pragma unroll
            for (int d4 = 0; d4 < 16; ++d4) { const f32x4 v = *(const f32x4*)(IDX32 + (rowb + s) * 384 + 256 + 4 * d4); kf[4 * d4] = v.x; kf[4 * d4 + 1] = v.y; kf[4 * d4 + 2] = v.z; kf[4 * d4 + 3] = v.w; }
#pragma unroll 1
            for (int q = 0; q < 8; ++q) {
                float sc = 0.f;
#pragma unroll
                for (int hd = 0; hd < 4; ++hd) {
                    float lg = 0.f;
#pragma unroll
                    for (int d4 = 0; d4 < 16; ++d4) { const f32x4 qv = *(const LAS f32x4*)(IQS + q * 256 + hd * 64 + 4 * d4); lg += kf[4 * d4] * qv.x + kf[4 * d4 + 1] * qv.y + kf[4 * d4 + 2] * qv.z + kf[4 * d4 + 3] * qv.w; }
                    sc += fmaxf(lg, 0.f) * wq8[q][hd];
                }
                SC[q * 4096 + s] = sc * 0.0625f;
            }
        }
    }
#else
    idx_score(a, SC, b, qblk, P, wave, lane);
#ifdef IDX_REP_SCORE
    idx_issue(a, b, qblk, wave, lane, P); idx_score(a, SC, b, qblk, P, wave, lane);
#endif
#endif
    __syncthreads();
#ifndef IDX_FP32
    if (has_next) idx_issue(a, b_next, qblk_next, wave, lane, P);
#endif
    {
        const int pos = p0 + wave, n = pos + 1;
        unsigned short* out = SEL + (rowb + pos) * 256;
        if (n <= 256) {
#pragma unroll
            for (int q = 0; q < 4; ++q) { const int j = lane + 64 * q; out[j] = (unsigned short)((j < n) ? j : 0xFFFF); }
        } else {
            LAS float* row = SC + wave * 4096;
            const int nslots = (n + 63) >> 6;
#ifndef IDX_REP_SELECT
#define IDX_REP_SELECT 1
#endif
            if (nslots <= 16) topk_select<16>(row, n, lane, out);
            else if (nslots <= 32) topk_select<32>(row, n, lane, out);
            else if (nslots <= 48) topk_select<48>(row, n, lane, out);
            else topk_select<64>(row, n, lane, out);
        }
    }
    __syncthreads();
}

__device__ __forceinline__ void phase3(const Args& a, LAS unsigned char* lds) {
    const int bid = blockIdx.x, G = gridDim.x;
#ifndef P3_MASK
#define P3_MASK 7
#endif
#ifndef P3_REP
#define P3_REP 0
#endif
    if (P3_MASK & 1) {
        GpPre GP; int tidg = threadIdx.x; asm volatile("" : "+v"(tidg));
        if (bid < 2048) gp_fetch(a, bid, tidg, GP);
        for (int it = bid; it < 2048; it += G) {
            const int nx = (it + G < 2048) ? it + G : -1;
            if (P3_REP & 1) { gdn_prep_item(a, lds, it, GP, it); gdn_prep_item(a, lds, it, GP, nx); } else gdn_prep_item(a, lds, it, GP, nx);
        }
    }
    if (P3_MASK & 2) {
#define IDX_MAP(j_, bb_, qb_) do { if (G == 256) { const int i_ = (j_) / G, c_ = (j_) % G, q0_ = (c_ >> 3) + 32 * (i_ >> 1); bb_ = c_ & 7; qb_ = (i_ & 1) ? 511 - q0_ : q0_; } else { bb_ = (j_) >> 9; qb_ = (j_) & 511; } } while (0)
        IdxPre P;
        const int tid_ = threadIdx.x, lane_ = tid_ & 63, wave_ = __builtin_amdgcn_readfirstlane(tid_ >> 6);
        int bb, qb;
        if (bid < 4096) { IDX_MAP(bid, bb, qb); idx_issue(a, bb, qb, wave_, lane_, P); }
        for (int j = bid; j < 4096; j += G) {
            IDX_MAP(j, bb, qb);
            int bn = 0, qn = 0; const bool hn = (j + G < 4096);
            if (hn) IDX_MAP(j + G, bn, qn);
            indexer_item(a, lds, bb, qb, P, hn, bn, qn);
            if (P3_REP & 2) { idx_issue(a, bb, qb, wave_, lane_, P); indexer_item(a, lds, bb, qb, P, false, 0, 0); if (hn) idx_issue(a, bn, qn, wave_, lane_, P); }
        }
#undef IDX_MAP
    }
    if (P3_MASK & 4) for (int it = bid; it < 256; it += G) kn_item(a, it);
}

constexpr int SC_ST = 0, SC_VNT = 34816, SC_O = 53248;
__device__ __forceinline__ v2u pack4(float a, float b, float c, float d) { v2u o; o.x = pk2(a, b); o.y = pk2(c, d); return o; }
__device__ __forceinline__ void scan_epilogue(const LAS float* OS, const v4u z0, const v4u z1, const LAS float* gainl, bf16* ydst, int tid) {
    const int row = tid >> 3, seg = tid & 7;
    float o[16];
#pragma unroll
    for (int q = 0; q < 4; ++q) { const f32x4 v = *(const LAS f32x4*)(OS + row * 132 + 16 * seg + 4 * q); o[4 * q] = v.x; o[4 * q + 1] = v.y; o[4 * q + 2] = v.z; o[4 * q + 3] = v.w; }
    float ss = 0.f;
#pragma unroll
    for (int i = 0; i < 16; ++i) ss += o[i] * o[i];
    ss += __shfl_xor(ss, 1); ss += __shfl_xor(ss, 2); ss += __shfl_xor(ss, 4);
    const float inv = rsqrtf(ss * (1.f / 128.f) + EPS);
    float z[16];
    z[0] = bflo(z0.x); z[1] = bfhi(z0.x); z[2] = bflo(z0.y); z[3] = bfhi(z0.y); z[4] = bflo(z0.z); z[5] = bfhi(z0.z); z[6] = bflo(z0.w); z[7] = bfhi(z0.w);
    z[8] = bflo(z1.x); z[9] = bfhi(z1.x); z[10] = bflo(z1.y); z[11] = bfhi(z1.y); z[12] = bflo(z1.z); z[13] = bfhi(z1.z); z[14] = bflo(z1.w); z[15] = bfhi(z1.w);
    float y[16];
#pragma unroll
    for (int q = 0; q < 4; ++q) { const f32x4 gq = *(const LAS f32x4*)(gainl + 16 * seg + 4 * q);
        y[4 * q] = o[4 * q] * inv * gq.x * silu_fast(z[4 * q]); y[4 * q + 1] = o[4 * q + 1] * inv * gq.y * silu_fast(z[4 * q + 1]); y[4 * q + 2] = o[4 * q + 2] * inv * gq.z * silu_fast(z[4 * q + 2]); y[4 * q + 3] = o[4 * q + 3] * inv * gq.w * silu_fast(z[4 * q + 3]); }
    v4u w0, w1;
    w0.x = pk2(y[0], y[1]); w0.y = pk2(y[2], y[3]); w0.z = pk2(y[4], y[5]); w0.w = pk2(y[6], y[7]);
    w1.x = pk2(y[8], y[9]); w1.y = pk2(y[10], y[11]); w1.z = pk2(y[12], y[13]); w1.w = pk2(y[14], y[15]);
    *(v4u*)(ydst) = w0; *(v4u*)(ydst + 8) = w1;
}
__device__ __forceinline__ void gdn_scan(const Args& a, LAS unsigned char* lds, int bh) {
    const int tid = threadIdx.x, lane = tid & 63, w = __builtin_amdgcn_readfirstlane(tid >> 6), r = lane & 15, g = lane >> 4;
    const int b = bh >> 2, h = bh & 3;
    LAS bf16* ST = (LAS bf16*)(lds + SC_ST); LAS bf16* VNT = (LAS bf16*)(lds + SC_VNT); LAS float* OS = (LAS float*)(lds + SC_O);
    const bf16* proj = (const bf16*)(a.ws + WS_PROJ); bf16* yab = (bf16*)(a.ws + WS_YAB);
    const float* GL = (const float*)(a.ws + WS_GL);
    for (int i = tid; i < 34816 / 4; i += 512) ((LAS unsigned*)ST)[i] = 0u;
    f32x4 S[8];
#pragma unroll
    for (int vt = 0; vt < 8; ++vt) S[vt] = (f32x4){0.f, 0.f, 0.f, 0.f};
    const int erow = tid >> 3, eseg = tid & 7;
    LAS float* gainl = (LAS float*)(lds + 87040);
    if (tid < 128) gainl[tid] = a.in[11][tid];
    const int ct = w & 3;
    const size_t cb = (size_t)bh * 64;
    const bf16* Wb = (const bf16*)((const unsigned char*)a.out + DO_W) + cb * 8192;
    const bf16* QDb = (const bf16*)((const unsigned char*)a.out + DO_QD) + cb * 8192;
    const bf16* KDTb = (const bf16*)((const unsigned char*)a.out + DO_KDT) + cb * 8192;
    const bf16* UTb = (const bf16*)((const unsigned char*)a.out + DO_UT) + cb * 8192;
    const bf16* Ab = (const bf16*)(a.ws + WS_GA) + cb * 4096;
    const bf16* Xb = (w < 4) ? Wb : QDb;
    const size_t tz = ((size_t)b * SEQ + erow) * PW + C_BZ + h * 128 + 16 * eseg;
    const size_t ty = ((size_t)b * SEQ + erow) * YW + 1024 + h * 128 + 16 * eseg;
    bf16x8 af[4], kd[2]; v4u xr[4]; float gl; v4u zh0, zh1;
#define SCAN_LOAD(n_, af_, kd_, xr_, gl_) do { \
        const bf16* X_ = Xb + (size_t)(n_) * 8192 + (ct * 4 * 64 + lane) * 8; \
        _Pragma("unroll") for (int ks = 0; ks < 4; ++ks) af_[ks] = *(const bf16x8*)(X_ + ks * 512); \
        const bf16* K_ = KDTb + (size_t)(n_) * 8192 + (w * 2 * 64 + lane) * 8; \
        kd_[0] = *(const bf16x8*)(K_); kd_[1] = *(const bf16x8*)(K_ + 512); \
        if (w >= 4) { const bf16* A_ = Ab + (size_t)(n_) * 4096 + (ct * 2 * 64 + lane) * 8; xr_[0] = *(const v4u*)(A_); xr_[1] = *(const v4u*)(A_ + 512); } \
        else { const bf16* U_ = UTb + (size_t)(n_) * 8192 + (ct * 8 * 64 + lane) * 4; _Pragma("unroll") for (int q_ = 0; q_ < 4; ++q_) { const v2u u0_ = *(const v2u*)(U_ + (2 * q_) * 256), u1_ = *(const v2u*)(U_ + (2 * q_ + 1) * 256); xr_[q_] = (v4u){u0_.x, u0_.y, u1_.x, u1_.y}; } } \
        gl_ = GL[cb + (n_)]; } while (0)
    SCAN_LOAD(0, af, kd, xr, gl);
    zh0 = (v4u){0u, 0u, 0u, 0u}; zh1 = zh0;
    __syncthreads();
    for (int n = 0; n < 64; ++n) {
        bf16x8 afn[4], kdn[2]; v4u xrn[4]; float gln;
        const int nn = (n < 63) ? n + 1 : 63;
        SCAN_LOAD(nn, afn, kdn, xrn, gln);
        const v4u zn0 = *(const v4u*)(proj + tz + (size_t)n * 64 * PW), zn1 = *(const v4u*)(proj + tz + (size_t)n * 64 * PW + 8);
        if (n > 0) scan_epilogue(OS, zh0, zh1, gainl, yab + ty + (size_t)(n - 1) * 64 * YW, tid);
        zh0 = zn0; zh1 = zn1;
        f32x4 acc[8];
#pragma unroll
        for (int vt = 0; vt < 8; ++vt) acc[vt] = (f32x4){0.f, 0.f, 0.f, 0.f};
#pragma unroll
        for (int ks = 0; ks < 4; ++ks) {
#pragma unroll
            for (int vt = 0; vt < 8; ++vt) {
                const bf16x8 bfr = *(const LAS bf16x8*)(ST + (16 * vt + r) * 136 + 32 * ks + 8 * g);
                acc[vt] = __builtin_amdgcn_mfma_f32_16x16x32_bf16(af[ks], bfr, acc[vt], 0, 0, 0);
            }
        }
        if (w < 4) {
#pragma unroll
            for (int vt = 0; vt < 8; ++vt) {
                const unsigned ux = (vt & 1) ? xr[vt >> 1].z : xr[vt >> 1].x, uy = (vt & 1) ? xr[vt >> 1].w : xr[vt >> 1].y;
                const v2u o = pack4(bflo(ux) - acc[vt][0], bfhi(ux) - acc[vt][1], bflo(uy) - acc[vt][2], bfhi(uy) - acc[vt][3]);
                *(LAS v2u*)(VNT + (16 * vt + r) * 72 + 16 * ct + 4 * g) = o;
            }
        }
        __syncthreads();
        if (w >= 4) {
#pragma unroll
            for (int ks = 0; ks < 2; ++ks)
#pragma unroll
                for (int vt = 0; vt < 8; ++vt) {
                    const bf16x8 vb = *(const LAS bf16x8*)(VNT + (16 * vt + r) * 72 + 32 * ks + 8 * g);
                    acc[vt] = __builtin_amdgcn_mfma_f32_16x16x32_bf16(__builtin_bit_cast(bf16x8, xr[ks]), vb, acc[vt], 0, 0, 0);
                }
#pragma unroll
            for (int vt = 0; vt < 8; ++vt)
#pragma unroll
                for (int rg = 0; rg < 4; ++rg) OS[(16 * ct + 4 * g + rg) * 132 + 16 * vt + r] = acc[vt][rg];
        }
#pragma unroll
        for (int vt = 0; vt < 8; ++vt) S[vt] = S[vt] * gl;
#pragma unroll
        for (int ks = 0; ks < 2; ++ks)
#pragma unroll
            for (int vt = 0; vt < 8; ++vt) {
                const bf16x8 vb = *(const LAS bf16x8*)(VNT + (16 * vt + r) * 72 + 32 * ks + 8 * g);
                S[vt] = __builtin_amdgcn_mfma_f32_16x16x32_bf16(kd[ks], vb, S[vt], 0, 0, 0);
            }
#pragma unroll
        for (int vt = 0; vt < 8; ++vt)
            *(LAS v2u*)(ST + (16 * vt + r) * 136 + 16 * w + 4 * g) = pack4(S[vt][0] + 0.f, S[vt][1] + 0.f, S[vt][2] + 0.f, S[vt][3] + 0.f);
#pragma unroll
        for (int ks = 0; ks < 4; ++ks) af[ks] = afn[ks];
        kd[0] = kdn[0]; kd[1] = kdn[1];
#pragma unroll
        for (int q = 0; q < 4; ++q) xr[q] = xrn[q];
        gl = gln;
        __syncthreads();
    }
    scan_epilogue(OS, zh0, zh1, gainl, yab + ty + (size_t)63 * 64 * YW, tid);
    __syncthreads();
#undef SCAN_LOAD
}

typedef short v4s __attribute__((ext_vector_type(4)));
constexpr int AQ_STRIDE = 272, AQ_WAVE_LDS = 64 * AQ_STRIDE + 512;
__device__ __forceinline__ void aq_flush(const Args& a, const v4u (&ost)[2], int tprev, int lane) {
    bf16* yp = (bf16*)(a.ws + WS_YAB) + (size_t)tprev * YW + (lane >> 3) * 128 + (lane & 7) * 16;
    *(v4u*)yp = ost[0]; *(v4u*)(yp + 8) = ost[1];
}
__device__ __forceinline__ void attn_query_q4(const Args& a, LAS unsigned char* wl, const LAS float* qgl, int t, int lane, v4u (&ost)[2], int& tprev) {
    const bf16* proj = (const bf16*)(a.ws + WS_PROJ); const bf16* KN = (const bf16*)(a.ws + WS_KN);
    const unsigned short* SEL = (const unsigned short*)(a.ws + WS_SEL); bf16* yab = (bf16*)(a.ws + WS_YAB);
    LAS unsigned char* KT = wl; LAS unsigned short* SL = (LAS unsigned short*)(wl + 64 * AQ_STRIDE);
    const int r = lane & 15, g = lane >> 4;
    const int b = t >> 12, pos = t & 4095;
    const bf16* knb = KN + (size_t)b * SEQ * 128;
    *(LAS v2u*)(SL + 4 * lane) = *(const v2u*)(SEL + (size_t)t * 256 + 4 * lane);
    bf16x8 qf[4];
    {
        const bf16* qp = proj + (size_t)t * PW + C_AQ + (r & 7) * 128 + 8 * g;
        float f[32]; float ss = 0.f;
#pragma unroll
        for (int ks = 0; ks < 4; ++ks) { const v4u raw = *(const v4u*)(qp + 32 * ks);
            f[8 * ks] = bflo(raw.x); f[8 * ks + 1] = bfhi(raw.x); f[8 * ks + 2] = bflo(raw.y); f[8 * ks + 3] = bfhi(raw.y); f[8 * ks + 4] = bflo(raw.z); f[8 * ks + 5] = bfhi(raw.z); f[8 * ks + 6] = bflo(raw.w); f[8 * ks + 7] = bfhi(raw.w); }
#pragma unroll
        for (int i = 0; i < 32; ++i) ss += f[i] * f[i];
        ss += __shfl_xor(ss, 16); ss += __shfl_xor(ss, 32);
        float inv = rsqrtf(ss * (1.f / 128.f) + EPS) * 0.08838834764831845f;
        if (r >= 8) inv = 0.f;
#pragma unroll
        for (int ks = 0; ks < 4; ++ks) { const f32x4 ga = *(const LAS f32x4*)(qgl + 32 * ks + 8 * g), gb = *(const LAS f32x4*)(qgl + 32 * ks + 8 * g + 4);
            v4u o; o.x = pk2(f[8 * ks] * inv * ga.x, f[8 * ks + 1] * inv * ga.y); o.y = pk2(f[8 * ks + 2] * inv * ga.z, f[8 * ks + 3] * inv * ga.w);
            o.z = pk2(f[8 * ks + 4] * inv * gb.x, f[8 * ks + 5] * inv * gb.y); o.w = pk2(f[8 * ks + 6] * inv * gb.z, f[8 * ks + 7] * inv * gb.w);
            qf[ks] = __builtin_bit_cast(bf16x8, o); }
    }
    LDS_WAIT();
    const int cnt = (pos + 1 < 256) ? pos + 1 : 256, nq = (cnt + 63) >> 6;
    const float slope = exp2f(-(float)((r & 7) + 1));
    float m_run = -INFINITY, l_run = 0.f;
    f32x4 O[8];
#pragma unroll
    for (int dt = 0; dt < 8; ++dt) O[dt] = (f32x4){0.f, 0.f, 0.f, 0.f};
    bf16x8 ka[4][4], kb[4][4];
#ifdef AQ_PROBE_DUP
#define AQ_DUP(dst_, p_) dst_ = *(const volatile bf16x8*)(p_)
#else
#define AQ_DUP(dst_, p_) do { } while (0)
#endif
#define AQ_LOAD(q_, k_) do { _Pragma("unroll") for (int kt = 0; kt < 4; ++kt) { int ix_ = SL[64 * (q_) + 16 * kt + r]; ix_ = (ix_ == 0xFFFF) ? 0 : ix_; \
        const bf16* kp_ = knb + (size_t)ix_ * 128 + 8 * g; _Pragma("unroll") for (int ks = 0; ks < 4; ++ks) { AQ_DUP(k_[kt][ks], kp_ + 32 * ks); k_[kt][ks] = *(const bf16x8*)(kp_ + 32 * ks); } } } while (0)
#define AQ_PASS(q_, k_) do { \
        f32x4 sc[4]; \
        _Pragma("unroll") for (int kt = 0; kt < 4; ++kt) { f32x4 acc = (f32x4){0.f, 0.f, 0.f, 0.f}; \
            _Pragma("unroll") for (int ks = 0; ks < 4; ++ks) { acc = __builtin_amdgcn_mfma_f32_16x16x32_bf16(k_[kt][ks], qf[ks], acc, 0, 0, 0); \
                *(LAS bf16x8*)(KT + (16 * kt + r) * AQ_STRIDE + (32 * ks + 8 * g) * 2) = k_[kt][ks]; } \
            sc[kt] = acc; } \
        float m = m_run; \
        _Pragma("unroll") for (int kt = 0; kt < 4; ++kt) { const v2u s4 = *(const LAS v2u*)(SL + 64 * (q_) + 16 * kt + 4 * g); \
            const int i0 = s4.x & 0xFFFF, i1 = s4.x >> 16, i2 = s4.y & 0xFFFF, i3 = s4.y >> 16; \
            sc[kt][0] = (i0 != 0xFFFF) ? sc[kt][0] - slope * (float)(pos - i0) : -INFINITY; sc[kt][1] = (i1 != 0xFFFF) ? sc[kt][1] - slope * (float)(pos - i1) : -INFINITY; \
            sc[kt][2] = (i2 != 0xFFFF) ? sc[kt][2] - slope * (float)(pos - i2) : -INFINITY; sc[kt][3] = (i3 != 0xFFFF) ? sc[kt][3] - slope * (float)(pos - i3) : -INFINITY; \
            m = fmaxf(fmaxf(m, fmaxf(sc[kt][0], sc[kt][1])), fmaxf(sc[kt][2], sc[kt][3])); } \
        m = fmaxf(m, __shfl_xor(m, 16)); m = fmaxf(m, __shfl_xor(m, 32)); \
        const float alpha = __expf(m_run - m); \
        float ls = 0.f; \
        _Pragma("unroll") for (int kt = 0; kt < 4; ++kt) _Pragma("unroll") for (int rg = 0; rg < 4; ++rg) { const float e = __expf(sc[kt][rg] - m); sc[kt][rg] = e; ls += e; } \
        l_run = l_run * alpha + ls; m_run = m; \
        _Pragma("unroll") for (int rg = 0; rg < 4; ++rg) { const float ah = __shfl(alpha, 4 * g + rg); _Pragma("unroll") for (int dt = 0; dt < 8; ++dt) O[dt][rg] *= ah; } \
        _Pragma("unroll") for (int c = 0; c < 2; ++c) { v4u o_; o_.x = pk2(sc[2 * c][0], sc[2 * c][1]); o_.y = pk2(sc[2 * c][2], sc[2 * c][3]); o_.z = pk2(sc[2 * c + 1][0], sc[2 * c + 1][1]); o_.w = pk2(sc[2 * c + 1][2], sc[2 * c + 1][3]); \
            const bf16x8 pa = __builtin_bit_cast(bf16x8, o_); \
            _Pragma("unroll") for (int dt = 0; dt < 8; ++dt) { \
                const v4s b0 = __builtin_amdgcn_ds_read_tr16_b64_v4i16((LAS v4s*)(tb + (32 * c) * AQ_STRIDE + 32 * dt)); \
                const v4s b1 = __builtin_amdgcn_ds_read_tr16_b64_v4i16((LAS v4s*)(tb + (32 * c + 16) * AQ_STRIDE + 32 * dt)); \
                const bf16x8 bfr = __builtin_shufflevector(b0, b1, 0, 1, 2, 3, 4, 5, 6, 7); \
                O[dt] = __builtin_amdgcn_mfma_f32_16x16x32_bf16(pa, bfr, O[dt], 0, 0, 0); } } \
        __builtin_amdgcn_sched_barrier(0); } while (0)
    const LAS unsigned char* tb = KT + (4 * g + (r >> 2)) * AQ_STRIDE + 8 * (r & 3);
    AQ_LOAD(0, ka);
    AQ_LOAD(1, kb);
    AQ_PASS(0, ka);
    AQ_LOAD(2, ka);
    aq_flush(a, ost, tprev, lane);
    if (nq > 1) AQ_PASS(1, kb);
    AQ_LOAD(3, kb);
    if (nq > 2) AQ_PASS(2, ka);
    if (nq > 3) AQ_PASS(3, kb);
#undef AQ_LOAD
#undef AQ_PASS
    l_run += __shfl_xor(l_run, 16); l_run += __shfl_xor(l_run, 32);
    const float il = 1.f / l_run;
    if (true) {
        float ih[4];
#pragma unroll
        for (int rg = 0; rg < 4; ++rg) ih[rg] = __shfl(il, 4 * g + rg);
        if (g < 2) {
#pragma unroll
            for (int rg = 0; rg < 4; ++rg)
#pragma unroll
                for (int dt = 0; dt < 8; ++dt) *(LAS unsigned short*)(KT + (4 * g + rg) * AQ_STRIDE + (16 * dt + r) * 2) = f2bf(O[dt][rg] * ih[rg]);
        }
    }
    LDS_WAIT();
    ost[0] = *(const LAS v4u*)(KT + (lane >> 3) * AQ_STRIDE + (lane & 7) * 32); ost[1] = *(const LAS v4u*)(KT + (lane >> 3) * AQ_STRIDE + (lane & 7) * 32 + 16);
    tprev = t;
    LDS_WAIT();
}

__device__ __forceinline__ void phase4(const Args& a, LAS unsigned char* lds) {
    const int bid = blockIdx.x, G = gridDim.x, tid = threadIdx.x, lane = tid & 63, wave = tid >> 6;
    const int nscan = (G >= 64) ? 32 : 0;
#ifndef P4_REP
#define P4_REP 0
#endif
    if (nscan && bid < 32) { gdn_scan(a, lds, bid); if (P4_REP & 1) { __syncthreads(); gdn_scan(a, lds, bid); } return; }
    if (!nscan) { for (int bh = bid; bh < 32; bh += G) gdn_scan(a, lds, bh); __syncthreads(); }
    LAS float* qg4 = (LAS float*)(lds + 8 * AQ_WAVE_LDS);
    if (tid < 128) qg4[tid] = a.in[5][tid];
    __syncthreads();
    LAS unsigned char* wl4 = lds + wave * AQ_WAVE_LDS;
    if (nscan == 32 && (G & 7) == 0) {
        const int bb = bid & 7, wl_i = ((bid - 32) >> 3) * 8 + wave, nwl = ((G - 32) >> 3) * 8;
        v4u ost[2] = {(v4u){0u, 0u, 0u, 0u}, (v4u){0u, 0u, 0u, 0u}}; int tprev = bb * SEQ + wl_i;
        for (int p = wl_i; p < SEQ; p += nwl) attn_query_q4(a, wl4, qg4, bb * SEQ + p, lane, ost, tprev);
        if (P4_REP & 2) for (int p = wl_i; p < SEQ; p += nwl) attn_query_q4(a, wl4, qg4, bb * SEQ + p, lane, ost, tprev);
        if (wl_i < SEQ) aq_flush(a, ost, tprev, lane);
    } else {
        const int gw = (bid - nscan) * 8 + wave, NGW = (G - nscan) * 8;
        v4u ost[2] = {(v4u){0u, 0u, 0u, 0u}, (v4u){0u, 0u, 0u, 0u}}; int tprev = gw;
        for (int t = gw; t < T_TOK; t += NGW) attn_query_q4(a, wl4, qg4, t, lane, ost, tprev);
        if (gw < T_TOK) aq_flush(a, ost, tprev, lane);
    }
}

#define INS16P(L, v_) do { float _x = (v_); \
    _Pragma("unroll") for (int _k = 0; _k < 16; ++_k) { const float _h = __builtin_fmaxf(L[_k], _x); _x = __builtin_fminf(L[_k], _x); L[_k] = _h; } } while (0)
#define CE_D(a_, b_) do { const float _h = __builtin_fmaxf(a_, b_), _l = __builtin_fminf(a_, b_); a_ = _h; b_ = _l; } while (0)
#define SORT16_DESC(A) do { CE_D(A[0], A[13]); CE_D(A[1], A[12]); CE_D(A[2], A[15]); CE_D(A[3], A[14]); CE_D(A[4], A[8]); CE_D(A[5], A[6]); CE_D(A[7], A[11]); CE_D(A[9], A[10]); CE_D(A[0], A[5]); CE_D(A[1], A[7]); CE_D(A[2], A[9]); CE_D(A[3], A[4]); CE_D(A[6], A[13]); CE_D(A[8], A[14]); CE_D(A[10], A[15]); CE_D(A[11], A[12]); CE_D(A[0], A[1]); CE_D(A[2], A[3]); CE_D(A[4], A[5]); CE_D(A[6], A[8]); CE_D(A[7], A[9]); CE_D(A[10], A[11]); CE_D(A[12], A[13]); CE_D(A[14], A[15]); CE_D(A[0], A[2]); CE_D(A[1], A[3]); CE_D(A[4], A[10]); CE_D(A[5], A[11]); CE_D(A[6], A[7]); CE_D(A[8], A[9]); CE_D(A[12], A[14]); CE_D(A[13], A[15]); CE_D(A[1], A[2]); CE_D(A[3], A[12]); CE_D(A[4], A[6]); CE_D(A[5], A[7]); CE_D(A[8], A[10]); CE_D(A[9], A[11]); CE_D(A[13], A[14]); CE_D(A[1], A[4]); CE_D(A[2], A[6]); CE_D(A[5], A[8]); CE_D(A[7], A[10]); CE_D(A[9], A[13]); CE_D(A[11], A[14]); CE_D(A[2], A[4]); CE_D(A[3], A[6]); CE_D(A[9], A[12]); CE_D(A[11], A[13]); CE_D(A[3], A[5]); CE_D(A[6], A[8]); CE_D(A[7], A[9]); CE_D(A[10], A[12]); CE_D(A[3], A[4]); CE_D(A[5], A[6]); CE_D(A[7], A[8]); CE_D(A[9], A[10]); CE_D(A[11], A[12]); CE_D(A[6], A[7]); CE_D(A[8], A[9]); } while (0)
#define MERGE16_TOP(L, B) do { \
    _Pragma("unroll") for (int i_ = 0; i_ < 16; ++i_) L[i_] = __builtin_fmaxf(L[i_], B[15 - i_]); \
    _Pragma("unroll") for (int j_ = 8; j_ > 0; j_ >>= 1) \
    _Pragma("unroll") for (int i_ = 0; i_ < 16; ++i_) { const int l_ = i_ ^ j_; if (l_ > i_) CE_D(L[i_], L[l_]); } } while (0)
__device__ __forceinline__ float packf(float v, unsigned id, unsigned mask) { return __uint_as_float((__float_as_uint(v) & ~mask) | id); }

__device__ __forceinline__ void peer_combine(const Args& a, const float (&L1)[16], const float (&L2)[16], int tt, int p, int lane) {
    int* expid = (int*)(a.ws + WS_EXPID); float* gate = (float*)(a.ws + WS_GATE);
    const int tok = lane & 31, ch = lane >> 5;
    float V1[16], V2[16];
#pragma unroll
    for (int k = 0; k < 16; ++k) { V1[k] = __uint_as_float(__float_as_uint(L1[k]) & ~127u); V2[k] = __uint_as_float(__float_as_uint(L2[k]) & ~127u); }
    float C[16];
#pragma unroll
    for (int k = 0; k < 16; ++k) C[k] = -INFINITY;
    {
#define PEER_STEP(ia_, ja_, ib_, jb_) do { const float sa_ = packf(V1[ia_] + V2[ja_], (unsigned)((ia_) * 16 + (ja_)), 255u), sb_ = packf(V1[ib_] + V2[jb_], (unsigned)((ib_) * 16 + (jb_)), 255u); INS16P(C, ch ? sb_ : sa_); } while (0)
        PEER_STEP(0, 0, 0, 1);
        PEER_STEP(0, 2, 0, 3);
        PEER_STEP(0, 4, 0, 5);
        PEER_STEP(0, 6, 0, 7);
        PEER_STEP(0, 8, 0, 9);
        PEER_STEP(0, 10, 0, 11);
        PEER_STEP(0, 12, 0, 13);
        PEER_STEP(0, 14, 0, 15);
        PEER_STEP(1, 0, 1, 1);
        PEER_STEP(1, 2, 1, 3);
        PEER_STEP(1, 4, 1, 5);
        PEER_STEP(1, 6, 1, 7);
        PEER_STEP(2, 0, 2, 1);
        PEER_STEP(2, 2, 2, 3);
        PEER_STEP(2, 4, 3, 0);
        PEER_STEP(3, 1, 3, 2);
        PEER_STEP(3, 3, 4, 0);
        PEER_STEP(4, 1, 4, 2);
        PEER_STEP(5, 0, 5, 1);
        PEER_STEP(6, 0, 6, 1);
        PEER_STEP(7, 0, 7, 1);
        PEER_STEP(8, 0, 9, 0);
        PEER_STEP(10, 0, 11, 0);
        PEER_STEP(12, 0, 13, 0);
        PEER_STEP(14, 0, 15, 0);
#undef PEER_STEP
        float B[16];
#pragma unroll
        for (int k = 0; k < 16; ++k) B[k] = __shfl_xor(C[k], 32);
        MERGE16_TOP(C, B);
    }
    {
        const float c0 = __uint_as_float(__float_as_uint(C[0]) & ~255u);
        float e[8], sum = 0.f; int ex[8];
#pragma unroll
        for (int kk = 0; kk < 8; ++kk) {
            float clo = C[kk], chi = C[8 + kk]; asm volatile("" : "+v"(clo), "+v"(chi));
            const unsigned cb = __float_as_uint(ch ? chi : clo); const int ci = (cb >> 4) & 15, cj = cb & 15;
            int i1 = 0, i2 = 0;
#pragma unroll
            for (int m = 0; m < 16; ++m) { i1 = (ci == m) ? (int)(__float_as_uint(L1[m]) & 127u) : i1; i2 = (cj == m) ? (int)(__float_as_uint(L2[m]) & 127u) : i2; }
            ex[kk] = i1 * 128 + i2;
            e[kk] = __expf(__uint_as_float(cb & ~255u) - c0); sum += e[kk];
        }
        sum += __shfl_xor(sum, 32);
        const float inv = 1.f / sum;
        const size_t base = ((size_t)(tt * 32 + tok) * 8 + p) * 16 + 8 * ch;
#pragma unroll
        for (int q = 0; q < 2; ++q) {
            *(v4u*)(expid + base + 4 * q) = (v4u){(unsigned)ex[4 * q], (unsigned)ex[4 * q + 1], (unsigned)ex[4 * q + 2], (unsigned)ex[4 * q + 3]};
            *(f32x4*)(gate + base + 4 * q) = (f32x4){e[4 * q] * inv, e[4 * q + 1] * inv, e[4 * q + 2] * inv, e[4 * q + 3] * inv};
        }
    }
}
__device__ __forceinline__ void peer_route_unit(const Args& a, LAS float* SC, int tt0, int p, int lane) {
    const bf16* query = (const bf16*)(a.ws + WS_QUERY); const bf16* subk = (const bf16*)(a.ws + WS_SUBK);
    const int r = lane & 15, g = lane >> 4;
    const int tok = lane & 31, ch = lane >> 5;
    LAS float* LST0 = SC + 32 * 36;
    LAS float* PARK = LST0 + 1024;
    float cur[16];
#pragma unroll 1
    for (int half = 0; half < 2; ++half) {
        bf16x8 af[2][2][4];
#pragma unroll
        for (int tile = 0; tile < 2; ++tile)
#pragma unroll
            for (int mt = 0; mt < 2; ++mt) {
                const bf16* qp = query + (size_t)((tt0 + tile) * 32 + mt * 16 + r) * 2048 + p * 256 + half * 128 + 8 * g;
#pragma unroll
                for (int ks = 0; ks < 4; ++ks) af[tile][mt][ks] = *(const bf16x8*)(qp + 32 * ks);
            }
#pragma unroll
        for (int pc = 0; pc < 4; ++pc) {
            bf16x8 bk[2][4];
            {
                const bf16* kp = subk + (size_t)((p * 2 + half) * 128 + pc * 32 + r) * 128 + 8 * g;
#pragma unroll
                for (int nt = 0; nt < 2; ++nt)
#pragma unroll
                    for (int ks = 0; ks < 4; ++ks) bk[nt][ks] = *(const bf16x8*)(kp + (size_t)nt * 16 * 128 + 32 * ks);
            }
#pragma unroll
            for (int tile = 0; tile < 2; ++tile) {
                if (pc == 0 && tile == 1) {
#pragma unroll
                    for (int k = 0; k < 16; ++k) PARK[k * 64 + lane] = cur[k];
                } else if (pc > 0) {
                    float tmp[16];
#pragma unroll
                    for (int k = 0; k < 16; ++k) tmp[k] = PARK[k * 64 + lane];
#pragma unroll
                    for (int k = 0; k < 16; ++k) PARK[k * 64 + lane] = cur[k];
#pragma unroll
                    for (int k = 0; k < 16; ++k) cur[k] = tmp[k];
                }
#pragma unroll
                for (int mt = 0; mt < 2; ++mt) {
#pragma unroll
                    for (int nt = 0; nt < 2; ++nt) {
                        f32x4 acc = (f32x4){0.f, 0.f, 0.f, 0.f};
#pragma unroll
                        for (int ks = 0; ks < 4; ++ks) acc = __builtin_amdgcn_mfma_f32_16x16x32_bf16(af[tile][mt][ks], bk[nt][ks], acc, 0, 0, 0);
#pragma unroll
                        for (int rg = 0; rg < 4; ++rg) SC[(mt * 16 + 4 * g + rg) * 36 + nt * 16 + r] = acc[rg];
                    }
                }
                LDS_WAIT();
                __builtin_amdgcn_sched_barrier(0);
                float Lt[16];
#pragma unroll
                for (int c4 = 0; c4 < 4; ++c4) {
                    const f32x4 v = *(const LAS f32x4*)(SC + tok * 36 + 16 * ch + 4 * c4);
                    const unsigned n0 = 32 * pc + 16 * ch + 4 * c4;
                    Lt[4 * c4] = packf(v.x, n0, 127u); Lt[4 * c4 + 1] = packf(v.y, n0 + 1, 127u); Lt[4 * c4 + 2] = packf(v.z, n0 + 2, 127u); Lt[4 * c4 + 3] = packf(v.w, n0 + 3, 127u);
                }
                SORT16_DESC(Lt);
                if (pc == 0) {
#pragma unroll
                    for (int k = 0; k < 16; ++k) cur[k] = Lt[k];
                } else MERGE16_TOP(cur, Lt);
                LDS_WAIT();
                __builtin_amdgcn_sched_barrier(0);
            }
        }
        {
            float B[16];
#pragma unroll
            for (int k = 0; k < 16; ++k) B[k] = __shfl_xor(cur[k], 32);
            MERGE16_TOP(cur, B);
        }
        float la[16];
#pragma unroll
        for (int k = 0; k < 16; ++k) la[k] = PARK[k * 64 + lane];
        {
            float B[16];
#pragma unroll
            for (int k = 0; k < 16; ++k) B[k] = __shfl_xor(la[k], 32);
            MERGE16_TOP(la, B);
        }
        if (half == 0) {
            if (ch == 0) {
#pragma unroll
                for (int k = 0; k < 16; ++k) { LST0[(0 * 16 + k) * 32 + tok] = la[k]; LST0[(1 * 16 + k) * 32 + tok] = cur[k]; }
            }
        } else {
            __builtin_amdgcn_sched_barrier(0);
            LDS_WAIT();
            {
                float L1[16];
#pragma unroll
                for (int k = 0; k < 16; ++k) L1[k] = LST0[(0 * 16 + k) * 32 + tok];
                peer_combine(a, L1, la, tt0, p, lane);
            }
            __builtin_amdgcn_sched_barrier(0);
            {
                float L1[16];
#pragma unroll
                for (int k = 0; k < 16; ++k) L1[k] = LST0[(1 * 16 + k) * 32 + tok];
                peer_combine(a, L1, cur, tt0 + 1, p, lane);
            }
        }
        LDS_WAIT();
    }
}
__device__ __forceinline__ void phase8(const Args& a, LAS unsigned char* lds) {
    const int tid = threadIdx.x, lane = tid & 63, wave = tid >> 6;
    LAS float* SC = (LAS float*)(lds + wave * 16896);
    const int gw = blockIdx.x * 8 + wave, NGW = gridDim.x * 8;
#ifndef P8_REP
#define P8_REP 1
#endif
    for (int rep_ = 0; rep_ < P8_REP; ++rep_)
    for (int u = gw; u < 512 * 8; u += NGW) peer_route_unit(a, SC, 2 * (u >> 3), u & 7, lane);
}

typedef float f32x2 __attribute__((ext_vector_type(2)));
__device__ __forceinline__ void cvt8(const v4u u, float* f) { f[0] = bflo(u.x); f[1] = bfhi(u.x); f[2] = bflo(u.y); f[3] = bfhi(u.y); f[4] = bflo(u.z); f[5] = bfhi(u.z); f[6] = bflo(u.w); f[7] = bfhi(u.w); }
__device__ __forceinline__ void cvt16_fp8(const v4u u, float* f) {
#pragma unroll
    for (int q = 0; q < 4; ++q) { const f32x2 lo = __builtin_amdgcn_cvt_pk_f32_fp8((int)u[q], false), hi = __builtin_amdgcn_cvt_pk_f32_fp8((int)u[q], true);
        f[4 * q] = lo.x; f[4 * q + 1] = lo.y; f[4 * q + 2] = hi.x; f[4 * q + 3] = hi.y; }
}
#define DPPF(x_, ctrl_) __builtin_bit_cast(float, __builtin_amdgcn_update_dpp(0, __builtin_bit_cast(int, (x_)), (ctrl_), 0xF, 0xF, false))
__device__ __forceinline__ float reduce8(const float* d, int lane) {
    const bool b0 = lane & 1, b1 = lane & 2, b2 = lane & 4;
    float s1[4], s2[2];
#pragma unroll
    for (int i = 0; i < 4; ++i) { const float a = b0 ? d[2 * i + 1] : d[2 * i], b = b0 ? d[2 * i] : d[2 * i + 1]; s1[i] = a + DPPF(b, 0xB1); }
#pragma unroll
    for (int i = 0; i < 2; ++i) { const float a = b1 ? s1[2 * i + 1] : s1[2 * i], b = b1 ? s1[2 * i] : s1[2 * i + 1]; s2[i] = a + DPPF(b, 0x4E); }
    const float a3 = b2 ? s2[1] : s2[0], b3 = b2 ? s2[0] : s2[1];
    float s = a3 + DPPF(b3, 0x124);
    s += DPPF(s, 0x128);
    s += __shfl_xor(s, 16); s += __shfl_xor(s, 32);
    return s;
}
#ifndef P9L_G
#define P9L_G 8
#endif
constexpr int P9LG = P9L_G, P9LP = 128 + P9LG;
constexpr int P9L_LISTS = 4 * (P9LP * 4 * 3);
#ifndef P9L_SH
#define P9L_SH 11
#endif
constexpr int P9L_NS = 16384 >> P9L_SH;
constexpr int P9L_WAVE = P9L_LISTS + 16 * (P9L_NS + 1);
__device__ __forceinline__ void phase9l(const Args& a, LAS unsigned char* lds) {
    const int tid = threadIdx.x, lane = tid & 63, wave = tid >> 6, G = gridDim.x;
    const unsigned char* UT = a.ws + WS_UT; const unsigned char* VT = a.ws + WS_VT;
    const float* SU = (const float*)(a.ws + WS_SU); const float* SV = (const float*)(a.ws + WS_SV);
    const int* expid = (const int*)(a.ws + WS_EXPID); const float* gate = (const float*)(a.ws + WS_GATE);
    const float* mod = (const float*)(a.ws + WS_MOD);
    LAS int* LE = (LAS int*)(lds + wave * P9L_WAVE);
    LAS float* LG = (LAS float*)(LE + 4 * P9LP);
    LAS float* LA = LG + 4 * P9LP;
    LAS int* OFFL = (LAS int*)(LA + 4 * P9LP);
    const bool isdiag = (lane >> 4) == ((lane & 15) >> 2);
    v4u h8n[4]; float hscn[4]; int en[4][2]; float gn[4][2];
#define P9_FETCH(tb_) do { _Pragma("unroll") for (int i = 0; i < 4; ++i) { const size_t t_ = (size_t)((tb_) + i); \
        h8n[i] = *(const v4u*)(a.ws + WS_H8 + t_ * DM + 16 * lane); hscn[i] = ((const float*)(a.ws + WS_HS))[t_]; \
        _Pragma("unroll") for (int q = 0; q < 2; ++q) { en[i][q] = expid[t_ * 128 + lane + 64 * q]; gn[i][q] = gate[t_ * 128 + lane + 64 * q]; } } } while (0)
    { const int tb0 = ((int)blockIdx.x * 8 + wave) * 4; if (tb0 < T_TOK) P9_FETCH(tb0); }
    for (int rd = 0; ; ++rd) {
        const int tb = ((rd * G + (int)blockIdx.x) * 8 + wave) * 4;
        if (tb >= T_TOK) break;
        const int tbn_ = (((rd + 1) * G + (int)blockIdx.x) * 8 + wave) * 4, tbn = (tbn_ < T_TOK) ? tbn_ : tb;
        v4u h8[4]; float hsc[4];
#pragma unroll
        for (int i = 0; i < 4; ++i) {
            h8[i] = h8n[i]; hsc[i] = hscn[i];
            int e[2]; float gq[2];
#pragma unroll
            for (int q = 0; q < 2; ++q) { e[q] = en[i][q]; gq[q] = gn[i][q]; }
            int base = 0;
#pragma unroll
            for (int s = 0; s < P9L_NS; ++s) {
                if (lane == 0) OFFL[i * (P9L_NS + 1) + s] = base;
#pragma unroll
                for (int q = 0; q < 2; ++q) {
                    const bool in = (e[q] >> P9L_SH) == s;
                    const unsigned long long mk = __builtin_amdgcn_ballot_w64(in);
                    const int pos = base + __builtin_amdgcn_mbcnt_hi((unsigned)(mk >> 32), __builtin_amdgcn_mbcnt_lo((unsigned)mk, 0));
                    if (in) { LE[i * P9LP + pos] = e[q]; LG[i * P9LP + pos] = gq[q]; }
                    base += __builtin_popcountll(mk);
                }
            }
            if (lane == 0) OFFL[i * (P9L_NS + 1) + P9L_NS] = 128;
            if (lane < P9LG) LE[i * P9LP + 128 + lane] = e[0];
        }
        LDS_WAIT();
#pragma unroll 1
        for (int s = 0; s < P9L_NS; ++s) {
#pragma unroll
            for (int i = 0; i < 4; ++i) {
                const int beg = __builtin_amdgcn_readfirstlane(OFFL[i * (P9L_NS + 1) + s]), end = __builtin_amdgcn_readfirstlane(OFFL[i * (P9L_NS + 1) + s + 1]);
                for (int g0 = beg; g0 < end; g0 += P9LG) {
                    const int n = end - g0;
                    const int ev = LE[i * P9LP + g0 + (lane & (P9LG - 1))];
                    v4u ua[P9LG];
                    if (n >= P9LG) {
#pragma unroll
                        for (int k = 0; k < P9LG; ++k) { const int e = __builtin_amdgcn_readlane(ev, k); ua[k] = *(const v4u*)(UT + (size_t)e * 1024 + 16 * lane); }
                    } else {
#pragma unroll
                        for (int k = 0; k < P9LG; ++k) { const int e = __builtin_amdgcn_readlane(ev, k); if (k < n) ua[k] = *(const v4u*)(UT + (size_t)e * 1024 + 16 * lane); else ua[k] = (v4u){0u, 0u, 0u, 0u}; }
                    }
                    const long hlo = (long)(((unsigned long long)h8[i].y << 32) | h8[i].x), hhi = (long)(((unsigned long long)h8[i].w << 32) | h8[i].z);
#pragma unroll
                    for (int k8 = 0; k8 < P9LG; k8 += 8) {
                        float dd[8];
#pragma unroll
                        for (int k = 0; k < 8; ++k) {
                            f32x4 cacc = (f32x4){0.f, 0.f, 0.f, 0.f};
                            cacc = __builtin_amdgcn_mfma_f32_16x16x32_fp8_fp8((long)(((unsigned long long)ua[k8 + k].y << 32) | ua[k8 + k].x), hlo, cacc, 0, 0, 0);
                            cacc = __builtin_amdgcn_mfma_f32_16x16x32_fp8_fp8((long)(((unsigned long long)ua[k8 + k].w << 32) | ua[k8 + k].z), hhi, cacc, 0, 0, 0);
                            const float c01 = (lane & 1) ? cacc[1] : cacc[0], c23 = (lane & 1) ? cacc[3] : cacc[2];
                            dd[k] = isdiag ? ((lane & 2) ? c23 : c01) : 0.f;
                        }
                        const float tot = reduce8(dd, lane);
                        if (lane < 8 && k8 + lane < n) LA[i * P9LP + g0 + k8 + lane] = tot;
                        __builtin_amdgcn_sched_barrier(0);
                    }
                }
            }
        }
        LDS_WAIT();
#pragma unroll
        for (int i = 0; i < 4; ++i)
#pragma unroll
            for (int q = 0; q < 2; ++q) { const int ix = i * P9LP + lane + 64 * q; const int e = LE[ix];
                const float dq = LA[ix] * SU[e] * hsc[i];
                LA[ix] = 0.5f * dq * (1.f + erff(dq * 0.70710678118654752f)) * LG[ix] * SV[e]; }
        LDS_WAIT();
        float y[4][16];
#pragma unroll
        for (int i = 0; i < 4; ++i)
#pragma unroll
            for (int c = 0; c < 16; ++c) y[i][c] = 0.f;
#pragma unroll 1
        for (int s = 0; s < P9L_NS; ++s) {
#pragma unroll
            for (int i = 0; i < 4; ++i) {
                const int beg = __builtin_amdgcn_readfirstlane(OFFL[i * (P9L_NS + 1) + s]), end = __builtin_amdgcn_readfirstlane(OFFL[i * (P9L_NS + 1) + s + 1]);
                for (int g0 = beg; g0 < end; g0 += P9LG) {
                    const int n = end - g0;
                    const int ev = LE[i * P9LP + g0 + (lane & (P9LG - 1))];
                    const float av = ((lane & (P9LG - 1)) < n) ? LA[i * P9LP + g0 + (lane & (P9LG - 1))] : 0.f;
                    v4u va[P9LG];
                    if (n >= P9LG) {
#pragma unroll
                        for (int k = 0; k < P9LG; ++k) { const int e = __builtin_amdgcn_readlane(ev, k); va[k] = *(const v4u*)(VT + (size_t)e * 1024 + 16 * lane); }
                    } else {
#pragma unroll
                        for (int k = 0; k < P9LG; ++k) { const int e = __builtin_amdgcn_readlane(ev, k); if (k < n) va[k] = *(const v4u*)(VT + (size_t)e * 1024 + 16 * lane); else va[k] = (v4u){0u, 0u, 0u, 0u}; }
                    }
#pragma unroll
                    for (int k = 0; k < P9LG; ++k) { const float aj = __builtin_bit_cast(float, __builtin_amdgcn_readlane(__builtin_bit_cast(int, av), k));
                        float f[16]; cvt16_fp8(va[k], f);
#pragma unroll
                        for (int c = 0; c < 16; ++c) y[i][c] = __builtin_fmaf(aj, f[c], y[i][c]);
                        if ((k & 3) == 3) __builtin_amdgcn_sched_barrier(0); }
                }
            }
        }
        P9_FETCH(tbn);
        {
            f32x4 xv[4][4], gv[4][4];
#pragma unroll
            for (int i = 0; i < 4; ++i) {
                const int t = tb + i, b = t >> 12;
                const float* orow = a.out + (size_t)t * DM + 16 * lane; const float* g2 = mod + b * 6144 + 5120 + 16 * lane;
#pragma unroll
                for (int q4 = 0; q4 < 4; ++q4) { xv[i][q4] = *(const f32x4*)(orow + 4 * q4); gv[i][q4] = *(const f32x4*)(g2 + 4 * q4); }
            }
            __builtin_amdgcn_sched_barrier(0);
#pragma unroll
            for (int i = 0; i < 4; ++i) {
                float* orow = a.out + (size_t)(tb + i) * DM + 16 * lane;
#pragma unroll
                for (int q4 = 0; q4 < 4; ++q4) {
                    const f32x4 yv = (f32x4){y[i][4 * q4], y[i][4 * q4 + 1], y[i][4 * q4 + 2], y[i][4 * q4 + 3]};
                    *(f32x4*)(orow + 4 * q4) = xv[i][q4] + gv[i][q4] * yv;
                }
            }
        }
        LDS_WAIT();
    }
}

#define XB_TMO      128
#define XB_XCNT(j)  (256  + 64 * (j))
#define XB_XSUB(j)  (1280 + 64 * (j))
#define XB_XGEN(j)  (2304 + 64 * (j))
#define XB_TOP      3328
#define XB_TOPGEN   3392
#define XCD_BAR_WORDS 3456
#define XB_SPIN_CAP (1u << 18)

__device__ __forceinline__ unsigned xb_ld(unsigned* p)              { return __hip_atomic_load(p, __ATOMIC_RELAXED, __HIP_MEMORY_SCOPE_AGENT); }
__device__ __forceinline__ unsigned xb_add(unsigned* p, unsigned v) { return __hip_atomic_fetch_add(p, v, __ATOMIC_RELAXED, __HIP_MEMORY_SCOPE_AGENT); }
__device__ __forceinline__ unsigned xb_xcc_id() { return (unsigned)__builtin_amdgcn_s_getreg((3 << 11) | 20) & 0xFu; }
#define XB_SPIN(cond, bar) do { unsigned _sp = 0; while (cond) { __builtin_amdgcn_s_sleep(1); \
    if ((++_sp & 255u) == 0u) { if (xb_ld(&(bar)[XB_TMO])) break; if (_sp > XB_SPIN_CAP) { atomicAdd(&(bar)[XB_TMO], 1u); break; } } } } while (0)

struct XcdBarrier {
    unsigned* bar; unsigned x;
    volatile LAS unsigned* st;
};

__device__ __forceinline__ XcdBarrier xcd_barrier_post(unsigned* bar, volatile LAS unsigned* st) {
    XcdBarrier b; b.bar = bar; b.x = xb_xcc_id(); b.st = st;
    if (threadIdx.x == 0) (void)xb_add(&bar[XB_XCNT(b.x)], 1u);
    return b;
}
__device__ __forceinline__ void xcd_barrier_complete(unsigned* bar, unsigned x, unsigned& nloc, unsigned& nx) {
    const unsigned G = gridDim.x * gridDim.y * gridDim.z;
    unsigned sum, cnt, mine, sp = 0u;
    for (;;) {
        sum = 0u; cnt = 0u; mine = 0u;
#pragma unroll
        for (unsigned j = 0; j < 16; ++j) { const unsigned c = xb_ld(&bar[XB_XCNT(j)]); sum += c; cnt += (c > 0u) ? 1u : 0u; mine = (j == x) ? c : mine; }
        if (sum == G) break;
        __builtin_amdgcn_s_sleep(1);
        if ((++sp & 255u) == 0u) { if (xb_ld(&bar[XB_TMO])) break; if (sp > XB_SPIN_CAP) { atomicAdd(&bar[XB_TMO], 1u); break; } }
    }
    nloc = mine > 0u ? mine : 1u; nx = cnt > 0u ? cnt : 1u;
}

__device__ __forceinline__ void xcd_barrier(const XcdBarrier& b) {
    asm volatile("s_waitcnt vmcnt(0)" ::: "memory");
    __syncthreads();
    if (threadIdx.x == 0) {
        unsigned* bar = b.bar;
        __builtin_amdgcn_s_waitcnt(0);
        unsigned nloc = b.st[0], nx = b.st[1];
        if (nloc == 0u) { xcd_barrier_complete(bar, b.x, nloc, nx); b.st[0] = nloc; b.st[1] = nx; }
        const unsigned old = xb_add(&bar[XB_XSUB(b.x)], 1u);
        const unsigned gen = old / nloc;
        if (old + 1u == (gen + 1u) * nloc) {
            __builtin_amdgcn_fence(__ATOMIC_RELEASE, "agent");
            asm volatile("s_waitcnt vmcnt(0)" ::: "memory");
            const unsigned og = xb_add(&bar[XB_TOP], 1u);
            const unsigned tg = og / nx;
            if (og + 1u == (tg + 1u) * nx) xb_add(&bar[XB_TOPGEN], 1u);
            else XB_SPIN(xb_ld(&bar[XB_TOPGEN]) == tg, bar);
            __builtin_amdgcn_fence(__ATOMIC_ACQUIRE, "agent");
            xb_add(&bar[XB_XGEN(b.x)], 1u);
            asm volatile("s_waitcnt vmcnt(0)" ::: "memory");
        } else {
            XB_SPIN(xb_ld(&bar[XB_XGEN(b.x)]) == gen, bar);
            __builtin_amdgcn_fence(__ATOMIC_ACQUIRE, "agent");
            asm volatile("s_waitcnt vmcnt(0)" ::: "memory");
        }
    }
    __syncthreads();
}

#ifndef GEMM_ALIGN
#define GEMM_ALIGN true
#endif
__global__ void __launch_bounds__(512, 2) mega_fwd(Args a) {
    extern __shared__ __attribute__((aligned(16))) unsigned char lds_raw[];
    LAS unsigned char* lds = (LAS unsigned char*)lds_raw;
    asm volatile("" : "+v"(lds));
    cg::grid_group grid = cg::this_grid();
#define MISC_PTR ((volatile LAS unsigned*)((LAS unsigned char*)lds_raw + (LDS_BYTES - 64)))
    if (threadIdx.x < 16) MISC_PTR[threadIdx.x] = 0u;
    __syncthreads();
    const unsigned xcc_id = xcd_barrier_post((unsigned*)(a.ws + WS_CTL) + 4096, MISC_PTR).x;
    grid.sync();
    unsigned char* ws = a.ws;
    const int lo = a.ph_lo, hi = a.ph_hi;
#ifndef PH_MASK
#define PH_MASK 0x3ff
#endif
#define IN(k) (((PH_MASK >> (k)) & 1) && lo <= (k) && (k) < hi)
#define SEAM(k) do { if (IN(k) && IN((k) + 1)) { if ((k) == 99) grid.sync(); else { XcdBarrier xb_; xb_.bar = (unsigned*)(a.ws + WS_CTL) + 4096; xb_.x = xcc_id; xb_.st = MISC_PTR; xcd_barrier(xb_); } } } while (0)
#ifndef REP_MASK
#define REP_MASK 0
#endif
#define RUNP(k, body) do { if (IN(k)) { body; if ((REP_MASK >> (k)) & 1) { grid.sync(); body; } } } while (0)
    RUNP(0, phase0(a, lds)); SEAM(0);
    RUNP(1, phase_norm(a.in[0], (const float*)(ws + WS_MOD), 0, 1024, (bf16*)(ws + WS_H))); SEAM(1);
    RUNP(2, ({
        pg8::Gemm g{(const pg8::bf16_t*)(ws + WS_H), (const pg8::bf16_t*)(ws + WS_WIN), T_TOK, PW, DM}; pg8::StaticOrder S; S.init(T_TOK, PW, gridDim.x, blockIdx.x);
        EpiBf E{(bf16*)(ws + WS_PROJ), PW};
        pg8::gemm_phase<EpiBf, pg8::StaticOrder, GEMM_ALIGN, true>(lds, g, S, E); })); SEAM(2);
#ifdef IDX_FP32
    if (IN(3)) { phase_idx32(a, lds); grid.sync(); }
#endif
    RUNP(3, phase3(a, lds)); SEAM(3);
    RUNP(4, phase4(a, lds)); SEAM(4);
    RUNP(5, ({
        pg8::Gemm g{(const pg8::bf16_t*)(ws + WS_YAB), (const pg8::bf16_t*)(ws + WS_BT2), T_TOK, DM, YW}; pg8::StaticOrder S; S.init(T_TOK, DM, gridDim.x, blockIdx.x);
        EpiX1 E{a.in[0], a.out, (const float*)(ws + WS_MOD)};
        pg8::gemm_phase<EpiX1, pg8::StaticOrder, GEMM_ALIGN, true>(lds, g, S, E); })); SEAM(5);
    RUNP(6, phase_norm(a.out, (const float*)(ws + WS_MOD), 3072, 4096, (bf16*)(ws + WS_H), ws + WS_H8, (float*)(ws + WS_HS))); SEAM(6);
    RUNP(7, ({
        pg8::Gemm g{(const pg8::bf16_t*)(ws + WS_H), (const pg8::bf16_t*)(ws + WS_WQ), T_TOK, 2048, DM}; pg8::StaticOrder S; S.init(T_TOK, 2048, gridDim.x, blockIdx.x);
        EpiBf E{(bf16*)(ws + WS_QUERY), 2048};
        pg8::gemm_phase<EpiBf, pg8::StaticOrder, GEMM_ALIGN, true>(lds, g, S, E); })); SEAM(7);
    RUNP(8, phase8(a, lds)); SEAM(8);
    if (IN(9)) { phase9l(a, lds); }
#undef IN
#undef SEAM
}

#ifndef MK_N_LAUNCHES
#define MK_N_LAUNCHES 1
#endif
extern "C" void kernel_launch(void* const* d_in, const int* in_sizes, int n_in, void* d_out, int out_size, void* d_ws, size_t ws_size, hipStream_t stream) {
    static int grid = 0;
    if (grid == 0) {
        int dev = 0, cus = 0, per_cu = 0;
        hipGetDevice(&dev);
        hipDeviceGetAttribute(&cus, hipDeviceAttributeMultiprocessorCount, dev);
        hipFuncSetAttribute((const void*)mega_fwd, hipFuncAttributeMaxDynamicSharedMemorySize, LDS_BYTES);
        hipOccupancyMaxActiveBlocksPerMultiprocessor(&per_cu, (const void*)mega_fwd, 512, LDS_BYTES);
        if (per_cu < 1) { fprintf(stderr, "kernel_launch: occupancy query says %d blocks per CU\n", per_cu); per_cu = 1; }
        grid = cus * 1;
        if (n_in != 17 || ws_size < WS_END) fprintf(stderr, "kernel_launch: unexpected n_in %d / ws_size %zu\n", n_in, ws_size);
    }
    (void)hipMemsetAsync((char*)d_ws + WS_CTL, 0, 65536, stream);
    Args a{};
    for (int i = 0; i < 17; ++i) a.in[i] = (const float*)d_in[i];
    a.out = (float*)d_out; a.ws = (unsigned char*)d_ws;
#if MK_N_LAUNCHES == 1
    a.ph_lo = 0; a.ph_hi = 10;
    void* args[] = {&a};
    hipError_t e = hipLaunchCooperativeKernel((const void*)mega_fwd, dim3(grid), dim3(512), args, LDS_BYTES, stream);
    if (e != hipSuccess) fprintf(stderr, "cooperative launch failed: %s (grid %d)\n", hipGetErrorString(e), grid);
#else
    for (int p = 0; p < 10; ++p) { a.ph_lo = p; a.ph_hi = p + 1; hipLaunchKernelGGL(mega_fwd, dim3(grid), dim3(512), LDS_BYTES, stream, a); }
#endif
}
```
